# Optimizing an MI355X kernel written in HIP

```python
import jax, jax.numpy as jnp
from jax import lax
import numpy as np

D_MODEL = 2048
BATCH = 8
SEQ = 2048
DEPTH = 4

HEAD_DIM = 64
N_FOX_HEADS = D_MODEL // 2 // HEAD_DIM
N_SWA_HEADS = D_MODEL // 2 // HEAD_DIM
N_SWA_KV_HEADS = max(1, N_SWA_HEADS // 8)
FOX_WIDTH = N_FOX_HEADS * HEAD_DIM
SWA_WIDTH = N_SWA_HEADS * HEAD_DIM
SWA_KV_WIDTH = N_SWA_KV_HEADS * HEAD_DIM
MIX_WIDTH = FOX_WIDTH + SWA_WIDTH
IN_SPLIT_SIZES = (FOX_WIDTH, FOX_WIDTH, FOX_WIDTH, N_FOX_HEADS, SWA_WIDTH, SWA_KV_WIDTH, SWA_KV_WIDTH)
IN_PROJ_WIDTH = sum(IN_SPLIT_SIZES)
D_FF = ((8 * D_MODEL // 3 + 255) // 256) * 256
N_META = 16
BLOCK = 128
WINDOW = 128
PAD = BLOCK - N_META
EPS = 1e-6
NEG_INF = -1e30

kernel_name = "hymba_fox_swa_sink_alibi_macaron"


def rms_norm(x, g):
    xf = x.astype(jnp.float32)
    y = xf * lax.rsqrt(jnp.mean(xf * xf, axis=-1, keepdims=True) + EPS)
    return (y * g.astype(jnp.float32)).astype(x.dtype)


def swiglu(x, w_gate, w_up, w_down):
    return (jax.nn.silu(x @ w_gate) * (x @ w_up)) @ w_down


def alibi_slopes(n_heads):
    return jnp.asarray(2.0 ** (-8.0 * np.arange(1, n_heads + 1) / n_heads), dtype=jnp.float32)


def forgetting_attention(q, k, v, log_f):
    L = q.shape[1]
    scale = HEAD_DIM ** -0.5
    c = jnp.cumsum(log_f, axis=1).transpose(0, 2, 1)
    pos = jnp.arange(L)
    outs = []
    for i in range(L // BLOCK):
        q0, q1 = i * BLOCK, (i + 1) * BLOCK
        s = jnp.einsum('bqhd,bkhd->bhqk', q[:, q0:q1], k[:, :q1]).astype(jnp.float32) * scale
        s = s + c[:, :, q0:q1, None] - c[:, :, None, :q1]
        qp = pos[q0:q1][:, None]
        kp = pos[:q1][None, :]
        allowed = (kp <= qp) & (kp >= PAD)
        p = jax.nn.softmax(jnp.where(allowed, s, NEG_INF), axis=-1)
        outs.append(jnp.einsum('bhqk,bkhd->bqhd', p.astype(v.dtype), v[:, :q1]))
    return jnp.concatenate(outs, axis=1)


def sliding_window_sink_attention(q, k, v, sinks):
    B, L, Hq, Dh = q.shape
    Hkv = k.shape[2]
    G = Hq // Hkv
    NB = L // BLOCK
    scale = HEAD_DIM ** -0.5
    qb = q.reshape(B, NB, BLOCK, Hkv, G, Dh)
    kb = k.reshape(B, NB, BLOCK, Hkv, Dh)
    vb = v.reshape(B, NB, BLOCK, Hkv, Dh)
    shift = ((0, 0), (1, 0), (0, 0), (0, 0), (0, 0))
    k_band = jnp.concatenate([jnp.pad(kb, shift)[:, :-1], kb], axis=2)
    v_band = jnp.concatenate([jnp.pad(vb, shift)[:, :-1], vb], axis=2)
    s = jnp.einsum('bnqhgd,bnkhd->bnhgqk', qb, k_band).astype(jnp.float32) * scale
    blk = jnp.arange(NB)[:, None] * BLOCK
    qpos = blk + jnp.arange(BLOCK)[None, :]
    kpos = blk - BLOCK + jnp.arange(2 * BLOCK)[None, :]
    dist = qpos[:, :, None] - kpos[:, None, :]
    allowed = (dist >= 0) & (dist < WINDOW) & (kpos[:, None, :] >= PAD)
    slopes = alibi_slopes(Hq).reshape(Hkv, G)[None, None, :, :, None, None]
    s = s - slopes * dist.astype(jnp.float32)[None, :, None, None]
    s = jnp.where(allowed[None, :, None, None], s, NEG_INF)
    sink = sinks.astype(jnp.float32).reshape(Hkv, G)[None, None, :, :, None, None]
    m = jnp.maximum(jnp.max(s, axis=-1, keepdims=True), sink)
    p = jnp.exp(s - m)
    p = p / (jnp.sum(p, axis=-1, keepdims=True) + jnp.exp(sink - m))
    o = jnp.einsum('bnhgqk,bnkhd->bnqhgd', p.astype(v.dtype), v_band)
    return o.reshape(B, L, Hq, Dh)


def setup_inputs(seed: int = 0) -> dict:
    key = jax.random.key(seed)
    ks = jax.random.split(key, 24)
    f32 = jnp.float32

    def nrm(k, shape, scale):
        return jax.random.normal(k, shape, f32) * scale

    def gain(k, shape):
        return 1.0 + 0.02 * jax.random.normal(k, shape, f32)

    return {
        "x": nrm(ks[0], (BATCH, SEQ, D_MODEL), 1.0),
        "meta_tokens": nrm(ks[1], (N_META, D_MODEL), 1.0),
        "ffn1_norm": gain(ks[2], (DEPTH, D_MODEL)),
        "ffn1_w_gate": nrm(ks[3], (DEPTH, D_MODEL, D_FF), D_MODEL ** -0.5),
        "ffn1_w_up": nrm(ks[4], (DEPTH, D_MODEL, D_FF), D_MODEL ** -0.5),
        "ffn1_w_down": nrm(ks[5], (DEPTH, D_FF, D_MODEL), D_FF ** -0.5),
        "mix_norm": gain(ks[6], (DEPTH, D_MODEL)),
        "w_in": nrm(ks[7], (DEPTH, D_MODEL, IN_PROJ_WIDTH), D_MODEL ** -0.5),
        "b_forget": 2.0 + 0.3 * jax.random.normal(ks[8], (DEPTH, N_FOX_HEADS), f32),
        "fox_q_norm": gain(ks[9], (DEPTH, HEAD_DIM)),
        "fox_k_norm": gain(ks[10], (DEPTH, HEAD_DIM)),
        "swa_q_norm": gain(ks[11], (DEPTH, HEAD_DIM)),
        "swa_k_norm": gain(ks[12], (DEPTH, HEAD_DIM)),
        "swa_sinks": nrm(ks[13], (DEPTH, N_SWA_HEADS), 1.0),
        "fox_out_norm": gain(ks[14], (DEPTH, FOX_WIDTH)),
        "swa_out_norm": gain(ks[15], (DEPTH, SWA_WIDTH)),
        "w_out": nrm(ks[16], (DEPTH, MIX_WIDTH, D_MODEL), MIX_WIDTH ** -0.5),
        "ffn2_norm": gain(ks[17], (DEPTH, D_MODEL)),
        "ffn2_w_gate": nrm(ks[18], (DEPTH, D_MODEL, D_FF), D_MODEL ** -0.5),
        "ffn2_w_up": nrm(ks[19], (DEPTH, D_MODEL, D_FF), D_MODEL ** -0.5),
        "ffn2_w_down": nrm(ks[20], (DEPTH, D_FF, D_MODEL), D_FF ** -0.5),
    }


def reference(x, meta_tokens, ffn1_norm, ffn1_w_gate, ffn1_w_up, ffn1_w_down, mix_norm, w_in,
              b_forget, fox_q_norm, fox_k_norm, swa_q_norm, swa_k_norm, swa_sinks,
              fox_out_norm, swa_out_norm, w_out, ffn2_norm, ffn2_w_gate, ffn2_w_up, ffn2_w_down):
    B, S, D = x.shape
    h = jnp.concatenate([
        jnp.zeros((B, PAD, D), x.dtype),
        jnp.broadcast_to(meta_tokens.astype(x.dtype)[None], (B, N_META, D)),
        x,
    ], axis=1)
    L = h.shape[1]
    split_idx = [int(v) for v in np.cumsum(IN_SPLIT_SIZES)[:-1]]

    for l in range(DEPTH):
        h = h + 0.5 * swiglu(rms_norm(h, ffn1_norm[l]), ffn1_w_gate[l], ffn1_w_up[l], ffn1_w_down[l])

        u = rms_norm(h, mix_norm[l]) @ w_in[l]
        fq, fk, fv, fz, sq, sk, sv = jnp.split(u, split_idx, axis=-1)
        fq = rms_norm(fq.reshape(B, L, N_FOX_HEADS, HEAD_DIM), fox_q_norm[l])
        fk = rms_norm(fk.reshape(B, L, N_FOX_HEADS, HEAD_DIM), fox_k_norm[l])
        fv = fv.reshape(B, L, N_FOX_HEADS, HEAD_DIM)
        log_f = jax.nn.log_sigmoid(fz.astype(jnp.float32) + b_forget[l].astype(jnp.float32))
        sq = rms_norm(sq.reshape(B, L, N_SWA_HEADS, HEAD_DIM), swa_q_norm[l])
        sk = rms_norm(sk.reshape(B, L, N_SWA_KV_HEADS, HEAD_DIM), swa_k_norm[l])
        sv = sv.reshape(B, L, N_SWA_KV_HEADS, HEAD_DIM)

        o_fox = forgetting_attention(fq, fk, fv, log_f).reshape(B, L, FOX_WIDTH)
        o_swa = sliding_window_sink_attention(sq, sk, sv, swa_sinks[l]).reshape(B, L, SWA_WIDTH)
        o = jnp.concatenate([rms_norm(o_fox, fox_out_norm[l]), rms_norm(o_swa, swa_out_norm[l])], axis=-1)
        h = h + o @ w_out[l]

        h = h + 0.5 * swiglu(rms_norm(h, ffn2_norm[l]), ffn2_w_gate[l], ffn2_w_up[l], ffn2_w_down[l])

    return h[:, BLOCK:]
```

```cpp
#include <hip/hip_runtime.h>
#include <cstdio>
#include <cstdint>

#ifndef MK_PER_PHASE
#define MK_PER_PHASE 0
#endif

namespace pg8 {
#define PG8_LAS __attribute__((address_space(3)))
#define PG8_GAS __attribute__((address_space(1)))
typedef unsigned short bf16_t;
typedef short bf16x8 __attribute__((ext_vector_type(8)));
typedef float f32x4 __attribute__((ext_vector_type(4)));
typedef unsigned u32x4 __attribute__((ext_vector_type(4)));
constexpr int BM = 256, BK = 64, HALF = 128, HTB = HALF * BK * 2  , STAGE_BYTES = 8 * HTB, NXCD = 8, WGM = 8;

__host__ __device__ __forceinline__ int lds_byte(int r, int c) { const int st = (r >> 4) * 2 + (c >> 5), rr = r & 15, cc = c & 31, ob = rr * 64 + cc * 2; return st * 1024 + (ob ^ (((ob >> 9) & 1) << 5)); }
__host__ __device__ __forceinline__ void stage_rc(int b, int& R, int& C) { const int st = b / 1024, sb = b % 1024, swz = sb ^ (((sb >> 9) & 1) << 5); R = (st >> 1) * 16 + swz / 64; C = (st & 1) * 32 + (swz % 64) / 2; }
__host__ __device__ __forceinline__ int perm32(int rho) { const int n = rho >> 4, i = rho & 15; return 8 * (i >> 2) + 4 * n + (i & 3); }

struct Unit { int pm, pn; };
struct Gemm { const bf16_t* A; const bf16_t* Bt; int M, N, K; };

struct StaticOrder {
    int nM, nN, nwg, G, c;
    __host__ __device__ void init(int M, int N, int G_, int c_) { nM = M / BM; nN = N / BM; nwg = nM * nN; G = G_; c = c_; }
    __host__ __device__ bool next(int i, Unit& u) const {
        const long L = (long)i * G + c; if (L >= nwg) return false;
        int wgid = (int)L; { const int q = nwg / NXCD, r = nwg % NXCD, xcd = wgid % NXCD, off = wgid / NXCD; wgid = (xcd < r ? xcd * (q + 1) : r * (q + 1) + (xcd - r) * q) + off; }
        const int nig = WGM * nN, gid = wgid / nig, fm = gid * WGM, gsz = (nM - fm) < WGM ? (nM - fm) : WGM;
        u.pm = fm + ((wgid % nig) % gsz); u.pn = (wgid % nig) / gsz; return true;
    }
    __device__ __forceinline__ void a_ready(const Unit&) const {}
    __device__ __forceinline__ void done(const Unit&) const {}
};

__device__ __forceinline__ unsigned cvt_pk_bf16(float lo, float hi) { unsigned r; asm volatile("v_cvt_pk_bf16_f32 %0, %1, %2" : "=v"(r) : "v"(lo), "v"(hi)); return r; }

__device__ __forceinline__ float silu_mul(float g, float u) {
    const float e = __builtin_amdgcn_exp2f(-1.4426950408889634f * g);
    return g * __builtin_amdgcn_rcpf(1.0f + e) * u;
}
struct EpiSwiGLU {
    static constexpr bool PERM = true, AFTER_DRAIN = false;
    PG8_GAS bf16_t* O; int ldc;
    __device__ __forceinline__ void operator()(const f32x4 (&acc)[2][2][4][2], const Unit& u, int wr, int wc, int fr, int fq) const {
        const int row0 = u.pm * BM + wr * 64 + fr, col0 = u.pn * HALF + wc * 32 + 8 * fq;
#pragma unroll
        for (int ai = 0; ai < 2; ++ai)
#pragma unroll
            for (int m = 0; m < 4; ++m) { PG8_GAS bf16_t* rowp = O + (size_t)(row0 + ai * HALF + m * 16) * ldc + col0;
                const f32x4 g0 = acc[ai][0][m][0], g1 = acc[ai][0][m][1], u0 = acc[ai][1][m][0], u1 = acc[ai][1][m][1];
                u32x4 w; w.x = cvt_pk_bf16(silu_mul(g0[0], u0[0]), silu_mul(g0[1], u0[1])); w.y = cvt_pk_bf16(silu_mul(g0[2], u0[2]), silu_mul(g0[3], u0[3]));
                w.z = cvt_pk_bf16(silu_mul(g1[0], u1[0]), silu_mul(g1[1], u1[1])); w.w = cvt_pk_bf16(silu_mul(g1[2], u1[2]), silu_mul(g1[3], u1[3]));
                *(PG8_GAS u32x4*)rowp = w; }
    }
};
struct EpiResAdd {
    static constexpr bool PERM = false, AFTER_DRAIN = false;
    const PG8_GAS float* base; PG8_GAS float* out; int ldc; float scale; int pm_limit;
    __device__ __forceinline__ void operator()(const f32x4 (&acc)[2][2][4][2], const Unit& u, int wr, int wc, int fr, int fq) const {
        if (u.pm >= pm_limit) return;
        const int row0 = u.pm * BM + wr * 64 + fr, col0 = u.pn * BM + wc * 32 + 4 * fq;
#pragma unroll
        for (int ai = 0; ai < 2; ++ai)
#pragma unroll
            for (int m = 0; m < 4; ++m) { const size_t off = (size_t)(row0 + ai * HALF + m * 16) * ldc + col0;
#pragma unroll
                for (int bj = 0; bj < 2; ++bj)
#pragma unroll
                    for (int n = 0; n < 2; ++n) { const f32x4 bs = *(const PG8_GAS f32x4*)(base + off + bj * HALF + n * 16); *(PG8_GAS f32x4*)(out + off + bj * HALF + n * 16) = bs + acc[ai][bj][m][n] * scale; }
                asm volatile("" ::: "memory"); }
    }
};
struct EpiInProj {
    static constexpr bool PERM = true, AFTER_DRAIN = false;
    PG8_GAS bf16_t *fq_, *fk_, *fv_, *sq_, *sk_, *sv_; PG8_GAS float* logf; const PG8_GAS float *g_fq, *g_fk, *g_sq, *g_sk, *bfg; float qscale;
    __device__ __forceinline__ void operator()(const f32x4 (&acc)[2][2][4][2], const Unit& u, int wr, int wc, int fr, int fq) const {
        const int row0 = u.pm * BM + wr * 64 + fr, pn = u.pn;
        if (pn == 17) {
            if (wc != 0) return;
            if (fq < 2) {
                const f32x4 b0 = *(const PG8_GAS f32x4*)(bfg + 8 * fq), b1 = *(const PG8_GAS f32x4*)(bfg + 8 * fq + 4);
#pragma unroll
                for (int ai = 0; ai < 2; ++ai)
#pragma unroll
                    for (int m = 0; m < 4; ++m) { PG8_GAS float* rowp = logf + (size_t)(row0 + ai * HALF + m * 16) * 16 + 8 * fq;
#pragma unroll
                        for (int n = 0; n < 2; ++n) { f32x4 t = acc[ai][0][m][n] + (n ? b1 : b0), o;
#pragma unroll
                            for (int j = 0; j < 4; ++j) o[j] = fminf(t[j], 0.f) - log1pf(expf(-fabsf(t[j])));
                            *(PG8_GAS f32x4*)(rowp + 4 * n) = o; } }
            }
            return;
        }
        PG8_GAS bf16_t* dst; int pitch, head; const PG8_GAS float* gain = nullptr; float sc = 1.f;
        if (pn < 16) { const int seg = pn >> 2; head = (pn & 3) * 4 + wc; pitch = 1024;
            if (seg == 0) { dst = fq_; gain = g_fq; sc = qscale; } else if (seg == 1) { dst = fk_; gain = g_fk; } else if (seg == 2) { dst = fv_; } else { dst = sq_; gain = g_sq; sc = qscale; } }
        else { pitch = 128; head = wc & 1; if (wc < 2) { dst = sk_; gain = g_sk; } else { dst = sv_; } }
        const int col0 = head * 64 + 8 * fq;
        if (gain) {
            f32x4 gv[2][2];
#pragma unroll
            for (int bj = 0; bj < 2; ++bj)
#pragma unroll
                for (int n = 0; n < 2; ++n) gv[bj][n] = *(const PG8_GAS f32x4*)(gain + 32 * bj + 8 * fq + 4 * n) * sc;
#pragma unroll
            for (int ai = 0; ai < 2; ++ai)
#pragma unroll
                for (int m = 0; m < 4; ++m) {
                    float ss = 0.f;
#pragma unroll
                    for (int bj = 0; bj < 2; ++bj)
#pragma unroll
                        for (int n = 0; n < 2; ++n) { const f32x4 x = acc[ai][bj][m][n]; ss += (x[0] * x[0] + x[1] * x[1]) + (x[2] * x[2] + x[3] * x[3]); }
                    ss += __shfl_xor(ss, 16); ss += __shfl_xor(ss, 32);
                    const float rinv = 1.0f / sqrtf(ss * (1.0f / 64.0f) + 1e-6f);
                    PG8_GAS bf16_t* rowp = dst + (size_t)(row0 + ai * HALF + m * 16) * pitch + col0;
#pragma unroll
                    for (int bj = 0; bj < 2; ++bj) { const f32x4 v0 = acc[ai][bj][m][0] * rinv * gv[bj][0], v1 = acc[ai][bj][m][1] * rinv * gv[bj][1];
                        u32x4 w; w.x = cvt_pk_bf16(v0[0], v0[1]); w.y = cvt_pk_bf16(v0[2], v0[3]); w.z = cvt_pk_bf16(v1[0], v1[1]); w.w = cvt_pk_bf16(v1[2], v1[3]);
                        *(PG8_GAS u32x4*)(rowp + 32 * bj) = w; }
                }
        } else {
#pragma unroll
            for (int ai = 0; ai < 2; ++ai)
#pragma unroll
                for (int m = 0; m < 4; ++m) { PG8_GAS bf16_t* rowp = dst + (size_t)(row0 + ai * HALF + m * 16) * pitch + col0;
#pragma unroll
                    for (int bj = 0; bj < 2; ++bj) { const f32x4 v0 = acc[ai][bj][m][0], v1 = acc[ai][bj][m][1];
                        u32x4 w; w.x = cvt_pk_bf16(v0[0], v0[1]); w.y = cvt_pk_bf16(v0[2], v0[3]); w.z = cvt_pk_bf16(v1[0], v1[1]); w.w = cvt_pk_bf16(v1[2], v1[3]);
                        *(PG8_GAS u32x4*)(rowp + 32 * bj) = w; } }
        }
    }
};

template <class Epi, class Sched, bool ALIGN_EPI = false, bool SP2 = false>
__device__ __forceinline__ void gemm_phase(PG8_LAS unsigned char* lds, const Gemm g, const Sched& S, const Epi& E) {
    int tid_l = threadIdx.x; asm volatile("" : "+v"(tid_l));
    const int tid = tid_l, wid = __builtin_amdgcn_readfirstlane(tid >> 6), lane = tid & 63, wr = wid >> 2, wc = wid & 3, fr = lane & 15, fq = lane >> 4;
    const int K = g.K, nt = K / BK;
    unsigned voffA[2], voffB[2];
#pragma unroll
    for (int i = 0; i < 2; ++i) { int R, C; stage_rc(tid * 16 + i * 8192, R, C); const int Rb = Epi::PERM ? ((R & ~31) + perm32(R & 31)) : R;
        voffA[i] = (unsigned)(R * K + C) * 2u; voffB[i] = (unsigned)(Rb * K + C) * 2u; }
    const size_t kstep = (size_t)(BK * 2);
    const size_t hstep = (size_t)HALF * K * 2;
    const size_t tstep = 2 * hstep;
    const unsigned ldsw = (unsigned)wid * 1024u;
    const int aoff = lds_byte(wr * 64 + fr, fq * 8), boff = lds_byte(wc * 32 + fr, fq * 8);
#define PG8_SA(b, h) (((b) * 2 + (h)) * HTB)
#define PG8_SB(b, h) ((4 + (b) * 2 + (h)) * HTB)
#define PG8_STAGE(bufoff, gbase, voff) do { _Pragma("unroll") for (int _i = 0; _i < 2; ++_i) \
        __builtin_amdgcn_global_load_lds((const unsigned*)((const char*)(gbase) + (voff)[_i]), (PG8_LAS unsigned*)(lds + (bufoff) + ldsw + _i * 8192), 16, 0, 0); } while (0)
#define PG8_LDA(dst, b, h) do { _Pragma("unroll") for (int m = 0; m < 4; ++m) _Pragma("unroll") for (int k = 0; k < 2; ++k) dst[m][k] = *(const PG8_LAS bf16x8*)(lds + PG8_SA(b, h) + aoff + m * 2048 + k * 1024); } while (0)
#define PG8_LDB(dst, b, h) do { _Pragma("unroll") for (int n = 0; n < 2; ++n) _Pragma("unroll") for (int k = 0; k < 2; ++k) dst[n][k] = *(const PG8_LAS bf16x8*)(lds + PG8_SB(b, h) + boff + n * 2048 + k * 1024); } while (0)
#define PG8_MMA(ai, bj, At, Bt) do { __builtin_amdgcn_s_setprio(1); _Pragma("unroll") for (int m = 0; m < 4; ++m) _Pragma("unroll") for (int n = 0; n < 2; ++n) _Pragma("unroll") for (int k = 0; k < 2; ++k) \
        acc[ai][bj][m][n] = __builtin_amdgcn_mfma_f32_16x16x32_bf16(Bt[n][k], At[m][k], acc[ai][bj][m][n], 0, 0, 0); __builtin_amdgcn_s_setprio(0); } while (0)
#define PG8_WAIT_V(n) asm volatile("s_waitcnt vmcnt(" #n ")" ::: "memory")
#define PG8_WAIT_L(n) asm volatile("s_waitcnt lgkmcnt(" #n ")" ::: "memory")
#define PG8_BAR __builtin_amdgcn_s_barrier()
#define PG8_SCHED __builtin_amdgcn_sched_barrier(0)
    Unit cur, nxt; int ui = 0;
    if (!S.next(0, cur)) return;
    f32x4 acc[2][2][4][2];
#pragma unroll
    for (int a = 0; a < 2; ++a)
#pragma unroll
        for (int b = 0; b < 2; ++b)
#pragma unroll
            for (int m = 0; m < 4; ++m)
#pragma unroll
                for (int n = 0; n < 2; ++n) acc[a][b][m][n] = (f32x4){0.f, 0.f, 0.f, 0.f};
    bf16x8 At[4][2], B0[2][2], B1[2][2];
    const char* cA = (const char*)g.A + (size_t)cur.pm * tstep; const char* cB = (const char*)g.Bt + (size_t)cur.pn * tstep;
    S.a_ready(cur);
    if constexpr (SP2) {
        PG8_STAGE(PG8_SB(0, 0), cB, voffB); PG8_STAGE(PG8_SB(0, 1), cB + hstep, voffB); PG8_STAGE(PG8_SA(0, 0), cA, voffA); PG8_STAGE(PG8_SA(0, 1), cA + hstep, voffA);
        if (wr == 1) PG8_BAR;
        PG8_WAIT_V(2); PG8_BAR;
        PG8_STAGE(PG8_SB(1, 0), cB + kstep, voffB); PG8_STAGE(PG8_SA(1, 0), cA + kstep, voffA); PG8_STAGE(PG8_SB(1, 1), cB + hstep + kstep, voffB);
        PG8_WAIT_V(6); PG8_BAR;
    } else {
        PG8_STAGE(PG8_SB(0, 0), cB, voffB); PG8_STAGE(PG8_SA(0, 0), cA, voffA); PG8_STAGE(PG8_SB(0, 1), cB + hstep, voffB); PG8_STAGE(PG8_SA(0, 1), cA + hstep, voffA);
        if (wr == 1) PG8_BAR;
        PG8_WAIT_V(4); PG8_BAR;
        PG8_STAGE(PG8_SB(1, 0), cB + kstep, voffB); PG8_STAGE(PG8_SA(1, 0), cA + kstep, voffA); PG8_STAGE(PG8_SB(1, 1), cB + hstep + kstep, voffB);
        PG8_WAIT_V(6); PG8_BAR;
    }
    for (;;) {
        const bool has_next = S.next(ui + 1, nxt);
        const char* nA = has_next ? (const char*)g.A + (size_t)nxt.pm * tstep : cA; const char* nB = has_next ? (const char*)g.Bt + (size_t)nxt.pn * tstep : cB;
        for (int t = 0; t < nt; t += 2) {
            const bool last = (t == nt - 2);
            const char* a1 = cA + (size_t)(t + 1) * kstep;
            const char* a2 = last ? nA : cA + (size_t)(t + 2) * kstep; const char* b2 = last ? nB : cB + (size_t)(t + 2) * kstep;
            const char* a3 = a2 + kstep; const char* b3 = b2 + kstep;
            if (last && has_next) S.a_ready(nxt);
            if constexpr (SP2) {
            PG8_LDB(B0, 0, 0); PG8_LDB(B1, 0, 1); PG8_SCHED; PG8_LDA(At, 0, 0); PG8_STAGE(PG8_SA(1, 1), a1 + hstep, voffA);
            PG8_WAIT_V(8); PG8_WAIT_L(0); PG8_BAR; PG8_MMA(0, 0, At, B0); PG8_MMA(0, 1, At, B1); PG8_BAR; PG8_SCHED;
            PG8_LDA(At, 0, 1); PG8_STAGE(PG8_SB(0, 0), b2, voffB); PG8_STAGE(PG8_SB(0, 1), b2 + hstep, voffB); PG8_STAGE(PG8_SA(0, 0), a2, voffA);
            PG8_WAIT_V(8); PG8_WAIT_L(0); PG8_BAR; PG8_MMA(1, 0, At, B0); PG8_MMA(1, 1, At, B1); PG8_BAR; PG8_SCHED;
            PG8_LDB(B0, 1, 0); PG8_LDB(B1, 1, 1); PG8_SCHED; PG8_LDA(At, 1, 0); PG8_STAGE(PG8_SA(0, 1), a2 + hstep, voffA);
            PG8_WAIT_V(8); PG8_WAIT_L(0); PG8_BAR; PG8_MMA(0, 0, At, B0); PG8_MMA(0, 1, At, B1); PG8_BAR; PG8_SCHED;
            PG8_LDA(At, 1, 1); PG8_STAGE(PG8_SB(1, 0), b3, voffB); PG8_STAGE(PG8_SB(1, 1), b3 + hstep, voffB); PG8_STAGE(PG8_SA(1, 0), a3, voffA);
            PG8_WAIT_V(8); PG8_WAIT_L(0); PG8_BAR; PG8_MMA(1, 0, At, B0); PG8_MMA(1, 1, At, B1); PG8_BAR; PG8_SCHED;
            } else {
            PG8_LDB(B0, 0, 0); PG8_SCHED; PG8_LDA(At, 0, 0); PG8_STAGE(PG8_SA(1, 1), a1 + hstep, voffA);
            PG8_WAIT_L(8); PG8_BAR; PG8_WAIT_L(0); PG8_MMA(0, 0, At, B0); PG8_BAR; PG8_SCHED;
            PG8_LDB(B1, 0, 1); PG8_STAGE(PG8_SB(0, 0), b2, voffB);
            PG8_BAR; PG8_WAIT_L(0); PG8_MMA(0, 1, At, B1); PG8_BAR;
            PG8_LDA(At, 0, 1); PG8_STAGE(PG8_SA(0, 0), a2, voffA);
            PG8_BAR; PG8_WAIT_L(0); PG8_MMA(1, 0, At, B0); PG8_BAR; PG8_SCHED;
            PG8_STAGE(PG8_SB(0, 1), b2 + hstep, voffB);
            PG8_WAIT_V(6); PG8_BAR; PG8_MMA(1, 1, At, B1); PG8_BAR;
            PG8_LDB(B0, 1, 0); PG8_SCHED; PG8_LDA(At, 1, 0); PG8_STAGE(PG8_SA(0, 1), a2 + hstep, voffA);
            PG8_WAIT_L(8); PG8_BAR; PG8_WAIT_L(0); PG8_MMA(0, 0, At, B0); PG8_BAR; PG8_SCHED;
            PG8_LDB(B1, 1, 1); PG8_STAGE(PG8_SB(1, 0), b3, voffB);
            PG8_BAR; PG8_WAIT_L(0); PG8_MMA(0, 1, At, B1); PG8_BAR;
            PG8_LDA(At, 1, 1); PG8_STAGE(PG8_SA(1, 0), a3, voffA);
            PG8_BAR; PG8_WAIT_L(0); PG8_MMA(1, 0, At, B0); PG8_BAR; PG8_SCHED;
            PG8_STAGE(PG8_SB(1, 1), b3 + hstep, voffB);
            PG8_WAIT_V(6); PG8_BAR; PG8_MMA(1, 1, At, B1); PG8_BAR;
            }
        }
        if constexpr (ALIGN_EPI) { if (wr == 0) PG8_BAR; }
        if constexpr (!Epi::AFTER_DRAIN) { E(acc, cur, wr, wc, fr, fq); S.done(cur); }
        if (!has_next) break;
#pragma unroll
        for (int a = 0; a < 2; ++a)
#pragma unroll
            for (int b = 0; b < 2; ++b)
#pragma unroll
                for (int m = 0; m < 4; ++m)
#pragma unroll
                    for (int n = 0; n < 2; ++n) acc[a][b][m][n] = (f32x4){0.f, 0.f, 0.f, 0.f};
        cur = nxt; cA = nA; cB = nB; ++ui;
        if constexpr (ALIGN_EPI) { if (wr == 1) PG8_BAR; }
    }
    PG8_WAIT_V(0);
    if constexpr (!ALIGN_EPI) { if (wr == 0) PG8_BAR; }
    PG8_BAR;
#undef PG8_SA
#undef PG8_SB
#undef PG8_STAGE
#undef PG8_LDA
#undef PG8_LDB
#undef PG8_MMA
#undef PG8_WAIT_V
#undef PG8_WAIT_L
#undef PG8_BAR
#undef PG8_SCHED
}
}

constexpr int NWAVES = 8;
constexpr int D = 2048, NB = 8, SEQ = 2048, DEPTH = 4, HD = 64, NH = 16, FF = 5632, NMETA = 16, PADN = 112;
constexpr int M_REAL = NB * SEQ;
constexpr int M_PAD = M_REAL + 256;
constexpr int META_BLK0 = M_REAL + 128;
constexpr int META_ROW = META_BLK0 + PADN;
constexpr int LPOS = SEQ + 128;
constexpr int N_GU = 2 * FF;
constexpr int N_IN = 18 * 256;
constexpr int IN_W = 4368;
constexpr float EPS = 1e-6f;
constexpr float LOG2E = 1.4426950408889634f;
constexpr float QSCALE = 0.125f * LOG2E;

constexpr size_t MiB = 1u << 20;
constexpr size_t WS_CTL = 0, CTL_ZERO_BYTES = 1 * MiB;
constexpr size_t SZ_WGU = (size_t)N_GU * D * 2, SZ_WD = (size_t)D * FF * 2, SZ_WIN = (size_t)N_IN * D * 2, SZ_WOUT = (size_t)D * D * 2;
constexpr size_t LW_GU1 = 0, LW_D1 = LW_GU1 + SZ_WGU, LW_IN = LW_D1 + SZ_WD, LW_OUT = LW_IN + SZ_WIN, LW_GU2 = LW_OUT + SZ_WOUT, LW_D2 = LW_GU2 + SZ_WGU, LW_STRIDE = LW_D2 + SZ_WD;
constexpr size_t WS_W = 1 * MiB;
constexpr size_t WS_H = WS_W + DEPTH * LW_STRIDE;
constexpr size_t WS_XN = WS_H + (size_t)M_PAD * D * 4;
constexpr size_t WS_O = WS_XN + (size_t)M_PAD * D * 2;
constexpr size_t WS_ACT = WS_O + (size_t)M_PAD * D * 2;
constexpr size_t SZ_QK = (size_t)M_PAD * 1024 * 2, SZ_KV = (size_t)M_PAD * 128 * 2;
constexpr size_t WS_FQ = WS_ACT, WS_FK = WS_FQ + SZ_QK, WS_FV = WS_FK + SZ_QK, WS_SQ = WS_FV + SZ_QK, WS_SK = WS_SQ + SZ_QK, WS_SV = WS_SK + SZ_KV, WS_LOGF = WS_SV + SZ_KV;
constexpr size_t WS_MIX_END = WS_LOGF + (size_t)M_PAD * 16 * 4;
constexpr size_t WS_ACT_END = WS_ACT + (size_t)M_PAD * FF * 2;
constexpr size_t WS_END = WS_MIX_END > WS_ACT_END ? WS_MIX_END : WS_ACT_END;
static_assert(LW_STRIDE % 256 == 0 && WS_H % 256 == 0 && WS_ACT % 256 == 0 && WS_SK % 256 == 0 && WS_LOGF % 256 == 0, "alignment");
constexpr int CW_TMO = 0, CW_BAR = 4096;

constexpr int RING_OFF = 0, RING_BYTES = 131072;
constexpr int LDSCTL_OFF = RING_BYTES, MISC_OFF = LDSCTL_OFF + 320, PTR_OFF = LDSCTL_OFF + 1024;
constexpr int LDS_BYTES = 147456;
constexpr int ATT_TAB_OFF = 0;
constexpr int ATT_WTOT_OFF = 8704;
constexpr int ATT_VST_OFF = 16384, ATT_VST_PITCH = 144, ATT_VST_BYTES = 32 * ATT_VST_PITCH;
static_assert(ATT_VST_OFF + NWAVES * ATT_VST_BYTES <= RING_BYTES, "attention LDS");

#define GAS __attribute__((address_space(1)))
#define LAS __attribute__((address_space(3)))
typedef unsigned short bf16;
typedef unsigned v4u __attribute__((ext_vector_type(4)));
typedef float f32x4 __attribute__((ext_vector_type(4)));
typedef float f32x16 __attribute__((ext_vector_type(16)));
typedef short bf16x8 __attribute__((ext_vector_type(8)));
typedef GAS unsigned gu32;
#define RLX_AGENT __ATOMIC_RELAXED, __HIP_MEMORY_SCOPE_AGENT
#define LDS_WAIT() asm volatile("s_waitcnt lgkmcnt(0)" ::: "memory")
__device__ __forceinline__ unsigned f2bf(float f) { unsigned u = __builtin_bit_cast(unsigned, f); return (u + 0x7fffu + ((u >> 16) & 1u)) >> 16; }
__device__ __forceinline__ unsigned pk2(float lo, float hi) { return f2bf(lo) | (f2bf(hi) << 16); }
__device__ __forceinline__ float bf2f(unsigned short b) { return __builtin_bit_cast(float, (unsigned)b << 16); }

#define XB_TMO      128
#define XB_XCNT(j)  (256  + 64 * (j))
#define XB_XSUB(j)  (1280 + 64 * (j))
#define XB_XGEN(j)  (2304 + 64 * (j))
#define XB_TOP      3328
#define XB_TOPGEN   3392
#define XCD_BAR_WORDS 3456
#define XB_SPIN_CAP (1u << 18)
__device__ __forceinline__ unsigned xb_ld(unsigned* p)              { return __hip_atomic_load(p, __ATOMIC_RELAXED, __HIP_MEMORY_SCOPE_AGENT); }
__device__ __forceinline__ unsigned xb_add(unsigned* p, unsigned v) { return __hip_atomic_fetch_add(p, v, __ATOMIC_RELAXED, __HIP_MEMORY_SCOPE_AGENT); }
__device__ __forceinline__ unsigned xb_xcc_id() { return (unsigned)__builtin_amdgcn_s_getreg((3 << 11) | 20) & 0xFu; }
#define XB_SPIN(cond, bar) do { unsigned _sp = 0; while (cond) { __builtin_amdgcn_s_sleep(1); \
    if ((++_sp & 255u) == 0u) { if (xb_ld(&(bar)[XB_TMO])) break; if (_sp > XB_SPIN_CAP) { atomicAdd(&(bar)[XB_TMO], 1u); break; } } } } while (0)
struct XcdBarrier { unsigned* bar; unsigned x; volatile LAS unsigned* st; };
__device__ __forceinline__ XcdBarrier xcd_barrier_post(unsigned* bar, volatile LAS unsigned* st) {
    XcdBarrier b; b.bar = bar; b.x = xb_xcc_id(); b.st = st;
    if (threadIdx.x == 0) (void)xb_add(&bar[XB_XCNT(b.x)], 1u);
    return b;
}
__device__ __forceinline__ void xcd_barrier_complete(unsigned* bar, unsigned x, unsigned& nloc, unsigned& nx) {
    const unsigned G = gridDim.x * gridDim.y * gridDim.z;
    unsigned sum, cnt, mine, sp = 0u;
    for (;;) {
        sum = 0u; cnt = 0u; mine = 0u;
#pragma unroll
        for (unsigned j = 0; j < 16; ++j) { const unsigned c = xb_ld(&bar[XB_XCNT(j)]); sum += c; cnt += (c > 0u) ? 1u : 0u; mine = (j == x) ? c : mine; }
        if (sum == G) break;
        __builtin_amdgcn_s_sleep(1);
        if ((++sp & 255u) == 0u) { if (xb_ld(&bar[XB_TMO])) break; if (sp > XB_SPIN_CAP) { atomicAdd(&bar[XB_TMO], 1u); break; } }
    }
    nloc = mine > 0u ? mine : 1u; nx = cnt > 0u ? cnt : 1u;
}
__device__ __forceinline__ void xcd_barrier(const XcdBarrier& b) {
    asm volatile("s_waitcnt vmcnt(0)" ::: "memory");
    __syncthreads();
    if (threadIdx.x == 0) {
        unsigned* bar = b.bar; asm volatile("" : "+s"(bar));
        __builtin_amdgcn_s_waitcnt(0);
        unsigned nloc = b.st[0], nx = b.st[1];
        if (nloc == 0u) { xcd_barrier_complete(bar, b.x, nloc, nx); b.st[0] = nloc; b.st[1] = nx; }
        const unsigned old = xb_add(&bar[XB_XSUB(b.x)], 1u);
        const unsigned gen = old / nloc;
        if (old + 1u == (gen + 1u) * nloc) {
            __builtin_amdgcn_fence(__ATOMIC_RELEASE, "agent");
            asm volatile("s_waitcnt vmcnt(0)" ::: "memory");
            const unsigned og = xb_add(&bar[XB_TOP], 1u);
            const unsigned tg = og / nx;
            if (og + 1u == (tg + 1u) * nx) xb_add(&bar[XB_TOPGEN], 1u);
            else XB_SPIN(xb_ld(&bar[XB_TOPGEN]) == tg, bar);
            __builtin_amdgcn_fence(__ATOMIC_ACQUIRE, "agent");
            xb_add(&bar[XB_XGEN(b.x)], 1u);
            asm volatile("s_waitcnt vmcnt(0)" ::: "memory");
        } else {
            XB_SPIN(xb_ld(&bar[XB_XGEN(b.x)]) == gen, bar);
            __builtin_amdgcn_fence(__ATOMIC_ACQUIRE, "agent");
            asm volatile("s_waitcnt vmcnt(0)" ::: "memory");
        }
    }
    __syncthreads();
}

struct Frame {
    LAS unsigned char* lds;
    volatile LAS unsigned* MISC;
    int tid, lane, wave;
    int vcu, G;
    unsigned char* ws;
};
#define LAUNDER_S(x) asm volatile("" : "+s"(x))
__device__ __forceinline__ const float* inptr(const Frame& F, int k) {
    const volatile LAS unsigned* t = (const volatile LAS unsigned*)(F.lds + PTR_OFF);
    const unsigned lo = __builtin_amdgcn_readfirstlane(t[2 * k]), hi = __builtin_amdgcn_readfirstlane(t[2 * k + 1]);
    return (const float*)(((unsigned long long)hi << 32) | lo);
}
__device__ __forceinline__ unsigned char* wsl(const Frame& F) { unsigned char* w = F.ws; LAUNDER_S(w); return w; }
__device__ __forceinline__ float wave_sum(float v) {
#pragma unroll
    for (int o = 1; o < 64; o <<= 1) v += __shfl_xor(v, o);
    return v;
}

__device__ __forceinline__ void transpose_item(const float* W, int Nsrc, int c0, int nvalid, int K, bf16* WT, int drow0, int k0, LAS float* scr, int lane) {
    const bool ok = (lane & 31) < nvalid;
#pragma unroll 8
    for (int i = 0; i < 32; ++i) { const int kk = 2 * i + (lane >> 5); scr[kk * 33 + (lane & 31)] = ok ? W[(size_t)(k0 + kk) * Nsrc + c0 + (lane & 31)] : 0.f; }
    LDS_WAIT(); asm volatile("" ::: "memory");
    const int c = lane & 7;
#pragma unroll
    for (int j = 0; j < 4; ++j) { const int n = (lane >> 3) + 8 * j; const LAS float* s = scr + (8 * c) * 33 + n;
        v4u o; o.x = pk2(s[0 * 33], s[1 * 33]); o.y = pk2(s[2 * 33], s[3 * 33]); o.z = pk2(s[4 * 33], s[5 * 33]); o.w = pk2(s[6 * 33], s[7 * 33]);
        *(v4u*)(WT + (size_t)(drow0 + n) * K + k0 + 8 * c) = o; }
    LDS_WAIT(); asm volatile("" ::: "memory");
}
constexpr int IT_GU = (D / 64) * (N_GU / 32), IT_D = (FF / 64) * (D / 32), IT_IN = (D / 64) * (N_IN / 32), IT_OUT = (D / 64) * (D / 32);
constexpr int IT_LAYER = 2 * IT_GU + 2 * IT_D + IT_IN + IT_OUT;
__device__ __forceinline__ void conv_gu(const float* Wg, const float* Wu, bf16* WT, int r, LAS float* scr, int lane) {
    constexpr int nrg = N_GU / 32; const int kb = r / nrg, rg = r % nrg, p = rg >> 3, q = rg & 7;
    transpose_item(q < 4 ? Wg : Wu, FF, 128 * p + 32 * (q & 3), 32, D, WT, 32 * rg, 64 * kb, scr, lane);
}
__device__ __forceinline__ void conv_plain(const float* W, int K, int N, bf16* WT, int r, LAS float* scr, int lane) {
    const int nrg = N / 32, kb = r / nrg, rg = r % nrg;
    transpose_item(W, N, 32 * rg, 32, K, WT, 32 * rg, 64 * kb, scr, lane);
}
__device__ __forceinline__ void conv_in(const float* W, bf16* WT, int r, LAS float* scr, int lane) {
    constexpr int nrg = N_IN / 32; const int kb = r / nrg, rg = r % nrg, pn = rg >> 3, q = rg & 7, bj = q >> 2, wc = q & 3;
    int c0, nv = 32;
    if (pn < 16) { const int seg = pn >> 2, base = seg == 0 ? 0 : seg == 1 ? 1024 : seg == 2 ? 2048 : 3088; c0 = base + 256 * (pn & 3) + 64 * wc + 32 * bj; }
    else if (pn == 16) { c0 = (wc < 2 ? 4112 + 64 * wc : 4240 + 64 * (wc - 2)) + 32 * bj; }
    else { c0 = 3072; nv = (q == 0) ? 16 : 0; }
    transpose_item(W, IN_W, c0, nv, D, WT, 32 * rg, 64 * kb, scr, lane);
}
__device__ __forceinline__ void p0_prologue(Frame& F) {
    LAS float* scr = (LAS float*)(F.lds + RING_OFF + F.wave * 16384);
    const int gw = F.vcu * NWAVES + F.wave, NGW = F.G * NWAVES;
    unsigned char* w = wsl(F);
    for (int it = gw; it < DEPTH * IT_LAYER; it += NGW) {
        const int l = it / IT_LAYER; int r = it % IT_LAYER;
        unsigned char* wl = w + WS_W + (size_t)l * LW_STRIDE;
        if (r < IT_GU) { conv_gu(inptr(F, 3) + (size_t)l * D * FF, inptr(F, 4) + (size_t)l * D * FF, (bf16*)(wl + LW_GU1), r, scr, F.lane); continue; } r -= IT_GU;
        if (r < IT_D) { conv_plain(inptr(F, 5) + (size_t)l * FF * D, FF, D, (bf16*)(wl + LW_D1), r, scr, F.lane); continue; } r -= IT_D;
        if (r < IT_IN) { conv_in(inptr(F, 7) + (size_t)l * D * IN_W, (bf16*)(wl + LW_IN), r, scr, F.lane); continue; } r -= IT_IN;
        if (r < IT_OUT) { conv_plain(inptr(F, 16) + (size_t)l * D * D, D, D, (bf16*)(wl + LW_OUT), r, scr, F.lane); continue; } r -= IT_OUT;
        if (r < IT_GU) { conv_gu(inptr(F, 18) + (size_t)l * D * FF, inptr(F, 19) + (size_t)l * D * FF, (bf16*)(wl + LW_GU2), r, scr, F.lane); continue; } r -= IT_GU;
        conv_plain(inptr(F, 20) + (size_t)l * FF * D, FF, D, (bf16*)(wl + LW_D2), r, scr, F.lane);
    }
    const float* x = inptr(F, 0); const float* meta = inptr(F, 1);
    float* H = (float*)(w + WS_H); bf16* O = (bf16*)(w + WS_O);
    for (int m = gw; m < M_PAD; m += NGW) {
        f32x4* hr = (f32x4*)(H + (size_t)m * D) + F.lane;
        if (m < M_REAL) { const f32x4* xr = (const f32x4*)(x + (size_t)m * D) + F.lane;
#pragma unroll
            for (int j = 0; j < 8; ++j) hr[64 * j] = xr[64 * j]; }
        else { const bool ism = m >= META_ROW; const f32x4* xr = (const f32x4*)(meta + (size_t)(ism ? m - META_ROW : 0) * D) + F.lane;
#pragma unroll
            for (int j = 0; j < 8; ++j) hr[64 * j] = ism ? xr[64 * j] : (f32x4){0.f, 0.f, 0.f, 0.f};
            v4u* orow = (v4u*)(O + (size_t)m * D) + F.lane;
#pragma unroll
            for (int j = 0; j < 4; ++j) orow[64 * j] = (v4u){0u, 0u, 0u, 0u}; }
    }
}
__device__ __forceinline__ void norm_phase(Frame& F, const float* g) {
    const int gw = F.vcu * NWAVES + F.wave, NGW = F.G * NWAVES;
    unsigned char* w = wsl(F); const GAS float* H = (const GAS float*)(w + WS_H); GAS bf16* XN = (GAS bf16*)(w + WS_XN);
    f32x4 gv[8];
#pragma unroll
    for (int j = 0; j < 8; ++j) gv[j] = ((const GAS f32x4*)g)[F.lane + 64 * j];
    for (int m = gw; m < M_PAD; m += NGW) {
        const GAS f32x4* hr = (const GAS f32x4*)(H + (size_t)m * D) + F.lane;
        f32x4 v[8]; float s = 0.f;
#pragma unroll
        for (int j = 0; j < 8; ++j) { v[j] = hr[64 * j]; s += (v[j].x * v[j].x + v[j].y * v[j].y) + (v[j].z * v[j].z + v[j].w * v[j].w); }
        const float rstd = 1.0f / sqrtf(wave_sum(s) * (1.0f / D) + EPS);
        GAS unsigned long long* o8 = (GAS unsigned long long*)(XN + (size_t)m * D) + F.lane;
#pragma unroll
        for (int j = 0; j < 8; ++j) { const f32x4 y = v[j] * rstd * gv[j]; o8[64 * j] = (unsigned long long)pk2(y.x, y.y) | ((unsigned long long)pk2(y.z, y.w) << 32); }
    }
}
__device__ __forceinline__ void onorm_phase(Frame& F, const float* gf, const float* gs) {
    const int gw = F.vcu * NWAVES + F.wave, NGW = F.G * NWAVES;
    unsigned char* w = wsl(F); const GAS bf16* O = (const GAS bf16*)(w + WS_O); GAS bf16* XN = (GAS bf16*)(w + WS_XN);
    for (int m = gw; m < M_PAD; m += NGW) {
        const GAS v4u* orow = (const GAS v4u*)(O + (size_t)m * D) + F.lane;
        GAS v4u* xrow = (GAS v4u*)(XN + (size_t)m * D) + F.lane;
        float x[4][8]; float sf = 0.f, ss = 0.f;
#pragma unroll
        for (int j = 0; j < 4; ++j) { const v4u w = orow[64 * j]; const unsigned ww[4] = {w.x, w.y, w.z, w.w};
#pragma unroll
            for (int e = 0; e < 4; ++e) { x[j][2 * e] = __builtin_bit_cast(float, ww[e] << 16); x[j][2 * e + 1] = __builtin_bit_cast(float, ww[e] & 0xffff0000u); }
            float q = 0.f;
#pragma unroll
            for (int e = 0; e < 8; ++e) q += x[j][e] * x[j][e];
            if (j < 2) sf += q; else ss += q; }
        const float rf = 1.0f / sqrtf(wave_sum(sf) * (1.0f / 1024.f) + EPS), rs = 1.0f / sqrtf(wave_sum(ss) * (1.0f / 1024.f) + EPS);
#pragma unroll
        for (int j = 0; j < 4; ++j) { const float* gp = (j < 2 ? gf : gs) + (j & 1) * 512 + 8 * F.lane; const f32x4 g0 = *(const GAS f32x4*)gp, g1 = *(const GAS f32x4*)(gp + 4); const float r = j < 2 ? rf : rs;
            v4u w; w.x = pk2(x[j][0] * r * g0.x, x[j][1] * r * g0.y); w.y = pk2(x[j][2] * r * g0.z, x[j][3] * r * g0.w); w.z = pk2(x[j][4] * r * g1.x, x[j][5] * r * g1.y); w.w = pk2(x[j][6] * r * g1.z, x[j][7] * r * g1.w);
            xrow[64 * j] = w; }
    }
}

__device__ __forceinline__ int crow(int r, int hi) { return (r & 3) + 8 * (r >> 2) + 4 * hi; }
template <int MODE  >
__device__ __forceinline__ void attn_block(Frame& F, unsigned char* w, int b  , int h, int i, const float* sinks) {
    const int lane = F.lane, r32 = lane & 31, hi = lane >> 5;
    const bool meta = b < 0;
    const int qpos0 = meta ? 96 : 128 + 32 * i;
    const int qrow0 = meta ? META_BLK0 + 96 : b * SEQ + 32 * i;
    const int cdiag = qpos0 >> 5;
    const int cfirst = (MODE == 0) ? 3 : (cdiag - 4 < 3 ? 3 : cdiag - 4);
    constexpr int KP = (MODE == 0) ? 1024 : 128;
    const int kvh = (MODE == 0) ? h : (h >> 3);
    const GAS bf16* Qp = (const GAS bf16*)(w + (MODE == 0 ? WS_FQ : WS_SQ)) + (size_t)qrow0 * 1024 + h * 64;
    const GAS bf16* Kb = (const GAS bf16*)(w + (MODE == 0 ? WS_FK : WS_SK)) + kvh * 64;
    const GAS bf16* Vb = (const GAS bf16*)(w + (MODE == 0 ? WS_FV : WS_SV)) + kvh * 64;
    const LAS float* cl2 = (const LAS float*)(F.lds + RING_OFF + ATT_TAB_OFF);
    LAS unsigned char* vst = F.lds + RING_OFF + ATT_VST_OFF + F.wave * ATT_VST_BYTES;
    const float sl2 = (MODE == 1) ? exp2f(-0.5f * (float)(h + 1)) * LOG2E : 0.f;
    bf16x8 qf[4];
#pragma unroll
    for (int s = 0; s < 4; ++s) qf[s] = *(const GAS bf16x8*)(Qp + (size_t)r32 * 1024 + 16 * s + 8 * hi);
#define CHUNK_ROW(ck) ((ck) == 3 ? META_BLK0 + 96 : b * SEQ + 32 * ((ck) - 4))
    bf16x8 kf[4], kn[4]; v4u vn[4];
    { const int rowk = CHUNK_ROW(cfirst);
#pragma unroll
      for (int s = 0; s < 4; ++s) kf[s] = *(const GAS bf16x8*)(Kb + (size_t)(rowk + r32) * KP + 16 * s + 8 * hi);
#pragma unroll
      for (int t = 0; t < 4; ++t) { const int p = lane + 64 * t; vn[t] = *(const GAS v4u*)(Vb + (size_t)(rowk + (p >> 3)) * KP + (p & 7) * 8); }
#pragma unroll
      for (int t = 0; t < 4; ++t) { const int p = lane + 64 * t; *(LAS v4u*)(vst + (p >> 3) * ATT_VST_PITCH + (p & 7) * 16) = vn[t]; } }
    float m_run = -1e30f, l_run = 0.f; f32x16 o0 = {}, o1 = {};
    const float NEG = -1e30f;
    for (int ck = cfirst; ck <= cdiag; ++ck) {
        const bool more = ck < cdiag;
        if (more) { const int rowk = CHUNK_ROW(ck + 1);
#pragma unroll
            for (int s = 0; s < 4; ++s) kn[s] = *(const GAS bf16x8*)(Kb + (size_t)(rowk + r32) * KP + 16 * s + 8 * hi);
#pragma unroll
            for (int t = 0; t < 4; ++t) { const int p = lane + 64 * t; vn[t] = *(const GAS v4u*)(Vb + (size_t)(rowk + (p >> 3)) * KP + (p & 7) * 8); } }
        f32x16 p = {};
#pragma unroll
        for (int s = 0; s < 4; ++s) p = __builtin_amdgcn_mfma_f32_32x32x16_bf16(kf[s], qf[s], p, 0, 0, 0);
        if (MODE == 0) {
#pragma unroll
            for (int g = 0; g < 4; ++g) { const f32x4 cb = *(const LAS f32x4*)(cl2 + 32 * ck + 8 * g + 4 * hi);
#pragma unroll
                for (int j = 0; j < 4; ++j) p[4 * g + j] -= cb[j]; }
        } else {
            const float kb0 = (float)(32 * ck - qpos0 + 4 * hi);
#pragma unroll
            for (int r = 0; r < 16; ++r) p[r] = fmaf(sl2, kb0 + (float)((r & 3) + 8 * (r >> 2)), p[r]);
            if (ck == 3) {
#pragma unroll
                for (int r = 0; r < 16; ++r) if (crow(r, hi) < 16) p[r] = NEG; }
            if (ck == cdiag - 4) {
#pragma unroll
                for (int r = 0; r < 16; ++r) if (crow(r, hi) <= r32) p[r] = NEG; }
        }
        if (ck == cdiag) {
#pragma unroll
            for (int r = 0; r < 16; ++r) if (crow(r, hi) > r32) p[r] = NEG; }
        float mx = p[0];
#pragma unroll
        for (int r = 1; r < 16; ++r) mx = fmaxf(mx, p[r]);
        mx = fmaxf(mx, __shfl_xor(mx, 32));
        const float m_new = fmaxf(m_run, mx), alpha = __builtin_amdgcn_exp2f(m_run - m_new);
        float rs = 0.f;
#pragma unroll
        for (int r = 0; r < 16; ++r) { p[r] = __builtin_amdgcn_exp2f(p[r] - m_new); rs += p[r]; }
        rs += __shfl_xor(rs, 32);
        l_run = l_run * alpha + rs; m_run = m_new;
#pragma unroll
        for (int r = 0; r < 16; ++r) { const float ar = __shfl(alpha, crow(r, hi)); o0[r] *= ar; o1[r] *= ar; }
        bf16x8 pf[2];
#pragma unroll
        for (int s = 0; s < 2; ++s) { v4u w; w.x = pg8::cvt_pk_bf16(p[8 * s + 0], p[8 * s + 1]); w.y = pg8::cvt_pk_bf16(p[8 * s + 2], p[8 * s + 3]); w.z = pg8::cvt_pk_bf16(p[8 * s + 4], p[8 * s + 5]); w.w = pg8::cvt_pk_bf16(p[8 * s + 6], p[8 * s + 7]);
            pf[s] = __builtin_bit_cast(bf16x8, w); }
#pragma unroll
        for (int s = 0; s < 2; ++s) {
            bf16x8 v0, v1;
#pragma unroll
            for (int j = 0; j < 8; ++j) { const int kv = 16 * s + 8 * (j >> 2) + (j & 3);
                const LAS unsigned short* vp = (const LAS unsigned short*)(vst + (kv + 4 * hi) * ATT_VST_PITCH) + r32;
                v0[j] = (short)vp[0]; v1[j] = (short)vp[32]; }
            o0 = __builtin_amdgcn_mfma_f32_32x32x16_bf16(pf[s], v0, o0, 0, 0, 0);
            o1 = __builtin_amdgcn_mfma_f32_32x32x16_bf16(pf[s], v1, o1, 0, 0, 0);
        }
        if (more) {
#pragma unroll
            for (int t = 0; t < 4; ++t) { const int p2 = lane + 64 * t; *(LAS v4u*)(vst + (p2 >> 3) * ATT_VST_PITCH + (p2 & 7) * 16) = vn[t]; }
#pragma unroll
            for (int s = 0; s < 4; ++s) kf[s] = kn[s];
        }
    }
#undef CHUNK_ROW
    if (MODE == 1) l_run += __builtin_amdgcn_exp2f(sinks[h] * LOG2E + sl2 * (float)r32 - m_run);
    const float inv = 1.0f / l_run;
    GAS bf16* Op = (GAS bf16*)(w + WS_O) + (size_t)qrow0 * D + (MODE == 0 ? 0 : 1024) + h * 64 + r32;
#pragma unroll
    for (int r = 0; r < 16; ++r) { const int q = crow(r, hi); float ir = __shfl(inv, q); if (meta && q < 16) ir = 0.f;
        Op[(size_t)q * D] = (bf16)f2bf(o0[r] * ir); Op[(size_t)q * D + 32] = (bf16)f2bf(o1[r] * ir); }
}
__device__ __forceinline__ void attn_phase(Frame& F, const float* sinks) {
    unsigned char* w = wsl(F); const GAS float* LOGF = (const GAS float*)(w + WS_LOGF);
    const int bh = F.vcu >> 1, fb = bh >> 4, fh = bh & 15;
    LAS float* tab = (LAS float*)(F.lds + RING_OFF + ATT_TAB_OFF);
    LAS float* wtot = (LAS float*)(F.lds + RING_OFF + ATT_WTOT_OFF);
    { float v[5]; float tsum = 0.f; const int p0 = 5 * F.tid;
#pragma unroll
      for (int j = 0; j < 5; ++j) { const int p = p0 + j; float x = 0.f;
          if (p >= PADN && p < LPOS) { const int row = p < 128 ? META_BLK0 + p : fb * SEQ + p - 128; x = LOGF[(size_t)row * 16 + fh]; }
          tsum += x; v[j] = tsum; }
      float inc = tsum;
#pragma unroll
      for (int o = 1; o < 64; o <<= 1) { const float t = __shfl_up(inc, o); if (F.lane >= o) inc += t; }
      if (F.lane == 63) wtot[F.wave] = inc;
      __syncthreads();
      float base = inc - tsum;
      for (int w = 0; w < F.wave; ++w) base += wtot[w];
#pragma unroll
      for (int j = 0; j < 5; ++j) { const int p = p0 + j; if (p < LPOS) tab[p] = (p < PADN) ? 1e30f : (base + v[j]) * LOG2E; }
      __syncthreads(); }
    { const int u = 8 * (F.vcu & 1) + F.wave;
      const bool has_meta = F.vcu < 32 && (F.vcu & 1) == 0 && F.wave == 0;
      for (int k = 0; k < (has_meta ? 5 : 4); ++k) { const int i = k == 0 ? u : k == 1 ? 31 - u : k == 2 ? 32 + u : 63 - u; attn_block<0>(F, w, k == 4 ? -1 : fb, fh, k == 4 ? 0 : i, sinks); } }
    { const int gw = F.vcu * NWAVES + F.wave;
      const bool has_meta = F.vcu < 32 && (F.vcu & 1) == 1 && F.wave == 0;
      for (int k = 0; k < (has_meta ? 5 : 4); ++k) { const int T = gw * 4 + k; attn_block<1>(F, w, k == 4 ? -1 : (T >> 10), k == 4 ? (F.vcu >> 1) : ((T >> 6) & 15), k == 4 ? 0 : (T & 63), sinks); } }
}

constexpr int PH_PER_LAYER = 11, N_PHASES = 1 + DEPTH * PH_PER_LAYER;
struct Args { const float* in[21]; float* out; unsigned char* ws; int ph_lo, ph_hi, li, pad; };
__global__ void __launch_bounds__(NWAVES * 64, 2) hymba_fwd(Args args) {
    extern __shared__ __attribute__((aligned(16))) unsigned char lds[];
    Frame F;
    F.lds = (LAS unsigned char*)lds;
    F.MISC = (volatile LAS unsigned*)(F.lds + MISC_OFF);
    F.tid = threadIdx.x; F.lane = F.tid & 63; F.wave = __builtin_amdgcn_readfirstlane(F.tid >> 6);
    F.G = gridDim.x; { const int bx = blockIdx.x; F.vcu = (F.G % 8 == 0) ? (bx % 8) * (F.G / 8) + bx / 8 : bx; }
    F.ws = args.ws;
    for (int u = F.tid; u < (LDS_BYTES - LDSCTL_OFF) / 4; u += NWAVES * 64) ((LAS unsigned*)(F.lds + LDSCTL_OFF))[u] = 0u;
    __syncthreads();
    {
        volatile LAS unsigned long long* pt = (volatile LAS unsigned long long*)(F.lds + PTR_OFF);
#pragma unroll
        for (int k = 0; k < 21; ++k) if (F.tid == k) pt[k] = (unsigned long long)args.in[k];
        if (F.tid == 21) pt[21] = (unsigned long long)args.out;
    }
    __syncthreads();
    gu32* ctl = (gu32*)(args.ws + WS_CTL);
    XcdBarrier bar; bar.bar = (unsigned*)(ctl + CW_BAR); bar.x = 0; bar.st = nullptr;
#if !MK_PER_PHASE
    bar = xcd_barrier_post((unsigned*)(ctl + CW_BAR), F.MISC + 8);
#endif
    const int lo = args.ph_lo, hi = args.ph_hi;
#define IN(k) (lo <= (k) && (k) < hi)
#define SEAM(k) do { if (IN(k) && IN((k) + 1)) { if (MK_PER_PHASE) { if (F.tid == 0) __hip_atomic_store((gu32*)(F.ws + WS_CTL) + CW_TMO, 0xBADBA0u, RLX_AGENT); } else xcd_barrier(bar); } } while (0)
#define PHASE_BEGIN(k) if (IN(k)) { Frame P = F; asm volatile("" : "+v"(P.tid), "+v"(P.lane), "+s"(P.wave), "+s"(P.vcu), "+s"(P.G), "+s"(P.ws)); \
        unsigned char* w = wsl(P); int ll = l; LAUNDER_S(ll); unsigned char* wl = w + WS_W + (size_t)ll * LW_STRIDE; (void)wl; int bxl = blockIdx.x; LAUNDER_S(bxl);
#define PHASE_END(k) } SEAM(k);
    typedef pg8::StaticOrder SO;
    if (IN(0)) { p0_prologue(F); } SEAM(0);
    for (int l = 0; l < DEPTH; ++l) {
        const int pb = 1 + l * PH_PER_LAYER;
        PHASE_BEGIN(pb + 0) norm_phase(P, inptr(P, 2) + (size_t)ll * D); PHASE_END(pb + 0)
        PHASE_BEGIN(pb + 1) pg8::Gemm g{(const bf16*)(w + WS_XN), (const bf16*)(wl + LW_GU1), M_PAD, N_GU, D}; SO S; S.init(M_PAD, N_GU, P.G, bxl);
            pg8::EpiSwiGLU E{(GAS bf16*)(w + WS_ACT), FF}; pg8::gemm_phase<pg8::EpiSwiGLU, SO, true, true>(P.lds + RING_OFF, g, S, E); PHASE_END(pb + 1)
        PHASE_BEGIN(pb + 2) pg8::Gemm g{(const bf16*)(w + WS_ACT), (const bf16*)(wl + LW_D1), M_PAD, D, FF}; SO S; S.init(M_PAD, D, P.G, bxl);
            pg8::EpiResAdd E{(const GAS float*)(w + WS_H), (GAS float*)(w + WS_H), D, 0.5f, 1 << 30}; pg8::gemm_phase<pg8::EpiResAdd, SO, true, true>(P.lds + RING_OFF, g, S, E); PHASE_END(pb + 2)
        PHASE_BEGIN(pb + 3) norm_phase(P, inptr(P, 6) + (size_t)ll * D); PHASE_END(pb + 3)
        PHASE_BEGIN(pb + 4) pg8::Gemm g{(const bf16*)(w + WS_XN), (const bf16*)(wl + LW_IN), M_PAD, N_IN, D}; SO S; S.init(M_PAD, N_IN, P.G, bxl);
            pg8::EpiInProj E{(GAS bf16*)(w + WS_FQ), (GAS bf16*)(w + WS_FK), (GAS bf16*)(w + WS_FV), (GAS bf16*)(w + WS_SQ), (GAS bf16*)(w + WS_SK), (GAS bf16*)(w + WS_SV), (GAS float*)(w + WS_LOGF),
                             (const GAS float*)(inptr(P, 9) + ll * HD), (const GAS float*)(inptr(P, 10) + ll * HD), (const GAS float*)(inptr(P, 11) + ll * HD), (const GAS float*)(inptr(P, 12) + ll * HD), (const GAS float*)(inptr(P, 8) + ll * NH), QSCALE};
            pg8::gemm_phase<pg8::EpiInProj, SO, true, true>(P.lds + RING_OFF, g, S, E); PHASE_END(pb + 4)
        PHASE_BEGIN(pb + 5) attn_phase(P, inptr(P, 13) + ll * NH); PHASE_END(pb + 5)
        PHASE_BEGIN(pb + 6) onorm_phase(P, inptr(P, 14) + (size_t)ll * 1024, inptr(P, 15) + (size_t)ll * 1024); PHASE_END(pb + 6)
        PHASE_BEGIN(pb + 7) pg8::Gemm g{(const bf16*)(w + WS_XN), (const bf16*)(wl + LW_OUT), M_PAD, D, D}; SO S; S.init(M_PAD, D, P.G, bxl);
            pg8::EpiResAdd E{(const GAS float*)(w + WS_H), (GAS float*)(w + WS_H), D, 1.0f, 1 << 30}; pg8::gemm_phase<pg8::EpiResAdd, SO, true, true>(P.lds + RING_OFF, g, S, E); PHASE_END(pb + 7)
        PHASE_BEGIN(pb + 8) norm_phase(P, inptr(P, 17) + (size_t)ll * D); PHASE_END(pb + 8)
        PHASE_BEGIN(pb + 9) pg8::Gemm g{(const bf16*)(w + WS_XN), (const bf16*)(wl + LW_GU2), M_PAD, N_GU, D}; SO S; S.init(M_PAD, N_GU, P.G, bxl);
            pg8::EpiSwiGLU E{(GAS bf16*)(w + WS_ACT), FF}; pg8::gemm_phase<pg8::EpiSwiGLU, SO, true, true>(P.lds + RING_OFF, g, S, E); PHASE_END(pb + 9)
        PHASE_BEGIN(pb + 10) pg8::Gemm g{(const bf16*)(w + WS_ACT), (const bf16*)(wl + LW_D2), M_PAD, D, FF}; SO S; S.init(M_PAD, D, P.G, bxl);
            const bool fin = (ll == DEPTH - 1);
            pg8::EpiResAdd E{(const GAS float*)(w + WS_H), fin ? (GAS float*)inptr(P, 21) : (GAS float*)(w + WS_H), D, 0.5f, fin ? M_REAL / 256 : (1 << 30)}; pg8::gemm_phase<pg8::EpiResAdd, SO, true, true>(P.lds + RING_OFF, g, S, E); PHASE_END(pb + 10)
    }
#undef IN
#undef SEAM
#undef PHASE_BEGIN
#undef PHASE_END
}

extern "C" void kernel_launch(void* const* d_in, const int* in_sizes, int n_in, void* d_out, int out_size, void* d_ws, size_t ws_size, hipStream_t stream) {
    static int grid = 0;
    if (grid == 0) {
        if (n_in != 21 || in_sizes[0] != M_REAL * D || out_size != M_REAL * D || ws_size < WS_END) { fprintf(stderr, "kernel_launch: unexpected shapes (n_in %d, in0 %d, out %d, ws %zu, need %zu); nothing launched\n", n_in, n_in > 0 ? in_sizes[0] : -1, out_size, ws_size, (size_t)WS_END); grid = -1; return; }
        int dev = 0, cus = 0, per_cu = 0;
        if (hipGetDevice(&dev) != hipSuccess || hipDeviceGetAttribute(&cus, hipDeviceAttributeMultiprocessorCount, dev) != hipSuccess) { fprintf(stderr, "kernel_launch: device query failed\n"); grid = -1; return; }
        if (hipFuncSetAttribute((const void*)hymba_fwd, hipFuncAttributeMaxDynamicSharedMemorySize, LDS_BYTES) != hipSuccess) { fprintf(stderr, "kernel_launch: hipFuncSetAttribute failed\n"); grid = -1; return; }
        if (hipOccupancyMaxActiveBlocksPerMultiprocessor(&per_cu, (const void*)hymba_fwd, NWAVES * 64, LDS_BYTES) != hipSuccess || per_cu < 1) fprintf(stderr, "kernel_launch: note: occupancy query reports %d workgroups per CU\n", per_cu);
        (void)hipGetLastError();
        grid = cus;
        if (grid != 256) fprintf(stderr, "kernel_launch: note: %d CUs (the attention phase's static deal assumes 256)\n", grid);
    }
    if (grid < 0) return;
    if (hipMemsetAsync((char*)d_ws + WS_CTL, 0, CTL_ZERO_BYTES, stream) != hipSuccess) { fprintf(stderr, "kernel_launch: memset failed\n"); return; }
    Args a{};
    for (int i = 0; i < 21; ++i) a.in[i] = (const float*)d_in[i];
    a.out = (float*)d_out; a.ws = (unsigned char*)d_ws; a.li = 0; a.pad = 0;
#if MK_PER_PHASE
    for (int ph = 0; ph < N_PHASES; ++ph) { a.ph_lo = ph; a.ph_hi = ph + 1; hipLaunchKernelGGL(hymba_fwd, dim3(grid), dim3(NWAVES * 64), LDS_BYTES, stream, a); }
#else
    a.ph_lo = 0; a.ph_hi = N_PHASES;
    hipLaunchKernelGGL(hymba_fwd, dim3(grid), dim3(NWAVES * 64), LDS_BYTES, stream, a);
#endif
    const hipError_t le = hipPeekAtLastError();
    if (le != hipSuccess) fprintf(stderr, "kernel_launch: launch failed: %s\n", hipGetErrorName(le));
}
```

```cpp
#include <hip/hip_runtime.h>
#include <cstdio>
#include <cstdint>

#ifndef MK_PER_PHASE
#define MK_PER_PHASE 0
#endif
#ifndef OVERLAP_CONV
#define OVERLAP_CONV 0
#endif
#ifndef PROBE_BLOCK
#define PROBE_BLOCK 0
#endif
#ifndef PROBE_CLASS
#define PROBE_CLASS (-1)
#endif

#define PROBE_ACC_OFF (131072 + 320 + 64)
__device__ __forceinline__ int my_tid();
namespace pg8 {
#define PG8_LAS __attribute__((address_space(3)))
#define PG8_GAS __attribute__((address_space(1)))
typedef unsigned short bf16_t;
typedef short bf16x8 __attribute__((ext_vector_type(8)));
typedef float f32x4 __attribute__((ext_vector_type(4)));
typedef unsigned u32x4 __attribute__((ext_vector_type(4)));
constexpr int BM = 256, BK = 64, HALF = 128, HTB = HALF * BK * 2  , STAGE_BYTES = 8 * HTB, NXCD = 8, WGM = 8;

__host__ __device__ __forceinline__ int lds_byte(int r, int c) { const int st = (r >> 4) * 2 + (c >> 5), rr = r & 15, cc = c & 31, ob = rr * 64 + cc * 2; return st * 1024 + (ob ^ (((ob >> 9) & 1) << 5)); }
__host__ __device__ __forceinline__ void stage_rc(int b, int& R, int& C) { const int st = b / 1024, sb = b % 1024, swz = sb ^ (((sb >> 9) & 1) << 5); R = (st >> 1) * 16 + swz / 64; C = (st & 1) * 32 + (swz % 64) / 2; }
__host__ __device__ __forceinline__ int perm32(int rho) { const int n = rho >> 4, i = rho & 15; return 8 * (i >> 2) + 4 * n + (i & 3); }

struct Unit { int pm, pn; };
struct Gemm { const bf16_t* A; const bf16_t* Bt; int M, N, K; };

struct StaticOrder {
    int nM, nN, nwg, G, c;
    __host__ __device__ void init(int M, int N, int G_, int c_) { nM = M / BM; nN = N / BM; nwg = nM * nN; G = G_; c = c_; }
    __host__ __device__ bool next(int i, Unit& u) const {
        const long L = (long)i * G + c; if (L >= nwg) return false;
        int wgid = (int)L; { const int q = nwg / NXCD, r = nwg % NXCD, xcd = wgid % NXCD, off = wgid / NXCD; wgid = (xcd < r ? xcd * (q + 1) : r * (q + 1) + (xcd - r) * q) + off; }
        const int nig = WGM * nN, gid = wgid / nig, fm = gid * WGM, gsz = (nM - fm) < WGM ? (nM - fm) : WGM;
        u.pm = fm + ((wgid % nig) % gsz); u.pn = (wgid % nig) / gsz; return true;
    }
    __device__ __forceinline__ void a_ready(const Unit&) const {}
    __device__ __forceinline__ void done(const Unit&) const {}
};

__device__ __forceinline__ unsigned cvt_pk_bf16(float lo, float hi) { unsigned r; asm volatile("v_cvt_pk_bf16_f32 %0, %1, %2" : "=v"(r) : "v"(lo), "v"(hi)); return r; }

template <class Epi, class Sched, bool ALIGN_EPI = false, bool SP2 = false>
__device__ __forceinline__ void gemm_phase(PG8_LAS unsigned char* lds, const Gemm g, const Sched& S, const Epi& E) {
    int tid_l = my_tid(); asm volatile("" : "+v"(tid_l));
    const int tid = tid_l, wid = __builtin_amdgcn_readfirstlane(tid >> 6), lane = tid & 63, wr = wid >> 2, wc = wid & 3, fr = lane & 15, fq = lane >> 4;
    const int K = g.K, nt = K / BK;
    unsigned voffA[2], voffB[2];
#pragma unroll
    for (int i = 0; i < 2; ++i) { int R, C; stage_rc(tid * 16 + i * 8192, R, C); const int Rb = Epi::PERM ? ((R & ~31) + perm32(R & 31)) : R;
        voffA[i] = (unsigned)(R * K + C) * 2u; voffB[i] = (unsigned)(Rb * K + C) * 2u; }
    const size_t kstep = (size_t)(BK * 2);
    const size_t hstep = (size_t)HALF * K * 2;
    const size_t tstep = 2 * hstep;
    const unsigned ldsw = (unsigned)wid * 1024u;
    const int aoff = lds_byte(wr * 64 + fr, fq * 8), boff = lds_byte(wc * 32 + fr, fq * 8);
#define PG8_SA(b, h) (((b) * 2 + (h)) * HTB)
#define PG8_SB(b, h) ((4 + (b) * 2 + (h)) * HTB)
#define PG8_STAGE(bufoff, gbase, voff) do { _Pragma("unroll") for (int _i = 0; _i < 2; ++_i) \
        __builtin_amdgcn_global_load_lds((const unsigned*)((const char*)(gbase) + (voff)[_i]), (PG8_LAS unsigned*)(lds + (bufoff) + ldsw + _i * 8192), 16, 0, 0); } while (0)
#define PG8_LDA(dst, b, h) do { _Pragma("unroll") for (int m = 0; m < 4; ++m) _Pragma("unroll") for (int k = 0; k < 2; ++k) dst[m][k] = *(const PG8_LAS bf16x8*)(lds + PG8_SA(b, h) + aoff + m * 2048 + k * 1024); } while (0)
#define PG8_LDB(dst, b, h) do { _Pragma("unroll") for (int n = 0; n < 2; ++n) _Pragma("unroll") for (int k = 0; k < 2; ++k) dst[n][k] = *(const PG8_LAS bf16x8*)(lds + PG8_SB(b, h) + boff + n * 2048 + k * 1024); } while (0)
#define PG8_MMA(ai, bj, At, Bt) do { __builtin_amdgcn_s_setprio(1); _Pragma("unroll") for (int m = 0; m < 4; ++m) _Pragma("unroll") for (int n = 0; n < 2; ++n) _Pragma("unroll") for (int k = 0; k < 2; ++k) \
        acc[ai][bj][m][n] = __builtin_amdgcn_mfma_f32_16x16x32_bf16(Bt[n][k], At[m][k], acc[ai][bj][m][n], 0, 0, 0); __builtin_amdgcn_s_setprio(0); } while (0)
#define PG8_WAIT_V(n) asm volatile("s_waitcnt vmcnt(" #n ")" ::: "memory")
#define PG8_WAIT_L(n) asm volatile("s_waitcnt lgkmcnt(" #n ")" ::: "memory")
#define PG8_BAR __builtin_amdgcn_s_barrier()
#define PG8_SCHED __builtin_amdgcn_sched_barrier(0)
    Unit cur, nxt; int ui = 0;
    if (!S.next(0, cur)) return;
    f32x4 acc[2][2][4][2];
#pragma unroll
    for (int a = 0; a < 2; ++a)
#pragma unroll
        for (int b = 0; b < 2; ++b)
#pragma unroll
            for (int m = 0; m < 4; ++m)
#pragma unroll
                for (int n = 0; n < 2; ++n) acc[a][b][m][n] = (f32x4){0.f, 0.f, 0.f, 0.f};
    bf16x8 At[4][2], B0[2][2], B1[2][2];
    const char* cA = (const char*)g.A + (size_t)cur.pm * tstep; const char* cB = (const char*)g.Bt + (size_t)cur.pn * tstep;
    S.a_ready(cur);
    if constexpr (SP2) {
        PG8_STAGE(PG8_SB(0, 0), cB, voffB); PG8_STAGE(PG8_SB(0, 1), cB + hstep, voffB); PG8_STAGE(PG8_SA(0, 0), cA, voffA); PG8_STAGE(PG8_SA(0, 1), cA + hstep, voffA);
        if (wr == 1) PG8_BAR;
        PG8_WAIT_V(2); PG8_BAR;
        PG8_STAGE(PG8_SB(1, 0), cB + kstep, voffB); PG8_STAGE(PG8_SA(1, 0), cA + kstep, voffA); PG8_STAGE(PG8_SB(1, 1), cB + hstep + kstep, voffB);
        PG8_WAIT_V(6); PG8_BAR;
    } else {
        PG8_STAGE(PG8_SB(0, 0), cB, voffB); PG8_STAGE(PG8_SA(0, 0), cA, voffA); PG8_STAGE(PG8_SB(0, 1), cB + hstep, voffB); PG8_STAGE(PG8_SA(0, 1), cA + hstep, voffA);
        if (wr == 1) PG8_BAR;
        PG8_WAIT_V(4); PG8_BAR;
        PG8_STAGE(PG8_SB(1, 0), cB + kstep, voffB); PG8_STAGE(PG8_SA(1, 0), cA + kstep, voffA); PG8_STAGE(PG8_SB(1, 1), cB + hstep + kstep, voffB);
        PG8_WAIT_V(6); PG8_BAR;
    }
    for (;;) {
        const bool has_next = S.next(ui + 1, nxt);
        const char* nA = has_next ? (const char*)g.A + (size_t)nxt.pm * tstep : cA; const char* nB = has_next ? (const char*)g.Bt + (size_t)nxt.pn * tstep : cB;
        for (int t = 0; t < nt; t += 2) {
            const bool last = (t == nt - 2);
            const char* a1 = cA + (size_t)(t + 1) * kstep;
            const char* a2 = last ? nA : cA + (size_t)(t + 2) * kstep; const char* b2 = last ? nB : cB + (size_t)(t + 2) * kstep;
            const char* a3 = a2 + kstep; const char* b3 = b2 + kstep;
            if (last && has_next) S.a_ready(nxt);
            if constexpr (Epi::MID) { if (t == nt / 2) E.mid(acc, cur, wr, wc, fr, fq); }
            if constexpr (SP2) {
            PG8_LDB(B0, 0, 0); PG8_LDB(B1, 0, 1); PG8_SCHED; PG8_LDA(At, 0, 0); PG8_STAGE(PG8_SA(1, 1), a1 + hstep, voffA);
            PG8_WAIT_V(8); PG8_WAIT_L(0); PG8_BAR; PG8_MMA(0, 0, At, B0); PG8_MMA(0, 1, At, B1); PG8_BAR; PG8_SCHED;
            PG8_LDA(At, 0, 1); PG8_STAGE(PG8_SB(0, 0), b2, voffB); PG8_STAGE(PG8_SB(0, 1), b2 + hstep, voffB); PG8_STAGE(PG8_SA(0, 0), a2, voffA);
            PG8_WAIT_V(8); PG8_WAIT_L(0); PG8_BAR; PG8_MMA(1, 0, At, B0); PG8_MMA(1, 1, At, B1); PG8_BAR; PG8_SCHED;
            PG8_LDB(B0, 1, 0); PG8_LDB(B1, 1, 1); PG8_SCHED; PG8_LDA(At, 1, 0); PG8_STAGE(PG8_SA(0, 1), a2 + hstep, voffA);
            PG8_WAIT_V(8); PG8_WAIT_L(0); PG8_BAR; PG8_MMA(0, 0, At, B0); PG8_MMA(0, 1, At, B1); PG8_BAR; PG8_SCHED;
            PG8_LDA(At, 1, 1); PG8_STAGE(PG8_SB(1, 0), b3, voffB); PG8_STAGE(PG8_SB(1, 1), b3 + hstep, voffB); PG8_STAGE(PG8_SA(1, 0), a3, voffA);
            PG8_WAIT_V(8); PG8_WAIT_L(0); PG8_BAR; PG8_MMA(1, 0, At, B0); PG8_MMA(1, 1, At, B1); PG8_BAR; PG8_SCHED;
            } else {
            PG8_LDB(B0, 0, 0); PG8_SCHED; PG8_LDA(At, 0, 0); PG8_STAGE(PG8_SA(1, 1), a1 + hstep, voffA);
            PG8_WAIT_L(8); PG8_BAR; PG8_WAIT_L(0); PG8_MMA(0, 0, At, B0); PG8_BAR; PG8_SCHED;
            PG8_LDB(B1, 0, 1); PG8_STAGE(PG8_SB(0, 0), b2, voffB);
            PG8_BAR; PG8_WAIT_L(0); PG8_MMA(0, 1, At, B1); PG8_BAR;
            PG8_LDA(At, 0, 1); PG8_STAGE(PG8_SA(0, 0), a2, voffA);
            PG8_BAR; PG8_WAIT_L(0); PG8_MMA(1, 0, At, B0); PG8_BAR; PG8_SCHED;
            PG8_STAGE(PG8_SB(0, 1), b2 + hstep, voffB);
            PG8_WAIT_V(6); PG8_BAR; PG8_MMA(1, 1, At, B1); PG8_BAR;
            PG8_LDB(B0, 1, 0); PG8_SCHED; PG8_LDA(At, 1, 0); PG8_STAGE(PG8_SA(0, 1), a2 + hstep, voffA);
            PG8_WAIT_L(8); PG8_BAR; PG8_WAIT_L(0); PG8_MMA(0, 0, At, B0); PG8_BAR; PG8_SCHED;
            PG8_LDB(B1, 1, 1); PG8_STAGE(PG8_SB(1, 0), b3, voffB);
            PG8_BAR; PG8_WAIT_L(0); PG8_MMA(0, 1, At, B1); PG8_BAR;
            PG8_LDA(At, 1, 1); PG8_STAGE(PG8_SA(1, 0), a3, voffA);
            PG8_BAR; PG8_WAIT_L(0); PG8_MMA(1, 0, At, B0); PG8_BAR; PG8_SCHED;
            PG8_STAGE(PG8_SB(1, 1), b3 + hstep, voffB);
            PG8_WAIT_V(6); PG8_BAR; PG8_MMA(1, 1, At, B1); PG8_BAR;
            }
        }
        if constexpr (ALIGN_EPI) { if (wr == 0) PG8_BAR; }
        if constexpr (PROBE_CLASS == 20 + Epi::ID) { unsigned long long t0_ = 0; if ((PROBE_BLOCK < 0 || (int)blockIdx.x == PROBE_BLOCK) && tid == 0) t0_ = __builtin_amdgcn_s_memrealtime();
            E(acc, cur, wr, wc, fr, fq); asm volatile("s_waitcnt vmcnt(0)" ::: "memory");
            if ((PROBE_BLOCK < 0 || (int)blockIdx.x == PROBE_BLOCK) && tid == 0) { volatile PG8_LAS unsigned long long* pa_ = (volatile PG8_LAS unsigned long long*)(lds + PROBE_ACC_OFF); *pa_ = *pa_ + (__builtin_amdgcn_s_memrealtime() - t0_); } }
        else if constexpr (!Epi::AFTER_DRAIN) { E(acc, cur, wr, wc, fr, fq); S.done(cur); }
        if (!has_next) break;
#pragma unroll
        for (int a = 0; a < 2; ++a)
#pragma unroll
            for (int b = 0; b < 2; ++b)
#pragma unroll
                for (int m = 0; m < 4; ++m)
#pragma unroll
                    for (int n = 0; n < 2; ++n) acc[a][b][m][n] = (f32x4){0.f, 0.f, 0.f, 0.f};
        cur = nxt; cA = nA; cB = nB; ++ui;
        if constexpr (ALIGN_EPI) { if (wr == 1) PG8_BAR; }
    }
    PG8_WAIT_V(0);
    if constexpr (!ALIGN_EPI) { if (wr == 0) PG8_BAR; }
    PG8_BAR;
#undef PG8_SA
#undef PG8_SB
#undef PG8_STAGE
#undef PG8_LDA
#undef PG8_LDB
#undef PG8_MMA
#undef PG8_WAIT_V
#undef PG8_WAIT_L
#undef PG8_BAR
#undef PG8_SCHED
}
}

constexpr int NWAVES = 8;
constexpr int D = 2048, NB = 8, SEQ = 2048, DEPTH = 4, HD = 64, NH = 16, FF = 5632, NMETA = 16, PADN = 112;
constexpr int M_REAL = NB * SEQ;
constexpr int M_PAD = M_REAL + 128;
constexpr int META_BLK0 = M_REAL;
constexpr int META_ROW = META_BLK0 + PADN;
constexpr int LPOS = SEQ + 128;
constexpr int N_GU = 2 * FF;
constexpr int N_IN = 18 * 256;
constexpr int IN_W = 4368;
constexpr float EPS = 1e-6f;
constexpr float LOG2E = 1.4426950408889634f;
constexpr float QSCALE = 0.125f * LOG2E;

constexpr size_t MiB = 1u << 20;
constexpr int NSLOT = 13;
constexpr size_t WS_CTL = 0, CTL_ZERO_BYTES = 1 * MiB;
constexpr size_t SZ_WGU = (size_t)N_GU * D * 2, SZ_WD = (size_t)D * FF * 2, SZ_WIN = (size_t)N_IN * D * 2, SZ_WOUT = (size_t)D * D * 2;
constexpr size_t LW_GU1 = 0, LW_D1 = LW_GU1 + SZ_WGU, LW_IN = LW_D1 + SZ_WD, LW_OUT = LW_IN + SZ_WIN, LW_GU2 = LW_OUT + SZ_WOUT, LW_D2 = LW_GU2 + SZ_WGU, LW_STRIDE = LW_D2 + SZ_WD;
constexpr size_t WS_W = 1 * MiB;
constexpr size_t WS_XN = WS_W + DEPTH * LW_STRIDE;
constexpr size_t WS_O = WS_XN + (size_t)M_PAD * D * 2;
constexpr size_t WS_ACT = WS_O + (size_t)M_PAD * D * 2;
constexpr size_t SZ_QK = (size_t)M_PAD * 1024 * 2, SZ_KV = (size_t)M_PAD * 128 * 2;
constexpr size_t WS_FQ = WS_ACT + (size_t)M_PAD * FF * 2, WS_FK = WS_FQ + SZ_QK, WS_FV = WS_FK + SZ_QK, WS_SQ = WS_FV + SZ_QK, WS_SK = WS_SQ + SZ_QK, WS_SV = WS_SK + SZ_KV, WS_LOGF = WS_SV + SZ_KV;
constexpr size_t WS_HB = WS_LOGF + (size_t)M_PAD * 16 * 4;
constexpr size_t WS_SSQ = WS_HB + (size_t)M_PAD * D * 2;
constexpr size_t WS_SSQM = WS_SSQ + (size_t)NSLOT * M_REAL * 32 * 4;
constexpr size_t WS_SSQO = WS_SSQM + (size_t)NSLOT * 16 * 128 * 4;
constexpr size_t WS_SSQOM = WS_SSQO + (size_t)M_REAL * 32 * 4;
constexpr size_t WS_END = WS_SSQOM + 16 * 32 * 4;
static_assert(LW_STRIDE % 256 == 0 && WS_XN % 256 == 0 && WS_ACT % 256 == 0 && WS_FQ % 256 == 0 && WS_SK % 256 == 0 && WS_LOGF % 256 == 0 && WS_HB % 256 == 0, "alignment");
constexpr int CW_TMO = 0, CW_BAR = 4096;

constexpr int RING_OFF = 0, RING_BYTES = 131072;
constexpr int LDSCTL_OFF = RING_BYTES, MISC_OFF = LDSCTL_OFF + 320, PTR_OFF = LDSCTL_OFF + 1024;
constexpr int LDS_BYTES = 155648;
constexpr int WID_OFF = LDSCTL_OFF + 1280;
constexpr int RSTD_ID_OFF = LDSCTL_OFF + 1536, RSTD_OFF = LDSCTL_OFF + 2048;
static_assert(RSTD_OFF + 8 * 128 * 4 <= LDS_BYTES, "LDS map");
constexpr int RSTD2_OFF = 148480;
static_assert(RSTD2_OFF + 8 * 128 * 4 <= LDS_BYTES, "LDS map");
constexpr int ATT_TAB_OFF = 139264;
constexpr int ATT_WTOT_OFF = ATT_TAB_OFF + 8704;
constexpr int ATT_FC_OFF = ATT_WTOT_OFF + 64;
constexpr int ATT_VST_OFF = 0, ATT_VST_PITCH = 128, ATT_VST_BYTES = 64 * ATT_VST_PITCH;
static_assert(ATT_VST_OFF + NWAVES * 2 * ATT_VST_BYTES <= RING_BYTES && ATT_FC_OFF + 256 <= RSTD2_OFF && RSTD_OFF + 8 * 128 * 4 <= ATT_TAB_OFF, "attention LDS");

#define GAS __attribute__((address_space(1)))
#define LAS __attribute__((address_space(3)))
typedef unsigned short bf16;
typedef unsigned v4u __attribute__((ext_vector_type(4)));
typedef float f32x4 __attribute__((ext_vector_type(4)));
typedef float f32x16 __attribute__((ext_vector_type(16)));
typedef short bf16x8 __attribute__((ext_vector_type(8)));
typedef GAS unsigned gu32;
#define RLX_AGENT __ATOMIC_RELAXED, __HIP_MEMORY_SCOPE_AGENT
#define LDS_WAIT() asm volatile("s_waitcnt lgkmcnt(0)" ::: "memory")
__device__ __forceinline__ unsigned f2bf(float f) { unsigned u = __builtin_bit_cast(unsigned, f); return (u + 0x7fffu + ((u >> 16) & 1u)) >> 16; }
__device__ __forceinline__ unsigned pk2(float lo, float hi) { return f2bf(lo) | (f2bf(hi) << 16); }
__device__ __forceinline__ float bf2f(unsigned short b) { return __builtin_bit_cast(float, (unsigned)b << 16); }

__device__ __forceinline__ int hw_wave_key() { return (int)(__builtin_amdgcn_s_getreg(((6 - 1) << 11) | 4) & 63u); }
__device__ __forceinline__ int my_tid() {
    extern __shared__ __attribute__((aligned(16))) unsigned char lds_dyn_[];
    const int wave = __builtin_amdgcn_readfirstlane(((const volatile LAS int*)((LAS unsigned char*)lds_dyn_ + WID_OFF))[hw_wave_key()]);
    unsigned zero = 0u; asm volatile("" : "+v"(zero));
    return wave * 64 + (int)__builtin_amdgcn_mbcnt_hi(~0u, __builtin_amdgcn_mbcnt_lo(~0u, zero));
}
__host__ __device__ __forceinline__ size_t kfrag_idx(int row, int nh, int head, int d) { return ((((size_t)(row >> 5) * nh + head) * 8 + (d >> 3)) * 32 + (row & 31)) * 8 + (d & 7); }
__host__ __device__ __forceinline__ size_t vfrag_idx(int row, int nh, int head, int d) { return (((((size_t)(row >> 4) * nh + head) * 2 + ((row >> 2) & 1)) * 64 + d) * 8) + (((row >> 3) & 1) * 4 + (row & 3)); }
namespace pg8 {
__device__ __forceinline__ unsigned long long tab_ptr(int k) {
    extern __shared__ __attribute__((aligned(16))) unsigned char lds_dyn_[];
    const volatile PG8_LAS unsigned* t = (const volatile PG8_LAS unsigned*)((PG8_LAS unsigned char*)lds_dyn_ + PTR_OFF);
    const unsigned lo = __builtin_amdgcn_readfirstlane(t[2 * k]), hi = __builtin_amdgcn_readfirstlane(t[2 * k + 1]);
    return ((unsigned long long)hi << 32) | lo;
}
__device__ __forceinline__ const PG8_LAS float* ensure_rstd(const PG8_GAS float* ssq, int slot, int pm, int wid, int wr, int lane) {
    extern __shared__ __attribute__((aligned(16))) unsigned char lds_dyn_[];
    volatile PG8_LAS unsigned* idw = (volatile PG8_LAS unsigned*)((PG8_LAS unsigned char*)lds_dyn_ + RSTD_ID_OFF) + wid;
    PG8_LAS float* rv = (PG8_LAS float*)((PG8_LAS unsigned char*)lds_dyn_ + RSTD_OFF) + wid * 128;
    const unsigned want = ((unsigned)(slot + 1) << 16) | (unsigned)(pm + 1);
    if ((unsigned)__builtin_amdgcn_readfirstlane(*idw) != want) {
#pragma unroll
        for (int j = 0; j < 2; ++j) { const int row = pm * BM + HALF * j + 64 * wr + lane; const PG8_GAS f32x4* pp = (const PG8_GAS f32x4*)(ssq + (size_t)row * 32); float t = 0.f;
#pragma unroll
            for (int q = 0; q < 8; ++q) { const f32x4 a = pp[q]; t += (a[0] + a[1]) + (a[2] + a[3]); }
            rv[64 * j + lane] = 1.0f / sqrtf(t * (1.0f / 2048.0f) + 1e-6f); }
        if (lane == 0) *idw = want;
        asm volatile("s_waitcnt lgkmcnt(0)" ::: "memory");
    }
    return rv;
}
__device__ __forceinline__ float silu_mul(float g, float u) {
    const float e = __builtin_amdgcn_exp2f(-1.4426950408889634f * g);
    return g * __builtin_amdgcn_rcpf(1.0f + e) * u;
}
struct EpiSwiGLU {
    static constexpr bool PERM = true, AFTER_DRAIN = false, MID = false; static constexpr int ID = 0;
    int slot;
    __device__ __forceinline__ void operator()(const f32x4 (&acc)[2][2][4][2], const Unit& u, int wr, int wc, int fr, int fq) const {
        PG8_GAS unsigned char* w = (PG8_GAS unsigned char*)tab_ptr(22); PG8_GAS bf16_t* O = (PG8_GAS bf16_t*)(w + WS_ACT); constexpr int ldc = FF; const PG8_GAS float* ssq = (const PG8_GAS float*)(w + WS_SSQ) + (size_t)slot * M_REAL * 32;
        const int row0 = u.pm * BM + wr * 64 + fr, col0 = u.pn * HALF + wc * 32 + 8 * fq;
        const PG8_LAS float* rv = ensure_rstd(ssq, slot, u.pm, wr * 4 + wc, wr, fr + 16 * fq);
        float rs[2][4];
#pragma unroll
        for (int ai = 0; ai < 2; ++ai)
#pragma unroll
            for (int m = 0; m < 4; ++m) rs[ai][m] = rv[64 * ai + 16 * m + fr];
#pragma unroll
        for (int ai = 0; ai < 2; ++ai)
#pragma unroll
            for (int m = 0; m < 4; ++m) { PG8_GAS bf16_t* rowp = O + (size_t)(row0 + ai * HALF + m * 16) * ldc + col0;
                const float r = rs[ai][m];
                const f32x4 g0 = acc[ai][0][m][0] * r, g1 = acc[ai][0][m][1] * r, u0 = acc[ai][1][m][0] * r, u1 = acc[ai][1][m][1] * r;
                u32x4 w; w.x = cvt_pk_bf16(silu_mul(g0[0], u0[0]), silu_mul(g0[1], u0[1])); w.y = cvt_pk_bf16(silu_mul(g0[2], u0[2]), silu_mul(g0[3], u0[3]));
                w.z = cvt_pk_bf16(silu_mul(g1[0], u1[0]), silu_mul(g1[1], u1[1])); w.w = cvt_pk_bf16(silu_mul(g1[2], u1[2]), silu_mul(g1[3], u1[3]));
                *(PG8_GAS u32x4*)rowp = w; }
    }
};
struct EpiResAdd {
    static constexpr bool PERM = true, AFTER_DRAIN = false, MID = false; static constexpr int ID = 1;
    float scale; int slot; int fin;
    __device__ __forceinline__ void operator()(const f32x4 (&acc)[2][2][4][2], const Unit& u, int wr, int wc, int fr, int fq) const {
        PG8_GAS unsigned char* w = (PG8_GAS unsigned char*)tab_ptr(22); PG8_GAS bf16_t* hb = (PG8_GAS bf16_t*)(w + WS_HB); PG8_GAS float* out = (PG8_GAS float*)tab_ptr(21);
        PG8_GAS float* ssq = (PG8_GAS float*)(w + WS_SSQ) + (size_t)slot * M_REAL * 32; constexpr int ldc = D;
        const int row0 = u.pm * BM + wr * 64 + fr, col0 = u.pn * BM + wc * 32 + 8 * fq;
        u32x4 bs[2][4][2];
#pragma unroll
        for (int ai = 0; ai < 2; ++ai)
#pragma unroll
            for (int m = 0; m < 4; ++m)
#pragma unroll
                for (int bj = 0; bj < 2; ++bj) bs[ai][m][bj] = *(const PG8_GAS u32x4*)(hb + (size_t)(row0 + ai * HALF + m * 16) * ldc + col0 + bj * HALF);
#pragma unroll
        for (int ai = 0; ai < 2; ++ai)
#pragma unroll
            for (int m = 0; m < 4; ++m) { float ss = 0.f; const size_t off = (size_t)(row0 + ai * HALF + m * 16) * ldc + col0;
#pragma unroll
                for (int bj = 0; bj < 2; ++bj) { const u32x4 b = bs[ai][m][bj]; const unsigned bw[4] = {b.x, b.y, b.z, b.w}; float v[8];
#pragma unroll
                    for (int e = 0; e < 4; ++e) { v[2 * e] = __builtin_bit_cast(float, bw[e] << 16) + scale * acc[ai][bj][m][e >> 1][(2 * e) & 3]; v[2 * e + 1] = __builtin_bit_cast(float, bw[e] & 0xffff0000u) + scale * acc[ai][bj][m][e >> 1][(2 * e + 1) & 3]; }
                    if (fin) { *(PG8_GAS f32x4*)(out + off + bj * HALF) = (f32x4){v[0], v[1], v[2], v[3]}; *(PG8_GAS f32x4*)(out + off + bj * HALF + 4) = (f32x4){v[4], v[5], v[6], v[7]}; }
                    else { u32x4 wv; wv.x = cvt_pk_bf16(v[0], v[1]); wv.y = cvt_pk_bf16(v[2], v[3]); wv.z = cvt_pk_bf16(v[4], v[5]); wv.w = cvt_pk_bf16(v[6], v[7]); *(PG8_GAS u32x4*)(hb + off + bj * HALF) = wv;
                        const unsigned ww[4] = {wv.x, wv.y, wv.z, wv.w};
#pragma unroll
                        for (int e = 0; e < 4; ++e) { const float lo = __builtin_bit_cast(float, ww[e] << 16), hi2 = __builtin_bit_cast(float, ww[e] & 0xffff0000u); ss += lo * lo + hi2 * hi2; } } }
                if (!fin) { ss += __shfl_xor(ss, 16); ss += __shfl_xor(ss, 32);
                    if (fq == 0) ssq[(size_t)(row0 + ai * HALF + m * 16) * 32 + u.pn * 4 + wc] = ss; } }
    }
};
__device__ __forceinline__ void ensure_rstd_o(const PG8_GAS float* ssqo, int slot, int pm, int wid, int wr, int lane, const PG8_LAS float*& rs_out, const PG8_LAS float*& ratio_out) {
    extern __shared__ __attribute__((aligned(16))) unsigned char lds_dyn_[];
    volatile PG8_LAS unsigned* idw = (volatile PG8_LAS unsigned*)((PG8_LAS unsigned char*)lds_dyn_ + RSTD_ID_OFF) + wid;
    PG8_LAS float* rv = (PG8_LAS float*)((PG8_LAS unsigned char*)lds_dyn_ + RSTD_OFF) + wid * 128;
    PG8_LAS float* rq = (PG8_LAS float*)((PG8_LAS unsigned char*)lds_dyn_ + RSTD2_OFF) + wid * 128;
    const unsigned want = ((0x4000u | (unsigned)(slot + 1)) << 16) | (unsigned)(pm + 1);
    if ((unsigned)__builtin_amdgcn_readfirstlane(*idw) != want) {
#pragma unroll
        for (int j = 0; j < 2; ++j) { const int row = pm * BM + HALF * j + 64 * wr + lane; const PG8_GAS f32x4* pp = (const PG8_GAS f32x4*)(ssqo + (size_t)row * 32); float tf = 0.f, ts = 0.f;
#pragma unroll
            for (int q = 0; q < 4; ++q) { const f32x4 a = pp[q], b = pp[4 + q]; tf += (a[0] + a[1]) + (a[2] + a[3]); ts += (b[0] + b[1]) + (b[2] + b[3]); }
            const float rf = 1.0f / sqrtf(tf * (1.0f / 1024.0f) + 1e-6f), rs = 1.0f / sqrtf(ts * (1.0f / 1024.0f) + 1e-6f);
            rv[64 * j + lane] = rs; rq[64 * j + lane] = rf / rs; }
        if (lane == 0) *idw = want;
        asm volatile("s_waitcnt lgkmcnt(0)" ::: "memory");
    }
    rs_out = rv; ratio_out = rq;
}
struct EpiOut {
    static constexpr bool PERM = true, AFTER_DRAIN = false, MID = true; static constexpr int ID = 3;
    int slot;
    __device__ __forceinline__ void mid(f32x4 (&acc)[2][2][4][2], const Unit& u, int wr, int wc, int fr, int fq) const {
        PG8_GAS unsigned char* w = (PG8_GAS unsigned char*)tab_ptr(22); const PG8_LAS float *rs, *rq; ensure_rstd_o((const PG8_GAS float*)(w + WS_SSQO), slot, u.pm, wr * 4 + wc, wr, fr + 16 * fq, rs, rq);
#pragma unroll
        for (int ai = 0; ai < 2; ++ai)
#pragma unroll
            for (int m = 0; m < 4; ++m) { const float q = rq[64 * ai + 16 * m + fr];
#pragma unroll
                for (int bj = 0; bj < 2; ++bj)
#pragma unroll
                    for (int n = 0; n < 2; ++n) acc[ai][bj][m][n] = acc[ai][bj][m][n] * q; }
    }
    __device__ __forceinline__ void operator()(const f32x4 (&acc)[2][2][4][2], const Unit& u, int wr, int wc, int fr, int fq) const {
        PG8_GAS unsigned char* w = (PG8_GAS unsigned char*)tab_ptr(22); PG8_GAS bf16_t* hb = (PG8_GAS bf16_t*)(w + WS_HB);
        PG8_GAS float* ssq = (PG8_GAS float*)(w + WS_SSQ) + (size_t)slot * M_REAL * 32; constexpr int ldc = D;
        const PG8_LAS float *rs, *rq; ensure_rstd_o((const PG8_GAS float*)(w + WS_SSQO), slot, u.pm, wr * 4 + wc, wr, fr + 16 * fq, rs, rq);
        const int row0 = u.pm * BM + wr * 64 + fr, col0 = u.pn * BM + wc * 32 + 8 * fq;
        u32x4 bs[2][4][2];
#pragma unroll
        for (int ai = 0; ai < 2; ++ai)
#pragma unroll
            for (int m = 0; m < 4; ++m)
#pragma unroll
                for (int bj = 0; bj < 2; ++bj) bs[ai][m][bj] = *(const PG8_GAS u32x4*)(hb + (size_t)(row0 + ai * HALF + m * 16) * ldc + col0 + bj * HALF);
#pragma unroll
        for (int ai = 0; ai < 2; ++ai)
#pragma unroll
            for (int m = 0; m < 4; ++m) { float ss = 0.f; const size_t off = (size_t)(row0 + ai * HALF + m * 16) * ldc + col0; const float scale = rs[64 * ai + 16 * m + fr];
#pragma unroll
                for (int bj = 0; bj < 2; ++bj) { const u32x4 b = bs[ai][m][bj]; const unsigned bw[4] = {b.x, b.y, b.z, b.w}; float v[8];
#pragma unroll
                    for (int e = 0; e < 4; ++e) { v[2 * e] = __builtin_bit_cast(float, bw[e] << 16) + scale * acc[ai][bj][m][e >> 1][(2 * e) & 3]; v[2 * e + 1] = __builtin_bit_cast(float, bw[e] & 0xffff0000u) + scale * acc[ai][bj][m][e >> 1][(2 * e + 1) & 3]; }
                    u32x4 wv; wv.x = cvt_pk_bf16(v[0], v[1]); wv.y = cvt_pk_bf16(v[2], v[3]); wv.z = cvt_pk_bf16(v[4], v[5]); wv.w = cvt_pk_bf16(v[6], v[7]); *(PG8_GAS u32x4*)(hb + off + bj * HALF) = wv;
                    const unsigned ww[4] = {wv.x, wv.y, wv.z, wv.w};
#pragma unroll
                    for (int e = 0; e < 4; ++e) { const float lo = __builtin_bit_cast(float, ww[e] << 16), hi2 = __builtin_bit_cast(float, ww[e] & 0xffff0000u); ss += lo * lo + hi2 * hi2; } }
                ss += __shfl_xor(ss, 16); ss += __shfl_xor(ss, 32);
                if (fq == 0) ssq[(size_t)(row0 + ai * HALF + m * 16) * 32 + u.pn * 4 + wc] = ss; }
    }
};
struct EpiInProj {
    static constexpr bool PERM = true, AFTER_DRAIN = false, MID = false; static constexpr int ID = 2;
    int ll, slot; float qscale;
    __device__ __forceinline__ void operator()(const f32x4 (&acc)[2][2][4][2], const Unit& u, int wr, int wc, int fr, int fq) const {
        PG8_GAS unsigned char* w = (PG8_GAS unsigned char*)tab_ptr(22); const PG8_GAS float* ssq = (const PG8_GAS float*)(w + WS_SSQ) + (size_t)slot * M_REAL * 32;
        PG8_GAS bf16_t *fq_ = (PG8_GAS bf16_t*)(w + WS_FQ), *fk_ = (PG8_GAS bf16_t*)(w + WS_FK), *fv_ = (PG8_GAS bf16_t*)(w + WS_FV), *sq_ = (PG8_GAS bf16_t*)(w + WS_SQ), *sk_ = (PG8_GAS bf16_t*)(w + WS_SK), *sv_ = (PG8_GAS bf16_t*)(w + WS_SV); PG8_GAS float* logf = (PG8_GAS float*)(w + WS_LOGF);
        const PG8_GAS float *g_fq = (const PG8_GAS float*)tab_ptr(9) + ll * HD, *g_fk = (const PG8_GAS float*)tab_ptr(10) + ll * HD, *g_sq = (const PG8_GAS float*)tab_ptr(11) + ll * HD, *g_sk = (const PG8_GAS float*)tab_ptr(12) + ll * HD, *bfg = (const PG8_GAS float*)tab_ptr(8) + ll * NH;
        const int row0 = u.pm * BM + wr * 64 + fr, pn = u.pn;
        if (pn == 17 && wc != 0) return;
        const PG8_LAS float* rv = ensure_rstd(ssq, slot, u.pm, wr * 4 + wc, wr, fr + 16 * fq);
        float rs[2][4];
#pragma unroll
        for (int ai = 0; ai < 2; ++ai)
#pragma unroll
            for (int m = 0; m < 4; ++m) rs[ai][m] = rv[64 * ai + 16 * m + fr];
        if (pn == 17) {
            if (wc != 0) return;
            if (fq < 2) {
                const f32x4 b0 = *(const PG8_GAS f32x4*)(bfg + 8 * fq), b1 = *(const PG8_GAS f32x4*)(bfg + 8 * fq + 4);
#pragma unroll
                for (int ai = 0; ai < 2; ++ai)
#pragma unroll
                    for (int m = 0; m < 4; ++m) { PG8_GAS float* rowp = logf + (size_t)(row0 + ai * HALF + m * 16) * 16 + 8 * fq;
#pragma unroll
                        for (int n = 0; n < 2; ++n) { f32x4 t = acc[ai][0][m][n] * rs[ai][m] + (n ? b1 : b0), o;
#pragma unroll
                            for (int j = 0; j < 4; ++j) o[j] = fminf(t[j], 0.f) - 0.69314718056f * __builtin_amdgcn_logf(1.0f + __builtin_amdgcn_exp2f(-1.4426950408889634f * fabsf(t[j])));
                            *(PG8_GAS f32x4*)(rowp + 4 * n) = o; } }
            }
            return;
        }
        PG8_GAS bf16_t* dst; int pitch, head, knh = 0; const PG8_GAS float* gain = nullptr; float sc = 1.f;
        if (pn < 16) { const int seg = pn >> 2; head = (pn & 3) * 4 + wc; pitch = 1024;
            if (seg == 0) { dst = fq_; gain = g_fq; sc = qscale; } else if (seg == 1) { dst = fk_; gain = g_fk; knh = 16; } else if (seg == 2) { dst = fv_; } else { dst = sq_; gain = g_sq; sc = qscale; } }
        else { pitch = 128; head = wc & 1; if (wc < 2) { dst = sk_; gain = g_sk; knh = 2; } else { dst = sv_; } }
        const int col0 = head * 64 + 8 * fq;
        if (gain) {
            f32x4 gv[2][2];
#pragma unroll
            for (int bj = 0; bj < 2; ++bj)
#pragma unroll
                for (int n = 0; n < 2; ++n) gv[bj][n] = *(const PG8_GAS f32x4*)(gain + 32 * bj + 8 * fq + 4 * n) * sc;
#pragma unroll
            for (int ai = 0; ai < 2; ++ai)
#pragma unroll
                for (int m = 0; m < 4; ++m) {
                    float ss = 0.f;
#pragma unroll
                    for (int bj = 0; bj < 2; ++bj)
#pragma unroll
                        for (int n = 0; n < 2; ++n) { const f32x4 x = acc[ai][bj][m][n]; ss += (x[0] * x[0] + x[1] * x[1]) + (x[2] * x[2] + x[3] * x[3]); }
                    ss += __shfl_xor(ss, 16); ss += __shfl_xor(ss, 32);
                    const float rinv = rs[ai][m] / sqrtf(ss * (1.0f / 64.0f) * rs[ai][m] * rs[ai][m] + 1e-6f);
                    const int row = row0 + ai * HALF + m * 16;
                    PG8_GAS bf16_t* rowp = dst + (size_t)row * pitch + col0;
#pragma unroll
                    for (int bj = 0; bj < 2; ++bj) { const f32x4 v0 = acc[ai][bj][m][0] * rinv * gv[bj][0], v1 = acc[ai][bj][m][1] * rinv * gv[bj][1];
                        u32x4 w; w.x = cvt_pk_bf16(v0[0], v0[1]); w.y = cvt_pk_bf16(v0[2], v0[3]); w.z = cvt_pk_bf16(v1[0], v1[1]); w.w = cvt_pk_bf16(v1[2], v1[3]);
                        if (knh) *(PG8_GAS u32x4*)(dst + kfrag_idx(row, knh, head, 32 * bj + 8 * fq)) = w;
                        else *(PG8_GAS u32x4*)(rowp + 32 * bj) = w; }
                }
        } else {
#pragma unroll
            for (int ai = 0; ai < 2; ++ai)
#pragma unroll
                for (int m = 0; m < 4; ++m) { const int row = row0 + ai * HALF + m * 16; const int vnh = (pn < 16) ? 16 : 2;
#pragma unroll
                    for (int bj = 0; bj < 2; ++bj) { const f32x4 v0 = acc[ai][bj][m][0] * rs[ai][m], v1 = acc[ai][bj][m][1] * rs[ai][m];
                        const unsigned wv[4] = {cvt_pk_bf16(v0[0], v0[1]), cvt_pk_bf16(v0[2], v0[3]), cvt_pk_bf16(v1[0], v1[1]), cvt_pk_bf16(v1[2], v1[3])};
                        PG8_GAS bf16_t* vp = dst + vfrag_idx(row, vnh, head, 32 * bj + 8 * fq);
#pragma unroll
                        for (int e = 0; e < 4; ++e) { vp[16 * e] = (bf16_t)(wv[e] & 0xffffu); vp[16 * e + 8] = (bf16_t)(wv[e] >> 16); } } }
        }
    }
};

}

#define XB_TMO      128
#define XB_XCNT(j)  (256  + 64 * (j))
#define XB_XSUB(j)  (1280 + 64 * (j))
#define XB_XGEN(j)  (2304 + 64 * (j))
#define XB_TOP      3328
#define XB_TOPGEN   3392
#define XCD_BAR_WORDS 3456
#define XB_SPIN_CAP (1u << 18)
__device__ __forceinline__ unsigned xb_ld(unsigned* p)              { return __hip_atomic_load(p, __ATOMIC_RELAXED, __HIP_MEMORY_SCOPE_AGENT); }
__device__ __forceinline__ unsigned xb_add(unsigned* p, unsigned v) { return __hip_atomic_fetch_add(p, v, __ATOMIC_RELAXED, __HIP_MEMORY_SCOPE_AGENT); }
__device__ __forceinline__ unsigned xb_xcc_id() { return (unsigned)__builtin_amdgcn_s_getreg((3 << 11) | 20) & 0xFu; }
#define XB_SPIN(cond, bar) do { unsigned _sp = 0; while (cond) { __builtin_amdgcn_s_sleep(1); \
    if ((++_sp & 255u) == 0u) { if (xb_ld(&(bar)[XB_TMO])) break; if (_sp > XB_SPIN_CAP) { atomicAdd(&(bar)[XB_TMO], 1u); break; } } } } while (0)
struct XcdBarrier { unsigned* bar; unsigned x; volatile LAS unsigned* st; };
__device__ __forceinline__ XcdBarrier xcd_barrier_post(unsigned* bar, volatile LAS unsigned* st) {
    XcdBarrier b; b.bar = bar; b.x = xb_xcc_id(); b.st = st;
    if (threadIdx.x == 0) (void)xb_add(&bar[XB_XCNT(b.x)], 1u);
    return b;
}
__device__ __forceinline__ void xcd_barrier_complete(unsigned* bar, unsigned x, unsigned& nloc, unsigned& nx) {
    const unsigned G = gridDim.x * gridDim.y * gridDim.z;
    unsigned sum, cnt, mine, sp = 0u;
    for (;;) {
        sum = 0u; cnt = 0u; mine = 0u;
#pragma unroll
        for (unsigned j = 0; j < 16; ++j) { const unsigned c = xb_ld(&bar[XB_XCNT(j)]); sum += c; cnt += (c > 0u) ? 1u : 0u; mine = (j == x) ? c : mine; }
        if (sum == G) break;
        __builtin_amdgcn_s_sleep(1);
        if ((++sp & 255u) == 0u) { if (xb_ld(&bar[XB_TMO])) break; if (sp > XB_SPIN_CAP) { atomicAdd(&bar[XB_TMO], 1u); break; } }
    }
    nloc = mine > 0u ? mine : 1u; nx = cnt > 0u ? cnt : 1u;
}
__device__ __forceinline__ void xcd_barrier(const XcdBarrier& b) {
    asm volatile("s_waitcnt vmcnt(0)" ::: "memory");
    __syncthreads();
    if (my_tid() == 0) {
        unsigned* bar = b.bar;
        __builtin_amdgcn_s_waitcnt(0);
        unsigned nloc = b.st[0], nx = b.st[1];
        if (nloc == 0u) { xcd_barrier_complete(bar, b.x, nloc, nx); b.st[0] = nloc; b.st[1] = nx; }
        const unsigned old = xb_add(&bar[XB_XSUB(b.x)], 1u);
        const unsigned gen = old / nloc;
        if (old + 1u == (gen + 1u) * nloc) {
            __builtin_amdgcn_fence(__ATOMIC_RELEASE, "agent");
            asm volatile("s_waitcnt vmcnt(0)" ::: "memory");
            const unsigned og = xb_add(&bar[XB_TOP], 1u);
            const unsigned tg = og / nx;
            if (og + 1u == (tg + 1u) * nx) xb_add(&bar[XB_TOPGEN], 1u);
            else XB_SPIN(xb_ld(&bar[XB_TOPGEN]) == tg, bar);
            __builtin_amdgcn_fence(__ATOMIC_ACQUIRE, "agent");
            xb_add(&bar[XB_XGEN(b.x)], 1u);
            asm volatile("s_waitcnt vmcnt(0)" ::: "memory");
        } else {
            XB_SPIN(xb_ld(&bar[XB_XGEN(b.x)]) == gen, bar);
            __builtin_amdgcn_fence(__ATOMIC_ACQUIRE, "agent");
            asm volatile("s_waitcnt vmcnt(0)" ::: "memory");
        }
    }
    __syncthreads();
}

struct Frame {
    LAS unsigned char* lds;
    volatile LAS unsigned* MISC;
    int tid, lane, wave;
    int vcu, G;
    unsigned char* ws;
};
__device__ __forceinline__ int launder_u(int x) { asm volatile("" : "+v"(x)); return __builtin_amdgcn_readfirstlane(x); }
#define LAUNDER_S(x) ((x) = launder_u(x))
__device__ __forceinline__ const float* inptr(const Frame& F, int k) {
    const volatile LAS unsigned* t = (const volatile LAS unsigned*)(F.lds + PTR_OFF);
    const unsigned lo = __builtin_amdgcn_readfirstlane(t[2 * k]), hi = __builtin_amdgcn_readfirstlane(t[2 * k + 1]);
    return (const float*)(((unsigned long long)hi << 32) | lo);
}
__device__ __forceinline__ unsigned char* wsl(const Frame& F) { const unsigned long long p = (unsigned long long)F.ws; const unsigned lo = (unsigned)launder_u((int)(unsigned)p), hi = (unsigned)launder_u((int)(unsigned)(p >> 32)); return (unsigned char*)(((unsigned long long)hi << 32) | lo); }
__device__ __forceinline__ Frame make_frame() {
    extern __shared__ __attribute__((aligned(16))) unsigned char lds_dyn_[];
    Frame F;
    F.lds = (LAS unsigned char*)lds_dyn_;
    F.MISC = (volatile LAS unsigned*)(F.lds + MISC_OFF);
    int t = my_tid(); asm volatile("" : "+v"(t));
    F.tid = t; F.lane = t & 63; F.wave = __builtin_amdgcn_readfirstlane(t >> 6);
    const int g = launder_u((int)gridDim.x), bx = launder_u((int)blockIdx.x);
    F.G = g; F.vcu = (g % 8 == 0) ? (bx % 8) * (g / 8) + bx / 8 : bx;
    F.ws = (unsigned char*)pg8::tab_ptr(22);
    return F;
}
__device__ __forceinline__ float wave_sum(float v) {
#pragma unroll
    for (int o = 1; o < 64; o <<= 1) v += __shfl_xor(v, o);
    return v;
}

constexpr int TP_PITCH = 144;
__device__ __forceinline__ void transpose_item64(const float* Wf, int Nsrc, int ca, int nva, int cb, int nvb, int K, bf16* WTf, int drow0, int k0, LAS unsigned char* scr, int lane, const float* gainf = nullptr) {
    const GAS float* W = (const GAS float*)Wf; GAS bf16* WT = (GAS bf16*)WTf;
    const int sub = (lane >> 3) & 1, c4 = 4 * (lane & 7), g = lane >> 4, nl = 32 * sub + c4;
    const bool ok = c4 < (sub ? nvb : nva);
    const GAS float* src = W + (size_t)(k0 + 2 * g) * Nsrc + (sub ? cb : ca) + c4;
    f32x4 v[16];
#pragma unroll
    for (int i = 0; i < 16; ++i) v[i] = ok ? *(const GAS f32x4*)(src + (size_t)(8 * (i >> 1) + (i & 1)) * Nsrc) : (f32x4){0.f, 0.f, 0.f, 0.f};
    if (gainf) { const GAS float* gp = (const GAS float*)gainf + k0 + 2 * g;
#pragma unroll
        for (int i = 0; i < 16; ++i) v[i] = v[i] * gp[8 * (i >> 1) + (i & 1)]; }
#pragma unroll
    for (int m = 0; m < 8; ++m)
#pragma unroll
        for (int j = 0; j < 4; ++j) *(LAS unsigned*)(scr + (nl + j) * TP_PITCH + (8 * m + 2 * g) * 2) = pk2(v[2 * m][j], v[2 * m + 1][j]);
    LDS_WAIT(); asm volatile("" ::: "memory");
#pragma unroll
    for (int t = 0; t < 8; ++t) { const int id = lane + 64 * t, n = id >> 3, c = id & 7;
        const v4u o = *(const LAS v4u*)(scr + n * TP_PITCH + 16 * c);
        *(GAS v4u*)(WT + (size_t)(drow0 + n) * K + k0 + 8 * c) = o; }
    LDS_WAIT(); asm volatile("" ::: "memory");
}
constexpr int IT_GU = (D / 64) * (N_GU / 64), IT_D = (FF / 64) * (D / 64), IT_IN = (D / 64) * (N_IN / 64), IT_OUT = (D / 64) * (D / 64);
constexpr int IT_LAYER = 2 * IT_GU + 2 * IT_D + IT_IN + IT_OUT;
__device__ __forceinline__ void conv_gu(const float* Wg, const float* Wu, bf16* WT, int r, LAS unsigned char* scr, int lane, const float* gain) {
    constexpr int nrg = N_GU / 64; const int kb = r / nrg, rg = r % nrg, p = rg >> 2, q = rg & 3; const int c0 = 128 * p + 64 * (q & 1);
    transpose_item64(q < 2 ? Wg : Wu, FF, c0, 32, c0 + 32, 32, D, WT, 64 * rg, 64 * kb, scr, lane, gain);
}
__device__ __forceinline__ void conv_plain(const float* W, int K, int N, bf16* WT, int r, LAS unsigned char* scr, int lane, const float* gain_lo = nullptr, const float* gain_hi = nullptr) {
    const int nrg = N / 64, kb = r / nrg, rg = r % nrg;
    const float* gain = gain_lo ? (64 * kb < 1024 ? gain_lo : gain_hi - 1024) : nullptr;
    transpose_item64(W, N, 64 * rg, 32, 64 * rg + 32, 32, K, WT, 64 * rg, 64 * kb, scr, lane, gain);
}
__device__ __forceinline__ int in_src_col(int pn, int wc, int bj) {
    if (pn < 16) { const int seg = pn >> 2, base = seg == 0 ? 0 : seg == 1 ? 1024 : seg == 2 ? 2048 : 3088; return base + 256 * (pn & 3) + 64 * wc + 32 * bj; }
    return (wc < 2 ? 4112 + 64 * wc : 4240 + 64 * (wc - 2)) + 32 * bj;
}
__device__ __forceinline__ void conv_in(const float* W, bf16* WT, int r, LAS unsigned char* scr, int lane, const float* gain) {
    constexpr int nrg = N_IN / 64; const int kb = r / nrg, rg = r % nrg, pn = rg >> 2, q = rg & 3, bj = q >> 1, wc0 = 2 * (q & 1);
    int ca, cb, nva = 32, nvb = 32;
    if (pn < 17) { ca = in_src_col(pn, wc0, bj); cb = in_src_col(pn, wc0 + 1, bj); }
    else { ca = 3072; cb = 3072; nva = (q == 0) ? 16 : 0; nvb = 0; }
    transpose_item64(W, IN_W, ca, nva, cb, nvb, D, WT, 64 * rg, 64 * kb, scr, lane, gain);
}
__device__ __forceinline__ void convert_item(Frame& F, unsigned char* w, int l, int r, LAS unsigned char* scr) {
    unsigned char* wl = w + WS_W + (size_t)l * LW_STRIDE;
    if (r < IT_GU) { conv_gu(inptr(F, 3) + (size_t)l * D * FF, inptr(F, 4) + (size_t)l * D * FF, (bf16*)(wl + LW_GU1), r, scr, F.lane, inptr(F, 2) + (size_t)l * D); return; } r -= IT_GU;
    if (r < IT_D) { conv_plain(inptr(F, 5) + (size_t)l * FF * D, FF, D, (bf16*)(wl + LW_D1), r, scr, F.lane); return; } r -= IT_D;
    if (r < IT_IN) { conv_in(inptr(F, 7) + (size_t)l * D * IN_W, (bf16*)(wl + LW_IN), r, scr, F.lane, inptr(F, 6) + (size_t)l * D); return; } r -= IT_IN;
    if (r < IT_OUT) { conv_plain(inptr(F, 16) + (size_t)l * D * D, D, D, (bf16*)(wl + LW_OUT), r, scr, F.lane, inptr(F, 14) + (size_t)l * 1024, inptr(F, 15) + (size_t)l * 1024); return; } r -= IT_OUT;
    if (r < IT_GU) { conv_gu(inptr(F, 18) + (size_t)l * D * FF, inptr(F, 19) + (size_t)l * D * FF, (bf16*)(wl + LW_GU2), r, scr, F.lane, inptr(F, 17) + (size_t)l * D); return; } r -= IT_GU;
    conv_plain(inptr(F, 20) + (size_t)l * FF * D, FF, D, (bf16*)(wl + LW_D2), r, scr, F.lane);
}
#define IDLE_CONV_K 4
constexpr int R_IDLE = IDLE_CONV_K * 128 * NWAVES, GU2_BASE = IT_GU + IT_D + IT_IN + IT_OUT;
static_assert(R_IDLE <= IT_GU, "idle-slot items are SwiGLU-2 items");
__device__ __forceinline__ void convert_layer(Frame& F, unsigned char* w, int l) {
    LAS unsigned char* scr = F.lds + RING_OFF + F.wave * 16384;
    const int gw = F.vcu * NWAVES + F.wave, NGW = F.G * NWAVES;
    if (F.G == 256) { for (int q = gw; q < IT_LAYER - R_IDLE; q += NGW) convert_item(F, w, l, q < GU2_BASE ? q : q + R_IDLE, scr); }
    else for (int r = gw; r < IT_LAYER; r += NGW) convert_item(F, w, l, r, scr);
}
__device__ __forceinline__ void p0_prologue(Frame& F) {
    const int gw = F.vcu * NWAVES + F.wave, NGW = F.G * NWAVES;
    unsigned char* w = wsl(F);
    for (int l = 0; l < (OVERLAP_CONV ? 1 : DEPTH); ++l) convert_layer(F, w, l);
    const GAS float* x = (const GAS float*)inptr(F, 0); const GAS float* meta = (const GAS float*)inptr(F, 1);
    GAS bf16* HB = (GAS bf16*)(w + WS_HB); GAS float* SSQ0 = (GAS float*)(w + WS_SSQ); GAS float* SSQM0 = (GAS float*)(w + WS_SSQM);
    for (int m = gw; m < M_REAL + NMETA; m += NGW) {
        const int row = m < M_REAL ? m : META_ROW + (m - M_REAL);
        GAS unsigned long long* hb8 = (GAS unsigned long long*)(HB + (size_t)row * D) + F.lane;
        const GAS f32x4* xr = (const GAS f32x4*)(m < M_REAL ? x + (size_t)m * D : meta + (size_t)(m - M_REAL) * D) + F.lane;
        float ss = 0.f;
#pragma unroll
        for (int j = 0; j < 8; ++j) { const f32x4 v = xr[64 * j]; const unsigned w0 = pk2(v.x, v.y), w1 = pk2(v.z, v.w); hb8[64 * j] = (unsigned long long)w0 | ((unsigned long long)w1 << 32);
            const float a0 = __builtin_bit_cast(float, w0 << 16), a1 = __builtin_bit_cast(float, w0 & 0xffff0000u), a2 = __builtin_bit_cast(float, w1 << 16), a3 = __builtin_bit_cast(float, w1 & 0xffff0000u);
            ss += (a0 * a0 + a1 * a1) + (a2 * a2 + a3 * a3); }
        ss = wave_sum(ss);
        if (m < M_REAL) { if (F.lane < 32) SSQ0[(size_t)m * 32 + F.lane] = F.lane == 0 ? ss : 0.f; }
        else { SSQM0[(m - M_REAL) * 128 + F.lane] = F.lane == 0 ? ss : 0.f; SSQM0[(m - M_REAL) * 128 + 64 + F.lane] = 0.f; }
    }
    if (gw < 48) { const int row = META_BLK0 + 64 + gw; const v4u z = (v4u){0u, 0u, 0u, 0u};
#pragma unroll
        for (int j = 0; j < 2; ++j) { ((GAS v4u*)(w + WS_FQ + (size_t)row * 2048))[F.lane + 64 * j] = z;
            ((GAS v4u*)(w + WS_SQ + (size_t)row * 2048))[F.lane + 64 * j] = z; } }
    {
        const v4u z = (v4u){0u, 0u, 0u, 0u}; constexpr int RB = (META_BLK0 + 64) >> 5;
        GAS v4u* fk = (GAS v4u*)((GAS bf16*)(w + WS_FK) + (size_t)RB * 16 * 2048); GAS v4u* sk = (GAS v4u*)((GAS bf16*)(w + WS_SK) + (size_t)RB * 2 * 2048);
        for (int i = gw * 64 + F.lane; i < 2 * 16 * 256; i += NGW * 64) fk[i] = z;
        for (int i = gw * 64 + F.lane; i < 2 * 2 * 256; i += NGW * 64) sk[i] = z;
        constexpr int G16 = (META_BLK0 + 64) >> 4;
        GAS v4u* fv = (GAS v4u*)((GAS bf16*)(w + WS_FV) + (size_t)G16 * 16 * 1024); GAS v4u* sv = (GAS v4u*)((GAS bf16*)(w + WS_SV) + (size_t)G16 * 2 * 1024);
        for (int i = gw * 64 + F.lane; i < 4 * 16 * 128; i += NGW * 64) fv[i] = z;
        for (int i = gw * 64 + F.lane; i < 4 * 2 * 128; i += NGW * 64) sv[i] = z; }
}
__device__ __forceinline__ void onorm_phase(Frame& F, const float* gf, const float* gs) {
    const int gw = F.vcu * NWAVES + F.wave, NGW = F.G * NWAVES;
    unsigned char* w = wsl(F); const GAS bf16* O = (const GAS bf16*)(w + WS_O); GAS bf16* XN = (GAS bf16*)(w + WS_XN);
    for (int mm = gw; mm < M_REAL + NMETA; mm += NGW) {
        const int m = mm < M_REAL ? mm : META_ROW + (mm - M_REAL);
        const GAS v4u* orow = (const GAS v4u*)(O + (size_t)m * D) + F.lane;
        GAS v4u* xrow = (GAS v4u*)(XN + (size_t)m * D) + F.lane;
        float x[4][8]; float sf = 0.f, ss = 0.f;
#pragma unroll
        for (int j = 0; j < 4; ++j) { const v4u w = orow[64 * j]; const unsigned ww[4] = {w.x, w.y, w.z, w.w};
#pragma unroll
            for (int e = 0; e < 4; ++e) { x[j][2 * e] = __builtin_bit_cast(float, ww[e] << 16); x[j][2 * e + 1] = __builtin_bit_cast(float, ww[e] & 0xffff0000u); }
            float q = 0.f;
#pragma unroll
            for (int e = 0; e < 8; ++e) q += x[j][e] * x[j][e];
            if (j < 2) sf += q; else ss += q; }
        const float rf = 1.0f / sqrtf(wave_sum(sf) * (1.0f / 1024.f) + EPS), rs = 1.0f / sqrtf(wave_sum(ss) * (1.0f / 1024.f) + EPS);
#pragma unroll
        for (int j = 0; j < 4; ++j) { const float* gp = (j < 2 ? gf : gs) + (j & 1) * 512 + 8 * F.lane; const f32x4 g0 = *(const GAS f32x4*)gp, g1 = *(const GAS f32x4*)(gp + 4); const float r = j < 2 ? rf : rs;
            v4u w; w.x = pk2(x[j][0] * r * g0.x, x[j][1] * r * g0.y); w.y = pk2(x[j][2] * r * g0.z, x[j][3] * r * g0.w); w.z = pk2(x[j][4] * r * g1.x, x[j][5] * r * g1.y); w.w = pk2(x[j][6] * r * g1.z, x[j][7] * r * g1.w);
            xrow[64 * j] = w; }
    }
}

constexpr int SK_RED_OFF = 0, SK_TILE_OFF = 65536, SK_RSTD_OFF = SK_TILE_OFF + 4096;
template <class Epi, int NST  >
__device__ __forceinline__ void skinny_phase(Frame& F, const GAS bf16* A, int lda, const GAS bf16* Bt, int K, const Epi& E) {
    constexpr int TC = Epi::TC;
    int lane = F.lane; asm volatile("" : "+v"(lane));
    const int w = F.wave;
    LAS float* red = (LAS float*)(F.lds + RING_OFF + SK_RED_OFF);
    LAS float* tile = (LAS float*)(F.lds + RING_OFF + SK_TILE_OFF);
    const int k0 = w * (NST * 32);
    bool first = true;
    for (int task = F.G - 1 - (int)blockIdx.x; task < E.ntasks(); task += F.G) {
        pg8::f32x4 acc[TC];
        const GAS bf16* bp[TC];
#pragma unroll
        for (int c = 0; c < TC; ++c) { acc[c] = (pg8::f32x4){0.f, 0.f, 0.f, 0.f}; bp[c] = Bt + (size_t)(E.btrow(task, c) + (lane & 15)) * K + k0 + 8 * (lane >> 4); }
        const GAS bf16* ap = A + (size_t)(lane & 15) * lda + k0 + 8 * (lane >> 4);
        bf16x8 av[NST], bv[TC][NST];
#pragma unroll
        for (int j = 0; j < NST; ++j) { av[j] = *(const GAS bf16x8*)(ap + 32 * j);
#pragma unroll
            for (int c = 0; c < TC; ++c) bv[c][j] = *(const GAS bf16x8*)(bp[c] + 32 * j); }
        if (first) {
            if constexpr (Epi::KHALF_SCALE) {
                LAS float* rv = (LAS float*)(F.lds + RING_OFF + SK_RSTD_OFF);
#pragma unroll
                for (int j = 0; j < 2; ++j) { const int row = 2 * w + j; float t = lane < 32 ? E.ssqom[row * 32 + lane] : 0.f;
#pragma unroll
                    for (int o = 1; o < 16; o <<= 1) t += __shfl_xor(t, o);
                    if (lane == 0) rv[row] = 1.0f / sqrtf(t * (1.0f / 1024.0f) + EPS); if (lane == 16) rv[16 + row] = 1.0f / sqrtf(t * (1.0f / 1024.0f) + EPS); }
            }
            if constexpr (Epi::NEED_RSTD) {
                LAS float* rv = (LAS float*)(F.lds + RING_OFF + SK_RSTD_OFF);
#pragma unroll
                for (int j = 0; j < 2; ++j) { const int row = 2 * w + j; const float t = wave_sum(E.ssqm[row * 128 + lane] + E.ssqm[row * 128 + 64 + lane]); if (lane == 0) rv[row] = 1.0f / sqrtf(t * (1.0f / D) + EPS); }
            }
            first = false;
        }
#pragma unroll
        for (int j = 0; j < NST; ++j)
#pragma unroll
            for (int c = 0; c < TC; ++c) acc[c] = __builtin_amdgcn_mfma_f32_16x16x32_bf16(av[j], bv[c][j], acc[c], 0, 0, 0);
#pragma unroll
        for (int c = 0; c < TC; ++c)
#pragma unroll
            for (int r = 0; r < 4; ++r) red[((w * TC + c) * 4 + r) * 64 + lane] = acc[c][r];
        __syncthreads();
        for (int e = F.tid; e < TC * 256; e += NWAVES * 64) { float sum = 0.f, sum2 = 0.f;
#pragma unroll
            for (int w2 = 0; w2 < 4; ++w2) { sum += red[w2 * TC * 256 + e]; sum2 += red[(w2 + 4) * TC * 256 + e]; }
            const int ln = e & 63, r = (e >> 6) & 3, c = e >> 8, orow = (ln >> 4) * 4 + r;
            if constexpr (Epi::KHALF_SCALE) { const LAS float* rv = (const LAS float*)(F.lds + RING_OFF + SK_RSTD_OFF); sum = sum * rv[orow] + sum2 * rv[16 + orow]; } else sum += sum2;
            tile[orow * 64 + 16 * c + (ln & 15)] = sum; }
        __syncthreads();
        E.store(F, task, tile);
        if (task + F.G < E.ntasks()) __syncthreads();
    }
}
struct SkGU {
    static constexpr int TC = 4; static constexpr bool NEED_RSTD = true, KHALF_SCALE = false;
    GAS bf16* act; const GAS float* ssqm;
    __device__ __forceinline__ int ntasks() const { return FF / 32; }
    __device__ __forceinline__ int btrow(int t, int c) const { const int p = t >> 2, q = t & 3; return 256 * p + 128 * (c >> 1) + 32 * q + 16 * (c & 1); }
    __device__ __forceinline__ void store(Frame& F, int t, const LAS float* tile) const {
        const int row = F.tid >> 5, col = F.tid & 31; const float r = ((const LAS float*)(F.lds + RING_OFF + SK_RSTD_OFF))[row];
        act[(size_t)(META_ROW + row) * FF + 32 * t + col] = (bf16)f2bf(pg8::silu_mul(tile[row * 64 + col] * r, tile[row * 64 + 32 + col] * r));
    }
};
struct SkRes {
    static constexpr int TC = 1; static constexpr bool NEED_RSTD = false, KHALF_SCALE = false;
    float scale; GAS bf16* hb; GAS float* ssqm;
    __device__ __forceinline__ int ntasks() const { return D / 16; }
    __device__ __forceinline__ int btrow(int t, int) const { return 16 * t; }
    __device__ __forceinline__ void store(Frame& F, int t, const LAS float* tile) const {
        if (F.tid < 256) { const int row = F.tid >> 4, col = F.tid & 15; const size_t off = (size_t)(META_ROW + row) * D + 16 * t + col;
            const unsigned hbits = f2bf(bf2f(hb[off]) + scale * tile[row * 64 + col]); hb[off] = (bf16)hbits; const float v = bf2f((bf16)hbits); float ss = v * v;
#pragma unroll
            for (int o = 1; o < 16; o <<= 1) ss += __shfl_xor(ss, o);
            if (col == 0) ssqm[row * 128 + t] = ss; }
    }
};
struct SkOut {
    static constexpr int TC = 1; static constexpr bool NEED_RSTD = false, KHALF_SCALE = true;
    float scale; GAS bf16* hb; GAS float* ssqm; const GAS float* ssqom;
    __device__ __forceinline__ int ntasks() const { return D / 16; }
    __device__ __forceinline__ int btrow(int t, int) const { return 16 * t; }
    __device__ __forceinline__ void store(Frame& F, int t, const LAS float* tile) const {
        if (F.tid < 256) { const int row = F.tid >> 4, col = F.tid & 15; const size_t off = (size_t)(META_ROW + row) * D + 16 * t + col;
            const unsigned hbits = f2bf(bf2f(hb[off]) + scale * tile[row * 64 + col]); hb[off] = (bf16)hbits; const float v = bf2f((bf16)hbits); float ss = v * v;
#pragma unroll
            for (int o = 1; o < 16; o <<= 1) ss += __shfl_xor(ss, o);
            if (col == 0) ssqm[row * 128 + t] = ss; }
    }
};
struct SkIn {
    static constexpr int TC = 4; static constexpr bool NEED_RSTD = true, KHALF_SCALE = false;
    GAS bf16 *fq_, *fk_, *fv_, *sq_, *sk_, *sv_; GAS float* logf; const GAS float *g_fq, *g_fk, *g_sq, *g_sk, *bfg; float qscale; const GAS float* ssqm;
    __device__ __forceinline__ int ntasks() const { return 69; }
    __device__ __forceinline__ int btrow(int t, int c) const { if (t == 68) return 17 * 256 + 16 * c; const int pn = t < 64 ? (t >> 2) : 16, wc = t < 64 ? (t & 3) : (t - 64); return 256 * pn + 128 * (c >> 1) + 32 * wc + 16 * (c & 1); }
    __device__ __forceinline__ void store(Frame& F, int t, const LAS float* tile) const {
        if (t == 68) { if (F.tid < 256) { const int row = F.tid >> 4, hh = F.tid & 15; const float z = tile[row * 64 + hh] * ((const LAS float*)(F.lds + RING_OFF + SK_RSTD_OFF))[row] + bfg[hh];
                logf[(size_t)(META_ROW + row) * 16 + hh] = fminf(z, 0.f) - 0.69314718056f * __builtin_amdgcn_logf(1.0f + __builtin_amdgcn_exp2f(-LOG2E * fabsf(z))); } return; }
        const int pn = t < 64 ? (t >> 2) : 16, wc = t < 64 ? (t & 3) : (t - 64);
        GAS bf16* dst; int pitch, head, knh = 0; const GAS float* gain = nullptr; float sc = 1.f;
        if (pn < 16) { const int seg = pn >> 2; head = (pn & 3) * 4 + wc; pitch = 1024;
            if (seg == 0) { dst = fq_; gain = g_fq; sc = qscale; } else if (seg == 1) { dst = fk_; gain = g_fk; knh = 16; } else if (seg == 2) { dst = fv_; } else { dst = sq_; gain = g_sq; sc = qscale; } }
        else { pitch = 128; head = wc & 1; if (wc < 2) { dst = sk_; gain = g_sk; knh = 2; } else { dst = sv_; } }
        const int row = F.tid >> 5, cp = F.tid & 31; const float rr = ((const LAS float*)(F.lds + RING_OFF + SK_RSTD_OFF))[row];
        float v0 = tile[row * 64 + 2 * cp] * rr, v1 = tile[row * 64 + 2 * cp + 1] * rr;
        if (gain) { float ss = v0 * v0 + v1 * v1;
#pragma unroll
            for (int o = 1; o < 32; o <<= 1) ss += __shfl_xor(ss, o);
            const float rinv = 1.0f / sqrtf(ss * (1.0f / 64.0f) + EPS); v0 = v0 * rinv * gain[2 * cp] * sc; v1 = v1 * rinv * gain[2 * cp + 1] * sc; }
        if (knh) *(GAS unsigned*)(dst + kfrag_idx(META_ROW + row, knh, head, 2 * cp)) = pk2(v0, v1);
        else if (!gain) { GAS bf16* vp = dst + vfrag_idx(META_ROW + row, pn < 16 ? 16 : 2, head, 2 * cp); const unsigned pw = pk2(v0, v1); vp[0] = (bf16)(pw & 0xffffu); vp[8] = (bf16)(pw >> 16); }
        else *(GAS unsigned*)(dst + (size_t)(META_ROW + row) * pitch + head * 64 + 2 * cp) = pk2(v0, v1);
    }
};

__device__ __forceinline__ int crow(int r, int hi) { return (r & 3) + 8 * (r >> 2) + 4 * hi; }
typedef short v4i16_t __attribute__((ext_vector_type(4)));
__device__ __forceinline__ float max3f(float a, float b, float c) { return fmaxf(fmaxf(a, b), c); }
constexpr float ATT_THR = 40.0f;
template <int MODE  >
__device__ __forceinline__ void attn_block(Frame& F, unsigned char* w, int b  , int h, int i, const float* sinks) {
    const int lane = F.lane, r32 = lane & 31, hi = lane >> 5;
    const bool meta = b < 0;
    const int qpos0 = meta ? 96 : 128 + 32 * i;
    const int qrow0 = meta ? META_BLK0 + 96 : b * SEQ + 32 * i;
    const int cd = qpos0 >> 6;
    const int cfirst = (MODE == 0) ? (meta ? 1 : __builtin_amdgcn_readfirstlane(((const volatile LAS int*)(F.lds + RING_OFF + ATT_FC_OFF))[i])) : ((qpos0 - 127) < 128 ? 1 : ((qpos0 - 127) >> 6));
    const int kvh = (MODE == 0) ? h : (h >> 3);
    const GAS bf16* Qp = (const GAS bf16*)(w + (MODE == 0 ? WS_FQ : WS_SQ)) + (size_t)qrow0 * 1024 + h * 64;
    const GAS bf16* Kb = (const GAS bf16*)(w + (MODE == 0 ? WS_FK : WS_SK)); constexpr int NHK = (MODE == 0) ? 16 : 2;
    const GAS bf16* Vb = (const GAS bf16*)(w + (MODE == 0 ? WS_FV : WS_SV));
    const LAS float* cl2 = (const LAS float*)(F.lds + RING_OFF + ATT_TAB_OFF);
    const float sl2 = (MODE == 1) ? exp2f(-0.5f * (float)(h + 1)) * LOG2E : 0.f;
    bf16x8 qf[4];
#pragma unroll
    for (int s = 0; s < 4; ++s) qf[s] = *(const GAS bf16x8*)(Qp + (size_t)r32 * 1024 + 16 * s + 8 * hi);
#define CHUNK_ROW(c) ((c) == 1 ? META_BLK0 + 64 : b * SEQ + 64 * ((c) - 2))
    bf16x8 kf[2][4];
    bf16x8 vf[4][2];
#define K_LOAD(rowk_) do { const GAS bf16* kp_ = Kb + ((((size_t)((rowk_) >> 5) * NHK + kvh) * 8 + hi) * 32 + r32) * 8;     \
        _Pragma("unroll") for (int t_ = 0; t_ < 2; ++t_) _Pragma("unroll") for (int s_ = 0; s_ < 4; ++s_) kf[t_][s_] = *(const GAS bf16x8*)(kp_ + ((size_t)t_ * NHK * 8 + 2 * s_) * 256); } while (0)
#define V_LOAD(rowk_) do { const GAS bf16* vp_ = Vb + ((((size_t)((rowk_) >> 4) * NHK + kvh) * 2 + hi) * 64 + r32) * 8;     \
        _Pragma("unroll") for (int g_ = 0; g_ < 4; ++g_) _Pragma("unroll") for (int d_ = 0; d_ < 2; ++d_) vf[g_][d_] = *(const GAS bf16x8*)(vp_ + (size_t)g_ * NHK * 1024 + d_ * 256); } while (0)
    { const int rowk = CHUNK_ROW(cfirst); K_LOAD(rowk); V_LOAD(rowk); }
    float m_run = 0.f, l_run = 0.f; f32x16 o0 = {}, o1 = {};
    const float NEG = -1e30f;
    for (int c = cfirst; c <= cd; ++c) {
        f32x16 p0 = {}, p1 = {};
        __builtin_amdgcn_s_setprio(1);
#pragma unroll
        for (int s = 0; s < 4; ++s) { p0 = __builtin_amdgcn_mfma_f32_32x32x16_bf16(kf[0][s], qf[s], p0, 0, 0, 0); p1 = __builtin_amdgcn_mfma_f32_32x32x16_bf16(kf[1][s], qf[s], p1, 0, 0, 0); }
        __builtin_amdgcn_s_setprio(0);
        if (c < cd) { const int rowk1 = CHUNK_ROW(c + 1); K_LOAD(rowk1); }
        if (MODE == 0) {
#pragma unroll
            for (int g = 0; g < 4; ++g) { const f32x4 cb0 = *(const LAS f32x4*)(cl2 + 64 * c + 8 * g + 4 * hi), cb1 = *(const LAS f32x4*)(cl2 + 64 * c + 32 + 8 * g + 4 * hi);
#pragma unroll
                for (int j = 0; j < 4; ++j) { p0[4 * g + j] = (p0[4 * g + j] - m_run) - cb0[j]; p1[4 * g + j] = (p1[4 * g + j] - m_run) - cb1[j]; } }
            if (c == cd) { const int dq = qpos0 + r32 - 64 * c - 4 * hi;
#pragma unroll
                for (int r = 0; r < 16; ++r) { const int e = (r & 3) + 8 * (r >> 2); if (e > dq) p0[r] = NEG; if (e + 32 > dq) p1[r] = NEG; } }
        } else {
            const float kb0 = (float)(64 * c - qpos0 + 4 * hi) - m_run / sl2;
#pragma unroll
            for (int r = 0; r < 16; ++r) { const float e = (float)((r & 3) + 8 * (r >> 2)); p0[r] = fmaf(sl2, kb0 + e, p0[r]); p1[r] = fmaf(sl2, kb0 + 32.f + e, p1[r]); }
            const int dq = qpos0 + r32 - 64 * c - 4 * hi;
            const int padlim = (c == 1) ? 48 - 4 * hi : -1;
#pragma unroll
            for (int r = 0; r < 16; ++r) { const int e = (r & 3) + 8 * (r >> 2);
                if ((unsigned)(dq - e) >= 128u || e < padlim) p0[r] = NEG;
                if ((unsigned)(dq - e - 32) >= 128u || e + 32 < padlim) p1[r] = NEG; }
        }
        float mx = max3f(p0[0], p0[1], p1[0]);
#pragma unroll
        for (int r = 2; r < 16; r += 2) mx = max3f(mx, p0[r], p0[r + 1]);
#pragma unroll
        for (int r = 1; r < 16; r += 2) mx = max3f(mx, p1[r], (r + 1 < 16) ? p1[r + 1] : p1[r]);
        mx = fmaxf(mx, __shfl_xor(mx, 32));
        const bool first = (c == cfirst);
        if (first || __any(mx > ATT_THR)) {
            const float dl = first ? fmaxf(mx, -200.f) : fmaxf(mx, 0.f);
            m_run += dl;
            const float alpha = first ? 0.f : __builtin_amdgcn_exp2f(-dl);
            l_run *= alpha;
#pragma unroll
            for (int r = 0; r < 16; ++r) { p0[r] -= dl; p1[r] -= dl; }
            if (!first) {
#pragma unroll
                for (int r = 0; r < 16; ++r) { const float ar = __shfl(alpha, crow(r, hi)); o0[r] *= ar; o1[r] *= ar; } }
        }
        float rs = 0.f;
#pragma unroll
        for (int r = 0; r < 16; ++r) { p0[r] = __builtin_amdgcn_exp2f(p0[r]); p1[r] = __builtin_amdgcn_exp2f(p1[r]); rs += p0[r] + p1[r]; }
        rs += __shfl_xor(rs, 32);
        l_run += rs;
#pragma unroll
        for (int t = 0; t < 2; ++t)
#pragma unroll
            for (int s = 0; s < 2; ++s) {
                const f32x16& pp = t ? p1 : p0;
                v4u wq; wq.x = pg8::cvt_pk_bf16(pp[8 * s + 0], pp[8 * s + 1]); wq.y = pg8::cvt_pk_bf16(pp[8 * s + 2], pp[8 * s + 3]); wq.z = pg8::cvt_pk_bf16(pp[8 * s + 4], pp[8 * s + 5]); wq.w = pg8::cvt_pk_bf16(pp[8 * s + 6], pp[8 * s + 7]);
                const bf16x8 pf = __builtin_bit_cast(bf16x8, wq);
                const bf16x8 v0 = vf[2 * t + s][0], v1 = vf[2 * t + s][1];
                o0 = __builtin_amdgcn_mfma_f32_32x32x16_bf16(pf, v0, o0, 0, 0, 0);
                o1 = __builtin_amdgcn_mfma_f32_32x32x16_bf16(pf, v1, o1, 0, 0, 0);
            }
        if (c < cd) { const int rowk1 = CHUNK_ROW(c + 1); V_LOAD(rowk1); }
    }
#undef CHUNK_ROW
#undef V_LOAD
#undef K_LOAD
    if (MODE == 1) l_run += __builtin_amdgcn_exp2f(sinks[h] * LOG2E + sl2 * (float)r32 - m_run);
    const float inv = 1.0f / l_run;
    const int qrow0e = launder_u(qrow0), he = launder_u(h);
    int lane_e = lane; asm volatile("" : "+v"(lane_e)); const int r32e = lane_e & 31, hie = lane_e >> 5;
    GAS bf16* Op = (GAS bf16*)(w + WS_O) + (size_t)qrow0e * D + (MODE == 0 ? 0 : 1024) + he * 64 + r32e;
    GAS float* sqo = meta ? (GAS float*)(w + WS_SSQOM) + (MODE == 0 ? 0 : 16) + he : (GAS float*)(w + WS_SSQO) + (size_t)qrow0e * 32 + (MODE == 0 ? 0 : 16) + he;
#pragma unroll
    for (int r = 0; r < 16; ++r) { const int q = crow(r, hie); float ir = __shfl(inv, q); if (meta && q < 16) ir = 0.f;
        const unsigned b0 = f2bf(o0[r] * ir), b1 = f2bf(o1[r] * ir);
        Op[(size_t)q * D] = (bf16)b0; Op[(size_t)q * D + 32] = (bf16)b1;
        const float v0 = bf2f((bf16)b0), v1 = bf2f((bf16)b1); float ss = v0 * v0 + v1 * v1;
#pragma unroll
        for (int o = 1; o < 32; o <<= 1) ss += __shfl_xor(ss, o);
        if (r32e == 0) { if (!meta) sqo[(size_t)q * 32] = ss; else if (q >= 16) sqo[(size_t)(q - 16) * 32] = ss; } }
}
__device__ __forceinline__ void attn_phase(Frame& F, const float* sinks, int next_layer  , const float* gq, const float* gk) {
    unsigned char* w = wsl(F); const GAS float* LOGF = (const GAS float*)(w + WS_LOGF);
    const int bh = F.vcu >> 1, fb = bh >> 4, fh = bh & 15;
    LAS float* tab = (LAS float*)(F.lds + RING_OFF + ATT_TAB_OFF);
    LAS float* wtot = (LAS float*)(F.lds + RING_OFF + ATT_WTOT_OFF);
    { float v[5]; float tsum = 0.f; const int p0 = 5 * F.tid;
#pragma unroll
      for (int j = 0; j < 5; ++j) { const int p = p0 + j; float x = 0.f;
          if (p >= PADN && p < LPOS) { const int row = p < 128 ? META_BLK0 + p : fb * SEQ + p - 128; x = LOGF[(size_t)row * 16 + fh]; }
          tsum += x; v[j] = tsum; }
      float inc = tsum;
#pragma unroll
      for (int o = 1; o < 64; o <<= 1) { const float t = __shfl_up(inc, o); if (F.lane >= o) inc += t; }
      if (F.lane == 63) wtot[F.wave] = inc;
      __syncthreads();
      float base = inc - tsum;
      for (int w = 0; w < F.wave; ++w) base += wtot[w];
#pragma unroll
      for (int j = 0; j < 5; ++j) { const int p = p0 + j; if (p < LPOS) tab[p] = (p < PADN) ? 1e30f : (base + v[j]) * LOG2E; }
      __syncthreads();
      if (F.wave == 0) { float mq = fabsf(((const GAS float*)gq)[F.lane]), mk = fabsf(((const GAS float*)gk)[F.lane]);
#pragma unroll
          for (int o = 1; o < 64; o <<= 1) { mq = fmaxf(mq, __shfl_xor(mq, o)); mk = fmaxf(mk, __shfl_xor(mk, o)); }
          const float thr = -(152.0f + 2.0f * (64.0f * QSCALE * mq * mk * 1.02f + 1.0f));
          const int q0pos = 128 + 32 * F.lane, cdl = q0pos >> 6; const float tq = tab[q0pos]; int c = 1;
          while (c < cdl && tq - tab[64 * c + 63] < thr) ++c;
          ((LAS int*)(F.lds + RING_OFF + ATT_FC_OFF))[F.lane] = c; }
      __syncthreads(); }
    const bool conv_first = F.wave < 4;
    if (next_layer < DEPTH && conv_first) convert_layer(F, w, next_layer);
    { const int u = 8 * (F.vcu & 1) + F.wave;
      const bool has_meta = F.vcu < 32 && (F.vcu & 1) == 0 && F.wave == 0;
      for (int k = 0; k < (has_meta ? 5 : 4); ++k) { const int i = k == 0 ? u : k == 1 ? 31 - u : k == 2 ? 32 + u : 63 - u; attn_block<0>(F, w, k == 4 ? -1 : fb, fh, k == 4 ? 0 : i, sinks); } }
    { const int gw = F.vcu * NWAVES + F.wave;
      const bool has_meta = F.vcu < 32 && (F.vcu & 1) == 1 && F.wave == 0;
      for (int k = 0; k < (has_meta ? 5 : 4); ++k) { const int T = gw * 4 + k; attn_block<1>(F, w, k == 4 ? -1 : (T >> 10), k == 4 ? (F.vcu >> 1) : ((T >> 6) & 15), k == 4 ? 0 : (T & 63), sinks); } }
    if (next_layer < DEPTH && !conv_first) { Frame F2 = make_frame(); convert_layer(F2, wsl(F2), next_layer); }
}

constexpr int PH_PER_LAYER = 7, N_PHASES = 1 + DEPTH * PH_PER_LAYER;
struct Args { const float* in[21]; float* out; unsigned char* ws; int ph_lo, ph_hi, li, pad; };
__global__ void __launch_bounds__(NWAVES * 64, 2) hymba_fwd(Args args) {
    extern __shared__ __attribute__((aligned(16))) unsigned char lds[];
    {
        LAS unsigned char* l0 = (LAS unsigned char*)lds; const int tid = threadIdx.x;
        for (int u = tid; u < (LDS_BYTES - LDSCTL_OFF) / 4; u += NWAVES * 64) ((LAS unsigned*)(l0 + LDSCTL_OFF))[u] = 0u;
        __syncthreads();
        if ((tid & 63) == 0) ((volatile LAS int*)(l0 + WID_OFF))[hw_wave_key()] = tid >> 6;
        volatile LAS unsigned long long* pt = (volatile LAS unsigned long long*)(l0 + PTR_OFF);
#pragma unroll
        for (int k = 0; k < 21; ++k) if (tid == k) pt[k] = (unsigned long long)args.in[k];
        if (tid == 21) pt[21] = (unsigned long long)args.out;
        if (tid == 22) pt[22] = (unsigned long long)args.ws;
        __syncthreads();
#if !MK_PER_PHASE
        (void)xcd_barrier_post((unsigned*)((gu32*)(args.ws + WS_CTL) + CW_BAR), (volatile LAS unsigned*)(l0 + MISC_OFF) + 8);
#endif
    }
    const int lo = args.ph_lo, hi = args.ph_hi;
#define IN(k) (lo <= (k) && (k) < hi)
#define PROBE_T0() if (PROBE_CLASS == 60 && (PROBE_BLOCK < 0 || (int)blockIdx.x == PROBE_BLOCK) && my_tid() == 0) { *(volatile LAS unsigned long long*)((LAS unsigned char*)lds + MISC_OFF + 72) = __builtin_amdgcn_s_memtime(); } else if (PROBE_CLASS >= 0 && (PROBE_BLOCK < 0 || (int)blockIdx.x == PROBE_BLOCK) && my_tid() == 0) { *(volatile LAS unsigned long long*)((LAS unsigned char*)lds + MISC_OFF + 72) = __builtin_amdgcn_s_memrealtime(); }
#define PROBE_T1(c) if (PROBE_CLASS == 60 && (c) == 2 && (PROBE_BLOCK < 0 || (int)blockIdx.x == PROBE_BLOCK) && my_tid() == 0) { volatile LAS unsigned long long* pa_ = (volatile LAS unsigned long long*)((LAS unsigned char*)lds + MISC_OFF + 64); *pa_ = *pa_ + (__builtin_amdgcn_s_memtime() - *(volatile LAS unsigned long long*)((LAS unsigned char*)lds + MISC_OFF + 72)) / 24ull; } else if (PROBE_CLASS == (c) && (PROBE_BLOCK < 0 || (int)blockIdx.x == PROBE_BLOCK) && my_tid() == 0) { volatile LAS unsigned long long* pa_ = (volatile LAS unsigned long long*)((LAS unsigned char*)lds + MISC_OFF + 64); *pa_ = *pa_ + (__builtin_amdgcn_s_memrealtime() - *(volatile LAS unsigned long long*)((LAS unsigned char*)lds + MISC_OFF + 72)); }
#define SEAM(k) do { if (IN(k) && IN((k) + 1)) { PROBE_T0() unsigned char* wsb_ = (unsigned char*)pg8::tab_ptr(22); \
        if (MK_PER_PHASE) { if (my_tid() == 0) __hip_atomic_store((gu32*)(wsb_ + WS_CTL) + CW_TMO, 0xBADBA0u, RLX_AGENT); } \
        else { XcdBarrier bar_; bar_.bar = (unsigned*)((gu32*)(wsb_ + WS_CTL) + CW_BAR); bar_.x = xb_xcc_id(); bar_.st = (volatile LAS unsigned*)((LAS unsigned char*)lds + MISC_OFF) + 8; xcd_barrier(bar_); if (PROBE_CLASS == 50) xcd_barrier(bar_); } PROBE_T1(8) } } while (0)
#define PHASE_BEGIN(k) if (IN(k)) { PROBE_T0() Frame P = make_frame(); \
        unsigned char* w = wsl(P); int ll = l; LAUNDER_S(ll); unsigned char* wl = w + WS_W + (size_t)ll * LW_STRIDE; (void)wl; int bxl = blockIdx.x; LAUNDER_S(bxl);
#define PHASE_END(k, c) PROBE_T1(c) } SEAM(k);
    typedef pg8::StaticOrder SO;
    if (IN(0)) { PROBE_T0() Frame P = make_frame(); p0_prologue(P); PROBE_T1(0) } SEAM(0);
    for (int l = 0; l < DEPTH; ++l) {
        const int pb = 1 + l * PH_PER_LAYER;
#define SSQ(j) ((GAS float*)(w + WS_SSQM) + (size_t)(3 * ll + (j)) * 16 * 128)
#define HBM ((const GAS bf16*)(w + WS_HB) + (size_t)META_ROW * D)
        PHASE_BEGIN(pb + 0) pg8::Gemm g{(const bf16*)(w + WS_HB), (const bf16*)(wl + LW_GU1), M_REAL, N_GU, D}; SO S; S.init(M_REAL, N_GU, P.G, bxl);
            pg8::EpiSwiGLU E{3 * ll + 0}; pg8::gemm_phase<pg8::EpiSwiGLU, SO, true, true>(P.lds + RING_OFF, g, S, E);
            SkGU K2{(GAS bf16*)(w + WS_ACT), SSQ(0)}; skinny_phase<SkGU, D / 256>(P, HBM, D, (const GAS bf16*)(wl + LW_GU1), D, K2); PHASE_END(pb + 0, 2)
        PHASE_BEGIN(pb + 1) pg8::Gemm g{(const bf16*)(w + WS_ACT), (const bf16*)(wl + LW_D1), M_REAL, D, FF}; SO S; S.init(M_REAL, D, P.G, bxl);
            pg8::EpiResAdd E{0.5f, 3 * ll + 1, 0}; pg8::gemm_phase<pg8::EpiResAdd, SO, true, true>(P.lds + RING_OFF, g, S, E);
            SkRes K2{0.5f, (GAS bf16*)(w + WS_HB), SSQ(1)}; skinny_phase<SkRes, FF / 256>(P, (const GAS bf16*)(w + WS_ACT) + (size_t)META_ROW * FF, FF, (const GAS bf16*)(wl + LW_D1), FF, K2); PHASE_END(pb + 1, 3)
        PHASE_BEGIN(pb + 2) pg8::Gemm g{(const bf16*)(w + WS_HB), (const bf16*)(wl + LW_IN), M_REAL, N_IN, D}; SO S; S.init(M_REAL, N_IN, P.G, bxl);
            pg8::EpiInProj E{ll, 3 * ll + 1, QSCALE};
            pg8::gemm_phase<pg8::EpiInProj, SO, true, true>(P.lds + RING_OFF, g, S, E);
            SkIn K2{(GAS bf16*)(w + WS_FQ), (GAS bf16*)(w + WS_FK), (GAS bf16*)(w + WS_FV), (GAS bf16*)(w + WS_SQ), (GAS bf16*)(w + WS_SK), (GAS bf16*)(w + WS_SV), (GAS float*)(w + WS_LOGF), (const GAS float*)(inptr(P, 9) + ll * HD), (const GAS float*)(inptr(P, 10) + ll * HD), (const GAS float*)(inptr(P, 11) + ll * HD), (const GAS float*)(inptr(P, 12) + ll * HD), (const GAS float*)(inptr(P, 8) + ll * NH), QSCALE, SSQ(1)}; skinny_phase<SkIn, D / 256>(P, HBM, D, (const GAS bf16*)(wl + LW_IN), D, K2);
            if (IDLE_CONV_K > 0 && P.G == 256 && bxl >= 128) { __syncthreads(); LAS unsigned char* scr = P.lds + RING_OFF + P.wave * 16384; const int iw = (bxl - 128) * NWAVES + P.wave;
                for (int k = 0; k < IDLE_CONV_K; ++k) convert_item(P, w, ll, GU2_BASE + iw + k * 128 * NWAVES, scr); }
            PHASE_END(pb + 2, 4)
        PHASE_BEGIN(pb + 3) attn_phase(P, inptr(P, 13) + ll * NH, OVERLAP_CONV ? ll + 1 : DEPTH, inptr(P, 9) + ll * HD, inptr(P, 10) + ll * HD); PHASE_END(pb + 3, 5)
        PHASE_BEGIN(pb + 4) pg8::Gemm g{(const bf16*)(w + WS_O), (const bf16*)(wl + LW_OUT), M_REAL, D, D}; SO S; S.init(M_REAL, D, P.G, bxl);
            pg8::EpiOut E{3 * ll + 2}; pg8::gemm_phase<pg8::EpiOut, SO, true, true>(P.lds + RING_OFF, g, S, E);
            SkOut K2{1.0f, (GAS bf16*)(w + WS_HB), SSQ(2), (const GAS float*)(w + WS_SSQOM)}; skinny_phase<SkOut, D / 256>(P, (const GAS bf16*)(w + WS_O) + (size_t)META_ROW * D, D, (const GAS bf16*)(wl + LW_OUT), D, K2); PHASE_END(pb + 4, 7)
        PHASE_BEGIN(pb + 5) pg8::Gemm g{(const bf16*)(w + WS_HB), (const bf16*)(wl + LW_GU2), M_REAL, N_GU, D}; SO S; S.init(M_REAL, N_GU, P.G, bxl);
            pg8::EpiSwiGLU E{3 * ll + 2}; pg8::gemm_phase<pg8::EpiSwiGLU, SO, true, true>(P.lds + RING_OFF, g, S, E);
            if (ll < DEPTH - 1) { SkGU K2{(GAS bf16*)(w + WS_ACT), SSQ(2)}; skinny_phase<SkGU, D / 256>(P, HBM, D, (const GAS bf16*)(wl + LW_GU2), D, K2); } PHASE_END(pb + 5, 2)
        PHASE_BEGIN(pb + 6) pg8::Gemm g{(const bf16*)(w + WS_ACT), (const bf16*)(wl + LW_D2), M_REAL, D, FF}; SO S; S.init(M_REAL, D, P.G, bxl);
            const bool fin = (ll == DEPTH - 1);
            pg8::EpiResAdd E{0.5f, 3 * ll + 3, fin ? 1 : 0}; pg8::gemm_phase<pg8::EpiResAdd, SO, true, true>(P.lds + RING_OFF, g, S, E);
            if (!fin) { SkRes K2{0.5f, (GAS bf16*)(w + WS_HB), SSQ(3)}; skinny_phase<SkRes, FF / 256>(P, (const GAS bf16*)(w + WS_ACT) + (size_t)META_ROW * FF, FF, (const GAS bf16*)(wl + LW_D2), FF, K2); } PHASE_END(pb + 6, 3)
#undef SSQ
#undef HBM
    }
    if (PROBE_CLASS >= 0 && (PROBE_BLOCK < 0 || (int)blockIdx.x == PROBE_BLOCK) && my_tid() == 0) { const unsigned long long t0 = __builtin_amdgcn_s_memrealtime(), dt = *(volatile LAS unsigned long long*)((LAS unsigned char*)lds + MISC_OFF + 64);
        while (__builtin_amdgcn_s_memrealtime() - t0 < dt) __builtin_amdgcn_s_sleep(8); }
#undef IN
#undef SEAM
#undef PHASE_BEGIN
#undef PHASE_END
}

extern "C" void kernel_launch(void* const* d_in, const int* in_sizes, int n_in, void* d_out, int out_size, void* d_ws, size_t ws_size, hipStream_t stream) {
    static int grid = 0;
    if (grid == 0) {
        if (n_in != 21 || in_sizes[0] != M_REAL * D || out_size != M_REAL * D || ws_size < WS_END) { fprintf(stderr, "kernel_launch: unexpected shapes (n_in %d, in0 %d, out %d, ws %zu, need %zu); nothing launched\n", n_in, n_in > 0 ? in_sizes[0] : -1, out_size, ws_size, (size_t)WS_END); grid = -1; return; }
        int dev = 0, cus = 0, per_cu = 0;
        if (hipGetDevice(&dev) != hipSuccess || hipDeviceGetAttribute(&cus, hipDeviceAttributeMultiprocessorCount, dev) != hipSuccess) { fprintf(stderr, "kernel_launch: device query failed\n"); grid = -1; return; }
        if (hipFuncSetAttribute((const void*)hymba_fwd, hipFuncAttributeMaxDynamicSharedMemorySize, LDS_BYTES) != hipSuccess) { fprintf(stderr, "kernel_launch: hipFuncSetAttribute failed\n"); grid = -1; return; }
        if (hipOccupancyMaxActiveBlocksPerMultiprocessor(&per_cu, (const void*)hymba_fwd, NWAVES * 64, LDS_BYTES) != hipSuccess || per_cu < 1) fprintf(stderr, "kernel_launch: note: occupancy query reports %d workgroups per CU\n", per_cu);
        (void)hipGetLastError();
        grid = cus;
        if (grid != 256) fprintf(stderr, "kernel_launch: note: %d CUs (the attention phase's static deal assumes 256)\n", grid);
    }
    if (grid < 0) return;
    if (hipMemsetAsync((char*)d_ws + WS_CTL, 0, CTL_ZERO_BYTES, stream) != hipSuccess) { fprintf(stderr, "kernel_launch: memset failed\n"); return; }
    Args a{};
    for (int i = 0; i < 21; ++i) a.in[i] = (const float*)d_in[i];
    a.out = (float*)d_out; a.ws = (unsigned char*)d_ws; a.li = 0; a.pad = 0;
#if MK_PER_PHASE
    for (int ph = 0; ph < N_PHASES; ++ph) { a.ph_lo = ph; a.ph_hi = ph + 1; hipLaunchKernelGGL(hymba_fwd, dim3(grid), dim3(NWAVES * 64), LDS_BYTES, stream, a); }
#else
    a.ph_lo = 0; a.ph_hi = N_PHASES;
    hipLaunchKernelGGL(hymba_fwd, dim3(grid), dim3(NWAVES * 64), LDS_BYTES, stream, a);
#endif
    const hipError_t le = hipPeekAtLastError();
    if (le != hipSuccess) fprintf(stderr, "kernel_launch: launch failed: %s\n", hipGetErrorName(le));
}
```

```cpp
#include <hip/hip_runtime.h>
#include <cstdio>
#include <cstdint>

#ifndef MK_PER_PHASE
#define MK_PER_PHASE 0
#endif
#ifndef OVERLAP_CONV
#define OVERLAP_CONV 0
#endif
#ifndef PROBE_BLOCK
#define PROBE_BLOCK 0
#endif
#ifndef PROBE_CLASS
#define PROBE_CLASS (-1)
#endif

#define PROBE_ACC_OFF (131072 + 320 + 64)
__device__ __forceinline__ int my_tid();
namespace pg8 {
#define PG8_LAS __attribute__((address_space(3)))
#define PG8_GAS __attribute__((address_space(1)))
typedef unsigned short bf16_t;
typedef short bf16x8 __attribute__((ext_vector_type(8)));
typedef float f32x4 __attribute__((ext_vector_type(4)));
typedef unsigned u32x4 __attribute__((ext_vector_type(4)));
constexpr int BM = 256, BK = 64, HALF = 128, HTB = HALF * BK * 2  , STAGE_BYTES = 8 * HTB, NXCD = 8, WGM = 8;

__host__ __device__ __forceinline__ int lds_byte(int r, int c) { const int st = (r >> 4) * 2 + (c >> 5), rr = r & 15, cc = c & 31, ob = rr * 64 + cc * 2; return st * 1024 + (ob ^ (((ob >> 9) & 1) << 5)); }
__host__ __device__ __forceinline__ void stage_rc(int b, int& R, int& C) { const int st = b / 1024, sb = b % 1024, swz = sb ^ (((sb >> 9) & 1) << 5); R = (st >> 1) * 16 + swz / 64; C = (st & 1) * 32 + (swz % 64) / 2; }
__host__ __device__ __forceinline__ int perm32(int rho) { const int n = rho >> 4, i = rho & 15; return 8 * (i >> 2) + 4 * n + (i & 3); }

struct Unit { int pm, pn; };
struct Gemm { const bf16_t* A; const bf16_t* Bt; int M, N, K; };

struct StaticOrder {
    int nM, nN, nwg, G, c;
    __host__ __device__ void init(int M, int N, int G_, int c_) { nM = M / BM; nN = N / BM; nwg = nM * nN; G = G_; c = c_; }
    __host__ __device__ bool next(int i, Unit& u) const {
        const long L = (long)i * G + c; if (L >= nwg) return false;
        int wgid = (int)L; { const int q = nwg / NXCD, r = nwg % NXCD, xcd = wgid % NXCD, off = wgid / NXCD; wgid = (xcd < r ? xcd * (q + 1) : r * (q + 1) + (xcd - r) * q) + off; }
        const int nig = WGM * nN, gid = wgid / nig, fm = gid * WGM, gsz = (nM - fm) < WGM ? (nM - fm) : WGM;
        u.pm = fm + ((wgid % nig) % gsz); u.pn = (wgid % nig) / gsz; return true;
    }
    __device__ __forceinline__ void a_ready(const Unit&) const {}
    __device__ __forceinline__ void done(const Unit&) const {}
};

__device__ __forceinline__ unsigned cvt_pk_bf16(float lo, float hi) { unsigned r; asm volatile("v_cvt_pk_bf16_f32 %0, %1, %2" : "=v"(r) : "v"(lo), "v"(hi)); return r; }

template <class Epi, class Sched, bool ALIGN_EPI = false, bool SP2 = false>
__device__ __forceinline__ void gemm_phase(PG8_LAS unsigned char* lds, const Gemm g, const Sched& S, const Epi& E) {
    int tid_l = my_tid(); asm volatile("" : "+v"(tid_l));
    const int tid = tid_l, wid = __builtin_amdgcn_readfirstlane(tid >> 6), lane = tid & 63, wr = wid >> 2, wc = wid & 3, fr = lane & 15, fq = lane >> 4;
    const int K = g.K, nt = K / BK;
    unsigned voffA[2], voffB[2];
#pragma unroll
    for (int i = 0; i < 2; ++i) { int R, C; stage_rc(tid * 16 + i * 8192, R, C); const int Rb = Epi::PERM ? ((R & ~31) + perm32(R & 31)) : R;
        voffA[i] = (unsigned)(R * K + C) * 2u; voffB[i] = (unsigned)(Rb * K + C) * 2u; }
    const size_t kstep = (size_t)(BK * 2);
    const size_t hstep = (size_t)HALF * K * 2;
    const size_t tstep = 2 * hstep;
    const unsigned ldsw = (unsigned)wid * 1024u;
    const int aoff = lds_byte(wr * 64 + fr, fq * 8), boff = lds_byte(wc * 32 + fr, fq * 8);
#define PG8_SA(b, h) (((b) * 2 + (h)) * HTB)
#define PG8_SB(b, h) ((4 + (b) * 2 + (h)) * HTB)
#define PG8_STAGE(bufoff, gbase, voff) do { _Pragma("unroll") for (int _i = 0; _i < 2; ++_i) \
        __builtin_amdgcn_global_load_lds((const unsigned*)((const char*)(gbase) + (voff)[_i]), (PG8_LAS unsigned*)(lds + (bufoff) + ldsw + _i * 8192), 16, 0, 0); } while (0)
#define PG8_LDA(dst, b, h) do { _Pragma("unroll") for (int m = 0; m < 4; ++m) _Pragma("unroll") for (int k = 0; k < 2; ++k) dst[m][k] = *(const PG8_LAS bf16x8*)(lds + PG8_SA(b, h) + aoff + m * 2048 + k * 1024); } while (0)
#define PG8_LDB(dst, b, h) do { _Pragma("unroll") for (int n = 0; n < 2; ++n) _Pragma("unroll") for (int k = 0; k < 2; ++k) dst[n][k] = *(const PG8_LAS bf16x8*)(lds + PG8_SB(b, h) + boff + n * 2048 + k * 1024); } while (0)
#define PG8_MMA(ai, bj, At, Bt) do { __builtin_amdgcn_s_setprio(1); _Pragma("unroll") for (int m = 0; m < 4; ++m) _Pragma("unroll") for (int n = 0; n < 2; ++n) _Pragma("unroll") for (int k = 0; k < 2; ++k) \
        acc[ai][bj][m][n] = __builtin_amdgcn_mfma_f32_16x16x32_bf16(Bt[n][k], At[m][k], acc[ai][bj][m][n], 0, 0, 0); __builtin_amdgcn_s_setprio(0); } while (0)
#define PG8_WAIT_V(n) asm volatile("s_waitcnt vmcnt(" #n ")" ::: "memory")
#define PG8_WAIT_L(n) asm volatile("s_waitcnt lgkmcnt(" #n ")" ::: "memory")
#define PG8_BAR __builtin_amdgcn_s_barrier()
#define PG8_SCHED __builtin_amdgcn_sched_barrier(0)
    Unit cur, nxt; int ui = 0;
    if (!S.next(0, cur)) return;
    f32x4 acc[2][2][4][2];
#pragma unroll
    for (int a = 0; a < 2; ++a)
#pragma unroll
        for (int b = 0; b < 2; ++b)
#pragma unroll
            for (int m = 0; m < 4; ++m)
#pragma unroll
                for (int n = 0; n < 2; ++n) acc[a][b][m][n] = (f32x4){0.f, 0.f, 0.f, 0.f};
    bf16x8 At[4][2], B0[2][2], B1[2][2];
    const char* cA = (const char*)g.A + (size_t)cur.pm * tstep; const char* cB = (const char*)g.Bt + (size_t)cur.pn * tstep;
    S.a_ready(cur);
    if constexpr (SP2) {
        PG8_STAGE(PG8_SB(0, 0), cB, voffB); PG8_STAGE(PG8_SB(0, 1), cB + hstep, voffB); PG8_STAGE(PG8_SA(0, 0), cA, voffA); PG8_STAGE(PG8_SA(0, 1), cA + hstep, voffA);
        if (wr == 1) PG8_BAR;
        PG8_WAIT_V(2); PG8_BAR;
        PG8_STAGE(PG8_SB(1, 0), cB + kstep, voffB); PG8_STAGE(PG8_SA(1, 0), cA + kstep, voffA); PG8_STAGE(PG8_SB(1, 1), cB + hstep + kstep, voffB);
        PG8_WAIT_V(6); PG8_BAR;
    } else {
        PG8_STAGE(PG8_SB(0, 0), cB, voffB); PG8_STAGE(PG8_SA(0, 0), cA, voffA); PG8_STAGE(PG8_SB(0, 1), cB + hstep, voffB); PG8_STAGE(PG8_SA(0, 1), cA + hstep, voffA);
        if (wr == 1) PG8_BAR;
        PG8_WAIT_V(4); PG8_BAR;
        PG8_STAGE(PG8_SB(1, 0), cB + kstep, voffB); PG8_STAGE(PG8_SA(1, 0), cA + kstep, voffA); PG8_STAGE(PG8_SB(1, 1), cB + hstep + kstep, voffB);
        PG8_WAIT_V(6); PG8_BAR;
    }
    for (;;) {
        const bool has_next = S.next(ui + 1, nxt);
        const char* nA = has_next ? (const char*)g.A + (size_t)nxt.pm * tstep : cA; const char* nB = has_next ? (const char*)g.Bt + (size_t)nxt.pn * tstep : cB;
        for (int t = 0; t < nt; t += 2) {
            const bool last = (t == nt - 2);
            const char* a1 = cA + (size_t)(t + 1) * kstep;
            const char* a2 = last ? nA : cA + (size_t)(t + 2) * kstep; const char* b2 = last ? nB : cB + (size_t)(t + 2) * kstep;
            const char* a3 = a2 + kstep; const char* b3 = b2 + kstep;
            if (last && has_next) S.a_ready(nxt);
            if constexpr (Epi::MID) { if (t == nt / 2) E.mid(acc, cur, wr, wc, fr, fq); }
            if constexpr (SP2) {
            PG8_LDB(B0, 0, 0); PG8_LDB(B1, 0, 1); PG8_SCHED; PG8_LDA(At, 0, 0); PG8_STAGE(PG8_SA(1, 1), a1 + hstep, voffA);
            PG8_WAIT_V(8); PG8_WAIT_L(0); PG8_BAR; PG8_MMA(0, 0, At, B0); PG8_MMA(0, 1, At, B1); PG8_BAR; PG8_SCHED;
            PG8_LDA(At, 0, 1); PG8_STAGE(PG8_SB(0, 0), b2, voffB); PG8_STAGE(PG8_SB(0, 1), b2 + hstep, voffB); PG8_STAGE(PG8_SA(0, 0), a2, voffA);
            PG8_WAIT_V(8); PG8_WAIT_L(0); PG8_BAR; PG8_MMA(1, 0, At, B0); PG8_MMA(1, 1, At, B1); PG8_BAR; PG8_SCHED;
            PG8_LDB(B0, 1, 0); PG8_LDB(B1, 1, 1); PG8_SCHED; PG8_LDA(At, 1, 0); PG8_STAGE(PG8_SA(0, 1), a2 + hstep, voffA);
            PG8_WAIT_V(8); PG8_WAIT_L(0); PG8_BAR; PG8_MMA(0, 0, At, B0); PG8_MMA(0, 1, At, B1); PG8_BAR; PG8_SCHED;
            PG8_LDA(At, 1, 1); PG8_STAGE(PG8_SB(1, 0), b3, voffB); PG8_STAGE(PG8_SB(1, 1), b3 + hstep, voffB); PG8_STAGE(PG8_SA(1, 0), a3, voffA);
            PG8_WAIT_V(8); PG8_WAIT_L(0); PG8_BAR; PG8_MMA(1, 0, At, B0); PG8_MMA(1, 1, At, B1); PG8_BAR; PG8_SCHED;
            } else {
            PG8_LDB(B0, 0, 0); PG8_SCHED; PG8_LDA(At, 0, 0); PG8_STAGE(PG8_SA(1, 1), a1 + hstep, voffA);
            PG8_WAIT_L(8); PG8_BAR; PG8_WAIT_L(0); PG8_MMA(0, 0, At, B0); PG8_BAR; PG8_SCHED;
            PG8_LDB(B1, 0, 1); PG8_STAGE(PG8_SB(0, 0), b2, voffB);
            PG8_BAR; PG8_WAIT_L(0); PG8_MMA(0, 1, At, B1); PG8_BAR;
            PG8_LDA(At, 0, 1); PG8_STAGE(PG8_SA(0, 0), a2, voffA);
            PG8_BAR; PG8_WAIT_L(0); PG8_MMA(1, 0, At, B0); PG8_BAR; PG8_SCHED;
            PG8_STAGE(PG8_SB(0, 1), b2 + hstep, voffB);
            PG8_WAIT_V(6); PG8_BAR; PG8_MMA(1, 1, At, B1); PG8_BAR;
            PG8_LDB(B0, 1, 0); PG8_SCHED; PG8_LDA(At, 1, 0); PG8_STAGE(PG8_SA(0, 1), a2 + hstep, voffA);
            PG8_WAIT_L(8); PG8_BAR; PG8_WAIT_L(0); PG8_MMA(0, 0, At, B0); PG8_BAR; PG8_SCHED;
            PG8_LDB(B1, 1, 1); PG8_STAGE(PG8_SB(1, 0), b3, voffB);
            PG8_BAR; PG8_WAIT_L(0); PG8_MMA(0, 1, At, B1); PG8_BAR;
            PG8_LDA(At, 1, 1); PG8_STAGE(PG8_SA(1, 0), a3, voffA);
            PG8_BAR; PG8_WAIT_L(0); PG8_MMA(1, 0, At, B0); PG8_BAR; PG8_SCHED;
            PG8_STAGE(PG8_SB(1, 1), b3 + hstep, voffB);
            PG8_WAIT_V(6); PG8_BAR; PG8_MMA(1, 1, At, B1); PG8_BAR;
            }
        }
        if constexpr (ALIGN_EPI) { if (wr == 0) PG8_BAR; }
        if constexpr (PROBE_CLASS == 20 + Epi::ID) { unsigned long long t0_ = 0; if ((PROBE_BLOCK < 0 || (int)blockIdx.x == PROBE_BLOCK) && tid == 0) t0_ = __builtin_amdgcn_s_memrealtime();
            E(acc, cur, wr, wc, fr, fq); asm volatile("s_waitcnt vmcnt(0)" ::: "memory");
            if ((PROBE_BLOCK < 0 || (int)blockIdx.x == PROBE_BLOCK) && tid == 0) { volatile PG8_LAS unsigned long long* pa_ = (volatile PG8_LAS unsigned long long*)(lds + PROBE_ACC_OFF); *pa_ = *pa_ + (__builtin_amdgcn_s_memrealtime() - t0_); } }
        else if constexpr (!Epi::AFTER_DRAIN) { E(acc, cur, wr, wc, fr, fq); S.done(cur); }
        if (!has_next) break;
#pragma unroll
        for (int a = 0; a < 2; ++a)
#pragma unroll
            for (int b = 0; b < 2; ++b)
#pragma unroll
                for (int m = 0; m < 4; ++m)
#pragma unroll
                    for (int n = 0; n < 2; ++n) acc[a][b][m][n] = (f32x4){0.f, 0.f, 0.f, 0.f};
        cur = nxt; cA = nA; cB = nB; ++ui;
        if constexpr (ALIGN_EPI) { if (wr == 1) PG8_BAR; }
    }
    PG8_WAIT_V(0);
    if constexpr (!ALIGN_EPI) { if (wr == 0) PG8_BAR; }
    PG8_BAR;
#undef PG8_SA
#undef PG8_SB
#undef PG8_STAGE
#undef PG8_LDA
#undef PG8_LDB
#undef PG8_MMA
#undef PG8_WAIT_V
#undef PG8_WAIT_L
#undef PG8_BAR
#undef PG8_SCHED
}
}

constexpr int NWAVES = 8;
constexpr int D = 2048, NB = 8, SEQ = 2048, DEPTH = 4, HD = 64, NH = 16, FF = 5632, NMETA = 16, PADN = 112;
constexpr int M_REAL = NB * SEQ;
constexpr int M_PAD = M_REAL + 128;
constexpr int META_BLK0 = M_REAL;
constexpr int META_ROW = META_BLK0 + PADN;
constexpr int LPOS = SEQ + 128;
constexpr int N_GU = 2 * FF;
constexpr int N_IN = 18 * 256;
constexpr int IN_W = 4368;
constexpr float EPS = 1e-6f;
constexpr float LOG2E = 1.4426950408889634f;
constexpr float QSCALE = 0.125f * LOG2E;

constexpr size_t MiB = 1u << 20;
constexpr int NSLOT = 13;
constexpr size_t WS_CTL = 0, CTL_ZERO_BYTES = 1 * MiB;
constexpr size_t SZ_WGU = (size_t)N_GU * D * 2, SZ_WD = (size_t)D * FF * 2, SZ_WIN = (size_t)N_IN * D * 2, SZ_WOUT = (size_t)D * D * 2;
constexpr size_t LW_GU1 = 0, LW_D1 = LW_GU1 + SZ_WGU, LW_IN = LW_D1 + SZ_WD, LW_OUT = LW_IN + SZ_WIN, LW_GU2 = LW_OUT + SZ_WOUT, LW_D2 = LW_GU2 + SZ_WGU, LW_STRIDE = LW_D2 + SZ_WD;
constexpr size_t WS_W = 1 * MiB;
constexpr size_t WS_XN = WS_W + DEPTH * LW_STRIDE;
constexpr size_t WS_O = WS_XN + (size_t)M_PAD * D * 2;
constexpr size_t WS_ACT = WS_O + (size_t)M_PAD * D * 2;
constexpr size_t SZ_QK = (size_t)M_PAD * 1024 * 2, SZ_KV = (size_t)M_PAD * 128 * 2;
constexpr size_t WS_FQ = WS_ACT + (size_t)M_PAD * FF * 2, WS_FK = WS_FQ + SZ_QK, WS_FV = WS_FK + SZ_QK, WS_SQ = WS_FV + SZ_QK, WS_SK = WS_SQ + SZ_QK, WS_SV = WS_SK + SZ_KV, WS_LOGF = WS_SV + SZ_KV;
constexpr size_t WS_HB = WS_LOGF + (size_t)M_PAD * 16 * 4;
constexpr size_t WS_SSQ = WS_HB + (size_t)M_PAD * D * 2;
constexpr size_t WS_SSQM = WS_SSQ + (size_t)NSLOT * M_REAL * 32 * 4;
constexpr size_t WS_SSQO = WS_SSQM + (size_t)NSLOT * 16 * 128 * 4;
constexpr size_t WS_SSQOM = WS_SSQO + (size_t)M_REAL * 32 * 4;
constexpr size_t WS_END = WS_SSQOM + 16 * 32 * 4;
static_assert(LW_STRIDE % 256 == 0 && WS_XN % 256 == 0 && WS_ACT % 256 == 0 && WS_FQ % 256 == 0 && WS_SK % 256 == 0 && WS_LOGF % 256 == 0 && WS_HB % 256 == 0, "alignment");
constexpr int CW_TMO = 0, CW_BAR = 4096;

constexpr int RING_OFF = 0, RING_BYTES = 131072;
constexpr int LDSCTL_OFF = RING_BYTES, MISC_OFF = LDSCTL_OFF + 320, PTR_OFF = LDSCTL_OFF + 1024;
constexpr int LDS_BYTES = 155648;
constexpr int WID_OFF = LDSCTL_OFF + 1280;
constexpr int RSTD_ID_OFF = LDSCTL_OFF + 1536, RSTD_OFF = LDSCTL_OFF + 2048;
static_assert(RSTD_OFF + 8 * 128 * 4 <= LDS_BYTES, "LDS map");
constexpr int RSTD2_OFF = 148480;
static_assert(RSTD2_OFF + 8 * 128 * 4 <= LDS_BYTES, "LDS map");
constexpr int ATT_TAB_OFF = 139264;
constexpr int ATT_WTOT_OFF = ATT_TAB_OFF + 8704;
constexpr int ATT_FC_OFF = ATT_WTOT_OFF + 64;
constexpr int ATT_TABF_OFF = 0, ATT_ZERO_OFF = 2176 * 16;
constexpr int ATT_VST_OFF = 0, ATT_VST_PITCH = 128, ATT_VST_BYTES = 64 * ATT_VST_PITCH;
static_assert(ATT_VST_OFF + NWAVES * 2 * ATT_VST_BYTES <= RING_BYTES && ATT_FC_OFF + 256 <= RSTD2_OFF && RSTD_OFF + 8 * 128 * 4 <= ATT_TAB_OFF, "attention LDS");

#define GAS __attribute__((address_space(1)))
#define LAS __attribute__((address_space(3)))
typedef unsigned short bf16;
typedef unsigned v4u __attribute__((ext_vector_type(4)));
typedef float f32x4 __attribute__((ext_vector_type(4)));
typedef float f32x16 __attribute__((ext_vector_type(16)));
typedef short bf16x8 __attribute__((ext_vector_type(8)));
typedef GAS unsigned gu32;
#define RLX_AGENT __ATOMIC_RELAXED, __HIP_MEMORY_SCOPE_AGENT
#define LDS_WAIT() asm volatile("s_waitcnt lgkmcnt(0)" ::: "memory")
__device__ __forceinline__ unsigned f2bf(float f) { unsigned u = __builtin_bit_cast(unsigned, f); return (u + 0x7fffu + ((u >> 16) & 1u)) >> 16; }
__device__ __forceinline__ unsigned pk2(float lo, float hi) { return f2bf(lo) | (f2bf(hi) << 16); }
__device__ __forceinline__ float bf2f(unsigned short b) { return __builtin_bit_cast(float, (unsigned)b << 16); }

__device__ __forceinline__ int hw_wave_key() { return (int)(__builtin_amdgcn_s_getreg(((6 - 1) << 11) | 4) & 63u); }
__device__ __forceinline__ int my_tid() {
    extern __shared__ __attribute__((aligned(16))) unsigned char lds_dyn_[];
    const int wave = __builtin_amdgcn_readfirstlane(((const volatile LAS int*)((LAS unsigned char*)lds_dyn_ + WID_OFF))[hw_wave_key()]);
    unsigned zero = 0u; asm volatile("" : "+v"(zero));
    return wave * 64 + (int)__builtin_amdgcn_mbcnt_hi(~0u, __builtin_amdgcn_mbcnt_lo(~0u, zero));
}
__host__ __device__ __forceinline__ size_t kfrag_idx(int row, int nh, int head, int d) { return ((((size_t)(row >> 5) * nh + head) * 8 + (d >> 3)) * 32 + (row & 31)) * 8 + (d & 7); }
__host__ __device__ __forceinline__ size_t vfrag_idx(int row, int nh, int head, int d) { return (((((size_t)(row >> 4) * nh + head) * 2 + ((row >> 2) & 1)) * 64 + d) * 8) + (((row >> 3) & 1) * 4 + (row & 3)); }
namespace pg8 {
__device__ __forceinline__ unsigned long long tab_ptr(int k) {
    extern __shared__ __attribute__((aligned(16))) unsigned char lds_dyn_[];
    const volatile PG8_LAS unsigned* t = (const volatile PG8_LAS unsigned*)((PG8_LAS unsigned char*)lds_dyn_ + PTR_OFF);
    const unsigned lo = __builtin_amdgcn_readfirstlane(t[2 * k]), hi = __builtin_amdgcn_readfirstlane(t[2 * k + 1]);
    return ((unsigned long long)hi << 32) | lo;
}
__device__ __forceinline__ const PG8_LAS float* ensure_rstd(const PG8_GAS float* ssq, int slot, int pm, int wid, int wr, int lane) {
    extern __shared__ __attribute__((aligned(16))) unsigned char lds_dyn_[];
    volatile PG8_LAS unsigned* idw = (volatile PG8_LAS unsigned*)((PG8_LAS unsigned char*)lds_dyn_ + RSTD_ID_OFF) + wid;
    PG8_LAS float* rv = (PG8_LAS float*)((PG8_LAS unsigned char*)lds_dyn_ + RSTD_OFF) + wid * 128;
    const unsigned want = ((unsigned)(slot + 1) << 16) | (unsigned)(pm + 1);
    if ((unsigned)__builtin_amdgcn_readfirstlane(*idw) != want) {
#pragma unroll
        for (int j = 0; j < 2; ++j) { const int row = pm * BM + HALF * j + 64 * wr + lane; const PG8_GAS f32x4* pp = (const PG8_GAS f32x4*)(ssq + (size_t)row * 32); float t = 0.f;
#pragma unroll
            for (int q = 0; q < 8; ++q) { const f32x4 a = pp[q]; t += (a[0] + a[1]) + (a[2] + a[3]); }
            rv[64 * j + lane] = 1.0f / sqrtf(t * (1.0f / 2048.0f) + 1e-6f); }
        if (lane == 0) *idw = want;
        asm volatile("s_waitcnt lgkmcnt(0)" ::: "memory");
    }
    return rv;
}
__device__ __forceinline__ float silu_mul(float g, float u) {
    const float e = __builtin_amdgcn_exp2f(-1.4426950408889634f * g);
    return g * __builtin_amdgcn_rcpf(1.0f + e) * u;
}
struct EpiSwiGLU {
    static constexpr bool PERM = true, AFTER_DRAIN = false, MID = false; static constexpr int ID = 0;
    int slot;
    __device__ __forceinline__ void operator()(const f32x4 (&acc)[2][2][4][2], const Unit& u, int wr, int wc, int fr, int fq) const {
        PG8_GAS unsigned char* w = (PG8_GAS unsigned char*)tab_ptr(22); PG8_GAS bf16_t* O = (PG8_GAS bf16_t*)(w + WS_ACT); constexpr int ldc = FF; const PG8_GAS float* ssq = (const PG8_GAS float*)(w + WS_SSQ) + (size_t)slot * M_REAL * 32;
        const int row0 = u.pm * BM + wr * 64 + fr, col0 = u.pn * HALF + wc * 32 + 8 * fq;
        const PG8_LAS float* rv = ensure_rstd(ssq, slot, u.pm, wr * 4 + wc, wr, fr + 16 * fq);
        float rs[2][4];
#pragma unroll
        for (int ai = 0; ai < 2; ++ai)
#pragma unroll
            for (int m = 0; m < 4; ++m) rs[ai][m] = rv[64 * ai + 16 * m + fr];
#pragma unroll
        for (int ai = 0; ai < 2; ++ai)
#pragma unroll
            for (int m = 0; m < 4; ++m) { PG8_GAS bf16_t* rowp = O + (size_t)(row0 + ai * HALF + m * 16) * ldc + col0;
                const float r = rs[ai][m];
                const f32x4 g0 = acc[ai][0][m][0] * r, g1 = acc[ai][0][m][1] * r, u0 = acc[ai][1][m][0] * r, u1 = acc[ai][1][m][1] * r;
                u32x4 w; w.x = cvt_pk_bf16(silu_mul(g0[0], u0[0]), silu_mul(g0[1], u0[1])); w.y = cvt_pk_bf16(silu_mul(g0[2], u0[2]), silu_mul(g0[3], u0[3]));
                w.z = cvt_pk_bf16(silu_mul(g1[0], u1[0]), silu_mul(g1[1], u1[1])); w.w = cvt_pk_bf16(silu_mul(g1[2], u1[2]), silu_mul(g1[3], u1[3]));
                *(PG8_GAS u32x4*)rowp = w; }
    }
};
struct EpiResAdd {
    static constexpr bool PERM = true, AFTER_DRAIN = false, MID = false; static constexpr int ID = 1;
    float scale; int slot; int fin;
    __device__ __forceinline__ void operator()(const f32x4 (&acc)[2][2][4][2], const Unit& u, int wr, int wc, int fr, int fq) const {
        PG8_GAS unsigned char* w = (PG8_GAS unsigned char*)tab_ptr(22); PG8_GAS bf16_t* hb = (PG8_GAS bf16_t*)(w + WS_HB); PG8_GAS float* out = (PG8_GAS float*)tab_ptr(21);
        PG8_GAS float* ssq = (PG8_GAS float*)(w + WS_SSQ) + (size_t)slot * M_REAL * 32; constexpr int ldc = D;
        const int row0 = u.pm * BM + wr * 64 + fr, col0 = u.pn * BM + wc * 32 + 8 * fq;
        u32x4 bs[2][4][2];
#pragma unroll
        for (int ai = 0; ai < 2; ++ai)
#pragma unroll
            for (int m = 0; m < 4; ++m)
#pragma unroll
                for (int bj = 0; bj < 2; ++bj) bs[ai][m][bj] = *(const PG8_GAS u32x4*)(hb + (size_t)(row0 + ai * HALF + m * 16) * ldc + col0 + bj * HALF);
#pragma unroll
        for (int ai = 0; ai < 2; ++ai)
#pragma unroll
            for (int m = 0; m < 4; ++m) { float ss = 0.f; const size_t off = (size_t)(row0 + ai * HALF + m * 16) * ldc + col0;
#pragma unroll
                for (int bj = 0; bj < 2; ++bj) { const u32x4 b = bs[ai][m][bj]; const unsigned bw[4] = {b.x, b.y, b.z, b.w}; float v[8];
#pragma unroll
                    for (int e = 0; e < 4; ++e) { v[2 * e] = __builtin_bit_cast(float, bw[e] << 16) + scale * acc[ai][bj][m][e >> 1][(2 * e) & 3]; v[2 * e + 1] = __builtin_bit_cast(float, bw[e] & 0xffff0000u) + scale * acc[ai][bj][m][e >> 1][(2 * e + 1) & 3]; }
                    if (fin) { *(PG8_GAS f32x4*)(out + off + bj * HALF) = (f32x4){v[0], v[1], v[2], v[3]}; *(PG8_GAS f32x4*)(out + off + bj * HALF + 4) = (f32x4){v[4], v[5], v[6], v[7]}; }
                    else { u32x4 wv; wv.x = cvt_pk_bf16(v[0], v[1]); wv.y = cvt_pk_bf16(v[2], v[3]); wv.z = cvt_pk_bf16(v[4], v[5]); wv.w = cvt_pk_bf16(v[6], v[7]); *(PG8_GAS u32x4*)(hb + off + bj * HALF) = wv;
                        const unsigned ww[4] = {wv.x, wv.y, wv.z, wv.w};
#pragma unroll
                        for (int e = 0; e < 4; ++e) { const float lo = __builtin_bit_cast(float, ww[e] << 16), hi2 = __builtin_bit_cast(float, ww[e] & 0xffff0000u); ss += lo * lo + hi2 * hi2; } } }
                if (!fin) { ss += __shfl_xor(ss, 16); ss += __shfl_xor(ss, 32);
                    if (fq == 0) ssq[(size_t)(row0 + ai * HALF + m * 16) * 32 + u.pn * 4 + wc] = ss; } }
    }
};
__device__ __forceinline__ void ensure_rstd_o(const PG8_GAS float* ssqo, int slot, int pm, int wid, int wr, int lane, const PG8_LAS float*& rs_out, const PG8_LAS float*& ratio_out) {
    extern __shared__ __attribute__((aligned(16))) unsigned char lds_dyn_[];
    volatile PG8_LAS unsigned* idw = (volatile PG8_LAS unsigned*)((PG8_LAS unsigned char*)lds_dyn_ + RSTD_ID_OFF) + wid;
    PG8_LAS float* rv = (PG8_LAS float*)((PG8_LAS unsigned char*)lds_dyn_ + RSTD_OFF) + wid * 128;
    PG8_LAS float* rq = (PG8_LAS float*)((PG8_LAS unsigned char*)lds_dyn_ + RSTD2_OFF) + wid * 128;
    const unsigned want = ((0x4000u | (unsigned)(slot + 1)) << 16) | (unsigned)(pm + 1);
    if ((unsigned)__builtin_amdgcn_readfirstlane(*idw) != want) {
#pragma unroll
        for (int j = 0; j < 2; ++j) { const int row = pm * BM + HALF * j + 64 * wr + lane; const PG8_GAS f32x4* pp = (const PG8_GAS f32x4*)(ssqo + (size_t)row * 32); float tf = 0.f, ts = 0.f;
#pragma unroll
            for (int q = 0; q < 4; ++q) { const f32x4 a = pp[q], b = pp[4 + q]; tf += (a[0] + a[1]) + (a[2] + a[3]); ts += (b[0] + b[1]) + (b[2] + b[3]); }
            const float rf = 1.0f / sqrtf(tf * (1.0f / 1024.0f) + 1e-6f), rs = 1.0f / sqrtf(ts * (1.0f / 1024.0f) + 1e-6f);
            rv[64 * j + lane] = rs; rq[64 * j + lane] = rf / rs; }
        if (lane == 0) *idw = want;
        asm volatile("s_waitcnt lgkmcnt(0)" ::: "memory");
    }
    rs_out = rv; ratio_out = rq;
}
struct EpiOut {
    static constexpr bool PERM = true, AFTER_DRAIN = false, MID = true; static constexpr int ID = 3;
    int slot;
    __device__ __forceinline__ void mid(f32x4 (&acc)[2][2][4][2], const Unit& u, int wr, int wc, int fr, int fq) const {
        PG8_GAS unsigned char* w = (PG8_GAS unsigned char*)tab_ptr(22); const PG8_LAS float *rs, *rq; ensure_rstd_o((const PG8_GAS float*)(w + WS_SSQO), slot, u.pm, wr * 4 + wc, wr, fr + 16 * fq, rs, rq);
#pragma unroll
        for (int ai = 0; ai < 2; ++ai)
#pragma unroll
            for (int m = 0; m < 4; ++m) { const float q = rq[64 * ai + 16 * m + fr];
#pragma unroll
                for (int bj = 0; bj < 2; ++bj)
#pragma unroll
                    for (int n = 0; n < 2; ++n) acc[ai][bj][m][n] = acc[ai][bj][m][n] * q; }
    }
    __device__ __forceinline__ void operator()(const f32x4 (&acc)[2][2][4][2], const Unit& u, int wr, int wc, int fr, int fq) const {
        PG8_GAS unsigned char* w = (PG8_GAS unsigned char*)tab_ptr(22); PG8_GAS bf16_t* hb = (PG8_GAS bf16_t*)(w + WS_HB);
        PG8_GAS float* ssq = (PG8_GAS float*)(w + WS_SSQ) + (size_t)slot * M_REAL * 32; constexpr int ldc = D;
        const PG8_LAS float *rs, *rq; ensure_rstd_o((const PG8_GAS float*)(w + WS_SSQO), slot, u.pm, wr * 4 + wc, wr, fr + 16 * fq, rs, rq);
        const int row0 = u.pm * BM + wr * 64 + fr, col0 = u.pn * BM + wc * 32 + 8 * fq;
        u32x4 bs[2][4][2];
#pragma unroll
        for (int ai = 0; ai < 2; ++ai)
#pragma unroll
            for (int m = 0; m < 4; ++m)
#pragma unroll
                for (int bj = 0; bj < 2; ++bj) bs[ai][m][bj] = *(const PG8_GAS u32x4*)(hb + (size_t)(row0 + ai * HALF + m * 16) * ldc + col0 + bj * HALF);
#pragma unroll
        for (int ai = 0; ai < 2; ++ai)
#pragma unroll
            for (int m = 0; m < 4; ++m) { float ss = 0.f; const size_t off = (size_t)(row0 + ai * HALF + m * 16) * ldc + col0; const float scale = rs[64 * ai + 16 * m + fr];
#pragma unroll
                for (int bj = 0; bj < 2; ++bj) { const u32x4 b = bs[ai][m][bj]; const unsigned bw[4] = {b.x, b.y, b.z, b.w}; float v[8];
#pragma unroll
                    for (int e = 0; e < 4; ++e) { v[2 * e] = __builtin_bit_cast(float, bw[e] << 16) + scale * acc[ai][bj][m][e >> 1][(2 * e) & 3]; v[2 * e + 1] = __builtin_bit_cast(float, bw[e] & 0xffff0000u) + scale * acc[ai][bj][m][e >> 1][(2 * e + 1) & 3]; }
                    u32x4 wv; wv.x = cvt_pk_bf16(v[0], v[1]); wv.y = cvt_pk_bf16(v[2], v[3]); wv.z = cvt_pk_bf16(v[4], v[5]); wv.w = cvt_pk_bf16(v[6], v[7]); *(PG8_GAS u32x4*)(hb + off + bj * HALF) = wv;
                    const unsigned ww[4] = {wv.x, wv.y, wv.z, wv.w};
#pragma unroll
                    for (int e = 0; e < 4; ++e) { const float lo = __builtin_bit_cast(float, ww[e] << 16), hi2 = __builtin_bit_cast(float, ww[e] & 0xffff0000u); ss += lo * lo + hi2 * hi2; } }
                ss += __shfl_xor(ss, 16); ss += __shfl_xor(ss, 32);
                if (fq == 0) ssq[(size_t)(row0 + ai * HALF + m * 16) * 32 + u.pn * 4 + wc] = ss; }
    }
};
struct EpiInProj {
    static constexpr bool PERM = true, AFTER_DRAIN = false, MID = false; static constexpr int ID = 2;
    int ll, slot; float qscale;
    __device__ __forceinline__ void operator()(const f32x4 (&acc)[2][2][4][2], const Unit& u, int wr, int wc, int fr, int fq) const {
        PG8_GAS unsigned char* w = (PG8_GAS unsigned char*)tab_ptr(22); const PG8_GAS float* ssq = (const PG8_GAS float*)(w + WS_SSQ) + (size_t)slot * M_REAL * 32;
        PG8_GAS bf16_t *fq_ = (PG8_GAS bf16_t*)(w + WS_FQ), *fk_ = (PG8_GAS bf16_t*)(w + WS_FK), *fv_ = (PG8_GAS bf16_t*)(w + WS_FV), *sq_ = (PG8_GAS bf16_t*)(w + WS_SQ), *sk_ = (PG8_GAS bf16_t*)(w + WS_SK), *sv_ = (PG8_GAS bf16_t*)(w + WS_SV); PG8_GAS float* logf = (PG8_GAS float*)(w + WS_LOGF);
        const PG8_GAS float *g_fq = (const PG8_GAS float*)tab_ptr(9) + ll * HD, *g_fk = (const PG8_GAS float*)tab_ptr(10) + ll * HD, *g_sq = (const PG8_GAS float*)tab_ptr(11) + ll * HD, *g_sk = (const PG8_GAS float*)tab_ptr(12) + ll * HD, *bfg = (const PG8_GAS float*)tab_ptr(8) + ll * NH;
        const int row0 = u.pm * BM + wr * 64 + fr, pn = u.pn;
        if (pn == 17 && wc != 0) return;
        const PG8_LAS float* rv = ensure_rstd(ssq, slot, u.pm, wr * 4 + wc, wr, fr + 16 * fq);
        float rs[2][4];
#pragma unroll
        for (int ai = 0; ai < 2; ++ai)
#pragma unroll
            for (int m = 0; m < 4; ++m) rs[ai][m] = rv[64 * ai + 16 * m + fr];
        if (pn == 17) {
            if (wc != 0) return;
            if (fq < 2) {
                const f32x4 b0 = *(const PG8_GAS f32x4*)(bfg + 8 * fq), b1 = *(const PG8_GAS f32x4*)(bfg + 8 * fq + 4);
#pragma unroll
                for (int ai = 0; ai < 2; ++ai)
#pragma unroll
                    for (int m = 0; m < 4; ++m) { PG8_GAS float* rowp = logf + (size_t)(row0 + ai * HALF + m * 16) * 16 + 8 * fq;
#pragma unroll
                        for (int n = 0; n < 2; ++n) { f32x4 t = acc[ai][0][m][n] * rs[ai][m] + (n ? b1 : b0), o;
#pragma unroll
                            for (int j = 0; j < 4; ++j) o[j] = fminf(t[j], 0.f) - 0.69314718056f * __builtin_amdgcn_logf(1.0f + __builtin_amdgcn_exp2f(-1.4426950408889634f * fabsf(t[j])));
                            *(PG8_GAS f32x4*)(rowp + 4 * n) = o; } }
            }
            return;
        }
        PG8_GAS bf16_t* dst; int pitch, head, knh = 0; const PG8_GAS float* gain = nullptr; float sc = 1.f;
        if (pn < 16) { const int seg = pn >> 2; head = (pn & 3) * 4 + wc; pitch = 1024;
            if (seg == 0) { dst = fq_; gain = g_fq; sc = qscale; } else if (seg == 1) { dst = fk_; gain = g_fk; knh = 16; } else if (seg == 2) { dst = fv_; } else { dst = sq_; gain = g_sq; sc = qscale; } }
        else { pitch = 128; head = wc & 1; if (wc < 2) { dst = sk_; gain = g_sk; knh = 2; } else { dst = sv_; } }
        const int col0 = head * 64 + 8 * fq;
        if (gain) {
            f32x4 gv[2][2];
#pragma unroll
            for (int bj = 0; bj < 2; ++bj)
#pragma unroll
                for (int n = 0; n < 2; ++n) gv[bj][n] = *(const PG8_GAS f32x4*)(gain + 32 * bj + 8 * fq + 4 * n) * sc;
#pragma unroll
            for (int ai = 0; ai < 2; ++ai)
#pragma unroll
                for (int m = 0; m < 4; ++m) {
                    float ss = 0.f;
#pragma unroll
                    for (int bj = 0; bj < 2; ++bj)
#pragma unroll
                        for (int n = 0; n < 2; ++n) { const f32x4 x = acc[ai][bj][m][n]; ss += (x[0] * x[0] + x[1] * x[1]) + (x[2] * x[2] + x[3] * x[3]); }
                    ss += __shfl_xor(ss, 16); ss += __shfl_xor(ss, 32);
                    const float rinv = rs[ai][m] / sqrtf(ss * (1.0f / 64.0f) * rs[ai][m] * rs[ai][m] + 1e-6f);
                    const int row = row0 + ai * HALF + m * 16;
                    PG8_GAS bf16_t* rowp = dst + (size_t)row * pitch + col0;
#pragma unroll
                    for (int bj = 0; bj < 2; ++bj) { const f32x4 v0 = acc[ai][bj][m][0] * rinv * gv[bj][0], v1 = acc[ai][bj][m][1] * rinv * gv[bj][1];
                        u32x4 w; w.x = cvt_pk_bf16(v0[0], v0[1]); w.y = cvt_pk_bf16(v0[2], v0[3]); w.z = cvt_pk_bf16(v1[0], v1[1]); w.w = cvt_pk_bf16(v1[2], v1[3]);
                        if (knh) *(PG8_GAS u32x4*)(dst + kfrag_idx(row, knh, head, 32 * bj + 8 * fq)) = w;
                        else *(PG8_GAS u32x4*)(rowp + 32 * bj) = w; }
                }
        } else {
#pragma unroll
            for (int ai = 0; ai < 2; ++ai)
#pragma unroll
                for (int m = 0; m < 4; ++m) { const int row = row0 + ai * HALF + m * 16; const int vnh = (pn < 16) ? 16 : 2;
#pragma unroll
                    for (int bj = 0; bj < 2; ++bj) { const f32x4 v0 = acc[ai][bj][m][0] * rs[ai][m], v1 = acc[ai][bj][m][1] * rs[ai][m];
                        const unsigned wv[4] = {cvt_pk_bf16(v0[0], v0[1]), cvt_pk_bf16(v0[2], v0[3]), cvt_pk_bf16(v1[0], v1[1]), cvt_pk_bf16(v1[2], v1[3])};
                        PG8_GAS bf16_t* vp = dst + vfrag_idx(row, vnh, head, 32 * bj + 8 * fq);
#pragma unroll
                        for (int e = 0; e < 4; ++e) { vp[16 * e] = (bf16_t)(wv[e] & 0xffffu); vp[16 * e + 8] = (bf16_t)(wv[e] >> 16); } } }
        }
    }
};

}

#define XB_TMO      128
#define XB_XCNT(j)  (256  + 64 * (j))
#define XB_XSUB(j)  (1280 + 64 * (j))
#define XB_XGEN(j)  (2304 + 64 * (j))
#define XB_TOP      3328
#define XB_TOPGEN   3392
#define XCD_BAR_WORDS 3456
#define XB_SPIN_CAP (1u << 18)
__device__ __forceinline__ unsigned xb_ld(unsigned* p)              { return __hip_atomic_load(p, __ATOMIC_RELAXED, __HIP_MEMORY_SCOPE_AGENT); }
__device__ __forceinline__ unsigned xb_add(unsigned* p, unsigned v) { return __hip_atomic_fetch_add(p, v, __ATOMIC_RELAXED, __HIP_MEMORY_SCOPE_AGENT); }
__device__ __forceinline__ unsigned xb_xcc_id() { return (unsigned)__builtin_amdgcn_s_getreg((3 << 11) | 20) & 0xFu; }
#define XB_SPIN(cond, bar) do { unsigned _sp = 0; while (cond) { __builtin_amdgcn_s_sleep(1); \
    if ((++_sp & 255u) == 0u) { if (xb_ld(&(bar)[XB_TMO])) break; if (_sp > XB_SPIN_CAP) { atomicAdd(&(bar)[XB_TMO], 1u); break; } } } } while (0)
struct XcdBarrier { unsigned* bar; unsigned x; volatile LAS unsigned* st; };
__device__ __forceinline__ XcdBarrier xcd_barrier_post(unsigned* bar, volatile LAS unsigned* st) {
    XcdBarrier b; b.bar = bar; b.x = xb_xcc_id(); b.st = st;
    if (threadIdx.x == 0) (void)xb_add(&bar[XB_XCNT(b.x)], 1u);
    return b;
}
__device__ __forceinline__ void xcd_barrier_complete(unsigned* bar, unsigned x, unsigned& nloc, unsigned& nx) {
    const unsigned G = gridDim.x * gridDim.y * gridDim.z;
    unsigned sum, cnt, mine, sp = 0u;
    for (;;) {
        sum = 0u; cnt = 0u; mine = 0u;
#pragma unroll
        for (unsigned j = 0; j < 16; ++j) { const unsigned c = xb_ld(&bar[XB_XCNT(j)]); sum += c; cnt += (c > 0u) ? 1u : 0u; mine = (j == x) ? c : mine; }
        if (sum == G) break;
        __builtin_amdgcn_s_sleep(1);
        if ((++sp & 255u) == 0u) { if (xb_ld(&bar[XB_TMO])) break; if (sp > XB_SPIN_CAP) { atomicAdd(&bar[XB_TMO], 1u); break; } }
    }
    nloc = mine > 0u ? mine : 1u; nx = cnt > 0u ? cnt : 1u;
}
__device__ __forceinline__ void xcd_barrier(const XcdBarrier& b) {
    asm volatile("s_waitcnt vmcnt(0)" ::: "memory");
    __syncthreads();
    if (my_tid() == 0) {
        unsigned* bar = b.bar;
        __builtin_amdgcn_s_waitcnt(0);
        unsigned nloc = b.st[0], nx = b.st[1];
        if (nloc == 0u) { xcd_barrier_complete(bar, b.x, nloc, nx); b.st[0] = nloc; b.st[1] = nx; }
        const unsigned old = xb_add(&bar[XB_XSUB(b.x)], 1u);
        const unsigned gen = old / nloc;
        if (old + 1u == (gen + 1u) * nloc) {
            __builtin_amdgcn_fence(__ATOMIC_RELEASE, "agent");
            asm volatile("s_waitcnt vmcnt(0)" ::: "memory");
            const unsigned og = xb_add(&bar[XB_TOP], 1u);
            const unsigned tg = og / nx;
            if (og + 1u == (tg + 1u) * nx) xb_add(&bar[XB_TOPGEN], 1u);
            else XB_SPIN(xb_ld(&bar[XB_TOPGEN]) == tg, bar);
            __builtin_amdgcn_fence(__ATOMIC_ACQUIRE, "agent");
            xb_add(&bar[XB_XGEN(b.x)], 1u);
            asm volatile("s_waitcnt vmcnt(0)" ::: "memory");
        } else {
            XB_SPIN(xb_ld(&bar[XB_XGEN(b.x)]) == gen, bar);
            __builtin_amdgcn_fence(__ATOMIC_ACQUIRE, "agent");
            asm volatile("s_waitcnt vmcnt(0)" ::: "memory");
        }
    }
    __syncthreads();
}

struct Frame {
    LAS unsigned char* lds;
    volatile LAS unsigned* MISC;
    int tid, lane, wave;
    int vcu, G;
    unsigned char* ws;
};
__device__ __forceinline__ int launder_u(int x) { asm volatile("" : "+v"(x)); return __builtin_amdgcn_readfirstlane(x); }
#define LAUNDER_S(x) ((x) = launder_u(x))
__device__ __forceinline__ const float* inptr(const Frame& F, int k) {
    const volatile LAS unsigned* t = (const volatile LAS unsigned*)(F.lds + PTR_OFF);
    const unsigned lo = __builtin_amdgcn_readfirstlane(t[2 * k]), hi = __builtin_amdgcn_readfirstlane(t[2 * k + 1]);
    return (const float*)(((unsigned long long)hi << 32) | lo);
}
__device__ __forceinline__ unsigned char* wsl(const Frame& F) { const unsigned long long p = (unsigned long long)F.ws; const unsigned lo = (unsigned)launder_u((int)(unsigned)p), hi = (unsigned)launder_u((int)(unsigned)(p >> 32)); return (unsigned char*)(((unsigned long long)hi << 32) | lo); }
__device__ __forceinline__ Frame make_frame() {
    extern __shared__ __attribute__((aligned(16))) unsigned char lds_dyn_[];
    Frame F;
    F.lds = (LAS unsigned char*)lds_dyn_;
    F.MISC = (volatile LAS unsigned*)(F.lds + MISC_OFF);
    int t = my_tid(); asm volatile("" : "+v"(t));
    F.tid = t; F.lane = t & 63; F.wave = __builtin_amdgcn_readfirstlane(t >> 6);
    const int g = launder_u((int)gridDim.x), bx = launder_u((int)blockIdx.x);
    F.G = g; F.vcu = (g % 8 == 0) ? (bx % 8) * (g / 8) + bx / 8 : bx;
    F.ws = (unsigned char*)pg8::tab_ptr(22);
    return F;
}
__device__ __forceinline__ float wave_sum(float v) {
#pragma unroll
    for (int o = 1; o < 64; o <<= 1) v += __shfl_xor(v, o);
    return v;
}

constexpr int TP_PITCH = 144;
__device__ __forceinline__ void transpose_item64(const float* Wf, int Nsrc, int ca, int nva, int cb, int nvb, int K, bf16* WTf, int drow0, int k0, LAS unsigned char* scr, int lane, const float* gainf = nullptr) {
    const GAS float* W = (const GAS float*)Wf; GAS bf16* WT = (GAS bf16*)WTf;
    const int sub = (lane >> 3) & 1, c4 = 4 * (lane & 7), g = lane >> 4, nl = 32 * sub + c4;
    const bool ok = c4 < (sub ? nvb : nva);
    const GAS float* src = W + (size_t)(k0 + 2 * g) * Nsrc + (sub ? cb : ca) + c4;
    f32x4 v[16];
#pragma unroll
    for (int i = 0; i < 16; ++i) v[i] = ok ? *(const GAS f32x4*)(src + (size_t)(8 * (i >> 1) + (i & 1)) * Nsrc) : (f32x4){0.f, 0.f, 0.f, 0.f};
    if (gainf) { const GAS float* gp = (const GAS float*)gainf + k0 + 2 * g;
#pragma unroll
        for (int i = 0; i < 16; ++i) v[i] = v[i] * gp[8 * (i >> 1) + (i & 1)]; }
#pragma unroll
    for (int m = 0; m < 8; ++m)
#pragma unroll
        for (int j = 0; j < 4; ++j) *(LAS unsigned*)(scr + (nl + j) * TP_PITCH + (8 * m + 2 * g) * 2) = pk2(v[2 * m][j], v[2 * m + 1][j]);
    LDS_WAIT(); asm volatile("" ::: "memory");
#pragma unroll
    for (int t = 0; t < 8; ++t) { const int id = lane + 64 * t, n = id >> 3, c = id & 7;
        const v4u o = *(const LAS v4u*)(scr + n * TP_PITCH + 16 * c);
        *(GAS v4u*)(WT + (size_t)(drow0 + n) * K + k0 + 8 * c) = o; }
    LDS_WAIT(); asm volatile("" ::: "memory");
}
constexpr int IT_GU = (D / 64) * (N_GU / 64), IT_D = (FF / 64) * (D / 64), IT_IN = (D / 64) * (N_IN / 64), IT_OUT = (D / 64) * (D / 64);
constexpr int IT_LAYER = 2 * IT_GU + 2 * IT_D + IT_IN + IT_OUT;
__device__ __forceinline__ void conv_gu(const float* Wg, const float* Wu, bf16* WT, int r, LAS unsigned char* scr, int lane, const float* gain) {
    constexpr int nrg = N_GU / 64; const int kb = r / nrg, rg = r % nrg, p = rg >> 2, q = rg & 3; const int c0 = 128 * p + 64 * (q & 1);
    transpose_item64(q < 2 ? Wg : Wu, FF, c0, 32, c0 + 32, 32, D, WT, 64 * rg, 64 * kb, scr, lane, gain);
}
__device__ __forceinline__ void conv_plain(const float* W, int K, int N, bf16* WT, int r, LAS unsigned char* scr, int lane, const float* gain_lo = nullptr, const float* gain_hi = nullptr) {
    const int nrg = N / 64, kb = r / nrg, rg = r % nrg;
    const float* gain = gain_lo ? (64 * kb < 1024 ? gain_lo : gain_hi - 1024) : nullptr;
    transpose_item64(W, N, 64 * rg, 32, 64 * rg + 32, 32, K, WT, 64 * rg, 64 * kb, scr, lane, gain);
}
__device__ __forceinline__ int in_src_col(int pn, int wc, int bj) {
    if (pn < 16) { const int seg = pn >> 2, base = seg == 0 ? 0 : seg == 1 ? 1024 : seg == 2 ? 2048 : 3088; return base + 256 * (pn & 3) + 64 * wc + 32 * bj; }
    return (wc < 2 ? 4112 + 64 * wc : 4240 + 64 * (wc - 2)) + 32 * bj;
}
__device__ __forceinline__ void conv_in(const float* W, bf16* WT, int r, LAS unsigned char* scr, int lane, const float* gain) {
    constexpr int nrg = N_IN / 64; const int kb = r / nrg, rg = r % nrg, pn = rg >> 2, q = rg & 3, bj = q >> 1, wc0 = 2 * (q & 1);
    int ca, cb, nva = 32, nvb = 32;
    if (pn < 17) { ca = in_src_col(pn, wc0, bj); cb = in_src_col(pn, wc0 + 1, bj); }
    else { ca = 3072; cb = 3072; nva = (q == 0) ? 16 : 0; nvb = 0; }
    transpose_item64(W, IN_W, ca, nva, cb, nvb, D, WT, 64 * rg, 64 * kb, scr, lane, gain);
}
__device__ __forceinline__ void convert_item(Frame& F, unsigned char* w, int l, int r, LAS unsigned char* scr) {
    unsigned char* wl = w + WS_W + (size_t)l * LW_STRIDE;
    if (r < IT_GU) { conv_gu(inptr(F, 3) + (size_t)l * D * FF, inptr(F, 4) + (size_t)l * D * FF, (bf16*)(wl + LW_GU1), r, scr, F.lane, inptr(F, 2) + (size_t)l * D); return; } r -= IT_GU;
    if (r < IT_D) { conv_plain(inptr(F, 5) + (size_t)l * FF * D, FF, D, (bf16*)(wl + LW_D1), r, scr, F.lane); return; } r -= IT_D;
    if (r < IT_IN) { conv_in(inptr(F, 7) + (size_t)l * D * IN_W, (bf16*)(wl + LW_IN), r, scr, F.lane, inptr(F, 6) + (size_t)l * D); return; } r -= IT_IN;
    if (r < IT_OUT) { conv_plain(inptr(F, 16) + (size_t)l * D * D, D, D, (bf16*)(wl + LW_OUT), r, scr, F.lane, inptr(F, 14) + (size_t)l * 1024, inptr(F, 15) + (size_t)l * 1024); return; } r -= IT_OUT;
    if (r < IT_GU) { conv_gu(inptr(F, 18) + (size_t)l * D * FF, inptr(F, 19) + (size_t)l * D * FF, (bf16*)(wl + LW_GU2), r, scr, F.lane, inptr(F, 17) + (size_t)l * D); return; } r -= IT_GU;
    conv_plain(inptr(F, 20) + (size_t)l * FF * D, FF, D, (bf16*)(wl + LW_D2), r, scr, F.lane);
}
#define IDLE_CONV_K 4
constexpr int R_IDLE = IDLE_CONV_K * 128 * NWAVES, GU2_BASE = IT_GU + IT_D + IT_IN + IT_OUT;
static_assert(R_IDLE <= IT_GU, "idle-slot items are SwiGLU-2 items");
__device__ __forceinline__ void convert_layer(Frame& F, unsigned char* w, int l) {
    LAS unsigned char* scr = F.lds + RING_OFF + F.wave * 16384;
    const int gw = F.vcu * NWAVES + F.wave, NGW = F.G * NWAVES;
    if (F.G == 256) { for (int q = gw; q < IT_LAYER - R_IDLE; q += NGW) convert_item(F, w, l, q < GU2_BASE ? q : q + R_IDLE, scr); }
    else for (int r = gw; r < IT_LAYER; r += NGW) convert_item(F, w, l, r, scr);
}
__device__ __forceinline__ void p0_prologue(Frame& F) {
    const int gw = F.vcu * NWAVES + F.wave, NGW = F.G * NWAVES;
    unsigned char* w = wsl(F);
    for (int l = 0; l < (OVERLAP_CONV ? 1 : DEPTH); ++l) convert_layer(F, w, l);
    const GAS float* x = (const GAS float*)inptr(F, 0); const GAS float* meta = (const GAS float*)inptr(F, 1);
    GAS bf16* HB = (GAS bf16*)(w + WS_HB); GAS float* SSQ0 = (GAS float*)(w + WS_SSQ); GAS float* SSQM0 = (GAS float*)(w + WS_SSQM);
    for (int m = gw; m < M_REAL + NMETA; m += NGW) {
        const int row = m < M_REAL ? m : META_ROW + (m - M_REAL);
        GAS unsigned long long* hb8 = (GAS unsigned long long*)(HB + (size_t)row * D) + F.lane;
        const GAS f32x4* xr = (const GAS f32x4*)(m < M_REAL ? x + (size_t)m * D : meta + (size_t)(m - M_REAL) * D) + F.lane;
        float ss = 0.f;
#pragma unroll
        for (int j = 0; j < 8; ++j) { const f32x4 v = xr[64 * j]; const unsigned w0 = pk2(v.x, v.y), w1 = pk2(v.z, v.w); hb8[64 * j] = (unsigned long long)w0 | ((unsigned long long)w1 << 32);
            const float a0 = __builtin_bit_cast(float, w0 << 16), a1 = __builtin_bit_cast(float, w0 & 0xffff0000u), a2 = __builtin_bit_cast(float, w1 << 16), a3 = __builtin_bit_cast(float, w1 & 0xffff0000u);
            ss += (a0 * a0 + a1 * a1) + (a2 * a2 + a3 * a3); }
        ss = wave_sum(ss);
        if (m < M_REAL) { if (F.lane < 32) SSQ0[(size_t)m * 32 + F.lane] = F.lane == 0 ? ss : 0.f; }
        else { SSQM0[(m - M_REAL) * 128 + F.lane] = F.lane == 0 ? ss : 0.f; SSQM0[(m - M_REAL) * 128 + 64 + F.lane] = 0.f; }
    }
    if (gw < 48) { const int row = META_BLK0 + 64 + gw; const v4u z = (v4u){0u, 0u, 0u, 0u};
#pragma unroll
        for (int j = 0; j < 2; ++j) { ((GAS v4u*)(w + WS_FQ + (size_t)row * 2048))[F.lane + 64 * j] = z;
            ((GAS v4u*)(w + WS_SQ + (size_t)row * 2048))[F.lane + 64 * j] = z; } }
    {
        const v4u z = (v4u){0u, 0u, 0u, 0u}; constexpr int RB = (META_BLK0 + 64) >> 5;
        GAS v4u* fk = (GAS v4u*)((GAS bf16*)(w + WS_FK) + (size_t)RB * 16 * 2048); GAS v4u* sk = (GAS v4u*)((GAS bf16*)(w + WS_SK) + (size_t)RB * 2 * 2048);
        for (int i = gw * 64 + F.lane; i < 2 * 16 * 256; i += NGW * 64) fk[i] = z;
        for (int i = gw * 64 + F.lane; i < 2 * 2 * 256; i += NGW * 64) sk[i] = z;
        constexpr int G16 = (META_BLK0 + 64) >> 4;
        GAS v4u* fv = (GAS v4u*)((GAS bf16*)(w + WS_FV) + (size_t)G16 * 16 * 1024); GAS v4u* sv = (GAS v4u*)((GAS bf16*)(w + WS_SV) + (size_t)G16 * 2 * 1024);
        for (int i = gw * 64 + F.lane; i < 4 * 16 * 128; i += NGW * 64) fv[i] = z;
        for (int i = gw * 64 + F.lane; i < 4 * 2 * 128; i += NGW * 64) sv[i] = z; }
}
__device__ __forceinline__ void onorm_phase(Frame& F, const float* gf, const float* gs) {
    const int gw = F.vcu * NWAVES + F.wave, NGW = F.G * NWAVES;
    unsigned char* w = wsl(F); const GAS bf16* O = (const GAS bf16*)(w + WS_O); GAS bf16* XN = (GAS bf16*)(w + WS_XN);
    for (int mm = gw; mm < M_REAL + NMETA; mm += NGW) {
        const int m = mm < M_REAL ? mm : META_ROW + (mm - M_REAL);
        const GAS v4u* orow = (const GAS v4u*)(O + (size_t)m * D) + F.lane;
        GAS v4u* xrow = (GAS v4u*)(XN + (size_t)m * D) + F.lane;
        float x[4][8]; float sf = 0.f, ss = 0.f;
#pragma unroll
        for (int j = 0; j < 4; ++j) { const v4u w = orow[64 * j]; const unsigned ww[4] = {w.x, w.y, w.z, w.w};
#pragma unroll
            for (int e = 0; e < 4; ++e) { x[j][2 * e] = __builtin_bit_cast(float, ww[e] << 16); x[j][2 * e + 1] = __builtin_bit_cast(float, ww[e] & 0xffff0000u); }
            float q = 0.f;
#pragma unroll
            for (int e = 0; e < 8; ++e) q += x[j][e] * x[j][e];
            if (j < 2) sf += q; else ss += q; }
        const float rf = 1.0f / sqrtf(wave_sum(sf) * (1.0f / 1024.f) + EPS), rs = 1.0f / sqrtf(wave_sum(ss) * (1.0f / 1024.f) + EPS);
#pragma unroll
        for (int j = 0; j < 4; ++j) { const float* gp = (j < 2 ? gf : gs) + (j & 1) * 512 + 8 * F.lane; const f32x4 g0 = *(const GAS f32x4*)gp, g1 = *(const GAS f32x4*)(gp + 4); const float r = j < 2 ? rf : rs;
            v4u w; w.x = pk2(x[j][0] * r * g0.x, x[j][1] * r * g0.y); w.y = pk2(x[j][2] * r * g0.z, x[j][3] * r * g0.w); w.z = pk2(x[j][4] * r * g1.x, x[j][5] * r * g1.y); w.w = pk2(x[j][6] * r * g1.z, x[j][7] * r * g1.w);
            xrow[64 * j] = w; }
    }
}

constexpr int SK_RED_OFF = 0, SK_TILE_OFF = 65536, SK_RSTD_OFF = SK_TILE_OFF + 4096;
template <class Epi, int NST  >
__device__ __forceinline__ void skinny_phase(Frame& F, const GAS bf16* A, int lda, const GAS bf16* Bt, int K, const Epi& E) {
    constexpr int TC = Epi::TC;
    int lane = F.lane; asm volatile("" : "+v"(lane));
    const int w = F.wave;
    LAS float* red = (LAS float*)(F.lds + RING_OFF + SK_RED_OFF);
    LAS float* tile = (LAS float*)(F.lds + RING_OFF + SK_TILE_OFF);
    const int k0 = w * (NST * 32);
    bool first = true;
    for (int task = F.G - 1 - (int)blockIdx.x; task < E.ntasks(); task += F.G) {
        pg8::f32x4 acc[TC];
        const GAS bf16* bp[TC];
#pragma unroll
        for (int c = 0; c < TC; ++c) { acc[c] = (pg8::f32x4){0.f, 0.f, 0.f, 0.f}; bp[c] = Bt + (size_t)(E.btrow(task, c) + (lane & 15)) * K + k0 + 8 * (lane >> 4); }
        const GAS bf16* ap = A + (size_t)(lane & 15) * lda + k0 + 8 * (lane >> 4);
        bf16x8 av[NST], bv[TC][NST];
#pragma unroll
        for (int j = 0; j < NST; ++j) { av[j] = *(const GAS bf16x8*)(ap + 32 * j);
#pragma unroll
            for (int c = 0; c < TC; ++c) bv[c][j] = *(const GAS bf16x8*)(bp[c] + 32 * j); }
        if (first) {
            if constexpr (Epi::KHALF_SCALE) {
                LAS float* rv = (LAS float*)(F.lds + RING_OFF + SK_RSTD_OFF);
#pragma unroll
                for (int j = 0; j < 2; ++j) { const int row = 2 * w + j; float t = lane < 32 ? E.ssqom[row * 32 + lane] : 0.f;
#pragma unroll
                    for (int o = 1; o < 16; o <<= 1) t += __shfl_xor(t, o);
                    if (lane == 0) rv[row] = 1.0f / sqrtf(t * (1.0f / 1024.0f) + EPS); if (lane == 16) rv[16 + row] = 1.0f / sqrtf(t * (1.0f / 1024.0f) + EPS); }
            }
            if constexpr (Epi::NEED_RSTD) {
                LAS float* rv = (LAS float*)(F.lds + RING_OFF + SK_RSTD_OFF);
#pragma unroll
                for (int j = 0; j < 2; ++j) { const int row = 2 * w + j; const float t = wave_sum(E.ssqm[row * 128 + lane] + E.ssqm[row * 128 + 64 + lane]); if (lane == 0) rv[row] = 1.0f / sqrtf(t * (1.0f / D) + EPS); }
            }
            first = false;
        }
#pragma unroll
        for (int j = 0; j < NST; ++j)
#pragma unroll
            for (int c = 0; c < TC; ++c) acc[c] = __builtin_amdgcn_mfma_f32_16x16x32_bf16(av[j], bv[c][j], acc[c], 0, 0, 0);
#pragma unroll
        for (int c = 0; c < TC; ++c)
#pragma unroll
            for (int r = 0; r < 4; ++r) red[((w * TC + c) * 4 + r) * 64 + lane] = acc[c][r];
        __syncthreads();
        for (int e = F.tid; e < TC * 256; e += NWAVES * 64) { float sum = 0.f, sum2 = 0.f;
#pragma unroll
            for (int w2 = 0; w2 < 4; ++w2) { sum += red[w2 * TC * 256 + e]; sum2 += red[(w2 + 4) * TC * 256 + e]; }
            const int ln = e & 63, r = (e >> 6) & 3, c = e >> 8, orow = (ln >> 4) * 4 + r;
            if constexpr (Epi::KHALF_SCALE) { const LAS float* rv = (const LAS float*)(F.lds + RING_OFF + SK_RSTD_OFF); sum = sum * rv[orow] + sum2 * rv[16 + orow]; } else sum += sum2;
            tile[orow * 64 + 16 * c + (ln & 15)] = sum; }
        __syncthreads();
        E.store(F, task, tile);
        if (task + F.G < E.ntasks()) __syncthreads();
    }
}
struct SkGU {
    static constexpr int TC = 4; static constexpr bool NEED_RSTD = true, KHALF_SCALE = false;
    GAS bf16* act; const GAS float* ssqm;
    __device__ __forceinline__ int ntasks() const { return FF / 32; }
    __device__ __forceinline__ int btrow(int t, int c) const { const int p = t >> 2, q = t & 3; return 256 * p + 128 * (c >> 1) + 32 * q + 16 * (c & 1); }
    __device__ __forceinline__ void store(Frame& F, int t, const LAS float* tile) const {
        const int row = F.tid >> 5, col = F.tid & 31; const float r = ((const LAS float*)(F.lds + RING_OFF + SK_RSTD_OFF))[row];
        act[(size_t)(META_ROW + row) * FF + 32 * t + col] = (bf16)f2bf(pg8::silu_mul(tile[row * 64 + col] * r, tile[row * 64 + 32 + col] * r));
    }
};
struct SkRes {
    static constexpr int TC = 1; static constexpr bool NEED_RSTD = false, KHALF_SCALE = false;
    float scale; GAS bf16* hb; GAS float* ssqm;
    __device__ __forceinline__ int ntasks() const { return D / 16; }
    __device__ __forceinline__ int btrow(int t, int) const { return 16 * t; }
    __device__ __forceinline__ void store(Frame& F, int t, const LAS float* tile) const {
        if (F.tid < 256) { const int row = F.tid >> 4, col = F.tid & 15; const size_t off = (size_t)(META_ROW + row) * D + 16 * t + col;
            const unsigned hbits = f2bf(bf2f(hb[off]) + scale * tile[row * 64 + col]); hb[off] = (bf16)hbits; const float v = bf2f((bf16)hbits); float ss = v * v;
#pragma unroll
            for (int o = 1; o < 16; o <<= 1) ss += __shfl_xor(ss, o);
            if (col == 0) ssqm[row * 128 + t] = ss; }
    }
};
struct SkOut {
    static constexpr int TC = 1; static constexpr bool NEED_RSTD = false, KHALF_SCALE = true;
    float scale; GAS bf16* hb; GAS float* ssqm; const GAS float* ssqom;
    __device__ __forceinline__ int ntasks() const { return D / 16; }
    __device__ __forceinline__ int btrow(int t, int) const { return 16 * t; }
    __device__ __forceinline__ void store(Frame& F, int t, const LAS float* tile) const {
        if (F.tid < 256) { const int row = F.tid >> 4, col = F.tid & 15; const size_t off = (size_t)(META_ROW + row) * D + 16 * t + col;
            const unsigned hbits = f2bf(bf2f(hb[off]) + scale * tile[row * 64 + col]); hb[off] = (bf16)hbits; const float v = bf2f((bf16)hbits); float ss = v * v;
#pragma unroll
            for (int o = 1; o < 16; o <<= 1) ss += __shfl_xor(ss, o);
            if (col == 0) ssqm[row * 128 + t] = ss; }
    }
};
struct SkIn {
    static constexpr int TC = 4; static constexpr bool NEED_RSTD = true, KHALF_SCALE = false;
    GAS bf16 *fq_, *fk_, *fv_, *sq_, *sk_, *sv_; GAS float* logf; const GAS float *g_fq, *g_fk, *g_sq, *g_sk, *bfg; float qscale; const GAS float* ssqm;
    __device__ __forceinline__ int ntasks() const { return 69; }
    __device__ __forceinline__ int btrow(int t, int c) const { if (t == 68) return 17 * 256 + 16 * c; const int pn = t < 64 ? (t >> 2) : 16, wc = t < 64 ? (t & 3) : (t - 64); return 256 * pn + 128 * (c >> 1) + 32 * wc + 16 * (c & 1); }
    __device__ __forceinline__ void store(Frame& F, int t, const LAS float* tile) const {
        if (t == 68) { if (F.tid < 256) { const int row = F.tid >> 4, hh = F.tid & 15; const float z = tile[row * 64 + hh] * ((const LAS float*)(F.lds + RING_OFF + SK_RSTD_OFF))[row] + bfg[hh];
                logf[(size_t)(META_ROW + row) * 16 + hh] = fminf(z, 0.f) - 0.69314718056f * __builtin_amdgcn_logf(1.0f + __builtin_amdgcn_exp2f(-LOG2E * fabsf(z))); } return; }
        const int pn = t < 64 ? (t >> 2) : 16, wc = t < 64 ? (t & 3) : (t - 64);
        GAS bf16* dst; int pitch, head, knh = 0; const GAS float* gain = nullptr; float sc = 1.f;
        if (pn < 16) { const int seg = pn >> 2; head = (pn & 3) * 4 + wc; pitch = 1024;
            if (seg == 0) { dst = fq_; gain = g_fq; sc = qscale; } else if (seg == 1) { dst = fk_; gain = g_fk; knh = 16; } else if (seg == 2) { dst = fv_; } else { dst = sq_; gain = g_sq; sc = qscale; } }
        else { pitch = 128; head = wc & 1; if (wc < 2) { dst = sk_; gain = g_sk; knh = 2; } else { dst = sv_; } }
        const int row = F.tid >> 5, cp = F.tid & 31; const float rr = ((const LAS float*)(F.lds + RING_OFF + SK_RSTD_OFF))[row];
        float v0 = tile[row * 64 + 2 * cp] * rr, v1 = tile[row * 64 + 2 * cp + 1] * rr;
        if (gain) { float ss = v0 * v0 + v1 * v1;
#pragma unroll
            for (int o = 1; o < 32; o <<= 1) ss += __shfl_xor(ss, o);
            const float rinv = 1.0f / sqrtf(ss * (1.0f / 64.0f) + EPS); v0 = v0 * rinv * gain[2 * cp] * sc; v1 = v1 * rinv * gain[2 * cp + 1] * sc; }
        if (knh) *(GAS unsigned*)(dst + kfrag_idx(META_ROW + row, knh, head, 2 * cp)) = pk2(v0, v1);
        else if (!gain) { GAS bf16* vp = dst + vfrag_idx(META_ROW + row, pn < 16 ? 16 : 2, head, 2 * cp); const unsigned pw = pk2(v0, v1); vp[0] = (bf16)(pw & 0xffffu); vp[8] = (bf16)(pw >> 16); }
        else *(GAS unsigned*)(dst + (size_t)(META_ROW + row) * pitch + head * 64 + 2 * cp) = pk2(v0, v1);
    }
};

__device__ __forceinline__ void split3(float x, unsigned& h, unsigned& m, unsigned& l) { h = f2bf(x); const float r = x - bf2f((unsigned short)h); m = f2bf(r); const float r2 = r - bf2f((unsigned short)m); l = f2bf(r2); }
__device__ __forceinline__ int crow(int r, int hi) { return (r & 3) + 8 * (r >> 2) + 4 * hi; }
typedef short v4i16_t __attribute__((ext_vector_type(4)));
__device__ __forceinline__ float max3f(float a, float b, float c) { return fmaxf(fmaxf(a, b), c); }
constexpr float ATT_THR = 40.0f;
constexpr int ATT_KV_OFF = 36864;
template <int MODE  >
__device__ __forceinline__ void attn_group(Frame& F, unsigned char* w, int gb, int kvh, int c_lo, int c_hi, bool active, int b  , int h, int i, const float* sinks) {
    const int lane = F.lane, r32 = lane & 31, hi = lane >> 5, wv = F.wave;
    const bool meta = b < 0;
    const int qpos0 = meta ? 96 : 128 + 32 * i;
    const int qrow0 = meta ? META_BLK0 + 96 : b * SEQ + 32 * i;
    const int cd = qpos0 >> 6;
    const int cfirst = (MODE == 0) ? (meta ? 1 : __builtin_amdgcn_readfirstlane(((const volatile LAS int*)(F.lds + RING_OFF + ATT_FC_OFF))[i])) : ((qpos0 - 127) < 128 ? 1 : ((qpos0 - 127) >> 6));
    constexpr int NHK = (MODE == 0) ? 16 : 2;
    const GAS bf16* Qp = (const GAS bf16*)(w + (MODE == 0 ? WS_FQ : WS_SQ)) + (size_t)qrow0 * 1024 + h * 64;
    const GAS bf16* kdma = (const GAS bf16*)(w + (MODE == 0 ? WS_FK : WS_SK)) + ((size_t)(wv >> 2) * NHK + kvh) * 2048 + (wv & 3) * 512 + lane * 8;
    const GAS bf16* vdma = (const GAS bf16*)(w + (MODE == 0 ? WS_FV : WS_SV)) + ((size_t)(wv >> 1) * NHK + kvh) * 1024 + (wv & 1) * 512 + lane * 8;
    LAS unsigned char* kvb = F.lds + RING_OFF + ATT_KV_OFF;
    const float sl2 = (MODE == 1) ? exp2f(-0.5f * (float)(h + 1)) * LOG2E : 0.f;
    const LAS unsigned char* tfp = F.lds + RING_OFF + (hi ? ATT_ZERO_OFF : ATT_TABF_OFF + r32 * 16); const int toff = hi ? 0 : 1;
    v4u mfr = hi ? (v4u){0u, 0u, 0u, 0u} : (v4u){0x3F803F80u, 0x3F80u, 0u, 0u};
    bf16x8 qf[4];
    if (active) {
#pragma unroll
        for (int s = 0; s < 4; ++s) qf[s] = *(const GAS bf16x8*)(Qp + (size_t)r32 * 1024 + 16 * s + 8 * hi);
    } else {
#pragma unroll
        for (int s = 0; s < 4; ++s) qf[s] = (bf16x8){0, 0, 0, 0, 0, 0, 0, 0};
    }
#define CHUNK_ROW(c) ((c) == 1 ? META_BLK0 + 64 : gb * SEQ + 64 * ((c) - 2))
#define KV_DMA(c_) do { const int rowk_ = CHUNK_ROW(c_); LAS unsigned char* d_ = kvb + ((c_) & 1) * 16384 + wv * 1024; \
        __builtin_amdgcn_global_load_lds((const unsigned*)(kdma + (size_t)(rowk_ >> 5) * (NHK * 2048)), (LAS unsigned*)d_, 16, 0, 0); \
        __builtin_amdgcn_global_load_lds((const unsigned*)(vdma + (size_t)(rowk_ >> 4) * (NHK * 1024)), (LAS unsigned*)(d_ + 8192), 16, 0, 0); } while (0)
    float m_run = 0.f, l_run = 0.f; f32x16 o0 = {}, o1 = {};
    const float NEG = -1e30f;
    __syncthreads();
    KV_DMA(c_lo);
    for (int c = c_lo; c <= c_hi; ++c) {
        asm volatile("s_waitcnt vmcnt(0) lgkmcnt(0)" ::: "memory"); __builtin_amdgcn_s_barrier(); __builtin_amdgcn_sched_barrier(0);
        if (c < c_hi) KV_DMA(c + 1);
        if (!(active && c >= cfirst && c <= cd)) continue;
        const LAS unsigned char* cb = kvb + (c & 1) * 16384 + hi * 512 + r32 * 16;
        bf16x8 kf[2][4];
#pragma unroll
        for (int t = 0; t < 2; ++t)
#pragma unroll
            for (int s = 0; s < 4; ++s) kf[t][s] = *(const LAS bf16x8*)(cb + t * 4096 + s * 1024);
        f32x16 p0 = {}, p1 = {};
        bf16x8 ab0, ab1;
        if (MODE == 0) { ab0 = *(const LAS bf16x8*)(tfp + toff * (1024 * c)); ab1 = *(const LAS bf16x8*)(tfp + toff * (1024 * c + 512)); }
        __builtin_amdgcn_s_setprio(1);
#pragma unroll
        for (int s = 0; s < 4; ++s) { p0 = __builtin_amdgcn_mfma_f32_32x32x16_bf16(kf[0][s], qf[s], p0, 0, 0, 0); p1 = __builtin_amdgcn_mfma_f32_32x32x16_bf16(kf[1][s], qf[s], p1, 0, 0, 0); }
        if (MODE == 0) { const bf16x8 mb = __builtin_bit_cast(bf16x8, mfr); p0 = __builtin_amdgcn_mfma_f32_32x32x16_bf16(ab0, mb, p0, 0, 0, 0); p1 = __builtin_amdgcn_mfma_f32_32x32x16_bf16(ab1, mb, p1, 0, 0, 0); }
        __builtin_amdgcn_s_setprio(0);
        bf16x8 vf[4][2];
#pragma unroll
        for (int g = 0; g < 4; ++g)
#pragma unroll
            for (int d = 0; d < 2; ++d) vf[g][d] = *(const LAS bf16x8*)(cb + 8192 + g * 2048 + hi * 512 + d * 512);
        if (MODE == 0) {
            if (c == cd) { const int dq = qpos0 + r32 - 64 * c - 4 * hi;
#pragma unroll
                for (int r = 0; r < 16; ++r) { const int e = (r & 3) + 8 * (r >> 2); if (e > dq) p0[r] = NEG; if (e + 32 > dq) p1[r] = NEG; } }
        } else {
            const float kb0 = (float)(64 * c - qpos0 + 4 * hi) - m_run / sl2;
#pragma unroll
            for (int r = 0; r < 16; ++r) { const float e = (float)((r & 3) + 8 * (r >> 2)); p0[r] = fmaf(sl2, kb0 + e, p0[r]); p1[r] = fmaf(sl2, kb0 + 32.f + e, p1[r]); }
            const int dq = qpos0 + r32 - 64 * c - 4 * hi;
            const int padlim = (c == 1) ? 48 - 4 * hi : -1;
            const bool interior = c != 1 && 64 * c + 63 <= qpos0 && 64 * c > qpos0 + 31 - 128;
            if (!interior) {
#pragma unroll
            for (int r = 0; r < 16; ++r) { const int e = (r & 3) + 8 * (r >> 2);
                if ((unsigned)(dq - e) >= 128u || e < padlim) p0[r] = NEG;
                if ((unsigned)(dq - e - 32) >= 128u || e + 32 < padlim) p1[r] = NEG; } }
        }
        float mx = max3f(p0[0], p0[1], p1[0]);
#pragma unroll
        for (int r = 2; r < 16; r += 2) mx = max3f(mx, p0[r], p0[r + 1]);
#pragma unroll
        for (int r = 1; r < 16; r += 2) mx = max3f(mx, p1[r], (r + 1 < 16) ? p1[r + 1] : p1[r]);
        mx = fmaxf(mx, __shfl_xor(mx, 32));
        const bool first = (c == cfirst);
        if (first || __any(mx > ATT_THR)) {
            const float dl = first ? fmaxf(mx, -200.f) : fmaxf(mx, 0.f);
            m_run += dl;
            if (MODE == 0) { unsigned h_, m_, l_; split3(-m_run, h_, m_, l_); if (!hi) { mfr.y = 0x3F80u | (h_ << 16); mfr.z = m_ | (l_ << 16); } }
            const float alpha = first ? 0.f : __builtin_amdgcn_exp2f(-dl);
            l_run *= alpha;
#pragma unroll
            for (int r = 0; r < 16; ++r) { p0[r] -= dl; p1[r] -= dl; }
            if (!first) {
#pragma unroll
                for (int r = 0; r < 16; ++r) { const float ar = __shfl(alpha, crow(r, hi)); o0[r] *= ar; o1[r] *= ar; } }
        }
        float rs = 0.f;
#pragma unroll
        for (int r = 0; r < 16; ++r) { p0[r] = __builtin_amdgcn_exp2f(p0[r]); p1[r] = __builtin_amdgcn_exp2f(p1[r]); rs += p0[r] + p1[r]; }
        rs += __shfl_xor(rs, 32);
        l_run += rs;
#pragma unroll
        for (int t = 0; t < 2; ++t)
#pragma unroll
            for (int s = 0; s < 2; ++s) {
                const f32x16& pp = t ? p1 : p0;
                v4u wq; wq.x = pg8::cvt_pk_bf16(pp[8 * s + 0], pp[8 * s + 1]); wq.y = pg8::cvt_pk_bf16(pp[8 * s + 2], pp[8 * s + 3]); wq.z = pg8::cvt_pk_bf16(pp[8 * s + 4], pp[8 * s + 5]); wq.w = pg8::cvt_pk_bf16(pp[8 * s + 6], pp[8 * s + 7]);
                const bf16x8 pf = __builtin_bit_cast(bf16x8, wq);
                const bf16x8 v0 = vf[2 * t + s][0], v1 = vf[2 * t + s][1];
                o0 = __builtin_amdgcn_mfma_f32_32x32x16_bf16(pf, v0, o0, 0, 0, 0);
                o1 = __builtin_amdgcn_mfma_f32_32x32x16_bf16(pf, v1, o1, 0, 0, 0);
            }
    }
#undef CHUNK_ROW
#undef KV_DMA
    if (!active) return;
    if (MODE == 1) l_run += __builtin_amdgcn_exp2f(sinks[h] * LOG2E + sl2 * (float)r32 - m_run);
    const float inv = 1.0f / l_run;
    const int qrow0e = launder_u(qrow0), he = launder_u(h);
    int lane_e = lane; asm volatile("" : "+v"(lane_e)); const int r32e = lane_e & 31, hie = lane_e >> 5;
    GAS bf16* Op = (GAS bf16*)(w + WS_O) + (size_t)qrow0e * D + (MODE == 0 ? 0 : 1024) + he * 64 + r32e;
    GAS float* sqo = meta ? (GAS float*)(w + WS_SSQOM) + (MODE == 0 ? 0 : 16) + he : (GAS float*)(w + WS_SSQO) + (size_t)qrow0e * 32 + (MODE == 0 ? 0 : 16) + he;
#pragma unroll
    for (int r = 0; r < 16; ++r) { const int q = crow(r, hie); float ir = __shfl(inv, q); if (meta && q < 16) ir = 0.f;
        const unsigned b0 = f2bf(o0[r] * ir), b1 = f2bf(o1[r] * ir);
        Op[(size_t)q * D] = (bf16)b0; Op[(size_t)q * D + 32] = (bf16)b1;
        const float v0 = bf2f((bf16)b0), v1 = bf2f((bf16)b1); float ss = v0 * v0 + v1 * v1;
#pragma unroll
        for (int o = 1; o < 32; o <<= 1) ss += __shfl_xor(ss, o);
        if (r32e == 0) { if (!meta) sqo[(size_t)q * 32] = ss; else if (q >= 16) sqo[(size_t)(q - 16) * 32] = ss; } }
}
__device__ __forceinline__ void attn_phase(Frame& F, const float* sinks, int next_layer  , const float* gq, const float* gk) {
    unsigned char* w = wsl(F); const GAS float* LOGF = (const GAS float*)(w + WS_LOGF);
    const int bh = F.vcu >> 1, fb = bh >> 4, fh = bh & 15;
    LAS float* tab = (LAS float*)(F.lds + RING_OFF + ATT_TAB_OFF);
    LAS float* wtot = (LAS float*)(F.lds + RING_OFF + ATT_WTOT_OFF);
    { float v[5]; float tsum = 0.f; const int p0 = 5 * F.tid;
#pragma unroll
      for (int j = 0; j < 5; ++j) { const int p = p0 + j; float x = 0.f;
          if (p >= PADN && p < LPOS) { const int row = p < 128 ? META_BLK0 + p : fb * SEQ + p - 128; x = LOGF[(size_t)row * 16 + fh]; }
          tsum += x; v[j] = tsum; }
      float inc = tsum;
#pragma unroll
      for (int o = 1; o < 64; o <<= 1) { const float t = __shfl_up(inc, o); if (F.lane >= o) inc += t; }
      if (F.lane == 63) wtot[F.wave] = inc;
      __syncthreads();
      float base = inc - tsum;
      for (int w = 0; w < F.wave; ++w) base += wtot[w];
#pragma unroll
      for (int j = 0; j < 5; ++j) { const int p = p0 + j; if (p < LPOS) { const float cv = (p < PADN) ? 1e30f : (base + v[j]) * LOG2E; tab[p] = cv;
          unsigned h_, m_, l_; split3(fmaxf(-cv, -60000.f), h_, m_, l_);
          LAS unsigned* tf = (LAS unsigned*)(F.lds + RING_OFF + ATT_TABF_OFF + p * 16); unsigned one2 = 0x3F803F80u, zz = 0u; asm volatile("" : "+v"(one2), "+v"(zz));
          tf[0] = h_ | (m_ << 16); tf[1] = l_ | (one2 << 16); tf[2] = one2; tf[3] = zz; } }
      if (F.tid < 4) ((LAS unsigned*)(F.lds + RING_OFF + ATT_ZERO_OFF))[F.tid] = 0u;
      __syncthreads();
      if (F.wave == 0) { float mq = fabsf(((const GAS float*)gq)[F.lane]), mk = fabsf(((const GAS float*)gk)[F.lane]);
#pragma unroll
          for (int o = 1; o < 64; o <<= 1) { mq = fmaxf(mq, __shfl_xor(mq, o)); mk = fmaxf(mk, __shfl_xor(mk, o)); }
          const float thr = -(152.0f + 2.0f * (64.0f * QSCALE * mq * mk * 1.02f + 1.0f));
          const int q0pos = 128 + 32 * F.lane, cdl = q0pos >> 6; const float tq = tab[q0pos]; int c = 1;
          while (c < cdl && tq - tab[64 * c + 63] < thr) ++c;
          ((LAS int*)(F.lds + RING_OFF + ATT_FC_OFF))[F.lane] = c; }
      __syncthreads(); }
    {
      const int odd = F.vcu & 1;
      for (int k = 0; k < 4; ++k) { const int g = (k == 0) ? odd : (k == 1) ? 3 - odd : (k == 2) ? 4 + odd : 7 - odd;
          int cf = 1 << 20;
#pragma unroll
          for (int j = 0; j < 8; ++j) cf = min(cf, ((const volatile LAS int*)(F.lds + RING_OFF + ATT_FC_OFF))[8 * g + j]);
          cf = __builtin_amdgcn_readfirstlane(cf);
          attn_group<0>(F, w, fb, fh, cf, (128 + 32 * (8 * g + 7)) >> 6, true, fb, fh, 8 * g + F.wave, sinks); }
      if (F.vcu < 32 && odd == 0) attn_group<0>(F, w, 0, fh, 1, 1, F.wave == 0, -1, fh, 0, sinks); }
    {
      for (int k = 0; k < 4; ++k) { const int T = F.vcu * 4 + k, sb = T >> 7, kvh = (T >> 6) & 1, i = T & 63; const int qp = 128 + 32 * i;
          attn_group<1>(F, w, sb, kvh, (qp - 127) < 128 ? 1 : ((qp - 127) >> 6), qp >> 6, true, sb, 8 * kvh + F.wave, i, sinks); }
      if (F.vcu < 32 && (F.vcu & 1) == 1) attn_group<1>(F, w, 0, (F.vcu >> 1) >> 3, 1, 1, F.wave == 0, -1, F.vcu >> 1, 0, sinks); }
    __syncthreads();
}

constexpr int PH_PER_LAYER = 7, N_PHASES = 1 + DEPTH * PH_PER_LAYER;
struct Args { const float* in[21]; float* out; unsigned char* ws; int ph_lo, ph_hi, li, pad; };
__global__ void __launch_bounds__(NWAVES * 64, 2) hymba_fwd(Args args) {
    extern __shared__ __attribute__((aligned(16))) unsigned char lds[];
    {
        LAS unsigned char* l0 = (LAS unsigned char*)lds; const int tid = threadIdx.x;
        for (int u = tid; u < (LDS_BYTES - LDSCTL_OFF) / 4; u += NWAVES * 64) ((LAS unsigned*)(l0 + LDSCTL_OFF))[u] = 0u;
        __syncthreads();
        if ((tid & 63) == 0) ((volatile LAS int*)(l0 + WID_OFF))[hw_wave_key()] = tid >> 6;
        volatile LAS unsigned long long* pt = (volatile LAS unsigned long long*)(l0 + PTR_OFF);
#pragma unroll
        for (int k = 0; k < 21; ++k) if (tid == k) pt[k] = (unsigned long long)args.in[k];
        if (tid == 21) pt[21] = (unsigned long long)args.out;
        if (tid == 22) pt[22] = (unsigned long long)args.ws;
        __syncthreads();
#if !MK_PER_PHASE
        (void)xcd_barrier_post((unsigned*)((gu32*)(args.ws + WS_CTL) + CW_BAR), (volatile LAS unsigned*)(l0 + MISC_OFF) + 8);
#endif
    }
    const int lo = args.ph_lo, hi = args.ph_hi;
#define IN(k) (lo <= (k) && (k) < hi)
#define PROBE_T0() if (PROBE_CLASS == 60 && (PROBE_BLOCK < 0 || (int)blockIdx.x == PROBE_BLOCK) && my_tid() == 0) { *(volatile LAS unsigned long long*)((LAS unsigned char*)lds + MISC_OFF + 72) = __builtin_amdgcn_s_memtime(); } else if (PROBE_CLASS >= 0 && (PROBE_BLOCK < 0 || (int)blockIdx.x == PROBE_BLOCK) && my_tid() == 0) { *(volatile LAS unsigned long long*)((LAS unsigned char*)lds + MISC_OFF + 72) = __builtin_amdgcn_s_memrealtime(); }
#define PROBE_T1(c) if (PROBE_CLASS == 60 && (c) == 2 && (PROBE_BLOCK < 0 || (int)blockIdx.x == PROBE_BLOCK) && my_tid() == 0) { volatile LAS unsigned long long* pa_ = (volatile LAS unsigned long long*)((LAS unsigned char*)lds + MISC_OFF + 64); *pa_ = *pa_ + (__builtin_amdgcn_s_memtime() - *(volatile LAS unsigned long long*)((LAS unsigned char*)lds + MISC_OFF + 72)) / 24ull; } else if (PROBE_CLASS == (c) && (PROBE_BLOCK < 0 || (int)blockIdx.x == PROBE_BLOCK) && my_tid() == 0) { volatile LAS unsigned long long* pa_ = (volatile LAS unsigned long long*)((LAS unsigned char*)lds + MISC_OFF + 64); *pa_ = *pa_ + (__builtin_amdgcn_s_memrealtime() - *(volatile LAS unsigned long long*)((LAS unsigned char*)lds + MISC_OFF + 72)); }
#define SEAM(k) do { if (IN(k) && IN((k) + 1)) { PROBE_T0() unsigned char* wsb_ = (unsigned char*)pg8::tab_ptr(22); \
        if (MK_PER_PHASE) { if (my_tid() == 0) __hip_atomic_store((gu32*)(wsb_ + WS_CTL) + CW_TMO, 0xBADBA0u, RLX_AGENT); } \
        else { XcdBarrier bar_; bar_.bar = (unsigned*)((gu32*)(wsb_ + WS_CTL) + CW_BAR); bar_.x = xb_xcc_id(); bar_.st = (volatile LAS unsigned*)((LAS unsigned char*)lds + MISC_OFF) + 8; xcd_barrier(bar_); if (PROBE_CLASS == 50) xcd_barrier(bar_); } PROBE_T1(8) } } while (0)
#define PHASE_BEGIN(k) if (IN(k)) { PROBE_T0() Frame P = make_frame(); \
        unsigned char* w = wsl(P); int ll = l; LAUNDER_S(ll); unsigned char* wl = w + WS_W + (size_t)ll * LW_STRIDE; (void)wl; int bxl = blockIdx.x; LAUNDER_S(bxl);
#define PHASE_END(k, c) PROBE_T1(c) } SEAM(k);
    typedef pg8::StaticOrder SO;
    if (IN(0)) { PROBE_T0() Frame P = make_frame(); p0_prologue(P); PROBE_T1(0) } SEAM(0);
    for (int l = 0; l < DEPTH; ++l) {
        const int pb = 1 + l * PH_PER_LAYER;
#define SSQ(j) ((GAS float*)(w + WS_SSQM) + (size_t)(3 * ll + (j)) * 16 * 128)
#define HBM ((const GAS bf16*)(w + WS_HB) + (size_t)META_ROW * D)
        PHASE_BEGIN(pb + 0) pg8::Gemm g{(const bf16*)(w + WS_HB), (const bf16*)(wl + LW_GU1), M_REAL, N_GU, D}; SO S; S.init(M_REAL, N_GU, P.G, bxl);
            pg8::EpiSwiGLU E{3 * ll + 0}; pg8::gemm_phase<pg8::EpiSwiGLU, SO, true, true>(P.lds + RING_OFF, g, S, E);
            SkGU K2{(GAS bf16*)(w + WS_ACT), SSQ(0)}; skinny_phase<SkGU, D / 256>(P, HBM, D, (const GAS bf16*)(wl + LW_GU1), D, K2); PHASE_END(pb + 0, 2)
        PHASE_BEGIN(pb + 1) pg8::Gemm g{(const bf16*)(w + WS_ACT), (const bf16*)(wl + LW_D1), M_REAL, D, FF}; SO S; S.init(M_REAL, D, P.G, bxl);
            pg8::EpiResAdd E{0.5f, 3 * ll + 1, 0}; pg8::gemm_phase<pg8::EpiResAdd, SO, true, true>(P.lds + RING_OFF, g, S, E);
            SkRes K2{0.5f, (GAS bf16*)(w + WS_HB), SSQ(1)}; skinny_phase<SkRes, FF / 256>(P, (const GAS bf16*)(w + WS_ACT) + (size_t)META_ROW * FF, FF, (const GAS bf16*)(wl + LW_D1), FF, K2); PHASE_END(pb + 1, 3)
        PHASE_BEGIN(pb + 2) pg8::Gemm g{(const bf16*)(w + WS_HB), (const bf16*)(wl + LW_IN), M_REAL, N_IN, D}; SO S; S.init(M_REAL, N_IN, P.G, bxl);
            pg8::EpiInProj E{ll, 3 * ll + 1, QSCALE};
            pg8::gemm_phase<pg8::EpiInProj, SO, true, true>(P.lds + RING_OFF, g, S, E);
            SkIn K2{(GAS bf16*)(w + WS_FQ), (GAS bf16*)(w + WS_FK), (GAS bf16*)(w + WS_FV), (GAS bf16*)(w + WS_SQ), (GAS bf16*)(w + WS_SK), (GAS bf16*)(w + WS_SV), (GAS float*)(w + WS_LOGF), (const GAS float*)(inptr(P, 9) + ll * HD), (const GAS float*)(inptr(P, 10) + ll * HD), (const GAS float*)(inptr(P, 11) + ll * HD), (const GAS float*)(inptr(P, 12) + ll * HD), (const GAS float*)(inptr(P, 8) + ll * NH), QSCALE, SSQ(1)}; skinny_phase<SkIn, D / 256>(P, HBM, D, (const GAS bf16*)(wl + LW_IN), D, K2);
            if (IDLE_CONV_K > 0 && P.G == 256 && bxl >= 128) { __syncthreads(); LAS unsigned char* scr = P.lds + RING_OFF + P.wave * 16384; const int iw = (bxl - 128) * NWAVES + P.wave;
                for (int k = 0; k < IDLE_CONV_K; ++k) convert_item(P, w, ll, GU2_BASE + iw + k * 128 * NWAVES, scr); }
            PHASE_END(pb + 2, 4)
        PHASE_BEGIN(pb + 3) attn_phase(P, inptr(P, 13) + ll * NH, OVERLAP_CONV ? ll + 1 : DEPTH, inptr(P, 9) + ll * HD, inptr(P, 10) + ll * HD); PHASE_END(pb + 3, 5)
        PHASE_BEGIN(pb + 4) pg8::Gemm g{(const bf16*)(w + WS_O), (const bf16*)(wl + LW_OUT), M_REAL, D, D}; SO S; S.init(M_REAL, D, P.G, bxl);
            pg8::EpiOut E{3 * ll + 2}; pg8::gemm_phase<pg8::EpiOut, SO, true, true>(P.lds + RING_OFF, g, S, E);
            SkOut K2{1.0f, (GAS bf16*)(w + WS_HB), SSQ(2), (const GAS float*)(w + WS_SSQOM)}; skinny_phase<SkOut, D / 256>(P, (const GAS bf16*)(w + WS_O) + (size_t)META_ROW * D, D, (const GAS bf16*)(wl + LW_OUT), D, K2); PHASE_END(pb + 4, 7)
        PHASE_BEGIN(pb + 5) pg8::Gemm g{(const bf16*)(w + WS_HB), (const bf16*)(wl + LW_GU2), M_REAL, N_GU, D}; SO S; S.init(M_REAL, N_GU, P.G, bxl);
            pg8::EpiSwiGLU E{3 * ll + 2}; pg8::gemm_phase<pg8::EpiSwiGLU, SO, true, true>(P.lds + RING_OFF, g, S, E);
            if (ll < DEPTH - 1) { SkGU K2{(GAS bf16*)(w + WS_ACT), SSQ(2)}; skinny_phase<SkGU, D / 256>(P, HBM, D, (const GAS bf16*)(wl + LW_GU2), D, K2); } PHASE_END(pb + 5, 2)
        PHASE_BEGIN(pb + 6) pg8::Gemm g{(const bf16*)(w + WS_ACT), (const bf16*)(wl + LW_D2), M_REAL, D, FF}; SO S; S.init(M_REAL, D, P.G, bxl);
            const bool fin = (ll == DEPTH - 1);
            pg8::EpiResAdd E{0.5f, 3 * ll + 3, fin ? 1 : 0}; pg8::gemm_phase<pg8::EpiResAdd, SO, true, true>(P.lds + RING_OFF, g, S, E);
            if (!fin) { SkRes K2{0.5f, (GAS bf16*)(w + WS_HB), SSQ(3)}; skinny_phase<SkRes, FF / 256>(P, (const GAS bf16*)(w + WS_ACT) + (size_t)META_ROW * FF, FF, (const GAS bf16*)(wl + LW_D2), FF, K2); } PHASE_END(pb + 6, 3)
#undef SSQ
#undef HBM
    }
    if (PROBE_CLASS >= 0 && (PROBE_BLOCK < 0 || (int)blockIdx.x == PROBE_BLOCK) && my_tid() == 0) { const unsigned long long t0 = __builtin_amdgcn_s_memrealtime(), dt = *(volatile LAS unsigned long long*)((LAS unsigned char*)lds + MISC_OFF + 64);
        while (__builtin_amdgcn_s_memrealtime() - t0 < dt) __builtin_amdgcn_s_sleep(8); }
#undef IN
#undef SEAM
#undef PHASE_BEGIN
#undef PHASE_END
}

extern "C" void kernel_launch(void* const* d_in, const int* in_sizes, int n_in, void* d_out, int out_size, void* d_ws, size_t ws_size, hipStream_t stream) {
    static int grid = 0;
    if (grid == 0) {
        if (n_in != 21 || in_sizes[0] != M_REAL * D || out_size != M_REAL * D || ws_size < WS_END) { fprintf(stderr, "kernel_launch: unexpected shapes (n_in %d, in0 %d, out %d, ws %zu, need %zu); nothing launched\n", n_in, n_in > 0 ? in_sizes[0] : -1, out_size, ws_size, (size_t)WS_END); grid = -1; return; }
        int dev = 0, cus = 0, per_cu = 0;
        if (hipGetDevice(&dev) != hipSuccess || hipDeviceGetAttribute(&cus, hipDeviceAttributeMultiprocessorCount, dev) != hipSuccess) { fprintf(stderr, "kernel_launch: device query failed\n"); grid = -1; return; }
        if (hipFuncSetAttribute((const void*)hymba_fwd, hipFuncAttributeMaxDynamicSharedMemorySize, LDS_BYTES) != hipSuccess) { fprintf(stderr, "kernel_launch: hipFuncSetAttribute failed\n"); grid = -1; return; }
        if (hipOccupancyMaxActiveBlocksPerMultiprocessor(&per_cu, (const void*)hymba_fwd, NWAVES * 64, LDS_BYTES) != hipSuccess || per_cu < 1) fprintf(stderr, "kernel_launch: note: occupancy query reports %d workgroups per CU\n", per_cu);
        (void)hipGetLastError();
        grid = cus;
        if (grid != 256) fprintf(stderr, "kernel_launch: note: %d CUs (the attention phase's static deal assumes 256)\n", grid);
    }
    if (grid < 0) return;
    if (hipMemsetAsync((char*)d_ws + WS_CTL, 0, CTL_ZERO_BYTES, stream) != hipSuccess) { fprintf(stderr, "kernel_launch: memset failed\n"); return; }
    Args a{};
    for (int i = 0; i < 21; ++i) a.in[i] = (const float*)d_in[i];
    a.out = (float*)d_out; a.ws = (unsigned char*)d_ws; a.li = 0; a.pad = 0;
#if MK_PER_PHASE
    for (int ph = 0; ph < N_PHASES; ++ph) { a.ph_lo = ph; a.ph_hi = ph + 1; hipLaunchKernelGGL(hymba_fwd, dim3(grid), dim3(NWAVES * 64), LDS_BYTES, stream, a); }
#else
    a.ph_lo = 0; a.ph_hi = N_PHASES;
    hipLaunchKernelGGL(hymba_fwd, dim3(grid), dim3(NWAVES * 64), LDS_BYTES, stream, a);
#endif
    const hipError_t le = hipPeekAtLastError();
    if (le != hipSuccess) fprintf(stderr, "kernel_launch: launch failed: %s\n", hipGetErrorName(le));
}
```

```cpp
#include <hip/hip_runtime.h>
#include <cstdio>
#include <cstdint>

#ifndef MK_PER_PHASE
#define MK_PER_PHASE 0
#endif
#ifndef OVERLAP_CONV
#define OVERLAP_CONV 0
#endif
#ifndef PROBE_BLOCK
#define PROBE_BLOCK 0
#endif
#ifndef PROBE_CLASS
#define PROBE_CLASS (-1)
#endif

#define PROBE_ACC_OFF (131072 + 320 + 64)
__device__ __forceinline__ int my_tid();
__device__ __forceinline__ int lane_now() { unsigned z = 0; asm volatile("" : "+v"(z)); return (int)__builtin_amdgcn_mbcnt_hi(~0u, __builtin_amdgcn_mbcnt_lo(~0u, z)); }
template <int O> __device__ __forceinline__ float shx(float v) {
    if constexpr (O < 32) return __builtin_bit_cast(float, __builtin_amdgcn_ds_swizzle(__builtin_bit_cast(int, v), (O << 10) | 0x1f));
    else return __builtin_bit_cast(float, __builtin_amdgcn_ds_bpermute((lane_now() ^ 32) << 2, __builtin_bit_cast(int, v)));
}
__device__ __forceinline__ float shi(float v, int idx) { return __builtin_bit_cast(float, __builtin_amdgcn_ds_bpermute(idx << 2, __builtin_bit_cast(int, v))); }
#define XSUM16(v) do { v += shx<1>(v); v += shx<2>(v); v += shx<4>(v); v += shx<8>(v); } while (0)
#define XSUM32(v) do { XSUM16(v); v += shx<16>(v); } while (0)
#define XSUM64(v) do { XSUM32(v); v += shx<32>(v); } while (0)
namespace pg8 {
#define PG8_LAS __attribute__((address_space(3)))
#define PG8_GAS __attribute__((address_space(1)))
typedef unsigned short bf16_t;
typedef short bf16x8 __attribute__((ext_vector_type(8)));
typedef float f32x4 __attribute__((ext_vector_type(4)));
typedef unsigned u32x4 __attribute__((ext_vector_type(4)));
constexpr int BM = 256, BK = 64, HALF = 128, HTB = HALF * BK * 2  , STAGE_BYTES = 8 * HTB, NXCD = 8, WGM = 8;

__host__ __device__ __forceinline__ int lds_byte(int r, int c) { const int st = (r >> 4) * 2 + (c >> 5), rr = r & 15, cc = c & 31, ob = rr * 64 + cc * 2; return st * 1024 + (ob ^ (((ob >> 9) & 1) << 5)); }
__host__ __device__ __forceinline__ void stage_rc(int b, int& R, int& C) { const int st = b / 1024, sb = b % 1024, swz = sb ^ (((sb >> 9) & 1) << 5); R = (st >> 1) * 16 + swz / 64; C = (st & 1) * 32 + (swz % 64) / 2; }
__host__ __device__ __forceinline__ int perm32(int rho) { const int n = rho >> 4, i = rho & 15; return 8 * (i >> 2) + 4 * n + (i & 3); }

struct Unit { int pm, pn; };
struct Gemm { const bf16_t* A; const bf16_t* Bt; int M, N, K; };

struct StaticOrder {
    int nM, nN, nwg, G, c;
    __host__ __device__ void init(int M, int N, int G_, int c_) { nM = M / BM; nN = N / BM; nwg = nM * nN; G = G_; c = c_; }
    __host__ __device__ bool next(int i, Unit& u) const {
        const long L = (long)i * G + c; if (L >= nwg) return false;
        int wgid = (int)L; { const int q = nwg / NXCD, r = nwg % NXCD, xcd = wgid % NXCD, off = wgid / NXCD; wgid = (xcd < r ? xcd * (q + 1) : r * (q + 1) + (xcd - r) * q) + off; }
        const int nig = WGM * nN, gid = wgid / nig, fm = gid * WGM, gsz = (nM - fm) < WGM ? (nM - fm) : WGM;
        u.pm = fm + ((wgid % nig) % gsz); u.pn = (wgid % nig) / gsz; return true;
    }
    __device__ __forceinline__ void a_ready(const Unit&) const {}
    __device__ __forceinline__ void done(const Unit&) const {}
};

__device__ __forceinline__ unsigned cvt_pk_bf16(float lo, float hi) { unsigned r; asm volatile("v_cvt_pk_bf16_f32 %0, %1, %2" : "=v"(r) : "v"(lo), "v"(hi)); return r; }

template <class Epi, class Sched, bool ALIGN_EPI = false, bool SP2 = false>
__device__ __forceinline__ void gemm_phase(PG8_LAS unsigned char* lds, const Gemm g, const Sched& S, const Epi& E) {
    int tid_l = my_tid(); asm volatile("" : "+v"(tid_l));
    const int tid = tid_l, wid = __builtin_amdgcn_readfirstlane(tid >> 6), lane = tid & 63, wr = wid >> 2, wc = wid & 3, fr = lane & 15, fq = lane >> 4;
    const int K = g.K, nt = K / BK;
    unsigned voffA[2], voffB[2];
#pragma unroll
    for (int i = 0; i < 2; ++i) { int R, C; stage_rc(tid * 16 + i * 8192, R, C); const int Rb = Epi::PERM ? ((R & ~31) + perm32(R & 31)) : R;
        voffA[i] = (unsigned)(R * K + C) * 2u; voffB[i] = (unsigned)(Rb * K + C) * 2u; }
    const size_t kstep = (size_t)(BK * 2);
    const size_t hstep = (size_t)HALF * K * 2;
    const size_t tstep = 2 * hstep;
    const unsigned ldsw = (unsigned)wid * 1024u;
    const int aoff = lds_byte(wr * 64 + fr, fq * 8), boff = lds_byte(wc * 32 + fr, fq * 8);
#define PG8_SA(b, h) (((b) * 2 + (h)) * HTB)
#define PG8_SB(b, h) ((4 + (b) * 2 + (h)) * HTB)
#define PG8_STAGE(bufoff, gbase, voff) do { _Pragma("unroll") for (int _i = 0; _i < 2; ++_i) \
        __builtin_amdgcn_global_load_lds((const unsigned*)((const char*)(gbase) + (voff)[_i]), (PG8_LAS unsigned*)(lds + (bufoff) + ldsw + _i * 8192), 16, 0, 0); } while (0)
#define PG8_LDA(dst, b, h) do { _Pragma("unroll") for (int m = 0; m < 4; ++m) _Pragma("unroll") for (int k = 0; k < 2; ++k) dst[m][k] = *(const PG8_LAS bf16x8*)(lds + PG8_SA(b, h) + aoff + m * 2048 + k * 1024); } while (0)
#define PG8_LDB(dst, b, h) do { _Pragma("unroll") for (int n = 0; n < 2; ++n) _Pragma("unroll") for (int k = 0; k < 2; ++k) dst[n][k] = *(const PG8_LAS bf16x8*)(lds + PG8_SB(b, h) + boff + n * 2048 + k * 1024); } while (0)
#define PG8_MMA(ai, bj, At, Bt) do { __builtin_amdgcn_s_setprio(1); _Pragma("unroll") for (int m = 0; m < 4; ++m) _Pragma("unroll") for (int n = 0; n < 2; ++n) _Pragma("unroll") for (int k = 0; k < 2; ++k) \
        acc[ai][bj][m][n] = __builtin_amdgcn_mfma_f32_16x16x32_bf16(Bt[n][k], At[m][k], acc[ai][bj][m][n], 0, 0, 0); __builtin_amdgcn_s_setprio(0); } while (0)
#define PG8_WAIT_V(n) asm volatile("s_waitcnt vmcnt(" #n ")" ::: "memory")
#define PG8_WAIT_L(n) asm volatile("s_waitcnt lgkmcnt(" #n ")" ::: "memory")
#define PG8_BAR __builtin_amdgcn_s_barrier()
#define PG8_SCHED __builtin_amdgcn_sched_barrier(0)
    Unit cur, nxt; int ui = 0;
    if (!S.next(0, cur)) return;
    f32x4 acc[2][2][4][2];
#pragma unroll
    for (int a = 0; a < 2; ++a)
#pragma unroll
        for (int b = 0; b < 2; ++b)
#pragma unroll
            for (int m = 0; m < 4; ++m)
#pragma unroll
                for (int n = 0; n < 2; ++n) acc[a][b][m][n] = (f32x4){0.f, 0.f, 0.f, 0.f};
    bf16x8 At[4][2], B0[2][2], B1[2][2];
    const char* cA = (const char*)g.A + (size_t)cur.pm * tstep; const char* cB = (const char*)g.Bt + (size_t)cur.pn * tstep;
    S.a_ready(cur);
    if constexpr (SP2) {
        PG8_STAGE(PG8_SB(0, 0), cB, voffB); PG8_STAGE(PG8_SB(0, 1), cB + hstep, voffB); PG8_STAGE(PG8_SA(0, 0), cA, voffA); PG8_STAGE(PG8_SA(0, 1), cA + hstep, voffA);
        if (wr == 1) PG8_BAR;
        PG8_WAIT_V(2); PG8_BAR;
        PG8_STAGE(PG8_SB(1, 0), cB + kstep, voffB); PG8_STAGE(PG8_SA(1, 0), cA + kstep, voffA); PG8_STAGE(PG8_SB(1, 1), cB + hstep + kstep, voffB);
        PG8_WAIT_V(6); PG8_BAR;
    } else {
        PG8_STAGE(PG8_SB(0, 0), cB, voffB); PG8_STAGE(PG8_SA(0, 0), cA, voffA); PG8_STAGE(PG8_SB(0, 1), cB + hstep, voffB); PG8_STAGE(PG8_SA(0, 1), cA + hstep, voffA);
        if (wr == 1) PG8_BAR;
        PG8_WAIT_V(4); PG8_BAR;
        PG8_STAGE(PG8_SB(1, 0), cB + kstep, voffB); PG8_STAGE(PG8_SA(1, 0), cA + kstep, voffA); PG8_STAGE(PG8_SB(1, 1), cB + hstep + kstep, voffB);
        PG8_WAIT_V(6); PG8_BAR;
    }
    for (;;) {
        const bool has_next = S.next(ui + 1, nxt);
        const char* nA = has_next ? (const char*)g.A + (size_t)nxt.pm * tstep : cA; const char* nB = has_next ? (const char*)g.Bt + (size_t)nxt.pn * tstep : cB;
        for (int t = 0; t < nt; t += 2) {
            const bool last = (t == nt - 2);
            const char* a1 = cA + (size_t)(t + 1) * kstep;
            const char* a2 = last ? nA : cA + (size_t)(t + 2) * kstep; const char* b2 = last ? nB : cB + (size_t)(t + 2) * kstep;
            const char* a3 = a2 + kstep; const char* b3 = b2 + kstep;
            if (last && has_next) S.a_ready(nxt);
            if constexpr (Epi::MID) { if (t == nt / 2) E.mid(acc, cur, wr, wc, fr, fq); }
            if constexpr (SP2) {
            PG8_LDB(B0, 0, 0); PG8_LDB(B1, 0, 1); PG8_SCHED; PG8_LDA(At, 0, 0); PG8_STAGE(PG8_SA(1, 1), a1 + hstep, voffA);
            PG8_WAIT_V(8); PG8_WAIT_L(0); PG8_BAR; PG8_MMA(0, 0, At, B0); PG8_MMA(0, 1, At, B1); PG8_BAR; PG8_SCHED;
            PG8_LDA(At, 0, 1); PG8_STAGE(PG8_SB(0, 0), b2, voffB); PG8_STAGE(PG8_SB(0, 1), b2 + hstep, voffB); PG8_STAGE(PG8_SA(0, 0), a2, voffA);
            PG8_WAIT_V(8); PG8_WAIT_L(0); PG8_BAR; PG8_MMA(1, 0, At, B0); PG8_MMA(1, 1, At, B1); PG8_BAR; PG8_SCHED;
            PG8_LDB(B0, 1, 0); PG8_LDB(B1, 1, 1); PG8_SCHED; PG8_LDA(At, 1, 0); PG8_STAGE(PG8_SA(0, 1), a2 + hstep, voffA);
            PG8_WAIT_V(8); PG8_WAIT_L(0); PG8_BAR; PG8_MMA(0, 0, At, B0); PG8_MMA(0, 1, At, B1); PG8_BAR; PG8_SCHED;
            PG8_LDA(At, 1, 1); PG8_STAGE(PG8_SB(1, 0), b3, voffB); PG8_STAGE(PG8_SB(1, 1), b3 + hstep, voffB); PG8_STAGE(PG8_SA(1, 0), a3, voffA);
            PG8_WAIT_V(8); PG8_WAIT_L(0); PG8_BAR; PG8_MMA(1, 0, At, B0); PG8_MMA(1, 1, At, B1); PG8_BAR; PG8_SCHED;
            } else {
            PG8_LDB(B0, 0, 0); PG8_SCHED; PG8_LDA(At, 0, 0); PG8_STAGE(PG8_SA(1, 1), a1 + hstep, voffA);
            PG8_WAIT_L(8); PG8_BAR; PG8_WAIT_L(0); PG8_MMA(0, 0, At, B0); PG8_BAR; PG8_SCHED;
            PG8_LDB(B1, 0, 1); PG8_STAGE(PG8_SB(0, 0), b2, voffB);
            PG8_BAR; PG8_WAIT_L(0); PG8_MMA(0, 1, At, B1); PG8_BAR;
            PG8_LDA(At, 0, 1); PG8_STAGE(PG8_SA(0, 0), a2, voffA);
            PG8_BAR; PG8_WAIT_L(0); PG8_MMA(1, 0, At, B0); PG8_BAR; PG8_SCHED;
            PG8_STAGE(PG8_SB(0, 1), b2 + hstep, voffB);
            PG8_WAIT_V(6); PG8_BAR; PG8_MMA(1, 1, At, B1); PG8_BAR;
            PG8_LDB(B0, 1, 0); PG8_SCHED; PG8_LDA(At, 1, 0); PG8_STAGE(PG8_SA(0, 1), a2 + hstep, voffA);
            PG8_WAIT_L(8); PG8_BAR; PG8_WAIT_L(0); PG8_MMA(0, 0, At, B0); PG8_BAR; PG8_SCHED;
            PG8_LDB(B1, 1, 1); PG8_STAGE(PG8_SB(1, 0), b3, voffB);
            PG8_BAR; PG8_WAIT_L(0); PG8_MMA(0, 1, At, B1); PG8_BAR;
            PG8_LDA(At, 1, 1); PG8_STAGE(PG8_SA(1, 0), a3, voffA);
            PG8_BAR; PG8_WAIT_L(0); PG8_MMA(1, 0, At, B0); PG8_BAR; PG8_SCHED;
            PG8_STAGE(PG8_SB(1, 1), b3 + hstep, voffB);
            PG8_WAIT_V(6); PG8_BAR; PG8_MMA(1, 1, At, B1); PG8_BAR;
            }
        }
        if constexpr (ALIGN_EPI) { if (wr == 0) PG8_BAR; }
        if constexpr (PROBE_CLASS == 20 + Epi::ID) { unsigned long long t0_ = 0; if ((PROBE_BLOCK < 0 || (int)blockIdx.x == PROBE_BLOCK) && tid == 0) t0_ = __builtin_amdgcn_s_memrealtime();
            E(acc, cur, wr, wc, fr, fq); asm volatile("s_waitcnt vmcnt(0)" ::: "memory");
            if ((PROBE_BLOCK < 0 || (int)blockIdx.x == PROBE_BLOCK) && tid == 0) { volatile PG8_LAS unsigned long long* pa_ = (volatile PG8_LAS unsigned long long*)(lds + PROBE_ACC_OFF); *pa_ = *pa_ + (__builtin_amdgcn_s_memrealtime() - t0_); } }
        else if constexpr (!Epi::AFTER_DRAIN) { E(acc, cur, wr, wc, fr, fq); S.done(cur); }
        if (!has_next) break;
#pragma unroll
        for (int a = 0; a < 2; ++a)
#pragma unroll
            for (int b = 0; b < 2; ++b)
#pragma unroll
                for (int m = 0; m < 4; ++m)
#pragma unroll
                    for (int n = 0; n < 2; ++n) acc[a][b][m][n] = (f32x4){0.f, 0.f, 0.f, 0.f};
        cur = nxt; cA = nA; cB = nB; ++ui;
        if constexpr (ALIGN_EPI) { if (wr == 1) PG8_BAR; }
    }
    PG8_WAIT_V(0);
    if constexpr (!ALIGN_EPI) { if (wr == 0) PG8_BAR; }
    PG8_BAR;
#undef PG8_SA
#undef PG8_SB
#undef PG8_STAGE
#undef PG8_LDA
#undef PG8_LDB
#undef PG8_MMA
#undef PG8_WAIT_V
#undef PG8_WAIT_L
#undef PG8_BAR
#undef PG8_SCHED
}
}

constexpr int NWAVES = 8;
constexpr int D = 2048, NB = 8, SEQ = 2048, DEPTH = 4, HD = 64, NH = 16, FF = 5632, NMETA = 16, PADN = 112;
constexpr int M_REAL = NB * SEQ;
constexpr int M_PAD = M_REAL + 128;
constexpr int META_BLK0 = M_REAL;
constexpr int META_ROW = META_BLK0 + PADN;
constexpr int LPOS = SEQ + 128;
constexpr int N_GU = 2 * FF;
constexpr int N_IN = 18 * 256;
constexpr int IN_W = 4368;
constexpr float EPS = 1e-6f;
constexpr float LOG2E = 1.4426950408889634f;
constexpr float QSCALE = 0.125f * LOG2E;

constexpr size_t MiB = 1u << 20;
constexpr int NSLOT = 13;
constexpr size_t WS_CTL = 0, CTL_ZERO_BYTES = 1 * MiB;
constexpr size_t SZ_WGU = (size_t)N_GU * D * 2, SZ_WD = (size_t)D * FF * 2, SZ_WIN = (size_t)N_IN * D * 2, SZ_WOUT = (size_t)D * D * 2;
constexpr size_t LW_GU1 = 0, LW_D1 = LW_GU1 + SZ_WGU, LW_IN = LW_D1 + SZ_WD, LW_OUT = LW_IN + SZ_WIN, LW_GU2 = LW_OUT + SZ_WOUT, LW_D2 = LW_GU2 + SZ_WGU, LW_STRIDE = LW_D2 + SZ_WD;
constexpr size_t WS_W = 1 * MiB;
constexpr size_t WS_XN = WS_W + DEPTH * LW_STRIDE;
constexpr size_t WS_O = WS_XN + (size_t)M_PAD * D * 2;
constexpr size_t WS_ACT = WS_O + (size_t)M_PAD * D * 2;
constexpr size_t SZ_QK = (size_t)M_PAD * 1024 * 2, SZ_KV = (size_t)M_PAD * 128 * 2;
constexpr size_t WS_FQ = WS_ACT + (size_t)M_PAD * FF * 2, WS_FK = WS_FQ + SZ_QK, WS_FV = WS_FK + SZ_QK, WS_SQ = WS_FV + SZ_QK, WS_SK = WS_SQ + SZ_QK, WS_SV = WS_SK + SZ_KV, WS_LOGF = WS_SV + SZ_KV;
constexpr size_t WS_HB = WS_LOGF + (size_t)M_PAD * 16 * 4;
constexpr size_t WS_SSQ = WS_HB + (size_t)M_PAD * D * 2;
constexpr size_t WS_SSQM = WS_SSQ + (size_t)NSLOT * M_REAL * 32 * 4;
constexpr size_t WS_SSQO = WS_SSQM + (size_t)NSLOT * 16 * 128 * 4;
constexpr size_t WS_SSQOM = WS_SSQO + (size_t)M_REAL * 32 * 4;
constexpr size_t WS_END = WS_SSQOM + 16 * 32 * 4;
static_assert(LW_STRIDE % 256 == 0 && WS_XN % 256 == 0 && WS_ACT % 256 == 0 && WS_FQ % 256 == 0 && WS_SK % 256 == 0 && WS_LOGF % 256 == 0 && WS_HB % 256 == 0, "alignment");
constexpr int CW_TMO = 0, CW_BAR = 4096;

constexpr int RING_OFF = 0, RING_BYTES = 131072;
constexpr int LDSCTL_OFF = RING_BYTES, MISC_OFF = LDSCTL_OFF + 320, PTR_OFF = LDSCTL_OFF + 1024;
constexpr int LDS_BYTES = 155648;
constexpr int WID_OFF = LDSCTL_OFF + 1280;
constexpr int RSTD_ID_OFF = LDSCTL_OFF + 1536, RSTD_OFF = LDSCTL_OFF + 2048;
static_assert(RSTD_OFF + 8 * 128 * 4 <= LDS_BYTES, "LDS map");
constexpr int RSTD2_OFF = 148480;
static_assert(RSTD2_OFF + 8 * 128 * 4 <= LDS_BYTES, "LDS map");
constexpr int ATT_TAB_OFF = 139264;
constexpr int ATT_WTOT_OFF = ATT_TAB_OFF + 8704;
constexpr int ATT_FC_OFF = ATT_WTOT_OFF + 64;
constexpr int ATT_TABF_OFF = 0, ATT_ZERO_OFF = 2176 * 16;
constexpr int ATT_VST_OFF = 0, ATT_VST_PITCH = 128, ATT_VST_BYTES = 64 * ATT_VST_PITCH;
static_assert(ATT_VST_OFF + NWAVES * 2 * ATT_VST_BYTES <= RING_BYTES && ATT_FC_OFF + 256 <= RSTD2_OFF && RSTD_OFF + 8 * 128 * 4 <= ATT_TAB_OFF, "attention LDS");

#define GAS __attribute__((address_space(1)))
#define LAS __attribute__((address_space(3)))
typedef unsigned short bf16;
typedef unsigned v4u __attribute__((ext_vector_type(4)));
typedef float f32x4 __attribute__((ext_vector_type(4)));
typedef float f32x16 __attribute__((ext_vector_type(16)));
typedef short bf16x8 __attribute__((ext_vector_type(8)));
typedef GAS unsigned gu32;
#define RLX_AGENT __ATOMIC_RELAXED, __HIP_MEMORY_SCOPE_AGENT
#define LDS_WAIT() asm volatile("s_waitcnt lgkmcnt(0)" ::: "memory")
__device__ __forceinline__ unsigned f2bf(float f) { unsigned u = __builtin_bit_cast(unsigned, f); return (u + 0x7fffu + ((u >> 16) & 1u)) >> 16; }
__device__ __forceinline__ unsigned pk2(float lo, float hi) { return f2bf(lo) | (f2bf(hi) << 16); }
__device__ __forceinline__ float bf2f(unsigned short b) { return __builtin_bit_cast(float, (unsigned)b << 16); }

__device__ __forceinline__ int hw_wave_key() { return (int)(__builtin_amdgcn_s_getreg(((6 - 1) << 11) | 4) & 63u); }
__device__ __forceinline__ int my_tid() {
    extern __shared__ __attribute__((aligned(16))) unsigned char lds_dyn_[];
    const int wave = __builtin_amdgcn_readfirstlane(((const volatile LAS int*)((LAS unsigned char*)lds_dyn_ + WID_OFF))[hw_wave_key()]);
    unsigned zero = 0u; asm volatile("" : "+v"(zero));
    return wave * 64 + (int)__builtin_amdgcn_mbcnt_hi(~0u, __builtin_amdgcn_mbcnt_lo(~0u, zero));
}
__host__ __device__ __forceinline__ size_t kfrag_idx(int row, int nh, int head, int d) { return ((((size_t)(row >> 5) * nh + head) * 8 + (d >> 3)) * 32 + (row & 31)) * 8 + (d & 7); }
__host__ __device__ __forceinline__ size_t vfrag_idx(int row, int nh, int head, int d) { return (((((size_t)(row >> 4) * nh + head) * 2 + ((row >> 2) & 1)) * 64 + d) * 8) + (((row >> 3) & 1) * 4 + (row & 3)); }
namespace pg8 {
__device__ __forceinline__ unsigned long long tab_ptr(int k) {
    extern __shared__ __attribute__((aligned(16))) unsigned char lds_dyn_[];
    const volatile PG8_LAS unsigned* t = (const volatile PG8_LAS unsigned*)((PG8_LAS unsigned char*)lds_dyn_ + PTR_OFF);
    const unsigned lo = __builtin_amdgcn_readfirstlane(t[2 * k]), hi = __builtin_amdgcn_readfirstlane(t[2 * k + 1]);
    return ((unsigned long long)hi << 32) | lo;
}
__device__ __forceinline__ const PG8_LAS float* ensure_rstd(const PG8_GAS float* ssq, int slot, int pm, int wid, int wr, int lane) {
    extern __shared__ __attribute__((aligned(16))) unsigned char lds_dyn_[];
    volatile PG8_LAS unsigned* idw = (volatile PG8_LAS unsigned*)((PG8_LAS unsigned char*)lds_dyn_ + RSTD_ID_OFF) + wid;
    PG8_LAS float* rv = (PG8_LAS float*)((PG8_LAS unsigned char*)lds_dyn_ + RSTD_OFF) + wid * 128;
    const unsigned want = ((unsigned)(slot + 1) << 16) | (unsigned)(pm + 1);
    if ((unsigned)__builtin_amdgcn_readfirstlane(*idw) != want) {
#pragma unroll
        for (int j = 0; j < 2; ++j) { const int row = pm * BM + HALF * j + 64 * wr + lane; const PG8_GAS f32x4* pp = (const PG8_GAS f32x4*)(ssq + (size_t)row * 32); float t = 0.f;
#pragma unroll
            for (int q = 0; q < 8; ++q) { const f32x4 a = pp[q]; t += (a[0] + a[1]) + (a[2] + a[3]); }
            rv[64 * j + lane] = 1.0f / sqrtf(t * (1.0f / 2048.0f) + 1e-6f); }
        if (lane == 0) *idw = want;
        asm volatile("s_waitcnt lgkmcnt(0)" ::: "memory");
    }
    return rv;
}
__device__ __forceinline__ float silu_mul(float g, float u) {
    const float e = __builtin_amdgcn_exp2f(-1.4426950408889634f * g);
    return g * __builtin_amdgcn_rcpf(1.0f + e) * u;
}
struct EpiSwiGLU {
    static constexpr bool PERM = true, AFTER_DRAIN = false, MID = false; static constexpr int ID = 0;
    int slot;
    __device__ __forceinline__ void operator()(const f32x4 (&acc)[2][2][4][2], const Unit& u, int wr, int wc, int fr, int fq) const {
        PG8_GAS unsigned char* w = (PG8_GAS unsigned char*)tab_ptr(22); PG8_GAS bf16_t* O = (PG8_GAS bf16_t*)(w + WS_ACT); constexpr int ldc = FF; const PG8_GAS float* ssq = (const PG8_GAS float*)(w + WS_SSQ) + (size_t)slot * M_REAL * 32;
        const int row0 = u.pm * BM + wr * 64 + fr, col0 = u.pn * HALF + wc * 32 + 8 * fq;
        const PG8_LAS float* rv = ensure_rstd(ssq, slot, u.pm, wr * 4 + wc, wr, fr + 16 * fq);
        float rs[2][4];
#pragma unroll
        for (int ai = 0; ai < 2; ++ai)
#pragma unroll
            for (int m = 0; m < 4; ++m) rs[ai][m] = rv[64 * ai + 16 * m + fr];
#pragma unroll
        for (int ai = 0; ai < 2; ++ai)
#pragma unroll
            for (int m = 0; m < 4; ++m) { PG8_GAS bf16_t* rowp = O + (size_t)(row0 + ai * HALF + m * 16) * ldc + col0;
                const float r = rs[ai][m];
                const f32x4 g0 = acc[ai][0][m][0] * r, g1 = acc[ai][0][m][1] * r, u0 = acc[ai][1][m][0] * r, u1 = acc[ai][1][m][1] * r;
                u32x4 w; w.x = cvt_pk_bf16(silu_mul(g0[0], u0[0]), silu_mul(g0[1], u0[1])); w.y = cvt_pk_bf16(silu_mul(g0[2], u0[2]), silu_mul(g0[3], u0[3]));
                w.z = cvt_pk_bf16(silu_mul(g1[0], u1[0]), silu_mul(g1[1], u1[1])); w.w = cvt_pk_bf16(silu_mul(g1[2], u1[2]), silu_mul(g1[3], u1[3]));
                *(PG8_GAS u32x4*)rowp = w; }
    }
};
struct EpiResAdd {
    static constexpr bool PERM = true, AFTER_DRAIN = false, MID = false; static constexpr int ID = 1;
    float scale; int slot; int fin;
    __device__ __forceinline__ void operator()(const f32x4 (&acc)[2][2][4][2], const Unit& u, int wr, int wc, int fr, int fq) const {
        PG8_GAS unsigned char* w = (PG8_GAS unsigned char*)tab_ptr(22); PG8_GAS bf16_t* hb = (PG8_GAS bf16_t*)(w + WS_HB); PG8_GAS float* out = (PG8_GAS float*)tab_ptr(21);
        PG8_GAS float* ssq = (PG8_GAS float*)(w + WS_SSQ) + (size_t)slot * M_REAL * 32; constexpr int ldc = D;
        const int row0 = u.pm * BM + wr * 64 + fr, col0 = u.pn * BM + wc * 32 + 8 * fq;
        u32x4 bs[2][4][2];
#pragma unroll
        for (int ai = 0; ai < 2; ++ai)
#pragma unroll
            for (int m = 0; m < 4; ++m)
#pragma unroll
                for (int bj = 0; bj < 2; ++bj) bs[ai][m][bj] = *(const PG8_GAS u32x4*)(hb + (size_t)(row0 + ai * HALF + m * 16) * ldc + col0 + bj * HALF);
#pragma unroll
        for (int ai = 0; ai < 2; ++ai)
#pragma unroll
            for (int m = 0; m < 4; ++m) { float ss = 0.f; const size_t off = (size_t)(row0 + ai * HALF + m * 16) * ldc + col0;
#pragma unroll
                for (int bj = 0; bj < 2; ++bj) { const u32x4 b = bs[ai][m][bj]; const unsigned bw[4] = {b.x, b.y, b.z, b.w}; float v[8];
#pragma unroll
                    for (int e = 0; e < 4; ++e) { v[2 * e] = __builtin_bit_cast(float, bw[e] << 16) + scale * acc[ai][bj][m][e >> 1][(2 * e) & 3]; v[2 * e + 1] = __builtin_bit_cast(float, bw[e] & 0xffff0000u) + scale * acc[ai][bj][m][e >> 1][(2 * e + 1) & 3]; }
                    if (fin) { *(PG8_GAS f32x4*)(out + off + bj * HALF) = (f32x4){v[0], v[1], v[2], v[3]}; *(PG8_GAS f32x4*)(out + off + bj * HALF + 4) = (f32x4){v[4], v[5], v[6], v[7]}; }
                    else { u32x4 wv; wv.x = cvt_pk_bf16(v[0], v[1]); wv.y = cvt_pk_bf16(v[2], v[3]); wv.z = cvt_pk_bf16(v[4], v[5]); wv.w = cvt_pk_bf16(v[6], v[7]); *(PG8_GAS u32x4*)(hb + off + bj * HALF) = wv;
                        const unsigned ww[4] = {wv.x, wv.y, wv.z, wv.w};
#pragma unroll
                        for (int e = 0; e < 4; ++e) { const float lo = __builtin_bit_cast(float, ww[e] << 16), hi2 = __builtin_bit_cast(float, ww[e] & 0xffff0000u); ss += lo * lo + hi2 * hi2; } } }
                if (!fin) { ss += shx<16>(ss); ss += shx<32>(ss);
                    if (fq == 0) ssq[(size_t)(row0 + ai * HALF + m * 16) * 32 + u.pn * 4 + wc] = ss; } }
    }
};
__device__ __forceinline__ void ensure_rstd_o(const PG8_GAS float* ssqo, int slot, int pm, int wid, int wr, int lane, const PG8_LAS float*& rs_out, const PG8_LAS float*& ratio_out) {
    extern __shared__ __attribute__((aligned(16))) unsigned char lds_dyn_[];
    volatile PG8_LAS unsigned* idw = (volatile PG8_LAS unsigned*)((PG8_LAS unsigned char*)lds_dyn_ + RSTD_ID_OFF) + wid;
    PG8_LAS float* rv = (PG8_LAS float*)((PG8_LAS unsigned char*)lds_dyn_ + RSTD_OFF) + wid * 128;
    PG8_LAS float* rq = (PG8_LAS float*)((PG8_LAS unsigned char*)lds_dyn_ + RSTD2_OFF) + wid * 128;
    const unsigned want = ((0x4000u | (unsigned)(slot + 1)) << 16) | (unsigned)(pm + 1);
    if ((unsigned)__builtin_amdgcn_readfirstlane(*idw) != want) {
#pragma unroll
        for (int j = 0; j < 2; ++j) { const int row = pm * BM + HALF * j + 64 * wr + lane; const PG8_GAS f32x4* pp = (const PG8_GAS f32x4*)(ssqo + (size_t)row * 32); float tf = 0.f, ts = 0.f;
#pragma unroll
            for (int q = 0; q < 4; ++q) { const f32x4 a = pp[q], b = pp[4 + q]; tf += (a[0] + a[1]) + (a[2] + a[3]); ts += (b[0] + b[1]) + (b[2] + b[3]); }
            const float rf = 1.0f / sqrtf(tf * (1.0f / 1024.0f) + 1e-6f), rs = 1.0f / sqrtf(ts * (1.0f / 1024.0f) + 1e-6f);
            rv[64 * j + lane] = rs; rq[64 * j + lane] = rf / rs; }
        if (lane == 0) *idw = want;
        asm volatile("s_waitcnt lgkmcnt(0)" ::: "memory");
    }
    rs_out = rv; ratio_out = rq;
}
struct EpiOut {
    static constexpr bool PERM = true, AFTER_DRAIN = false, MID = true; static constexpr int ID = 3;
    int slot;
    __device__ __forceinline__ void mid(f32x4 (&acc)[2][2][4][2], const Unit& u, int wr, int wc, int fr, int fq) const {
        PG8_GAS unsigned char* w = (PG8_GAS unsigned char*)tab_ptr(22); const PG8_LAS float *rs, *rq; ensure_rstd_o((const PG8_GAS float*)(w + WS_SSQO), slot, u.pm, wr * 4 + wc, wr, fr + 16 * fq, rs, rq);
#pragma unroll
        for (int ai = 0; ai < 2; ++ai)
#pragma unroll
            for (int m = 0; m < 4; ++m) { const float q = rq[64 * ai + 16 * m + fr];
#pragma unroll
                for (int bj = 0; bj < 2; ++bj)
#pragma unroll
                    for (int n = 0; n < 2; ++n) acc[ai][bj][m][n] = acc[ai][bj][m][n] * q; }
    }
    __device__ __forceinline__ void operator()(const f32x4 (&acc)[2][2][4][2], const Unit& u, int wr, int wc, int fr, int fq) const {
        PG8_GAS unsigned char* w = (PG8_GAS unsigned char*)tab_ptr(22); PG8_GAS bf16_t* hb = (PG8_GAS bf16_t*)(w + WS_HB);
        PG8_GAS float* ssq = (PG8_GAS float*)(w + WS_SSQ) + (size_t)slot * M_REAL * 32; constexpr int ldc = D;
        const PG8_LAS float *rs, *rq; ensure_rstd_o((const PG8_GAS float*)(w + WS_SSQO), slot, u.pm, wr * 4 + wc, wr, fr + 16 * fq, rs, rq);
        const int row0 = u.pm * BM + wr * 64 + fr, col0 = u.pn * BM + wc * 32 + 8 * fq;
        u32x4 bs[2][4][2];
#pragma unroll
        for (int ai = 0; ai < 2; ++ai)
#pragma unroll
            for (int m = 0; m < 4; ++m)
#pragma unroll
                for (int bj = 0; bj < 2; ++bj) bs[ai][m][bj] = *(const PG8_GAS u32x4*)(hb + (size_t)(row0 + ai * HALF + m * 16) * ldc + col0 + bj * HALF);
#pragma unroll
        for (int ai = 0; ai < 2; ++ai)
#pragma unroll
            for (int m = 0; m < 4; ++m) { float ss = 0.f; const size_t off = (size_t)(row0 + ai * HALF + m * 16) * ldc + col0; const float scale = rs[64 * ai + 16 * m + fr];
#pragma unroll
                for (int bj = 0; bj < 2; ++bj) { const u32x4 b = bs[ai][m][bj]; const unsigned bw[4] = {b.x, b.y, b.z, b.w}; float v[8];
#pragma unroll
                    for (int e = 0; e < 4; ++e) { v[2 * e] = __builtin_bit_cast(float, bw[e] << 16) + scale * acc[ai][bj][m][e >> 1][(2 * e) & 3]; v[2 * e + 1] = __builtin_bit_cast(float, bw[e] & 0xffff0000u) + scale * acc[ai][bj][m][e >> 1][(2 * e + 1) & 3]; }
                    u32x4 wv; wv.x = cvt_pk_bf16(v[0], v[1]); wv.y = cvt_pk_bf16(v[2], v[3]); wv.z = cvt_pk_bf16(v[4], v[5]); wv.w = cvt_pk_bf16(v[6], v[7]); *(PG8_GAS u32x4*)(hb + off + bj * HALF) = wv;
                    const unsigned ww[4] = {wv.x, wv.y, wv.z, wv.w};
#pragma unroll
                    for (int e = 0; e < 4; ++e) { const float lo = __builtin_bit_cast(float, ww[e] << 16), hi2 = __builtin_bit_cast(float, ww[e] & 0xffff0000u); ss += lo * lo + hi2 * hi2; } }
                ss += shx<16>(ss); ss += shx<32>(ss);
                if (fq == 0) ssq[(size_t)(row0 + ai * HALF + m * 16) * 32 + u.pn * 4 + wc] = ss; }
    }
};
struct EpiInProj {
    static constexpr bool PERM = true, AFTER_DRAIN = false, MID = false; static constexpr int ID = 2;
    int ll, slot; float qscale;
    __device__ __forceinline__ void operator()(const f32x4 (&acc)[2][2][4][2], const Unit& u, int wr, int wc, int fr, int fq) const {
        PG8_GAS unsigned char* w = (PG8_GAS unsigned char*)tab_ptr(22); const PG8_GAS float* ssq = (const PG8_GAS float*)(w + WS_SSQ) + (size_t)slot * M_REAL * 32;
        PG8_GAS bf16_t *fq_ = (PG8_GAS bf16_t*)(w + WS_FQ), *fk_ = (PG8_GAS bf16_t*)(w + WS_FK), *fv_ = (PG8_GAS bf16_t*)(w + WS_FV), *sq_ = (PG8_GAS bf16_t*)(w + WS_SQ), *sk_ = (PG8_GAS bf16_t*)(w + WS_SK), *sv_ = (PG8_GAS bf16_t*)(w + WS_SV); PG8_GAS float* logf = (PG8_GAS float*)(w + WS_LOGF);
        const PG8_GAS float *g_fq = (const PG8_GAS float*)tab_ptr(9) + ll * HD, *g_fk = (const PG8_GAS float*)tab_ptr(10) + ll * HD, *g_sq = (const PG8_GAS float*)tab_ptr(11) + ll * HD, *g_sk = (const PG8_GAS float*)tab_ptr(12) + ll * HD, *bfg = (const PG8_GAS float*)tab_ptr(8) + ll * NH;
        const int row0 = u.pm * BM + wr * 64 + fr, pn = u.pn;
        if (pn == 17 && wc != 0) return;
        const PG8_LAS float* rv = ensure_rstd(ssq, slot, u.pm, wr * 4 + wc, wr, fr + 16 * fq);
        float rs[2][4];
#pragma unroll
        for (int ai = 0; ai < 2; ++ai)
#pragma unroll
            for (int m = 0; m < 4; ++m) rs[ai][m] = rv[64 * ai + 16 * m + fr];
        if (pn == 17) {
            if (wc != 0) return;
            if (fq < 2) {
                const f32x4 b0 = *(const PG8_GAS f32x4*)(bfg + 8 * fq), b1 = *(const PG8_GAS f32x4*)(bfg + 8 * fq + 4);
#pragma unroll
                for (int ai = 0; ai < 2; ++ai)
#pragma unroll
                    for (int m = 0; m < 4; ++m) { PG8_GAS float* rowp = logf + (size_t)(row0 + ai * HALF + m * 16) * 16 + 8 * fq;
#pragma unroll
                        for (int n = 0; n < 2; ++n) { f32x4 t = acc[ai][0][m][n] * rs[ai][m] + (n ? b1 : b0), o;
#pragma unroll
                            for (int j = 0; j < 4; ++j) o[j] = fminf(t[j], 0.f) - 0.69314718056f * __builtin_amdgcn_logf(1.0f + __builtin_amdgcn_exp2f(-1.4426950408889634f * fabsf(t[j])));
                            *(PG8_GAS f32x4*)(rowp + 4 * n) = o; } }
            }
            return;
        }
        PG8_GAS bf16_t* dst; int pitch, head, knh = 0; const PG8_GAS float* gain = nullptr; float sc = 1.f;
        if (pn < 16) { const int seg = pn >> 2; head = (pn & 3) * 4 + wc; pitch = 1024;
            if (seg == 0) { dst = fq_; gain = g_fq; sc = qscale; } else if (seg == 1) { dst = fk_; gain = g_fk; knh = 16; } else if (seg == 2) { dst = fv_; } else { dst = sq_; gain = g_sq; sc = qscale; } }
        else { pitch = 128; head = wc & 1; if (wc < 2) { dst = sk_; gain = g_sk; knh = 2; } else { dst = sv_; } }
        const int col0 = head * 64 + 8 * fq;
        if (gain) {
            f32x4 gv[2][2];
#pragma unroll
            for (int bj = 0; bj < 2; ++bj)
#pragma unroll
                for (int n = 0; n < 2; ++n) gv[bj][n] = *(const PG8_GAS f32x4*)(gain + 32 * bj + 8 * fq + 4 * n) * sc;
#pragma unroll
            for (int ai = 0; ai < 2; ++ai)
#pragma unroll
                for (int m = 0; m < 4; ++m) {
                    float ss = 0.f;
#pragma unroll
                    for (int bj = 0; bj < 2; ++bj)
#pragma unroll
                        for (int n = 0; n < 2; ++n) { const f32x4 x = acc[ai][bj][m][n]; ss += (x[0] * x[0] + x[1] * x[1]) + (x[2] * x[2] + x[3] * x[3]); }
                    ss += shx<16>(ss); ss += shx<32>(ss);
                    const float rinv = rs[ai][m] / sqrtf(ss * (1.0f / 64.0f) * rs[ai][m] * rs[ai][m] + 1e-6f);
                    const int row = row0 + ai * HALF + m * 16;
                    PG8_GAS bf16_t* rowp = dst + (size_t)row * pitch + col0;
#pragma unroll
                    for (int bj = 0; bj < 2; ++bj) { const f32x4 v0 = acc[ai][bj][m][0] * rinv * gv[bj][0], v1 = acc[ai][bj][m][1] * rinv * gv[bj][1];
                        u32x4 w; w.x = cvt_pk_bf16(v0[0], v0[1]); w.y = cvt_pk_bf16(v0[2], v0[3]); w.z = cvt_pk_bf16(v1[0], v1[1]); w.w = cvt_pk_bf16(v1[2], v1[3]);
                        if (knh) *(PG8_GAS u32x4*)(dst + kfrag_idx(row, knh, head, 32 * bj + 8 * fq)) = w;
                        else *(PG8_GAS u32x4*)(rowp + 32 * bj) = w; }
                }
        } else {
#pragma unroll
            for (int ai = 0; ai < 2; ++ai)
#pragma unroll
                for (int m = 0; m < 4; ++m) { const int row = row0 + ai * HALF + m * 16; const int vnh = (pn < 16) ? 16 : 2;
#pragma unroll
                    for (int bj = 0; bj < 2; ++bj) { const f32x4 v0 = acc[ai][bj][m][0] * rs[ai][m], v1 = acc[ai][bj][m][1] * rs[ai][m];
                        const unsigned wv[4] = {cvt_pk_bf16(v0[0], v0[1]), cvt_pk_bf16(v0[2], v0[3]), cvt_pk_bf16(v1[0], v1[1]), cvt_pk_bf16(v1[2], v1[3])};
                        PG8_GAS bf16_t* vp = dst + vfrag_idx(row, vnh, head, 32 * bj + 8 * fq);
#pragma unroll
                        for (int e = 0; e < 4; ++e) { vp[16 * e] = (bf16_t)(wv[e] & 0xffffu); vp[16 * e + 8] = (bf16_t)(wv[e] >> 16); } } }
        }
    }
};

}

#define XB_TMO      128
#define XB_XCNT(j)  (256  + 64 * (j))
#define XB_XSUB(j)  (1280 + 64 * (j))
#define XB_XGEN(j)  (2304 + 64 * (j))
#define XB_TOP      3328
#define XB_TOPGEN   3392
#define XCD_BAR_WORDS 3456
#define XB_SPIN_CAP (1u << 18)
__device__ __forceinline__ unsigned xb_ld(unsigned* p)              { return __hip_atomic_load(p, __ATOMIC_RELAXED, __HIP_MEMORY_SCOPE_AGENT); }
__device__ __forceinline__ unsigned xb_add(unsigned* p, unsigned v) { return __hip_atomic_fetch_add(p, v, __ATOMIC_RELAXED, __HIP_MEMORY_SCOPE_AGENT); }
__device__ __forceinline__ unsigned xb_xcc_id() { return (unsigned)__builtin_amdgcn_s_getreg((3 << 11) | 20) & 0xFu; }
#define XB_SPIN(cond, bar) do { unsigned _sp = 0; while (cond) { __builtin_amdgcn_s_sleep(1); \
    if ((++_sp & 255u) == 0u) { if (xb_ld(&(bar)[XB_TMO])) break; if (_sp > XB_SPIN_CAP) { atomicAdd(&(bar)[XB_TMO], 1u); break; } } } } while (0)
struct XcdBarrier { unsigned* bar; unsigned x; volatile LAS unsigned* st; };
__device__ __forceinline__ XcdBarrier xcd_barrier_post(unsigned* bar, volatile LAS unsigned* st) {
    XcdBarrier b; b.bar = bar; b.x = xb_xcc_id(); b.st = st;
    if (threadIdx.x == 0) (void)xb_add(&bar[XB_XCNT(b.x)], 1u);
    return b;
}
__device__ __forceinline__ void xcd_barrier_complete(unsigned* bar, unsigned x, unsigned& nloc, unsigned& nx) {
    const unsigned G = gridDim.x * gridDim.y * gridDim.z;
    unsigned sum, cnt, mine, sp = 0u;
    for (;;) {
        sum = 0u; cnt = 0u; mine = 0u;
#pragma unroll
        for (unsigned j = 0; j < 16; ++j) { const unsigned c = xb_ld(&bar[XB_XCNT(j)]); sum += c; cnt += (c > 0u) ? 1u : 0u; mine = (j == x) ? c : mine; }
        if (sum == G) break;
        __builtin_amdgcn_s_sleep(1);
        if ((++sp & 255u) == 0u) { if (xb_ld(&bar[XB_TMO])) break; if (sp > XB_SPIN_CAP) { atomicAdd(&bar[XB_TMO], 1u); break; } }
    }
    nloc = mine > 0u ? mine : 1u; nx = cnt > 0u ? cnt : 1u;
}
__device__ __forceinline__ void xcd_barrier(const XcdBarrier& b) {
    asm volatile("s_waitcnt vmcnt(0)" ::: "memory");
    __syncthreads();
    if (my_tid() == 0) {
        unsigned* bar = b.bar;
        __builtin_amdgcn_s_waitcnt(0);
        unsigned nloc = b.st[0], nx = b.st[1];
        if (nloc == 0u) { xcd_barrier_complete(bar, b.x, nloc, nx); b.st[0] = nloc; b.st[1] = nx; }
        const unsigned old = xb_add(&bar[XB_XSUB(b.x)], 1u);
        const unsigned gen = old / nloc;
        if (old + 1u == (gen + 1u) * nloc) {
            __builtin_amdgcn_fence(__ATOMIC_RELEASE, "agent");
            asm volatile("s_waitcnt vmcnt(0)" ::: "memory");
            const unsigned og = xb_add(&bar[XB_TOP], 1u);
            const unsigned tg = og / nx;
            if (og + 1u == (tg + 1u) * nx) xb_add(&bar[XB_TOPGEN], 1u);
            else XB_SPIN(xb_ld(&bar[XB_TOPGEN]) == tg, bar);
            __builtin_amdgcn_fence(__ATOMIC_ACQUIRE, "agent");
            xb_add(&bar[XB_XGEN(b.x)], 1u);
            asm volatile("s_waitcnt vmcnt(0)" ::: "memory");
        } else {
            XB_SPIN(xb_ld(&bar[XB_XGEN(b.x)]) == gen, bar);
            __builtin_amdgcn_fence(__ATOMIC_ACQUIRE, "agent");
            asm volatile("s_waitcnt vmcnt(0)" ::: "memory");
        }
    }
    __syncthreads();
}

struct Frame {
    LAS unsigned char* lds;
    volatile LAS unsigned* MISC;
    int tid, lane, wave;
    int vcu, G;
    unsigned char* ws;
};
__device__ __forceinline__ int launder_u(int x) { asm volatile("" : "+v"(x)); return __builtin_amdgcn_readfirstlane(x); }
#define LAUNDER_S(x) ((x) = launder_u(x))
__device__ __forceinline__ const float* inptr(const Frame& F, int k) {
    const volatile LAS unsigned* t = (const volatile LAS unsigned*)(F.lds + PTR_OFF);
    const unsigned lo = __builtin_amdgcn_readfirstlane(t[2 * k]), hi = __builtin_amdgcn_readfirstlane(t[2 * k + 1]);
    return (const float*)(((unsigned long long)hi << 32) | lo);
}
__device__ __forceinline__ unsigned char* wsl(const Frame& F) { const unsigned long long p = (unsigned long long)F.ws; const unsigned lo = (unsigned)launder_u((int)(unsigned)p), hi = (unsigned)launder_u((int)(unsigned)(p >> 32)); return (unsigned char*)(((unsigned long long)hi << 32) | lo); }
__device__ __forceinline__ Frame make_frame() {
    extern __shared__ __attribute__((aligned(16))) unsigned char lds_dyn_[];
    Frame F;
    F.lds = (LAS unsigned char*)lds_dyn_;
    F.MISC = (volatile LAS unsigned*)(F.lds + MISC_OFF);
    int t = my_tid(); asm volatile("" : "+v"(t));
    F.tid = t; F.lane = t & 63; F.wave = __builtin_amdgcn_readfirstlane(t >> 6);
    const int g = launder_u((int)gridDim.x), bx = launder_u((int)blockIdx.x);
    F.G = g; F.vcu = (g % 8 == 0) ? (bx % 8) * (g / 8) + bx / 8 : bx;
    F.ws = (unsigned char*)pg8::tab_ptr(22);
    return F;
}
__device__ __forceinline__ float wave_sum(float v) {
    XSUM64(v);
    return v;
}

constexpr int TP_PITCH = 144;
__device__ __forceinline__ void transpose_item64(const float* Wf, int Nsrc, int ca, int nva, int cb, int nvb, int K, bf16* WTf, int drow0, int k0, LAS unsigned char* scr, int lane, const float* gainf = nullptr) {
    const GAS float* W = (const GAS float*)Wf; GAS bf16* WT = (GAS bf16*)WTf;
    const int sub = (lane >> 3) & 1, c4 = 4 * (lane & 7), g = lane >> 4, nl = 32 * sub + c4;
    const bool ok = c4 < (sub ? nvb : nva);
    const GAS float* src = W + (size_t)(k0 + 2 * g) * Nsrc + (sub ? cb : ca) + c4;
    f32x4 v[16];
#pragma unroll
    for (int i = 0; i < 16; ++i) v[i] = ok ? *(const GAS f32x4*)(src + (size_t)(8 * (i >> 1) + (i & 1)) * Nsrc) : (f32x4){0.f, 0.f, 0.f, 0.f};
    if (gainf) { const GAS float* gp = (const GAS float*)gainf + k0 + 2 * g;
#pragma unroll
        for (int i = 0; i < 16; ++i) v[i] = v[i] * gp[8 * (i >> 1) + (i & 1)]; }
#pragma unroll
    for (int m = 0; m < 8; ++m)
#pragma unroll
        for (int j = 0; j < 4; ++j) *(LAS unsigned*)(scr + (nl + j) * TP_PITCH + (8 * m + 2 * g) * 2) = pk2(v[2 * m][j], v[2 * m + 1][j]);
    LDS_WAIT(); asm volatile("" ::: "memory");
#pragma unroll
    for (int t = 0; t < 8; ++t) { const int id = lane + 64 * t, n = id >> 3, c = id & 7;
        const v4u o = *(const LAS v4u*)(scr + n * TP_PITCH + 16 * c);
        *(GAS v4u*)(WT + (size_t)(drow0 + n) * K + k0 + 8 * c) = o; }
    LDS_WAIT(); asm volatile("" ::: "memory");
}
constexpr int IT_GU = (D / 64) * (N_GU / 64), IT_D = (FF / 64) * (D / 64), IT_IN = (D / 64) * (N_IN / 64), IT_OUT = (D / 64) * (D / 64);
constexpr int IT_LAYER = 2 * IT_GU + 2 * IT_D + IT_IN + IT_OUT;
__device__ __forceinline__ void conv_gu(const float* Wg, const float* Wu, bf16* WT, int r, LAS unsigned char* scr, int lane, const float* gain) {
    constexpr int nrg = N_GU / 64; const int kb = r / nrg, rg = r % nrg, p = rg >> 2, q = rg & 3; const int c0 = 128 * p + 64 * (q & 1);
    transpose_item64(q < 2 ? Wg : Wu, FF, c0, 32, c0 + 32, 32, D, WT, 64 * rg, 64 * kb, scr, lane, gain);
}
__device__ __forceinline__ void conv_plain(const float* W, int K, int N, bf16* WT, int r, LAS unsigned char* scr, int lane, const float* gain_lo = nullptr, const float* gain_hi = nullptr) {
    const int nrg = N / 64, kb = r / nrg, rg = r % nrg;
    const float* gain = gain_lo ? (64 * kb < 1024 ? gain_lo : gain_hi - 1024) : nullptr;
    transpose_item64(W, N, 64 * rg, 32, 64 * rg + 32, 32, K, WT, 64 * rg, 64 * kb, scr, lane, gain);
}
__device__ __forceinline__ int in_src_col(int pn, int wc, int bj) {
    if (pn < 16) { const int seg = pn >> 2, base = seg == 0 ? 0 : seg == 1 ? 1024 : seg == 2 ? 2048 : 3088; return base + 256 * (pn & 3) + 64 * wc + 32 * bj; }
    return (wc < 2 ? 4112 + 64 * wc : 4240 + 64 * (wc - 2)) + 32 * bj;
}
__device__ __forceinline__ void conv_in(const float* W, bf16* WT, int r, LAS unsigned char* scr, int lane, const float* gain) {
    constexpr int nrg = N_IN / 64; const int kb = r / nrg, rg = r % nrg, pn = rg >> 2, q = rg & 3, bj = q >> 1, wc0 = 2 * (q & 1);
    int ca, cb, nva = 32, nvb = 32;
    if (pn < 17) { ca = in_src_col(pn, wc0, bj); cb = in_src_col(pn, wc0 + 1, bj); }
    else { ca = 3072; cb = 3072; nva = (q == 0) ? 16 : 0; nvb = 0; }
    transpose_item64(W, IN_W, ca, nva, cb, nvb, D, WT, 64 * rg, 64 * kb, scr, lane, gain);
}
__device__ __forceinline__ void convert_item(Frame& F, unsigned char* w, int l, int r, LAS unsigned char* scr) {
    unsigned char* wl = w + WS_W + (size_t)l * LW_STRIDE;
    if (r < IT_GU) { conv_gu(inptr(F, 3) + (size_t)l * D * FF, inptr(F, 4) + (size_t)l * D * FF, (bf16*)(wl + LW_GU1), r, scr, F.lane, inptr(F, 2) + (size_t)l * D); return; } r -= IT_GU;
    if (r < IT_D) { conv_plain(inptr(F, 5) + (size_t)l * FF * D, FF, D, (bf16*)(wl + LW_D1), r, scr, F.lane); return; } r -= IT_D;
    if (r < IT_IN) { conv_in(inptr(F, 7) + (size_t)l * D * IN_W, (bf16*)(wl + LW_IN), r, scr, F.lane, inptr(F, 6) + (size_t)l * D); return; } r -= IT_IN;
    if (r < IT_OUT) { conv_plain(inptr(F, 16) + (size_t)l * D * D, D, D, (bf16*)(wl + LW_OUT), r, scr, F.lane, inptr(F, 14) + (size_t)l * 1024, inptr(F, 15) + (size_t)l * 1024); return; } r -= IT_OUT;
    if (r < IT_GU) { conv_gu(inptr(F, 18) + (size_t)l * D * FF, inptr(F, 19) + (size_t)l * D * FF, (bf16*)(wl + LW_GU2), r, scr, F.lane, inptr(F, 17) + (size_t)l * D); return; } r -= IT_GU;
    conv_plain(inptr(F, 20) + (size_t)l * FF * D, FF, D, (bf16*)(wl + LW_D2), r, scr, F.lane);
}
#define IDLE_CONV_K 4
constexpr int R_IDLE = IDLE_CONV_K * 128 * NWAVES, GU2_BASE = IT_GU + IT_D + IT_IN + IT_OUT;
static_assert(R_IDLE <= IT_GU, "idle-slot items are SwiGLU-2 items");
__device__ __forceinline__ void convert_layer(Frame& F, unsigned char* w, int l) {
    LAS unsigned char* scr = F.lds + RING_OFF + F.wave * 16384;
    const int gw = F.vcu * NWAVES + F.wave, NGW = F.G * NWAVES;
    if (F.G == 256) { for (int q = gw; q < IT_LAYER - R_IDLE; q += NGW) convert_item(F, w, l, q < GU2_BASE ? q : q + R_IDLE, scr); }
    else for (int r = gw; r < IT_LAYER; r += NGW) convert_item(F, w, l, r, scr);
}
__device__ __forceinline__ void p0_prologue(Frame& F) {
    const int gw = F.vcu * NWAVES + F.wave, NGW = F.G * NWAVES;
    unsigned char* w = wsl(F);
    for (int l = 0; l < (OVERLAP_CONV ? 1 : DEPTH); ++l) convert_layer(F, w, l);
    const GAS float* x = (const GAS float*)inptr(F, 0); const GAS float* meta = (const GAS float*)inptr(F, 1);
    GAS bf16* HB = (GAS bf16*)(w + WS_HB); GAS float* SSQ0 = (GAS float*)(w + WS_SSQ); GAS float* SSQM0 = (GAS float*)(w + WS_SSQM);
    for (int m = gw; m < M_REAL + NMETA; m += NGW) {
        const int row = m < M_REAL ? m : META_ROW + (m - M_REAL);
        GAS unsigned long long* hb8 = (GAS unsigned long long*)(HB + (size_t)row * D) + F.lane;
        const GAS f32x4* xr = (const GAS f32x4*)(m < M_REAL ? x + (size_t)m * D : meta + (size_t)(m - M_REAL) * D) + F.lane;
        float ss = 0.f;
#pragma unroll
        for (int j = 0; j < 8; ++j) { const f32x4 v = xr[64 * j]; const unsigned w0 = pk2(v.x, v.y), w1 = pk2(v.z, v.w); hb8[64 * j] = (unsigned long long)w0 | ((unsigned long long)w1 << 32);
            const float a0 = __builtin_bit_cast(float, w0 << 16), a1 = __builtin_bit_cast(float, w0 & 0xffff0000u), a2 = __builtin_bit_cast(float, w1 << 16), a3 = __builtin_bit_cast(float, w1 & 0xffff0000u);
            ss += (a0 * a0 + a1 * a1) + (a2 * a2 + a3 * a3); }
        ss = wave_sum(ss);
        if (m < M_REAL) { if (F.lane < 32) SSQ0[(size_t)m * 32 + F.lane] = F.lane == 0 ? ss : 0.f; }
        else { SSQM0[(m - M_REAL) * 128 + F.lane] = F.lane == 0 ? ss : 0.f; SSQM0[(m - M_REAL) * 128 + 64 + F.lane] = 0.f; }
    }
    if (gw < 48) { const int row = META_BLK0 + 64 + gw; const v4u z = (v4u){0u, 0u, 0u, 0u};
#pragma unroll
        for (int j = 0; j < 2; ++j) { ((GAS v4u*)(w + WS_FQ + (size_t)row * 2048))[F.lane + 64 * j] = z;
            ((GAS v4u*)(w + WS_SQ + (size_t)row * 2048))[F.lane + 64 * j] = z; } }
    {
        const v4u z = (v4u){0u, 0u, 0u, 0u}; constexpr int RB = (META_BLK0 + 64) >> 5;
        GAS v4u* fk = (GAS v4u*)((GAS bf16*)(w + WS_FK) + (size_t)RB * 16 * 2048); GAS v4u* sk = (GAS v4u*)((GAS bf16*)(w + WS_SK) + (size_t)RB * 2 * 2048);
        for (int i = gw * 64 + F.lane; i < 2 * 16 * 256; i += NGW * 64) fk[i] = z;
        for (int i = gw * 64 + F.lane; i < 2 * 2 * 256; i += NGW * 64) sk[i] = z;
        constexpr int G16 = (META_BLK0 + 64) >> 4;
        GAS v4u* fv = (GAS v4u*)((GAS bf16*)(w + WS_FV) + (size_t)G16 * 16 * 1024); GAS v4u* sv = (GAS v4u*)((GAS bf16*)(w + WS_SV) + (size_t)G16 * 2 * 1024);
        for (int i = gw * 64 + F.lane; i < 4 * 16 * 128; i += NGW * 64) fv[i] = z;
        for (int i = gw * 64 + F.lane; i < 4 * 2 * 128; i += NGW * 64) sv[i] = z; }
}
__device__ __forceinline__ void onorm_phase(Frame& F, const float* gf, const float* gs) {
    const int gw = F.vcu * NWAVES + F.wave, NGW = F.G * NWAVES;
    unsigned char* w = wsl(F); const GAS bf16* O = (const GAS bf16*)(w + WS_O); GAS bf16* XN = (GAS bf16*)(w + WS_XN);
    for (int mm = gw; mm < M_REAL + NMETA; mm += NGW) {
        const int m = mm < M_REAL ? mm : META_ROW + (mm - M_REAL);
        const GAS v4u* orow = (const GAS v4u*)(O + (size_t)m * D) + F.lane;
        GAS v4u* xrow = (GAS v4u*)(XN + (size_t)m * D) + F.lane;
        float x[4][8]; float sf = 0.f, ss = 0.f;
#pragma unroll
        for (int j = 0; j < 4; ++j) { const v4u w = orow[64 * j]; const unsigned ww[4] = {w.x, w.y, w.z, w.w};
#pragma unroll
            for (int e = 0; e < 4; ++e) { x[j][2 * e] = __builtin_bit_cast(float, ww[e] << 16); x[j][2 * e + 1] = __builtin_bit_cast(float, ww[e] & 0xffff0000u); }
            float q = 0.f;
#pragma unroll
            for (int e = 0; e < 8; ++e) q += x[j][e] * x[j][e];
            if (j < 2) sf += q; else ss += q; }
        const float rf = 1.0f / sqrtf(wave_sum(sf) * (1.0f / 1024.f) + EPS), rs = 1.0f / sqrtf(wave_sum(ss) * (1.0f / 1024.f) + EPS);
#pragma unroll
        for (int j = 0; j < 4; ++j) { const float* gp = (j < 2 ? gf : gs) + (j & 1) * 512 + 8 * F.lane; const f32x4 g0 = *(const GAS f32x4*)gp, g1 = *(const GAS f32x4*)(gp + 4); const float r = j < 2 ? rf : rs;
            v4u w; w.x = pk2(x[j][0] * r * g0.x, x[j][1] * r * g0.y); w.y = pk2(x[j][2] * r * g0.z, x[j][3] * r * g0.w); w.z = pk2(x[j][4] * r * g1.x, x[j][5] * r * g1.y); w.w = pk2(x[j][6] * r * g1.z, x[j][7] * r * g1.w);
            xrow[64 * j] = w; }
    }
}

constexpr int SK_RED_OFF = 0, SK_TILE_OFF = 65536, SK_RSTD_OFF = SK_TILE_OFF + 4096;
template <class Epi, int NST  >
__device__ __forceinline__ void skinny_phase(Frame& F, const GAS bf16* A, int lda, const GAS bf16* Bt, int K, const Epi& E) {
    constexpr int TC = Epi::TC;
    int lane = F.lane; asm volatile("" : "+v"(lane));
    const int w = F.wave;
    LAS float* red = (LAS float*)(F.lds + RING_OFF + SK_RED_OFF);
    LAS float* tile = (LAS float*)(F.lds + RING_OFF + SK_TILE_OFF);
    const int k0 = w * (NST * 32);
    bool first = true;
    for (int task = F.G - 1 - (int)blockIdx.x; task < E.ntasks(); task += F.G) {
        pg8::f32x4 acc[TC];
        const GAS bf16* bp[TC];
#pragma unroll
        for (int c = 0; c < TC; ++c) { acc[c] = (pg8::f32x4){0.f, 0.f, 0.f, 0.f}; bp[c] = Bt + (size_t)(E.btrow(task, c) + (lane & 15)) * K + k0 + 8 * (lane >> 4); }
        const GAS bf16* ap = A + (size_t)(lane & 15) * lda + k0 + 8 * (lane >> 4);
        bf16x8 av[NST], bv[TC][NST];
#pragma unroll
        for (int j = 0; j < NST; ++j) { av[j] = *(const GAS bf16x8*)(ap + 32 * j);
#pragma unroll
            for (int c = 0; c < TC; ++c) bv[c][j] = *(const GAS bf16x8*)(bp[c] + 32 * j); }
        if (first) {
            if constexpr (Epi::KHALF_SCALE) {
                LAS float* rv = (LAS float*)(F.lds + RING_OFF + SK_RSTD_OFF);
#pragma unroll
                for (int j = 0; j < 2; ++j) { const int row = 2 * w + j; float t = lane < 32 ? E.ssqom[row * 32 + lane] : 0.f;
                    XSUM16(t);
                    if (lane == 0) rv[row] = 1.0f / sqrtf(t * (1.0f / 1024.0f) + EPS); if (lane == 16) rv[16 + row] = 1.0f / sqrtf(t * (1.0f / 1024.0f) + EPS); }
            }
            if constexpr (Epi::NEED_RSTD) {
                LAS float* rv = (LAS float*)(F.lds + RING_OFF + SK_RSTD_OFF);
#pragma unroll
                for (int j = 0; j < 2; ++j) { const int row = 2 * w + j; const float t = wave_sum(E.ssqm[row * 128 + lane] + E.ssqm[row * 128 + 64 + lane]); if (lane == 0) rv[row] = 1.0f / sqrtf(t * (1.0f / D) + EPS); }
            }
            first = false;
        }
#pragma unroll
        for (int j = 0; j < NST; ++j)
#pragma unroll
            for (int c = 0; c < TC; ++c) acc[c] = __builtin_amdgcn_mfma_f32_16x16x32_bf16(av[j], bv[c][j], acc[c], 0, 0, 0);
#pragma unroll
        for (int c = 0; c < TC; ++c)
#pragma unroll
            for (int r = 0; r < 4; ++r) red[((w * TC + c) * 4 + r) * 64 + lane] = acc[c][r];
        __syncthreads();
        for (int e = F.tid; e < TC * 256; e += NWAVES * 64) { float sum = 0.f, sum2 = 0.f;
#pragma unroll
            for (int w2 = 0; w2 < 4; ++w2) { sum += red[w2 * TC * 256 + e]; sum2 += red[(w2 + 4) * TC * 256 + e]; }
            const int ln = e & 63, r = (e >> 6) & 3, c = e >> 8, orow = (ln >> 4) * 4 + r;
            if constexpr (Epi::KHALF_SCALE) { const LAS float* rv = (const LAS float*)(F.lds + RING_OFF + SK_RSTD_OFF); sum = sum * rv[orow] + sum2 * rv[16 + orow]; } else sum += sum2;
            tile[orow * 64 + 16 * c + (ln & 15)] = sum; }
        __syncthreads();
        E.store(F, task, tile);
        if (task + F.G < E.ntasks()) __syncthreads();
    }
}
struct SkGU {
    static constexpr int TC = 4; static constexpr bool NEED_RSTD = true, KHALF_SCALE = false;
    GAS bf16* act; const GAS float* ssqm;
    __device__ __forceinline__ int ntasks() const { return FF / 32; }
    __device__ __forceinline__ int btrow(int t, int c) const { const int p = t >> 2, q = t & 3; return 256 * p + 128 * (c >> 1) + 32 * q + 16 * (c & 1); }
    __device__ __forceinline__ void store(Frame& F, int t, const LAS float* tile) const {
        const int row = F.tid >> 5, col = F.tid & 31; const float r = ((const LAS float*)(F.lds + RING_OFF + SK_RSTD_OFF))[row];
        act[(size_t)(META_ROW + row) * FF + 32 * t + col] = (bf16)f2bf(pg8::silu_mul(tile[row * 64 + col] * r, tile[row * 64 + 32 + col] * r));
    }
};
struct SkRes {
    static constexpr int TC = 1; static constexpr bool NEED_RSTD = false, KHALF_SCALE = false;
    float scale; GAS bf16* hb; GAS float* ssqm;
    __device__ __forceinline__ int ntasks() const { return D / 16; }
    __device__ __forceinline__ int btrow(int t, int) const { return 16 * t; }
    __device__ __forceinline__ void store(Frame& F, int t, const LAS float* tile) const {
        if (F.tid < 256) { const int row = F.tid >> 4, col = F.tid & 15; const size_t off = (size_t)(META_ROW + row) * D + 16 * t + col;
            const unsigned hbits = f2bf(bf2f(hb[off]) + scale * tile[row * 64 + col]); hb[off] = (bf16)hbits; const float v = bf2f((bf16)hbits); float ss = v * v;
            XSUM16(ss);
            if (col == 0) ssqm[row * 128 + t] = ss; }
    }
};
struct SkOut {
    static constexpr int TC = 1; static constexpr bool NEED_RSTD = false, KHALF_SCALE = true;
    float scale; GAS bf16* hb; GAS float* ssqm; const GAS float* ssqom;
    __device__ __forceinline__ int ntasks() const { return D / 16; }
    __device__ __forceinline__ int btrow(int t, int) const { return 16 * t; }
    __device__ __forceinline__ void store(Frame& F, int t, const LAS float* tile) const {
        if (F.tid < 256) { const int row = F.tid >> 4, col = F.tid & 15; const size_t off = (size_t)(META_ROW + row) * D + 16 * t + col;
            const unsigned hbits = f2bf(bf2f(hb[off]) + scale * tile[row * 64 + col]); hb[off] = (bf16)hbits; const float v = bf2f((bf16)hbits); float ss = v * v;
            XSUM16(ss);
            if (col == 0) ssqm[row * 128 + t] = ss; }
    }
};
struct SkIn {
    static constexpr int TC = 4; static constexpr bool NEED_RSTD = true, KHALF_SCALE = false;
    GAS bf16 *fq_, *fk_, *fv_, *sq_, *sk_, *sv_; GAS float* logf; const GAS float *g_fq, *g_fk, *g_sq, *g_sk, *bfg; float qscale; const GAS float* ssqm;
    __device__ __forceinline__ int ntasks() const { return 69; }
    __device__ __forceinline__ int btrow(int t, int c) const { if (t == 68) return 17 * 256 + 16 * c; const int pn = t < 64 ? (t >> 2) : 16, wc = t < 64 ? (t & 3) : (t - 64); return 256 * pn + 128 * (c >> 1) + 32 * wc + 16 * (c & 1); }
    __device__ __forceinline__ void store(Frame& F, int t, const LAS float* tile) const {
        if (t == 68) { if (F.tid < 256) { const int row = F.tid >> 4, hh = F.tid & 15; const float z = tile[row * 64 + hh] * ((const LAS float*)(F.lds + RING_OFF + SK_RSTD_OFF))[row] + bfg[hh];
                logf[(size_t)(META_ROW + row) * 16 + hh] = fminf(z, 0.f) - 0.69314718056f * __builtin_amdgcn_logf(1.0f + __builtin_amdgcn_exp2f(-LOG2E * fabsf(z))); } return; }
        const int pn = t < 64 ? (t >> 2) : 16, wc = t < 64 ? (t & 3) : (t - 64);
        GAS bf16* dst; int pitch, head, knh = 0; const GAS float* gain = nullptr; float sc = 1.f;
        if (pn < 16) { const int seg = pn >> 2; head = (pn & 3) * 4 + wc; pitch = 1024;
            if (seg == 0) { dst = fq_; gain = g_fq; sc = qscale; } else if (seg == 1) { dst = fk_; gain = g_fk; knh = 16; } else if (seg == 2) { dst = fv_; } else { dst = sq_; gain = g_sq; sc = qscale; } }
        else { pitch = 128; head = wc & 1; if (wc < 2) { dst = sk_; gain = g_sk; knh = 2; } else { dst = sv_; } }
        const int row = F.tid >> 5, cp = F.tid & 31; const float rr = ((const LAS float*)(F.lds + RING_OFF + SK_RSTD_OFF))[row];
        float v0 = tile[row * 64 + 2 * cp] * rr, v1 = tile[row * 64 + 2 * cp + 1] * rr;
        if (gain) { float ss = v0 * v0 + v1 * v1;
            XSUM32(ss);
            const float rinv = 1.0f / sqrtf(ss * (1.0f / 64.0f) + EPS); v0 = v0 * rinv * gain[2 * cp] * sc; v1 = v1 * rinv * gain[2 * cp + 1] * sc; }
        if (knh) *(GAS unsigned*)(dst + kfrag_idx(META_ROW + row, knh, head, 2 * cp)) = pk2(v0, v1);
        else if (!gain) { GAS bf16* vp = dst + vfrag_idx(META_ROW + row, pn < 16 ? 16 : 2, head, 2 * cp); const unsigned pw = pk2(v0, v1); vp[0] = (bf16)(pw & 0xffffu); vp[8] = (bf16)(pw >> 16); }
        else *(GAS unsigned*)(dst + (size_t)(META_ROW + row) * pitch + head * 64 + 2 * cp) = pk2(v0, v1);
    }
};

__device__ __forceinline__ void split3(float x, unsigned& h, unsigned& m, unsigned& l) { h = f2bf(x); const float r = x - bf2f((unsigned short)h); m = f2bf(r); const float r2 = r - bf2f((unsigned short)m); l = f2bf(r2); }
__device__ __forceinline__ int crow(int r, int hi) { return (r & 3) + 8 * (r >> 2) + 4 * hi; }
typedef short v4i16_t __attribute__((ext_vector_type(4)));
__device__ __forceinline__ float max3f(float a, float b, float c) { return fmaxf(fmaxf(a, b), c); }
constexpr float ATT_THR = 40.0f;
constexpr int ATT_KV_OFF = 36864;
template <int MODE  >
__device__ __forceinline__ void attn_group(Frame& F, unsigned char* w, int gb, int kvh, int c_lo, int c_hi, bool active, int b  , int h, int i, const float* sinks) {
    const int lane = F.lane, r32 = lane & 31, hi = lane >> 5, wv = F.wave;
    const bool meta = b < 0;
    const int qpos0 = meta ? 96 : 128 + 32 * i;
    const int qrow0 = meta ? META_BLK0 + 96 : b * SEQ + 32 * i;
    const int cd = qpos0 >> 6;
    const int cfirst = (MODE == 0) ? (meta ? 1 : __builtin_amdgcn_readfirstlane(((const volatile LAS int*)(F.lds + RING_OFF + ATT_FC_OFF))[i])) : ((qpos0 - 127) < 128 ? 1 : ((qpos0 - 127) >> 6));
    constexpr int NHK = (MODE == 0) ? 16 : 2;
    const GAS bf16* Qp = (const GAS bf16*)(w + (MODE == 0 ? WS_FQ : WS_SQ)) + (size_t)qrow0 * 1024 + h * 64;
    const GAS bf16* kdma = (const GAS bf16*)(w + (MODE == 0 ? WS_FK : WS_SK)) + ((size_t)(wv >> 2) * NHK + kvh) * 2048 + (wv & 3) * 512 + lane * 8;
    const GAS bf16* vdma = (const GAS bf16*)(w + (MODE == 0 ? WS_FV : WS_SV)) + ((size_t)(wv >> 1) * NHK + kvh) * 1024 + (wv & 1) * 512 + lane * 8;
    LAS unsigned char* kvb = F.lds + RING_OFF + ATT_KV_OFF;
    const float sl2 = (MODE == 1) ? exp2f(-0.5f * (float)(h + 1)) * LOG2E : 0.f;
    const LAS unsigned char* tfp = F.lds + RING_OFF + (hi ? ATT_ZERO_OFF : ATT_TABF_OFF + r32 * 16); const int toff = hi ? 0 : 1;
    v4u mfr = hi ? (v4u){0u, 0u, 0u, 0u} : (v4u){0x3F803F80u, 0x3F80u, 0u, 0u};
    bf16x8 qf[4];
    if (active) {
#pragma unroll
        for (int s = 0; s < 4; ++s) qf[s] = *(const GAS bf16x8*)(Qp + (size_t)r32 * 1024 + 16 * s + 8 * hi);
    } else {
#pragma unroll
        for (int s = 0; s < 4; ++s) qf[s] = (bf16x8){0, 0, 0, 0, 0, 0, 0, 0};
    }
#define CHUNK_ROW(c) ((c) == 1 ? META_BLK0 + 64 : gb * SEQ + 64 * ((c) - 2))
#define KV_DMA(c_) do { const int rowk_ = CHUNK_ROW(c_); LAS unsigned char* d_ = kvb + ((c_) & 1) * 16384 + wv * 1024; \
        __builtin_amdgcn_global_load_lds((const unsigned*)(kdma + (size_t)(rowk_ >> 5) * (NHK * 2048)), (LAS unsigned*)d_, 16, 0, 0); \
        __builtin_amdgcn_global_load_lds((const unsigned*)(vdma + (size_t)(rowk_ >> 4) * (NHK * 1024)), (LAS unsigned*)(d_ + 8192), 16, 0, 0); } while (0)
    float m_run = 0.f, l_run = 0.f; f32x16 o0 = {}, o1 = {};
    const float NEG = -1e30f;
    __syncthreads();
    KV_DMA(c_lo);
    for (int c = c_lo; c <= c_hi; ++c) {
        asm volatile("s_waitcnt vmcnt(0) lgkmcnt(0)" ::: "memory"); __builtin_amdgcn_s_barrier(); __builtin_amdgcn_sched_barrier(0);
        if (c < c_hi) KV_DMA(c + 1);
        if (!(active && c >= cfirst && c <= cd)) continue;
        const LAS unsigned char* cb = kvb + (c & 1) * 16384 + hi * 512 + r32 * 16;
        bf16x8 kf[2][4];
#pragma unroll
        for (int t = 0; t < 2; ++t)
#pragma unroll
            for (int s = 0; s < 4; ++s) kf[t][s] = *(const LAS bf16x8*)(cb + t * 4096 + s * 1024);
        f32x16 p0 = {}, p1 = {};
        bf16x8 ab0, ab1;
        if (MODE == 0) { ab0 = *(const LAS bf16x8*)(tfp + toff * (1024 * c)); ab1 = *(const LAS bf16x8*)(tfp + toff * (1024 * c + 512)); }
        __builtin_amdgcn_s_setprio(1);
#pragma unroll
        for (int s = 0; s < 4; ++s) { p0 = __builtin_amdgcn_mfma_f32_32x32x16_bf16(kf[0][s], qf[s], p0, 0, 0, 0); p1 = __builtin_amdgcn_mfma_f32_32x32x16_bf16(kf[1][s], qf[s], p1, 0, 0, 0); }
        if (MODE == 0) { const bf16x8 mb = __builtin_bit_cast(bf16x8, mfr); p0 = __builtin_amdgcn_mfma_f32_32x32x16_bf16(ab0, mb, p0, 0, 0, 0); p1 = __builtin_amdgcn_mfma_f32_32x32x16_bf16(ab1, mb, p1, 0, 0, 0); }
        __builtin_amdgcn_s_setprio(0);
        bf16x8 vf[4][2];
#pragma unroll
        for (int g = 0; g < 4; ++g)
#pragma unroll
            for (int d = 0; d < 2; ++d) vf[g][d] = *(const LAS bf16x8*)(cb + 8192 + g * 2048 + hi * 512 + d * 512);
        if (MODE == 0) {
            if (c == cd) { const int dq = qpos0 + r32 - 64 * c - 4 * hi;
#pragma unroll
                for (int r = 0; r < 16; ++r) { const int e = (r & 3) + 8 * (r >> 2); if (e > dq) p0[r] = NEG; if (e + 32 > dq) p1[r] = NEG; } }
        } else {
            const float kb0 = (float)(64 * c - qpos0 + 4 * hi) - m_run / sl2;
#pragma unroll
            for (int r = 0; r < 16; ++r) { const float e = (float)((r & 3) + 8 * (r >> 2)); p0[r] = fmaf(sl2, kb0 + e, p0[r]); p1[r] = fmaf(sl2, kb0 + 32.f + e, p1[r]); }
            const int dq = qpos0 + r32 - 64 * c - 4 * hi;
            const int padlim = (c == 1) ? 48 - 4 * hi : -1;
            const bool interior = c != 1 && 64 * c + 63 <= qpos0 && 64 * c > qpos0 + 31 - 128;
            if (!interior) {
#pragma unroll
            for (int r = 0; r < 16; ++r) { const int e = (r & 3) + 8 * (r >> 2);
                if ((unsigned)(dq - e) >= 128u || e < padlim) p0[r] = NEG;
                if ((unsigned)(dq - e - 32) >= 128u || e + 32 < padlim) p1[r] = NEG; } }
        }
        float mx = max3f(p0[0], p0[1], p1[0]);
#pragma unroll
        for (int r = 2; r < 16; r += 2) mx = max3f(mx, p0[r], p0[r + 1]);
#pragma unroll
        for (int r = 1; r < 16; r += 2) mx = max3f(mx, p1[r], (r + 1 < 16) ? p1[r + 1] : p1[r]);
        const bool first = (c == cfirst);
        if (first || __any(mx > ATT_THR)) {
            mx = fmaxf(mx, shx<32>(mx));
            const float dl = first ? fmaxf(mx, -200.f) : fmaxf(mx, 0.f);
            m_run += dl;
            if (MODE == 0) { unsigned h_, m_, l_; split3(-m_run, h_, m_, l_); if (!hi) { mfr.y = 0x3F80u | (h_ << 16); mfr.z = m_ | (l_ << 16); } }
            const float alpha = first ? 0.f : __builtin_amdgcn_exp2f(-dl);
            l_run *= alpha;
#pragma unroll
            for (int r = 0; r < 16; ++r) { p0[r] -= dl; p1[r] -= dl; }
            if (!first) {
#pragma unroll
                for (int r = 0; r < 16; ++r) { const float ar = shi(alpha, crow(r, hi)); o0[r] *= ar; o1[r] *= ar; } }
        }
        float rs = 0.f;
#pragma unroll
        for (int r = 0; r < 16; ++r) { p0[r] = __builtin_amdgcn_exp2f(p0[r]); p1[r] = __builtin_amdgcn_exp2f(p1[r]); rs += p0[r] + p1[r]; }
        l_run += rs;
#pragma unroll
        for (int t = 0; t < 2; ++t)
#pragma unroll
            for (int s = 0; s < 2; ++s) {
                const f32x16& pp = t ? p1 : p0;
                v4u wq; wq.x = pg8::cvt_pk_bf16(pp[8 * s + 0], pp[8 * s + 1]); wq.y = pg8::cvt_pk_bf16(pp[8 * s + 2], pp[8 * s + 3]); wq.z = pg8::cvt_pk_bf16(pp[8 * s + 4], pp[8 * s + 5]); wq.w = pg8::cvt_pk_bf16(pp[8 * s + 6], pp[8 * s + 7]);
                const bf16x8 pf = __builtin_bit_cast(bf16x8, wq);
                const bf16x8 v0 = vf[2 * t + s][0], v1 = vf[2 * t + s][1];
                o0 = __builtin_amdgcn_mfma_f32_32x32x16_bf16(pf, v0, o0, 0, 0, 0);
                o1 = __builtin_amdgcn_mfma_f32_32x32x16_bf16(pf, v1, o1, 0, 0, 0);
            }
    }
#undef CHUNK_ROW
#undef KV_DMA
    if (!active) return;
    l_run += shx<32>(l_run);
    if (MODE == 1) l_run += __builtin_amdgcn_exp2f(sinks[h] * LOG2E + sl2 * (float)r32 - m_run);
    const float inv = 1.0f / l_run;
    const int qrow0e = launder_u(qrow0), he = launder_u(h);
    int lane_e = lane; asm volatile("" : "+v"(lane_e)); const int r32e = lane_e & 31, hie = lane_e >> 5;
    GAS bf16* Op = (GAS bf16*)(w + WS_O) + (size_t)qrow0e * D + (MODE == 0 ? 0 : 1024) + he * 64 + r32e;
    GAS float* sqo = meta ? (GAS float*)(w + WS_SSQOM) + (MODE == 0 ? 0 : 16) + he : (GAS float*)(w + WS_SSQO) + (size_t)qrow0e * 32 + (MODE == 0 ? 0 : 16) + he;
#pragma unroll
    for (int r = 0; r < 16; ++r) { const int q = crow(r, hie); float ir = shi(inv, q); if (meta && q < 16) ir = 0.f;
        const unsigned b0 = f2bf(o0[r] * ir), b1 = f2bf(o1[r] * ir);
        Op[(size_t)q * D] = (bf16)b0; Op[(size_t)q * D + 32] = (bf16)b1;
        const float v0 = bf2f((bf16)b0), v1 = bf2f((bf16)b1); float ss = v0 * v0 + v1 * v1;
        XSUM32(ss);
        if (r32e == 0) { if (!meta) sqo[(size_t)q * 32] = ss; else if (q >= 16) sqo[(size_t)(q - 16) * 32] = ss; } }
}
__device__ __forceinline__ void attn_phase(Frame& F, const float* sinks, int next_layer  , const float* gq, const float* gk) {
    unsigned char* w = wsl(F); const GAS float* LOGF = (const GAS float*)(w + WS_LOGF);
    const int bh = F.vcu >> 1, fb = bh >> 4, fh = bh & 15;
    LAS float* tab = (LAS float*)(F.lds + RING_OFF + ATT_TAB_OFF);
    LAS float* wtot = (LAS float*)(F.lds + RING_OFF + ATT_WTOT_OFF);
    { float v[5]; float tsum = 0.f; const int p0 = 5 * F.tid;
#pragma unroll
      for (int j = 0; j < 5; ++j) { const int p = p0 + j; float x = 0.f;
          if (p >= PADN && p < LPOS) { const int row = p < 128 ? META_BLK0 + p : fb * SEQ + p - 128; x = LOGF[(size_t)row * 16 + fh]; }
          tsum += x; v[j] = tsum; }
      float inc = tsum;
#pragma unroll
      for (int o = 1; o < 64; o <<= 1) { const float t = shi(inc, F.lane - o); if (F.lane >= o) inc += t; }
      if (F.lane == 63) wtot[F.wave] = inc;
      __syncthreads();
      float base = inc - tsum;
      for (int w = 0; w < F.wave; ++w) base += wtot[w];
#pragma unroll
      for (int j = 0; j < 5; ++j) { const int p = p0 + j; if (p < LPOS) { const float cv = (p < PADN) ? 1e30f : (base + v[j]) * LOG2E; tab[p] = cv;
          unsigned h_, m_, l_; split3(fmaxf(-cv, -60000.f), h_, m_, l_);
          LAS unsigned* tf = (LAS unsigned*)(F.lds + RING_OFF + ATT_TABF_OFF + p * 16); unsigned one2 = 0x3F803F80u, zz = 0u; asm volatile("" : "+v"(one2), "+v"(zz));
          tf[0] = h_ | (m_ << 16); tf[1] = l_ | (one2 << 16); tf[2] = one2; tf[3] = zz; } }
      if (F.tid < 4) ((LAS unsigned*)(F.lds + RING_OFF + ATT_ZERO_OFF))[F.tid] = 0u;
      __syncthreads();
      if (F.wave == 0) { float mq = fabsf(((const GAS float*)gq)[F.lane]), mk = fabsf(((const GAS float*)gk)[F.lane]);
#define XMAX_(v, O) v = fmaxf(v, shx<O>(v))
          XMAX_(mq, 1); XMAX_(mq, 2); XMAX_(mq, 4); XMAX_(mq, 8); XMAX_(mq, 16); XMAX_(mq, 32); XMAX_(mk, 1); XMAX_(mk, 2); XMAX_(mk, 4); XMAX_(mk, 8); XMAX_(mk, 16); XMAX_(mk, 32);
#undef XMAX_
          const float thr = -(152.0f + 2.0f * (64.0f * QSCALE * mq * mk * 1.02f + 1.0f));
          const int q0pos = 128 + 32 * F.lane, cdl = q0pos >> 6; const float tq = tab[q0pos]; int c = 1;
          while (c < cdl && tq - tab[64 * c + 63] < thr) ++c;
          ((LAS int*)(F.lds + RING_OFF + ATT_FC_OFF))[F.lane] = c; }
      __syncthreads(); }
    {
      const int odd = F.vcu & 1;
      for (int k = 0; k < 4; ++k) { const int g = (k == 0) ? odd : (k == 1) ? 3 - odd : (k == 2) ? 4 + odd : 7 - odd;
          int cf = 1 << 20;
#pragma unroll
          for (int j = 0; j < 8; ++j) cf = min(cf, ((const volatile LAS int*)(F.lds + RING_OFF + ATT_FC_OFF))[8 * g + j]);
          cf = __builtin_amdgcn_readfirstlane(cf);
          attn_group<0>(F, w, fb, fh, cf, (128 + 32 * (8 * g + 7)) >> 6, true, fb, fh, 8 * g + F.wave, sinks); }
      if (F.vcu < 32 && odd == 0) attn_group<0>(F, w, 0, fh, 1, 1, F.wave == 0, -1, fh, 0, sinks); }
    {
      for (int k = 0; k < 4; ++k) { const int T = F.vcu * 4 + k, sb = T >> 7, kvh = (T >> 6) & 1, i = T & 63; const int qp = 128 + 32 * i;
          attn_group<1>(F, w, sb, kvh, (qp - 127) < 128 ? 1 : ((qp - 127) >> 6), qp >> 6, true, sb, 8 * kvh + F.wave, i, sinks); }
      if (F.vcu < 32 && (F.vcu & 1) == 1) attn_group<1>(F, w, 0, (F.vcu >> 1) >> 3, 1, 1, F.wave == 0, -1, F.vcu >> 1, 0, sinks); }
    __syncthreads();
}

constexpr int PH_PER_LAYER = 7, N_PHASES = 1 + DEPTH * PH_PER_LAYER;
struct Args { const float* in[21]; float* out; unsigned char* ws; int ph_lo, ph_hi, li, pad; };
__global__ void __launch_bounds__(NWAVES * 64, 2) hymba_fwd(Args args) {
    extern __shared__ __attribute__((aligned(16))) unsigned char lds[];
    {
        LAS unsigned char* l0 = (LAS unsigned char*)lds; const int tid = threadIdx.x;
        for (int u = tid; u < (LDS_BYTES - LDSCTL_OFF) / 4; u += NWAVES * 64) ((LAS unsigned*)(l0 + LDSCTL_OFF))[u] = 0u;
        __syncthreads();
        if ((tid & 63) == 0) ((volatile LAS int*)(l0 + WID_OFF))[hw_wave_key()] = tid >> 6;
        volatile LAS unsigned long long* pt = (volatile LAS unsigned long long*)(l0 + PTR_OFF);
#pragma unroll
        for (int k = 0; k < 21; ++k) if (tid == k) pt[k] = (unsigned long long)args.in[k];
        if (tid == 21) pt[21] = (unsigned long long)args.out;
        if (tid == 22) pt[22] = (unsigned long long)args.ws;
        __syncthreads();
#if !MK_PER_PHASE
        (void)xcd_barrier_post((unsigned*)((gu32*)(args.ws + WS_CTL) + CW_BAR), (volatile LAS unsigned*)(l0 + MISC_OFF) + 8);
#endif
    }
    const int lo = args.ph_lo, hi = args.ph_hi;
#define IN(k) (lo <= (k) && (k) < hi)
#define PROBE_T0() if (PROBE_CLASS == 60 && (PROBE_BLOCK < 0 || (int)blockIdx.x == PROBE_BLOCK) && my_tid() == 0) { *(volatile LAS unsigned long long*)((LAS unsigned char*)lds + MISC_OFF + 72) = __builtin_amdgcn_s_memtime(); } else if (PROBE_CLASS >= 0 && (PROBE_BLOCK < 0 || (int)blockIdx.x == PROBE_BLOCK) && my_tid() == 0) { *(volatile LAS unsigned long long*)((LAS unsigned char*)lds + MISC_OFF + 72) = __builtin_amdgcn_s_memrealtime(); }
#define PROBE_T1(c) if (PROBE_CLASS == 60 && (c) == 2 && (PROBE_BLOCK < 0 || (int)blockIdx.x == PROBE_BLOCK) && my_tid() == 0) { volatile LAS unsigned long long* pa_ = (volatile LAS unsigned long long*)((LAS unsigned char*)lds + MISC_OFF + 64); *pa_ = *pa_ + (__builtin_amdgcn_s_memtime() - *(volatile LAS unsigned long long*)((LAS unsigned char*)lds + MISC_OFF + 72)) / 24ull; } else if (PROBE_CLASS == (c) && (PROBE_BLOCK < 0 || (int)blockIdx.x == PROBE_BLOCK) && my_tid() == 0) { volatile LAS unsigned long long* pa_ = (volatile LAS unsigned long long*)((LAS unsigned char*)lds + MISC_OFF + 64); *pa_ = *pa_ + (__builtin_amdgcn_s_memrealtime() - *(volatile LAS unsigned long long*)((LAS unsigned char*)lds + MISC_OFF + 72)); }
#define SEAM(k) do { if (IN(k) && IN((k) + 1)) { PROBE_T0() unsigned char* wsb_ = (unsigned char*)pg8::tab_ptr(22); \
        if (MK_PER_PHASE) { if (my_tid() == 0) __hip_atomic_store((gu32*)(wsb_ + WS_CTL) + CW_TMO, 0xBADBA0u, RLX_AGENT); } \
        else { XcdBarrier bar_; bar_.bar = (unsigned*)((gu32*)(wsb_ + WS_CTL) + CW_BAR); bar_.x = xb_xcc_id(); bar_.st = (volatile LAS unsigned*)((LAS unsigned char*)lds + MISC_OFF) + 8; xcd_barrier(bar_); if (PROBE_CLASS == 50) xcd_barrier(bar_); } PROBE_T1(8) } } while (0)
#define PHASE_BEGIN(k) if (IN(k)) { PROBE_T0() Frame P = make_frame(); \
        unsigned char* w = wsl(P); int ll = l; LAUNDER_S(ll); unsigned char* wl = w + WS_W + (size_t)ll * LW_STRIDE; (void)wl; int bxl = blockIdx.x; LAUNDER_S(bxl);
#define PHASE_END(k, c) PROBE_T1(c) } SEAM(k);
    typedef pg8::StaticOrder SO;
    if (IN(0)) { PROBE_T0() Frame P = make_frame(); p0_prologue(P); PROBE_T1(0) } SEAM(0);
    for (int l = 0; l < DEPTH; ++l) {
        const int pb = 1 + l * PH_PER_LAYER;
#define SSQ(j) ((GAS float*)(w + WS_SSQM) + (size_t)(3 * ll + (j)) * 16 * 128)
#define HBM ((const GAS bf16*)(w + WS_HB) + (size_t)META_ROW * D)
        PHASE_BEGIN(pb + 0) pg8::Gemm g{(const bf16*)(w + WS_HB), (const bf16*)(wl + LW_GU1), M_REAL, N_GU, D}; SO S; S.init(M_REAL, N_GU, P.G, bxl);
            pg8::EpiSwiGLU E{3 * ll + 0}; pg8::gemm_phase<pg8::EpiSwiGLU, SO, true, true>(P.lds + RING_OFF, g, S, E);
            SkGU K2{(GAS bf16*)(w + WS_ACT), SSQ(0)}; skinny_phase<SkGU, D / 256>(P, HBM, D, (const GAS bf16*)(wl + LW_GU1), D, K2); PHASE_END(pb + 0, 2)
        PHASE_BEGIN(pb + 1) pg8::Gemm g{(const bf16*)(w + WS_ACT), (const bf16*)(wl + LW_D1), M_REAL, D, FF}; SO S; S.init(M_REAL, D, P.G, bxl);
            pg8::EpiResAdd E{0.5f, 3 * ll + 1, 0}; pg8::gemm_phase<pg8::EpiResAdd, SO, true, true>(P.lds + RING_OFF, g, S, E);
            SkRes K2{0.5f, (GAS bf16*)(w + WS_HB), SSQ(1)}; skinny_phase<SkRes, FF / 256>(P, (const GAS bf16*)(w + WS_ACT) + (size_t)META_ROW * FF, FF, (const GAS bf16*)(wl + LW_D1), FF, K2); PHASE_END(pb + 1, 3)
        PHASE_BEGIN(pb + 2) pg8::Gemm g{(const bf16*)(w + WS_HB), (const bf16*)(wl + LW_IN), M_REAL, N_IN, D}; SO S; S.init(M_REAL, N_IN, P.G, bxl);
            pg8::EpiInProj E{ll, 3 * ll + 1, QSCALE};
            pg8::gemm_phase<pg8::EpiInProj, SO, true, true>(P.lds + RING_OFF, g, S, E);
            SkIn K2{(GAS bf16*)(w + WS_FQ), (GAS bf16*)(w + WS_FK), (GAS bf16*)(w + WS_FV), (GAS bf16*)(w + WS_SQ), (GAS bf16*)(w + WS_SK), (GAS bf16*)(w + WS_SV), (GAS float*)(w + WS_LOGF), (const GAS float*)(inptr(P, 9) + ll * HD), (const GAS float*)(inptr(P, 10) + ll * HD), (const GAS float*)(inptr(P, 11) + ll * HD), (const GAS float*)(inptr(P, 12) + ll * HD), (const GAS float*)(inptr(P, 8) + ll * NH), QSCALE, SSQ(1)}; skinny_phase<SkIn, D / 256>(P, HBM, D, (const GAS bf16*)(wl + LW_IN), D, K2);
            if (IDLE_CONV_K > 0 && P.G == 256 && bxl >= 128) { __syncthreads(); LAS unsigned char* scr = P.lds + RING_OFF + P.wave * 16384; const int iw = (bxl - 128) * NWAVES + P.wave;
                for (int k = 0; k < IDLE_CONV_K; ++k) convert_item(P, w, ll, GU2_BASE + iw + k * 128 * NWAVES, scr); }
            PHASE_END(pb + 2, 4)
        PHASE_BEGIN(pb + 3) attn_phase(P, inptr(P, 13) + ll * NH, OVERLAP_CONV ? ll + 1 : DEPTH, inptr(P, 9) + ll * HD, inptr(P, 10) + ll * HD); PHASE_END(pb + 3, 5)
        PHASE_BEGIN(pb + 4) pg8::Gemm g{(const bf16*)(w + WS_O), (const bf16*)(wl + LW_OUT), M_REAL, D, D}; SO S; S.init(M_REAL, D, P.G, bxl);
            pg8::EpiOut E{3 * ll + 2}; pg8::gemm_phase<pg8::EpiOut, SO, true, true>(P.lds + RING_OFF, g, S, E);
            SkOut K2{1.0f, (GAS bf16*)(w + WS_HB), SSQ(2), (const GAS float*)(w + WS_SSQOM)}; skinny_phase<SkOut, D / 256>(P, (const GAS bf16*)(w + WS_O) + (size_t)META_ROW * D, D, (const GAS bf16*)(wl + LW_OUT), D, K2); PHASE_END(pb + 4, 7)
        PHASE_BEGIN(pb + 5) pg8::Gemm g{(const bf16*)(w + WS_HB), (const bf16*)(wl + LW_GU2), M_REAL, N_GU, D}; SO S; S.init(M_REAL, N_GU, P.G, bxl);
            pg8::EpiSwiGLU E{3 * ll + 2}; pg8::gemm_phase<pg8::EpiSwiGLU, SO, true, true>(P.lds + RING_OFF, g, S, E);
            if (ll < DEPTH - 1) { SkGU K2{(GAS bf16*)(w + WS_ACT), SSQ(2)}; skinny_phase<SkGU, D / 256>(P, HBM, D, (const GAS bf16*)(wl + LW_GU2), D, K2); } PHASE_END(pb + 5, 2)
        PHASE_BEGIN(pb + 6) pg8::Gemm g{(const bf16*)(w + WS_ACT), (const bf16*)(wl + LW_D2), M_REAL, D, FF}; SO S; S.init(M_REAL, D, P.G, bxl);
            const bool fin = (ll == DEPTH - 1);
            pg8::EpiResAdd E{0.5f, 3 * ll + 3, fin ? 1 : 0}; pg8::gemm_phase<pg8::EpiResAdd, SO, true, true>(P.lds + RING_OFF, g, S, E);
            if (!fin) { SkRes K2{0.5f, (GAS bf16*)(w + WS_HB), SSQ(3)}; skinny_phase<SkRes, FF / 256>(P, (const GAS bf16*)(w + WS_ACT) + (size_t)META_ROW * FF, FF, (const GAS bf16*)(wl + LW_D2), FF, K2); } PHASE_END(pb + 6, 3)
#undef SSQ
#undef HBM
    }
    if (PROBE_CLASS >= 0 && (PROBE_BLOCK < 0 || (int)blockIdx.x == PROBE_BLOCK) && my_tid() == 0) { const unsigned long long t0 = __builtin_amdgcn_s_memrealtime(), dt = *(volatile LAS unsigned long long*)((LAS unsigned char*)lds + MISC_OFF + 64);
        while (__builtin_amdgcn_s_memrealtime() - t0 < dt) __builtin_amdgcn_s_sleep(8); }
#undef IN
#undef SEAM
#undef PHASE_BEGIN
#undef PHASE_END
}

extern "C" void kernel_launch(void* const* d_in, const int* in_sizes, int n_in, void* d_out, int out_size, void* d_ws, size_t ws_size, hipStream_t stream) {
    static int grid = 0;
    if (grid == 0) {
        if (n_in != 21 || in_sizes[0] != M_REAL * D || out_size != M_REAL * D || ws_size < WS_END) { fprintf(stderr, "kernel_launch: unexpected shapes (n_in %d, in0 %d, out %d, ws %zu, need %zu); nothing launched\n", n_in, n_in > 0 ? in_sizes[0] : -1, out_size, ws_size, (size_t)WS_END); grid = -1; return; }
        int dev = 0, cus = 0, per_cu = 0;
        if (hipGetDevice(&dev) != hipSuccess || hipDeviceGetAttribute(&cus, hipDeviceAttributeMultiprocessorCount, dev) != hipSuccess) { fprintf(stderr, "kernel_launch: device query failed\n"); grid = -1; return; }
        if (hipFuncSetAttribute((const void*)hymba_fwd, hipFuncAttributeMaxDynamicSharedMemorySize, LDS_BYTES) != hipSuccess) { fprintf(stderr, "kernel_launch: hipFuncSetAttribute failed\n"); grid = -1; return; }
        if (hipOccupancyMaxActiveBlocksPerMultiprocessor(&per_cu, (const void*)hymba_fwd, NWAVES * 64, LDS_BYTES) != hipSuccess || per_cu < 1) fprintf(stderr, "kernel_launch: note: occupancy query reports %d workgroups per CU\n", per_cu);
        (void)hipGetLastError();
        grid = cus;
        if (grid != 256) fprintf(stderr, "kernel_launch: note: %d CUs (the attention phase's static deal assumes 256)\n", grid);
    }
    if (grid < 0) return;
    if (hipMemsetAsync((char*)d_ws + WS_CTL, 0, CTL_ZERO_BYTES, stream) != hipSuccess) { fprintf(stderr, "kernel_launch: memset failed\n"); return; }
    Args a{};
    for (int i = 0; i < 21; ++i) a.in[i] = (const float*)d_in[i];
    a.out = (float*)d_out; a.ws = (unsigned char*)d_ws; a.li = 0; a.pad = 0;
#if MK_PER_PHASE
    for (int ph = 0; ph < N_PHASES; ++ph) { a.ph_lo = ph; a.ph_hi = ph + 1; hipLaunchKernelGGL(hymba_fwd, dim3(grid), dim3(NWAVES * 64), LDS_BYTES, stream, a); }
#else
    a.ph_lo = 0; a.ph_hi = N_PHASES;
    hipLaunchKernelGGL(hymba_fwd, dim3(grid), dim3(NWAVES * 64), LDS_BYTES, stream, a);
#endif
    const hipError_t le = hipPeekAtLastError();
    if (le != hipSuccess) fprintf(stderr, "kernel_launch: launch failed: %s\n", hipGetErrorName(le));
}
```

```cpp
#include <hip/hip_runtime.h>
#include <cstdio>
#include <cstdint>

#ifndef MK_PER_PHASE
#define MK_PER_PHASE 0
#endif
#ifndef OVERLAP_CONV
#define OVERLAP_CONV 0
#endif
#ifndef PROBE_BLOCK
#define PROBE_BLOCK 0
#endif
#ifndef PROBE_CLASS
#define PROBE_CLASS (-1)
#endif

#define PROBE_ACC_OFF (131072 + 320 + 64)
__device__ __forceinline__ int my_tid();
__device__ __forceinline__ int lane_now() { unsigned z = 0; asm volatile("" : "+v"(z)); return (int)__builtin_amdgcn_mbcnt_hi(~0u, __builtin_amdgcn_mbcnt_lo(~0u, z)); }
template <int O> __device__ __forceinline__ float shx(float v) {
    if constexpr (O < 32) return __builtin_bit_cast(float, __builtin_amdgcn_ds_swizzle(__builtin_bit_cast(int, v), (O << 10) | 0x1f));
    else return __builtin_bit_cast(float, __builtin_amdgcn_ds_bpermute((lane_now() ^ 32) << 2, __builtin_bit_cast(int, v)));
}
__device__ __forceinline__ float shi(float v, int idx) { return __builtin_bit_cast(float, __builtin_amdgcn_ds_bpermute(idx << 2, __builtin_bit_cast(int, v))); }
#define XSUM16(v) do { v += shx<1>(v); v += shx<2>(v); v += shx<4>(v); v += shx<8>(v); } while (0)
#define XSUM32(v) do { XSUM16(v); v += shx<16>(v); } while (0)
#define XSUM64(v) do { XSUM32(v); v += shx<32>(v); } while (0)
namespace pg8 {
#define PG8_LAS __attribute__((address_space(3)))
#define PG8_GAS __attribute__((address_space(1)))
typedef unsigned short bf16_t;
typedef short bf16x8 __attribute__((ext_vector_type(8)));
typedef float f32x4 __attribute__((ext_vector_type(4)));
typedef unsigned u32x4 __attribute__((ext_vector_type(4)));
constexpr int BM = 256, BK = 64, HALF = 128, HTB = HALF * BK * 2  , STAGE_BYTES = 8 * HTB, NXCD = 8, WGM = 8;

__host__ __device__ __forceinline__ int lds_byte(int r, int c) { const int st = (r >> 4) * 2 + (c >> 5), rr = r & 15, cc = c & 31, ob = rr * 64 + cc * 2; return st * 1024 + (ob ^ (((ob >> 9) & 1) << 5)); }
__host__ __device__ __forceinline__ void stage_rc(int b, int& R, int& C) { const int st = b / 1024, sb = b % 1024, swz = sb ^ (((sb >> 9) & 1) << 5); R = (st >> 1) * 16 + swz / 64; C = (st & 1) * 32 + (swz % 64) / 2; }
__host__ __device__ __forceinline__ int perm32(int rho) { const int n = rho >> 4, i = rho & 15; return 8 * (i >> 2) + 4 * n + (i & 3); }

struct Unit { int pm, pn; };
struct Gemm { const bf16_t* A; const bf16_t* Bt; int M, N, K; };

struct StaticOrder {
    int nM, nN, nwg, G, c;
    __host__ __device__ void init(int M, int N, int G_, int c_) { nM = M / BM; nN = N / BM; nwg = nM * nN; G = G_; c = c_; }
    __host__ __device__ bool next(int i, Unit& u) const {
        const long L = (long)i * G + c; if (L >= nwg) return false;
        int wgid = (int)L; { const int q = nwg / NXCD, r = nwg % NXCD, xcd = wgid % NXCD, off = wgid / NXCD; wgid = (xcd < r ? xcd * (q + 1) : r * (q + 1) + (xcd - r) * q) + off; }
        const int nig = WGM * nN, gid = wgid / nig, fm = gid * WGM, gsz = (nM - fm) < WGM ? (nM - fm) : WGM;
        u.pm = fm + ((wgid % nig) % gsz); u.pn = (wgid % nig) / gsz; return true;
    }
    __device__ __forceinline__ void a_ready(const Unit&) const {}
    __device__ __forceinline__ void done(const Unit&) const {}
};

__device__ __forceinline__ unsigned cvt_pk_bf16(float lo, float hi) { unsigned r; asm volatile("v_cvt_pk_bf16_f32 %0, %1, %2" : "=v"(r) : "v"(lo), "v"(hi)); return r; }

template <class Epi, class Sched, bool ALIGN_EPI = false, bool SP2 = false>
__device__ __forceinline__ void gemm_phase(PG8_LAS unsigned char* lds, const Gemm g, const Sched& S, const Epi& E) {
    int tid_l = my_tid(); asm volatile("" : "+v"(tid_l));
    const int tid = tid_l, wid = __builtin_amdgcn_readfirstlane(tid >> 6), lane = tid & 63, wr = wid >> 2, wc = wid & 3, fr = lane & 15, fq = lane >> 4;
    const int K = g.K, nt = K / BK;
    unsigned voffA[2], voffB[2];
#pragma unroll
    for (int i = 0; i < 2; ++i) { int R, C; stage_rc(tid * 16 + i * 8192, R, C); const int Rb = Epi::PERM ? ((R & ~31) + perm32(R & 31)) : R;
        voffA[i] = (unsigned)(R * K + C) * 2u; voffB[i] = (unsigned)(Rb * K + C) * 2u; }
    const size_t kstep = (size_t)(BK * 2);
    const size_t hstep = (size_t)HALF * K * 2;
    const size_t tstep = 2 * hstep;
    const unsigned ldsw = (unsigned)wid * 1024u;
    const int aoff = lds_byte(wr * 64 + fr, fq * 8), boff = lds_byte(wc * 32 + fr, fq * 8);
#define PG8_SA(b, h) (((b) * 2 + (h)) * HTB)
#define PG8_SB(b, h) ((4 + (b) * 2 + (h)) * HTB)
#define PG8_STAGE(bufoff, gbase, voff) do { _Pragma("unroll") for (int _i = 0; _i < 2; ++_i) \
        __builtin_amdgcn_global_load_lds((const unsigned*)((const char*)(gbase) + (voff)[_i]), (PG8_LAS unsigned*)(lds + (bufoff) + ldsw + _i * 8192), 16, 0, 0); } while (0)
#define PG8_LDA(dst, b, h) do { _Pragma("unroll") for (int m = 0; m < 4; ++m) _Pragma("unroll") for (int k = 0; k < 2; ++k) dst[m][k] = *(const PG8_LAS bf16x8*)(lds + PG8_SA(b, h) + aoff + m * 2048 + k * 1024); } while (0)
#define PG8_LDB(dst, b, h) do { _Pragma("unroll") for (int n = 0; n < 2; ++n) _Pragma("unroll") for (int k = 0; k < 2; ++k) dst[n][k] = *(const PG8_LAS bf16x8*)(lds + PG8_SB(b, h) + boff + n * 2048 + k * 1024); } while (0)
#define PG8_MMA(ai, bj, At, Bt) do { __builtin_amdgcn_s_setprio(1); _Pragma("unroll") for (int m = 0; m < 4; ++m) _Pragma("unroll") for (int n = 0; n < 2; ++n) _Pragma("unroll") for (int k = 0; k < 2; ++k) \
        acc[ai][bj][m][n] = __builtin_amdgcn_mfma_f32_16x16x32_bf16(Bt[n][k], At[m][k], acc[ai][bj][m][n], 0, 0, 0); __builtin_amdgcn_s_setprio(0); } while (0)
#define PG8_WAIT_V(n) asm volatile("s_waitcnt vmcnt(" #n ")" ::: "memory")
#define PG8_WAIT_L(n) asm volatile("s_waitcnt lgkmcnt(" #n ")" ::: "memory")
#define PG8_BAR __builtin_amdgcn_s_barrier()
#define PG8_SCHED __builtin_amdgcn_sched_barrier(0)
    Unit cur, nxt; int ui = 0;
    if (!S.next(0, cur)) return;
    f32x4 acc[2][2][4][2];
#pragma unroll
    for (int a = 0; a < 2; ++a)
#pragma unroll
        for (int b = 0; b < 2; ++b)
#pragma unroll
            for (int m = 0; m < 4; ++m)
#pragma unroll
                for (int n = 0; n < 2; ++n) acc[a][b][m][n] = (f32x4){0.f, 0.f, 0.f, 0.f};
    bf16x8 At[4][2], B0[2][2], B1[2][2];
    const char* cA = (const char*)g.A + (size_t)cur.pm * tstep; const char* cB = (const char*)g.Bt + (size_t)cur.pn * tstep;
    S.a_ready(cur);
    if constexpr (SP2) {
        PG8_STAGE(PG8_SB(0, 0), cB, voffB); PG8_STAGE(PG8_SB(0, 1), cB + hstep, voffB); PG8_STAGE(PG8_SA(0, 0), cA, voffA); PG8_STAGE(PG8_SA(0, 1), cA + hstep, voffA);
        if (wr == 1) PG8_BAR;
        PG8_WAIT_V(2); PG8_BAR;
        PG8_STAGE(PG8_SB(1, 0), cB + kstep, voffB); PG8_STAGE(PG8_SA(1, 0), cA + kstep, voffA); PG8_STAGE(PG8_SB(1, 1), cB + hstep + kstep, voffB);
        PG8_WAIT_V(6); PG8_BAR;
    } else {
        PG8_STAGE(PG8_SB(0, 0), cB, voffB); PG8_STAGE(PG8_SA(0, 0), cA, voffA); PG8_STAGE(PG8_SB(0, 1), cB + hstep, voffB); PG8_STAGE(PG8_SA(0, 1), cA + hstep, voffA);
        if (wr == 1) PG8_BAR;
        PG8_WAIT_V(4); PG8_BAR;
        PG8_STAGE(PG8_SB(1, 0), cB + kstep, voffB); PG8_STAGE(PG8_SA(1, 0), cA + kstep, voffA); PG8_STAGE(PG8_SB(1, 1), cB + hstep + kstep, voffB);
        PG8_WAIT_V(6); PG8_BAR;
    }
    for (;;) {
        const bool has_next = S.next(ui + 1, nxt);
        const char* nA = has_next ? (const char*)g.A + (size_t)nxt.pm * tstep : cA; const char* nB = has_next ? (const char*)g.Bt + (size_t)nxt.pn * tstep : cB;
        for (int t = 0; t < nt; t += 2) {
            const bool last = (t == nt - 2);
            const char* a1 = cA + (size_t)(t + 1) * kstep;
            const char* a2 = last ? nA : cA + (size_t)(t + 2) * kstep; const char* b2 = last ? nB : cB + (size_t)(t + 2) * kstep;
            const char* a3 = a2 + kstep; const char* b3 = b2 + kstep;
            if (last && has_next) S.a_ready(nxt);
            if constexpr (Epi::MID) { if (t == nt / 2) E.mid(acc, cur, wr, wc, fr, fq); }
            if constexpr (SP2) {
            PG8_LDB(B0, 0, 0); PG8_LDB(B1, 0, 1); PG8_SCHED; PG8_LDA(At, 0, 0); PG8_STAGE(PG8_SA(1, 1), a1 + hstep, voffA);
            PG8_WAIT_V(8); PG8_WAIT_L(0); PG8_BAR; PG8_MMA(0, 0, At, B0); PG8_MMA(0, 1, At, B1); PG8_BAR; PG8_SCHED;
            PG8_LDA(At, 0, 1); PG8_STAGE(PG8_SB(0, 0), b2, voffB); PG8_STAGE(PG8_SB(0, 1), b2 + hstep, voffB); PG8_STAGE(PG8_SA(0, 0), a2, voffA);
            PG8_WAIT_V(8); PG8_WAIT_L(0); PG8_BAR; PG8_MMA(1, 0, At, B0); PG8_MMA(1, 1, At, B1); PG8_BAR; PG8_SCHED;
            PG8_LDB(B0, 1, 0); PG8_LDB(B1, 1, 1); PG8_SCHED; PG8_LDA(At, 1, 0); PG8_STAGE(PG8_SA(0, 1), a2 + hstep, voffA);
            PG8_WAIT_V(8); PG8_WAIT_L(0); PG8_BAR; PG8_MMA(0, 0, At, B0); PG8_MMA(0, 1, At, B1); PG8_BAR; PG8_SCHED;
            PG8_LDA(At, 1, 1); PG8_STAGE(PG8_SB(1, 0), b3, voffB); PG8_STAGE(PG8_SB(1, 1), b3 + hstep, voffB); PG8_STAGE(PG8_SA(1, 0), a3, voffA);
            PG8_WAIT_V(8); PG8_WAIT_L(0); PG8_BAR; PG8_MMA(1, 0, At, B0); PG8_MMA(1, 1, At, B1); PG8_BAR; PG8_SCHED;
            } else {
            PG8_LDB(B0, 0, 0); PG8_SCHED; PG8_LDA(At, 0, 0); PG8_STAGE(PG8_SA(1, 1), a1 + hstep, voffA);
            PG8_WAIT_L(8); PG8_BAR; PG8_WAIT_L(0); PG8_MMA(0, 0, At, B0); PG8_BAR; PG8_SCHED;
            PG8_LDB(B1, 0, 1); PG8_STAGE(PG8_SB(0, 0), b2, voffB);
            PG8_BAR; PG8_WAIT_L(0); PG8_MMA(0, 1, At, B1); PG8_BAR;
            PG8_LDA(At, 0, 1); PG8_STAGE(PG8_SA(0, 0), a2, voffA);
            PG8_BAR; PG8_WAIT_L(0); PG8_MMA(1, 0, At, B0); PG8_BAR; PG8_SCHED;
            PG8_STAGE(PG8_SB(0, 1), b2 + hstep, voffB);
            PG8_WAIT_V(6); PG8_BAR; PG8_MMA(1, 1, At, B1); PG8_BAR;
            PG8_LDB(B0, 1, 0); PG8_SCHED; PG8_LDA(At, 1, 0); PG8_STAGE(PG8_SA(0, 1), a2 + hstep, voffA);
            PG8_WAIT_L(8); PG8_BAR; PG8_WAIT_L(0); PG8_MMA(0, 0, At, B0); PG8_BAR; PG8_SCHED;
            PG8_LDB(B1, 1, 1); PG8_STAGE(PG8_SB(1, 0), b3, voffB);
            PG8_BAR; PG8_WAIT_L(0); PG8_MMA(0, 1, At, B1); PG8_BAR;
            PG8_LDA(At, 1, 1); PG8_STAGE(PG8_SA(1, 0), a3, voffA);
            PG8_BAR; PG8_WAIT_L(0); PG8_MMA(1, 0, At, B0); PG8_BAR; PG8_SCHED;
            PG8_STAGE(PG8_SB(1, 1), b3 + hstep, voffB);
            PG8_WAIT_V(6); PG8_BAR; PG8_MMA(1, 1, At, B1); PG8_BAR;
            }
        }
        if constexpr (ALIGN_EPI) { if (wr == 0) PG8_BAR; }
        if constexpr (PROBE_CLASS == 20 + Epi::ID) { unsigned long long t0_ = 0; if ((PROBE_BLOCK < 0 || (int)blockIdx.x == PROBE_BLOCK) && tid == 0) t0_ = __builtin_amdgcn_s_memrealtime();
            E(acc, cur, wr, wc, fr, fq); asm volatile("s_waitcnt vmcnt(0)" ::: "memory");
            if ((PROBE_BLOCK < 0 || (int)blockIdx.x == PROBE_BLOCK) && tid == 0) { volatile PG8_LAS unsigned long long* pa_ = (volatile PG8_LAS unsigned long long*)(lds + PROBE_ACC_OFF); *pa_ = *pa_ + (__builtin_amdgcn_s_memrealtime() - t0_); } }
        else if constexpr (!Epi::AFTER_DRAIN) { E(acc, cur, wr, wc, fr, fq); S.done(cur); }
        if (!has_next) break;
#pragma unroll
        for (int a = 0; a < 2; ++a)
#pragma unroll
            for (int b = 0; b < 2; ++b)
#pragma unroll
                for (int m = 0; m < 4; ++m)
#pragma unroll
                    for (int n = 0; n < 2; ++n) acc[a][b][m][n] = (f32x4){0.f, 0.f, 0.f, 0.f};
        cur = nxt; cA = nA; cB = nB; ++ui;
        if constexpr (ALIGN_EPI) { if (wr == 1) PG8_BAR; }
    }
    PG8_WAIT_V(0);
    if constexpr (!ALIGN_EPI) { if (wr == 0) PG8_BAR; }
    PG8_BAR;
#undef PG8_SA
#undef PG8_SB
#undef PG8_STAGE
#undef PG8_LDA
#undef PG8_LDB
#undef PG8_MMA
#undef PG8_WAIT_V
#undef PG8_WAIT_L
#undef PG8_BAR
#undef PG8_SCHED
}
}

constexpr int NWAVES = 8;
constexpr int D = 2048, NB = 8, SEQ = 2048, DEPTH = 4, HD = 64, NH = 16, FF = 5632, NMETA = 16, PADN = 112;
constexpr int M_REAL = NB * SEQ;
constexpr int M_PAD = M_REAL + 128;
constexpr int META_BLK0 = M_REAL;
constexpr int META_ROW = META_BLK0 + PADN;
constexpr int LPOS = SEQ + 128;
constexpr int N_GU = 2 * FF;
constexpr int N_IN = 18 * 256;
constexpr int IN_W = 4368;
constexpr float EPS = 1e-6f;
constexpr float LOG2E = 1.4426950408889634f;
constexpr float QSCALE = 0.125f * LOG2E;

constexpr size_t MiB = 1u << 20;
constexpr int NSLOT = 13;
constexpr size_t WS_CTL = 0, CTL_ZERO_BYTES = 1 * MiB;
constexpr size_t SZ_WGU = (size_t)N_GU * D * 2, SZ_WD = (size_t)D * FF * 2, SZ_WIN = (size_t)N_IN * D * 2, SZ_WOUT = (size_t)D * D * 2;
constexpr size_t LW_GU1 = 0, LW_D1 = LW_GU1 + SZ_WGU, LW_IN = LW_D1 + SZ_WD, LW_OUT = LW_IN + SZ_WIN, LW_GU2 = LW_OUT + SZ_WOUT, LW_D2 = LW_GU2 + SZ_WGU, LW_STRIDE = LW_D2 + SZ_WD;
constexpr size_t WS_W = 1 * MiB;
constexpr size_t WS_XN = WS_W + DEPTH * LW_STRIDE;
constexpr size_t WS_O = WS_XN + (size_t)M_PAD * D * 2;
constexpr size_t WS_ACT = WS_O + (size_t)M_PAD * D * 2;
constexpr size_t SZ_QK = (size_t)M_PAD * 1024 * 2, SZ_KV = (size_t)M_PAD * 128 * 2;
constexpr size_t WS_FQ = WS_ACT + (size_t)M_PAD * FF * 2, WS_FK = WS_FQ + SZ_QK, WS_FV = WS_FK + SZ_QK, WS_SQ = WS_FV + SZ_QK, WS_SK = WS_SQ + SZ_QK, WS_SV = WS_SK + SZ_KV, WS_LOGF = WS_SV + SZ_KV;
constexpr size_t WS_HB = WS_LOGF + (size_t)M_PAD * 16 * 4;
constexpr size_t WS_SSQ = WS_HB + (size_t)M_PAD * D * 2;
constexpr size_t WS_SSQM = WS_SSQ + (size_t)NSLOT * M_REAL * 32 * 4;
constexpr size_t WS_SSQO = WS_SSQM + (size_t)NSLOT * 16 * 128 * 4;
constexpr size_t WS_SSQOM = WS_SSQO + (size_t)M_REAL * 32 * 4;
constexpr size_t WS_END = WS_SSQOM + 16 * 32 * 4;
static_assert(LW_STRIDE % 256 == 0 && WS_XN % 256 == 0 && WS_ACT % 256 == 0 && WS_FQ % 256 == 0 && WS_SK % 256 == 0 && WS_LOGF % 256 == 0 && WS_HB % 256 == 0, "alignment");
constexpr int CW_TMO = 0, CW_BAR = 4096;

constexpr int RING_OFF = 0, RING_BYTES = 131072;
constexpr int LDSCTL_OFF = RING_BYTES, MISC_OFF = LDSCTL_OFF + 320, PTR_OFF = LDSCTL_OFF + 1024;
constexpr int LDS_BYTES = 155648;
constexpr int WID_OFF = LDSCTL_OFF + 1280;
constexpr int RSTD_ID_OFF = LDSCTL_OFF + 1536, RSTD_OFF = LDSCTL_OFF + 2048;
static_assert(RSTD_OFF + 8 * 128 * 4 <= LDS_BYTES, "LDS map");
constexpr int RSTD2_OFF = 148480;
static_assert(RSTD2_OFF + 8 * 128 * 4 <= LDS_BYTES, "LDS map");
constexpr int ATT_TAB_OFF = 139264;
constexpr int ATT_WTOT_OFF = ATT_TAB_OFF + 8704;
constexpr int ATT_FC_OFF = ATT_WTOT_OFF + 64;
constexpr int ATT_TABF_OFF = 0, ATT_ZERO_OFF = 2176 * 16;
constexpr int ATT_VST_OFF = 0, ATT_VST_PITCH = 128, ATT_VST_BYTES = 64 * ATT_VST_PITCH;
static_assert(ATT_VST_OFF + NWAVES * 2 * ATT_VST_BYTES <= RING_BYTES && ATT_FC_OFF + 256 <= RSTD2_OFF && RSTD_OFF + 8 * 128 * 4 <= ATT_TAB_OFF, "attention LDS");

#define GAS __attribute__((address_space(1)))
#define LAS __attribute__((address_space(3)))
typedef unsigned short bf16;
typedef unsigned v4u __attribute__((ext_vector_type(4)));
typedef float f32x4 __attribute__((ext_vector_type(4)));
typedef float f32x16 __attribute__((ext_vector_type(16)));
typedef short bf16x8 __attribute__((ext_vector_type(8)));
typedef GAS unsigned gu32;
#define RLX_AGENT __ATOMIC_RELAXED, __HIP_MEMORY_SCOPE_AGENT
#define LDS_WAIT() asm volatile("s_waitcnt lgkmcnt(0)" ::: "memory")
__device__ __forceinline__ unsigned f2bf(float f) { unsigned u = __builtin_bit_cast(unsigned, f); return (u + 0x7fffu + ((u >> 16) & 1u)) >> 16; }
__device__ __forceinline__ unsigned pk2(float lo, float hi) { return f2bf(lo) | (f2bf(hi) << 16); }
__device__ __forceinline__ float bf2f(unsigned short b) { return __builtin_bit_cast(float, (unsigned)b << 16); }

__device__ __forceinline__ int hw_wave_key() { return (int)(__builtin_amdgcn_s_getreg(((6 - 1) << 11) | 4) & 63u); }
__device__ __forceinline__ int my_tid() {
    extern __shared__ __attribute__((aligned(16))) unsigned char lds_dyn_[];
    const int wave = __builtin_amdgcn_readfirstlane(((const volatile LAS int*)((LAS unsigned char*)lds_dyn_ + WID_OFF))[hw_wave_key()]);
    unsigned zero = 0u; asm volatile("" : "+v"(zero));
    return wave * 64 + (int)__builtin_amdgcn_mbcnt_hi(~0u, __builtin_amdgcn_mbcnt_lo(~0u, zero));
}
__host__ __device__ __forceinline__ size_t kfrag_idx(int row, int nh, int head, int d) { return ((((size_t)(row >> 5) * nh + head) * 8 + (d >> 3)) * 32 + (row & 31)) * 8 + (d & 7); }
__host__ __device__ __forceinline__ size_t vfrag_idx(int row, int nh, int head, int d) { return (((((size_t)(row >> 4) * nh + head) * 2 + ((row >> 2) & 1)) * 64 + d) * 8) + (((row >> 3) & 1) * 4 + (row & 3)); }
namespace pg8 {
__device__ __forceinline__ unsigned long long tab_ptr(int k) {
    extern __shared__ __attribute__((aligned(16))) unsigned char lds_dyn_[];
    const volatile PG8_LAS unsigned* t = (const volatile PG8_LAS unsigned*)((PG8_LAS unsigned char*)lds_dyn_ + PTR_OFF);
    const unsigned lo = __builtin_amdgcn_readfirstlane(t[2 * k]), hi = __builtin_amdgcn_readfirstlane(t[2 * k + 1]);
    return ((unsigned long long)hi << 32) | lo;
}
__device__ __forceinline__ const PG8_LAS float* ensure_rstd(const PG8_GAS float* ssq, int slot, int pm, int wid, int wr, int lane) {
    extern __shared__ __attribute__((aligned(16))) unsigned char lds_dyn_[];
    volatile PG8_LAS unsigned* idw = (volatile PG8_LAS unsigned*)((PG8_LAS unsigned char*)lds_dyn_ + RSTD_ID_OFF) + wid;
    PG8_LAS float* rv = (PG8_LAS float*)((PG8_LAS unsigned char*)lds_dyn_ + RSTD_OFF) + wid * 128;
    const unsigned want = ((unsigned)(slot + 1) << 16) | (unsigned)(pm + 1);
    if ((unsigned)__builtin_amdgcn_readfirstlane(*idw) != want) {
#pragma unroll
        for (int j = 0; j < 2; ++j) { const int row = pm * BM + HALF * j + 64 * wr + lane; const PG8_GAS f32x4* pp = (const PG8_GAS f32x4*)(ssq + (size_t)row * 32); float t = 0.f;
#pragma unroll
            for (int q = 0; q < 8; ++q) { const f32x4 a = pp[q]; t += (a[0] + a[1]) + (a[2] + a[3]); }
            rv[64 * j + lane] = 1.0f / sqrtf(t * (1.0f / 2048.0f) + 1e-6f); }
        if (lane == 0) *idw = want;
        asm volatile("s_waitcnt lgkmcnt(0)" ::: "memory");
    }
    return rv;
}
__device__ __forceinline__ float silu_mul(float g, float u) {
    const float e = __builtin_amdgcn_exp2f(-1.4426950408889634f * g);
    return g * __builtin_amdgcn_rcpf(1.0f + e) * u;
}
struct EpiSwiGLU {
    static constexpr bool PERM = true, AFTER_DRAIN = false, MID = false; static constexpr int ID = 0;
    int slot;
    __device__ __forceinline__ void operator()(const f32x4 (&acc)[2][2][4][2], const Unit& u, int wr, int wc, int fr, int fq) const {
        PG8_GAS unsigned char* w = (PG8_GAS unsigned char*)tab_ptr(22); PG8_GAS bf16_t* O = (PG8_GAS bf16_t*)(w + WS_ACT); constexpr int ldc = FF; const PG8_GAS float* ssq = (const PG8_GAS float*)(w + WS_SSQ) + (size_t)slot * M_REAL * 32;
        const int row0 = u.pm * BM + wr * 64 + fr, col0 = u.pn * HALF + wc * 32 + 8 * fq;
        const PG8_LAS float* rv = ensure_rstd(ssq, slot, u.pm, wr * 4 + wc, wr, fr + 16 * fq);
        float rs[2][4];
#pragma unroll
        for (int ai = 0; ai < 2; ++ai)
#pragma unroll
            for (int m = 0; m < 4; ++m) rs[ai][m] = rv[64 * ai + 16 * m + fr];
#pragma unroll
        for (int ai = 0; ai < 2; ++ai)
#pragma unroll
            for (int m = 0; m < 4; ++m) { PG8_GAS bf16_t* rowp = O + (size_t)(row0 + ai * HALF + m * 16) * ldc + col0;
                const float r = rs[ai][m];
                const f32x4 g0 = acc[ai][0][m][0] * r, g1 = acc[ai][0][m][1] * r, u0 = acc[ai][1][m][0] * r, u1 = acc[ai][1][m][1] * r;
                u32x4 w; w.x = cvt_pk_bf16(silu_mul(g0[0], u0[0]), silu_mul(g0[1], u0[1])); w.y = cvt_pk_bf16(silu_mul(g0[2], u0[2]), silu_mul(g0[3], u0[3]));
                w.z = cvt_pk_bf16(silu_mul(g1[0], u1[0]), silu_mul(g1[1], u1[1])); w.w = cvt_pk_bf16(silu_mul(g1[2], u1[2]), silu_mul(g1[3], u1[3]));
                *(PG8_GAS u32x4*)rowp = w; }
    }
};
struct EpiResAdd {
    static constexpr bool PERM = true, AFTER_DRAIN = false, MID = false; static constexpr int ID = 1;
    float scale; int slot; int fin;
    __device__ __forceinline__ void operator()(const f32x4 (&acc)[2][2][4][2], const Unit& u, int wr, int wc, int fr, int fq) const {
        PG8_GAS unsigned char* w = (PG8_GAS unsigned char*)tab_ptr(22); PG8_GAS bf16_t* hb = (PG8_GAS bf16_t*)(w + WS_HB); PG8_GAS float* out = (PG8_GAS float*)tab_ptr(21);
        PG8_GAS float* ssq = (PG8_GAS float*)(w + WS_SSQ) + (size_t)slot * M_REAL * 32; constexpr int ldc = D;
        const int row0 = u.pm * BM + wr * 64 + fr, col0 = u.pn * BM + wc * 32 + 8 * fq;
        u32x4 bs[2][4][2];
#pragma unroll
        for (int ai = 0; ai < 2; ++ai)
#pragma unroll
            for (int m = 0; m < 4; ++m)
#pragma unroll
                for (int bj = 0; bj < 2; ++bj) bs[ai][m][bj] = *(const PG8_GAS u32x4*)(hb + (size_t)(row0 + ai * HALF + m * 16) * ldc + col0 + bj * HALF);
#pragma unroll
        for (int ai = 0; ai < 2; ++ai)
#pragma unroll
            for (int m = 0; m < 4; ++m) { float ss = 0.f; const size_t off = (size_t)(row0 + ai * HALF + m * 16) * ldc + col0;
#pragma unroll
                for (int bj = 0; bj < 2; ++bj) { const u32x4 b = bs[ai][m][bj]; const unsigned bw[4] = {b.x, b.y, b.z, b.w}; float v[8];
#pragma unroll
                    for (int e = 0; e < 4; ++e) { v[2 * e] = __builtin_bit_cast(float, bw[e] << 16) + scale * acc[ai][bj][m][e >> 1][(2 * e) & 3]; v[2 * e + 1] = __builtin_bit_cast(float, bw[e] & 0xffff0000u) + scale * acc[ai][bj][m][e >> 1][(2 * e + 1) & 3]; }
                    if (fin) { *(PG8_GAS f32x4*)(out + off + bj * HALF) = (f32x4){v[0], v[1], v[2], v[3]}; *(PG8_GAS f32x4*)(out + off + bj * HALF + 4) = (f32x4){v[4], v[5], v[6], v[7]}; }
                    else { u32x4 wv; wv.x = cvt_pk_bf16(v[0], v[1]); wv.y = cvt_pk_bf16(v[2], v[3]); wv.z = cvt_pk_bf16(v[4], v[5]); wv.w = cvt_pk_bf16(v[6], v[7]); *(PG8_GAS u32x4*)(hb + off + bj * HALF) = wv;
                        const unsigned ww[4] = {wv.x, wv.y, wv.z, wv.w};
#pragma unroll
                        for (int e = 0; e < 4; ++e) { const float lo = __builtin_bit_cast(float, ww[e] << 16), hi2 = __builtin_bit_cast(float, ww[e] & 0xffff0000u); ss += lo * lo + hi2 * hi2; } } }
                if (!fin) { ss += shx<16>(ss); ss += shx<32>(ss);
                    if (fq == 0) ssq[(size_t)(row0 + ai * HALF + m * 16) * 32 + u.pn * 4 + wc] = ss; } }
    }
};
__device__ __forceinline__ void ensure_rstd_o(const PG8_GAS float* ssqo, int slot, int pm, int wid, int wr, int lane, const PG8_LAS float*& rs_out, const PG8_LAS float*& ratio_out) {
    extern __shared__ __attribute__((aligned(16))) unsigned char lds_dyn_[];
    volatile PG8_LAS unsigned* idw = (volatile PG8_LAS unsigned*)((PG8_LAS unsigned char*)lds_dyn_ + RSTD_ID_OFF) + wid;
    PG8_LAS float* rv = (PG8_LAS float*)((PG8_LAS unsigned char*)lds_dyn_ + RSTD_OFF) + wid * 128;
    PG8_LAS float* rq = (PG8_LAS float*)((PG8_LAS unsigned char*)lds_dyn_ + RSTD2_OFF) + wid * 128;
    const unsigned want = ((0x4000u | (unsigned)(slot + 1)) << 16) | (unsigned)(pm + 1);
    if ((unsigned)__builtin_amdgcn_readfirstlane(*idw) != want) {
#pragma unroll
        for (int j = 0; j < 2; ++j) { const int row = pm * BM + HALF * j + 64 * wr + lane; const PG8_GAS f32x4* pp = (const PG8_GAS f32x4*)(ssqo + (size_t)row * 32); float tf = 0.f, ts = 0.f;
#pragma unroll
            for (int q = 0; q < 4; ++q) { const f32x4 a = pp[q], b = pp[4 + q]; tf += (a[0] + a[1]) + (a[2] + a[3]); ts += (b[0] + b[1]) + (b[2] + b[3]); }
            const float rf = 1.0f / sqrtf(tf * (1.0f / 1024.0f) + 1e-6f), rs = 1.0f / sqrtf(ts * (1.0f / 1024.0f) + 1e-6f);
            rv[64 * j + lane] = rs; rq[64 * j + lane] = rf / rs; }
        if (lane == 0) *idw = want;
        asm volatile("s_waitcnt lgkmcnt(0)" ::: "memory");
    }
    rs_out = rv; ratio_out = rq;
}
struct EpiOut {
    static constexpr bool PERM = true, AFTER_DRAIN = false, MID = true; static constexpr int ID = 3;
    int slot;
    __device__ __forceinline__ void mid(f32x4 (&acc)[2][2][4][2], const Unit& u, int wr, int wc, int fr, int fq) const {
        PG8_GAS unsigned char* w = (PG8_GAS unsigned char*)tab_ptr(22); const PG8_LAS float *rs, *rq; ensure_rstd_o((const PG8_GAS float*)(w + WS_SSQO), slot, u.pm, wr * 4 + wc, wr, fr + 16 * fq, rs, rq);
#pragma unroll
        for (int ai = 0; ai < 2; ++ai)
#pragma unroll
            for (int m = 0; m < 4; ++m) { const float q = rq[64 * ai + 16 * m + fr];
#pragma unroll
                for (int bj = 0; bj < 2; ++bj)
#pragma unroll
                    for (int n = 0; n < 2; ++n) acc[ai][bj][m][n] = acc[ai][bj][m][n] * q; }
    }
    __device__ __forceinline__ void operator()(const f32x4 (&acc)[2][2][4][2], const Unit& u, int wr, int wc, int fr, int fq) const {
        PG8_GAS unsigned char* w = (PG8_GAS unsigned char*)tab_ptr(22); PG8_GAS bf16_t* hb = (PG8_GAS bf16_t*)(w + WS_HB);
        PG8_GAS float* ssq = (PG8_GAS float*)(w + WS_SSQ) + (size_t)slot * M_REAL * 32; constexpr int ldc = D;
        const PG8_LAS float *rs, *rq; ensure_rstd_o((const PG8_GAS float*)(w + WS_SSQO), slot, u.pm, wr * 4 + wc, wr, fr + 16 * fq, rs, rq);
        const int row0 = u.pm * BM + wr * 64 + fr, col0 = u.pn * BM + wc * 32 + 8 * fq;
        u32x4 bs[2][4][2];
#pragma unroll
        for (int ai = 0; ai < 2; ++ai)
#pragma unroll
            for (int m = 0; m < 4; ++m)
#pragma unroll
                for (int bj = 0; bj < 2; ++bj) bs[ai][m][bj] = *(const PG8_GAS u32x4*)(hb + (size_t)(row0 + ai * HALF + m * 16) * ldc + col0 + bj * HALF);
#pragma unroll
        for (int ai = 0; ai < 2; ++ai)
#pragma unroll
            for (int m = 0; m < 4; ++m) { float ss = 0.f; const size_t off = (size_t)(row0 + ai * HALF + m * 16) * ldc + col0; const float scale = rs[64 * ai + 16 * m + fr];
#pragma unroll
                for (int bj = 0; bj < 2; ++bj) { const u32x4 b = bs[ai][m][bj]; const unsigned bw[4] = {b.x, b.y, b.z, b.w}; float v[8];
#pragma unroll
                    for (int e = 0; e < 4; ++e) { v[2 * e] = __builtin_bit_cast(float, bw[e] << 16) + scale * acc[ai][bj][m][e >> 1][(2 * e) & 3]; v[2 * e + 1] = __builtin_bit_cast(float, bw[e] & 0xffff0000u) + scale * acc[ai][bj][m][e >> 1][(2 * e + 1) & 3]; }
                    u32x4 wv; wv.x = cvt_pk_bf16(v[0], v[1]); wv.y = cvt_pk_bf16(v[2], v[3]); wv.z = cvt_pk_bf16(v[4], v[5]); wv.w = cvt_pk_bf16(v[6], v[7]); *(PG8_GAS u32x4*)(hb + off + bj * HALF) = wv;
                    const unsigned ww[4] = {wv.x, wv.y, wv.z, wv.w};
#pragma unroll
                    for (int e = 0; e < 4; ++e) { const float lo = __builtin_bit_cast(float, ww[e] << 16), hi2 = __builtin_bit_cast(float, ww[e] & 0xffff0000u); ss += lo * lo + hi2 * hi2; } }
                ss += shx<16>(ss); ss += shx<32>(ss);
                if (fq == 0) ssq[(size_t)(row0 + ai * HALF + m * 16) * 32 + u.pn * 4 + wc] = ss; }
    }
};
struct EpiInProj {
    static constexpr bool PERM = true, AFTER_DRAIN = false, MID = false; static constexpr int ID = 2;
    int ll, slot; float qscale;
    __device__ __forceinline__ void operator()(const f32x4 (&acc)[2][2][4][2], const Unit& u, int wr, int wc, int fr, int fq) const {
        PG8_GAS unsigned char* w = (PG8_GAS unsigned char*)tab_ptr(22); const PG8_GAS float* ssq = (const PG8_GAS float*)(w + WS_SSQ) + (size_t)slot * M_REAL * 32;
        PG8_GAS bf16_t *fq_ = (PG8_GAS bf16_t*)(w + WS_FQ), *fk_ = (PG8_GAS bf16_t*)(w + WS_FK), *fv_ = (PG8_GAS bf16_t*)(w + WS_FV), *sq_ = (PG8_GAS bf16_t*)(w + WS_SQ), *sk_ = (PG8_GAS bf16_t*)(w + WS_SK), *sv_ = (PG8_GAS bf16_t*)(w + WS_SV); PG8_GAS float* logf = (PG8_GAS float*)(w + WS_LOGF);
        const PG8_GAS float *g_fq = (const PG8_GAS float*)tab_ptr(9) + ll * HD, *g_fk = (const PG8_GAS float*)tab_ptr(10) + ll * HD, *g_sq = (const PG8_GAS float*)tab_ptr(11) + ll * HD, *g_sk = (const PG8_GAS float*)tab_ptr(12) + ll * HD, *bfg = (const PG8_GAS float*)tab_ptr(8) + ll * NH;
        const int row0 = u.pm * BM + wr * 64 + fr, pn = u.pn;
        if (pn == 17 && wc != 0) return;
        const PG8_LAS float* rv = ensure_rstd(ssq, slot, u.pm, wr * 4 + wc, wr, fr + 16 * fq);
        float rs[2][4];
#pragma unroll
        for (int ai = 0; ai < 2; ++ai)
#pragma unroll
            for (int m = 0; m < 4; ++m) rs[ai][m] = rv[64 * ai + 16 * m + fr];
        if (pn == 17) {
            if (wc != 0) return;
            if (fq < 2) {
                const f32x4 b0 = *(const PG8_GAS f32x4*)(bfg + 8 * fq), b1 = *(const PG8_GAS f32x4*)(bfg + 8 * fq + 4);
#pragma unroll
                for (int ai = 0; ai < 2; ++ai)
#pragma unroll
                    for (int m = 0; m < 4; ++m) { PG8_GAS float* rowp = logf + (size_t)(row0 + ai * HALF + m * 16) * 16 + 8 * fq;
#pragma unroll
                        for (int n = 0; n < 2; ++n) { f32x4 t = acc[ai][0][m][n] * rs[ai][m] + (n ? b1 : b0), o;
#pragma unroll
                            for (int j = 0; j < 4; ++j) o[j] = fminf(t[j], 0.f) - 0.69314718056f * __builtin_amdgcn_logf(1.0f + __builtin_amdgcn_exp2f(-1.4426950408889634f * fabsf(t[j])));
                            *(PG8_GAS f32x4*)(rowp + 4 * n) = o; } }
            }
            return;
        }
        PG8_GAS bf16_t* dst; int pitch, head, knh = 0; const PG8_GAS float* gain = nullptr; float sc = 1.f;
        if (pn < 16) { const int seg = pn >> 2; head = (pn & 3) * 4 + wc; pitch = 1024;
            if (seg == 0) { dst = fq_; gain = g_fq; sc = qscale; } else if (seg == 1) { dst = fk_; gain = g_fk; knh = 16; } else if (seg == 2) { dst = fv_; } else { dst = sq_; gain = g_sq; sc = qscale; } }
        else { pitch = 128; head = wc & 1; if (wc < 2) { dst = sk_; gain = g_sk; knh = 2; } else { dst = sv_; } }
        const int col0 = head * 64 + 8 * fq;
        if (gain) {
            f32x4 gv[2][2];
#pragma unroll
            for (int bj = 0; bj < 2; ++bj)
#pragma unroll
                for (int n = 0; n < 2; ++n) gv[bj][n] = *(const PG8_GAS f32x4*)(gain + 32 * bj + 8 * fq + 4 * n) * sc;
#pragma unroll
            for (int ai = 0; ai < 2; ++ai)
#pragma unroll
                for (int m = 0; m < 4; ++m) {
                    float ss = 0.f;
#pragma unroll
                    for (int bj = 0; bj < 2; ++bj)
#pragma unroll
                        for (int n = 0; n < 2; ++n) { const f32x4 x = acc[ai][bj][m][n]; ss += (x[0] * x[0] + x[1] * x[1]) + (x[2] * x[2] + x[3] * x[3]); }
                    ss += shx<16>(ss); ss += shx<32>(ss);
                    const float rinv = rs[ai][m] / sqrtf(ss * (1.0f / 64.0f) * rs[ai][m] * rs[ai][m] + 1e-6f);
                    const int row = row0 + ai * HALF + m * 16;
                    PG8_GAS bf16_t* rowp = dst + (size_t)row * pitch + col0;
#pragma unroll
                    for (int bj = 0; bj < 2; ++bj) { const f32x4 v0 = acc[ai][bj][m][0] * rinv * gv[bj][0], v1 = acc[ai][bj][m][1] * rinv * gv[bj][1];
                        u32x4 w; w.x = cvt_pk_bf16(v0[0], v0[1]); w.y = cvt_pk_bf16(v0[2], v0[3]); w.z = cvt_pk_bf16(v1[0], v1[1]); w.w = cvt_pk_bf16(v1[2], v1[3]);
                        if (knh) *(PG8_GAS u32x4*)(dst + kfrag_idx(row, knh, head, 32 * bj + 8 * fq)) = w;
                        else *(PG8_GAS u32x4*)(rowp + 32 * bj) = w; }
                }
        } else {
#pragma unroll
            for (int ai = 0; ai < 2; ++ai)
#pragma unroll
                for (int m = 0; m < 4; ++m) { const int row = row0 + ai * HALF + m * 16; const int vnh = (pn < 16) ? 16 : 2;
#pragma unroll
                    for (int bj = 0; bj < 2; ++bj) { const f32x4 v0 = acc[ai][bj][m][0] * rs[ai][m], v1 = acc[ai][bj][m][1] * rs[ai][m];
                        const unsigned wv[4] = {cvt_pk_bf16(v0[0], v0[1]), cvt_pk_bf16(v0[2], v0[3]), cvt_pk_bf16(v1[0], v1[1]), cvt_pk_bf16(v1[2], v1[3])};
                        PG8_GAS bf16_t* vp = dst + vfrag_idx(row, vnh, head, 32 * bj + 8 * fq);
#pragma unroll
                        for (int e = 0; e < 4; ++e) { vp[16 * e] = (bf16_t)(wv[e] & 0xffffu); vp[16 * e + 8] = (bf16_t)(wv[e] >> 16); } } }
        }
    }
};

}

#define XB_TMO      128
#define XB_XCNT(j)  (256  + 64 * (j))
#define XB_XSUB(j)  (1280 + 64 * (j))
#define XB_XGEN(j)  (2304 + 64 * (j))
#define XB_TOP      3328
#define XB_TOPGEN   3392
#define XCD_BAR_WORDS 3456
#define XB_SPIN_CAP (1u << 18)
__device__ __forceinline__ unsigned xb_ld(unsigned* p)              { return __hip_atomic_load(p, __ATOMIC_RELAXED, __HIP_MEMORY_SCOPE_AGENT); }
__device__ __forceinline__ unsigned xb_add(unsigned* p, unsigned v) { return __hip_atomic_fetch_add(p, v, __ATOMIC_RELAXED, __HIP_MEMORY_SCOPE_AGENT); }
__device__ __forceinline__ unsigned xb_xcc_id() { return (unsigned)__builtin_amdgcn_s_getreg((3 << 11) | 20) & 0xFu; }
#define XB_SPIN(cond, bar) do { unsigned _sp = 0; while (cond) { __builtin_amdgcn_s_sleep(1); \
    if ((++_sp & 255u) == 0u) { if (xb_ld(&(bar)[XB_TMO])) break; if (_sp > XB_SPIN_CAP) { atomicAdd(&(bar)[XB_TMO], 1u); break; } } } } while (0)
struct XcdBarrier { unsigned* bar; unsigned x; volatile LAS unsigned* st; };
__device__ __forceinline__ XcdBarrier xcd_barrier_post(unsigned* bar, volatile LAS unsigned* st) {
    XcdBarrier b; b.bar = bar; b.x = xb_xcc_id(); b.st = st;
    if (threadIdx.x == 0) (void)xb_add(&bar[XB_XCNT(b.x)], 1u);
    return b;
}
__device__ __forceinline__ void xcd_barrier_complete(unsigned* bar, unsigned x, unsigned& nloc, unsigned& nx) {
    const unsigned G = gridDim.x * gridDim.y * gridDim.z;
    unsigned sum, cnt, mine, sp = 0u;
    for (;;) {
        sum = 0u; cnt = 0u; mine = 0u;
#pragma unroll
        for (unsigned j = 0; j < 16; ++j) { const unsigned c = xb_ld(&bar[XB_XCNT(j)]); sum += c; cnt += (c > 0u) ? 1u : 0u; mine = (j == x) ? c : mine; }
        if (sum == G) break;
        __builtin_amdgcn_s_sleep(1);
        if ((++sp & 255u) == 0u) { if (xb_ld(&bar[XB_TMO])) break; if (sp > XB_SPIN_CAP) { atomicAdd(&bar[XB_TMO], 1u); break; } }
    }
    nloc = mine > 0u ? mine : 1u; nx = cnt > 0u ? cnt : 1u;
}
__device__ __forceinline__ void xcd_barrier(const XcdBarrier& b) {
    asm volatile("s_waitcnt vmcnt(0)" ::: "memory");
    __syncthreads();
    if (my_tid() == 0) {
        unsigned* bar = b.bar;
        __builtin_amdgcn_s_waitcnt(0);
        unsigned nloc = b.st[0], nx = b.st[1];
        if (nloc == 0u) { xcd_barrier_complete(bar, b.x, nloc, nx); b.st[0] = nloc; b.st[1] = nx; }
        const unsigned old = xb_add(&bar[XB_XSUB(b.x)], 1u);
        const unsigned gen = old / nloc;
        if (old + 1u == (gen + 1u) * nloc) {
            __builtin_amdgcn_fence(__ATOMIC_RELEASE, "agent");
            asm volatile("s_waitcnt vmcnt(0)" ::: "memory");
            const unsigned og = xb_add(&bar[XB_TOP], 1u);
            const unsigned tg = og / nx;
            if (og + 1u == (tg + 1u) * nx) xb_add(&bar[XB_TOPGEN], 1u);
            else XB_SPIN(xb_ld(&bar[XB_TOPGEN]) == tg, bar);
            __builtin_amdgcn_fence(__ATOMIC_ACQUIRE, "agent");
            xb_add(&bar[XB_XGEN(b.x)], 1u);
            asm volatile("s_waitcnt vmcnt(0)" ::: "memory");
        } else {
            XB_SPIN(xb_ld(&bar[XB_XGEN(b.x)]) == gen, bar);
            __builtin_amdgcn_fence(__ATOMIC_ACQUIRE, "agent");
            asm volatile("s_waitcnt vmcnt(0)" ::: "memory");
        }
    }
    __syncthreads();
}

struct Frame {
    LAS unsigned char* lds;
    volatile LAS unsigned* MISC;
    int tid, lane, wave;
    int vcu, G;
    unsigned char* ws;
};
__device__ __forceinline__ int launder_u(int x) { asm volatile("" : "+v"(x)); return __builtin_amdgcn_readfirstlane(x); }
#define LAUNDER_S(x) ((x) = launder_u(x))
__device__ __forceinline__ const float* inptr(const Frame& F, int k) {
    const volatile LAS unsigned* t = (const volatile LAS unsigned*)(F.lds + PTR_OFF);
    const unsigned lo = __builtin_amdgcn_readfirstlane(t[2 * k]), hi = __builtin_amdgcn_readfirstlane(t[2 * k + 1]);
    return (const float*)(((unsigned long long)hi << 32) | lo);
}
__device__ __forceinline__ unsigned char* wsl(const Frame& F) { const unsigned long long p = (unsigned long long)F.ws; const unsigned lo = (unsigned)launder_u((int)(unsigned)p), hi = (unsigned)launder_u((int)(unsigned)(p >> 32)); return (unsigned char*)(((unsigned long long)hi << 32) | lo); }
__device__ __forceinline__ Frame make_frame() {
    extern __shared__ __attribute__((aligned(16))) unsigned char lds_dyn_[];
    Frame F;
    F.lds = (LAS unsigned char*)lds_dyn_;
    F.MISC = (volatile LAS unsigned*)(F.lds + MISC_OFF);
    int t = my_tid(); asm volatile("" : "+v"(t));
    F.tid = t; F.lane = t & 63; F.wave = __builtin_amdgcn_readfirstlane(t >> 6);
    const int g = launder_u((int)gridDim.x), bx = launder_u((int)blockIdx.x);
    F.G = g; F.vcu = (g % 8 == 0) ? (bx % 8) * (g / 8) + bx / 8 : bx;
    F.ws = (unsigned char*)pg8::tab_ptr(22);
    return F;
}
__device__ __forceinline__ float wave_sum(float v) {
    XSUM64(v);
    return v;
}

constexpr int TP_PITCH = 144;
__device__ __forceinline__ void transpose_item64(const float* Wf, int Nsrc, int ca, int nva, int cb, int nvb, int K, bf16* WTf, int drow0, int k0, LAS unsigned char* scr, int lane, const float* gainf = nullptr) {
    const GAS float* W = (const GAS float*)Wf; GAS bf16* WT = (GAS bf16*)WTf;
    const int sub = (lane >> 3) & 1, c4 = 4 * (lane & 7), g = lane >> 4, nl = 32 * sub + c4;
    const bool ok = c4 < (sub ? nvb : nva);
    const GAS float* src = W + (size_t)(k0 + 2 * g) * Nsrc + (sub ? cb : ca) + c4;
    f32x4 v[16];
#pragma unroll
    for (int i = 0; i < 16; ++i) v[i] = ok ? *(const GAS f32x4*)(src + (size_t)(8 * (i >> 1) + (i & 1)) * Nsrc) : (f32x4){0.f, 0.f, 0.f, 0.f};
    if (gainf) { const GAS float* gp = (const GAS float*)gainf + k0 + 2 * g;
#pragma unroll
        for (int i = 0; i < 16; ++i) v[i] = v[i] * gp[8 * (i >> 1) + (i & 1)]; }
#pragma unroll
    for (int m = 0; m < 8; ++m)
#pragma unroll
        for (int j = 0; j < 4; ++j) *(LAS unsigned*)(scr + (nl + j) * TP_PITCH + (8 * m + 2 * g) * 2) = pk2(v[2 * m][j], v[2 * m + 1][j]);
    LDS_WAIT(); asm volatile("" ::: "memory");
#pragma unroll
    for (int t = 0; t < 8; ++t) { const int id = lane + 64 * t, n = id >> 3, c = id & 7;
        const v4u o = *(const LAS v4u*)(scr + n * TP_PITCH + 16 * c);
        *(GAS v4u*)(WT + (size_t)(drow0 + n) * K + k0 + 8 * c) = o; }
    LDS_WAIT(); asm volatile("" ::: "memory");
}
constexpr int IT_GU = (D / 64) * (N_GU / 64), IT_D = (FF / 64) * (D / 64), IT_IN = (D / 64) * (N_IN / 64), IT_OUT = (D / 64) * (D / 64);
constexpr int IT_LAYER = 2 * IT_GU + 2 * IT_D + IT_IN + IT_OUT;
__device__ __forceinline__ void conv_gu(const float* Wg, const float* Wu, bf16* WT, int r, LAS unsigned char* scr, int lane, const float* gain) {
    constexpr int nrg = N_GU / 64; const int kb = r / nrg, rg = r % nrg, p = rg >> 2, q = rg & 3; const int c0 = 128 * p + 64 * (q & 1);
    transpose_item64(q < 2 ? Wg : Wu, FF, c0, 32, c0 + 32, 32, D, WT, 64 * rg, 64 * kb, scr, lane, gain);
}
__device__ __forceinline__ void conv_plain(const float* W, int K, int N, bf16* WT, int r, LAS unsigned char* scr, int lane, const float* gain_lo = nullptr, const float* gain_hi = nullptr) {
    const int nrg = N / 64, kb = r / nrg, rg = r % nrg;
    const float* gain = gain_lo ? (64 * kb < 1024 ? gain_lo : gain_hi - 1024) : nullptr;
    transpose_item64(W, N, 64 * rg, 32, 64 * rg + 32, 32, K, WT, 64 * rg, 64 * kb, scr, lane, gain);
}
__device__ __forceinline__ int in_src_col(int pn, int wc, int bj) {
    if (pn < 16) { const int seg = pn >> 2, base = seg == 0 ? 0 : seg == 1 ? 1024 : seg == 2 ? 2048 : 3088; return base + 256 * (pn & 3) + 64 * wc + 32 * bj; }
    return (wc < 2 ? 4112 + 64 * wc : 4240 + 64 * (wc - 2)) + 32 * bj;
}
__device__ __forceinline__ void conv_in(const float* W, bf16* WT, int r, LAS unsigned char* scr, int lane, const float* gain) {
    constexpr int nrg = N_IN / 64; const int kb = r / nrg, rg = r % nrg, pn = rg >> 2, q = rg & 3, bj = q >> 1, wc0 = 2 * (q & 1);
    int ca, cb, nva = 32, nvb = 32;
    if (pn < 17) { ca = in_src_col(pn, wc0, bj); cb = in_src_col(pn, wc0 + 1, bj); }
    else { ca = 3072; cb = 3072; nva = (q == 0) ? 16 : 0; nvb = 0; }
    transpose_item64(W, IN_W, ca, nva, cb, nvb, D, WT, 64 * rg, 64 * kb, scr, lane, gain);
}
__device__ __forceinline__ void convert_item(Frame& F, unsigned char* w, int l, int r, LAS unsigned char* scr) {
    unsigned char* wl = w + WS_W + (size_t)l * LW_STRIDE;
    if (r < IT_GU) { conv_gu(inptr(F, 3) + (size_t)l * D * FF, inptr(F, 4) + (size_t)l * D * FF, (bf16*)(wl + LW_GU1), r, scr, F.lane, inptr(F, 2) + (size_t)l * D); return; } r -= IT_GU;
    if (r < IT_D) { conv_plain(inptr(F, 5) + (size_t)l * FF * D, FF, D, (bf16*)(wl + LW_D1), r, scr, F.lane); return; } r -= IT_D;
    if (r < IT_IN) { conv_in(inptr(F, 7) + (size_t)l * D * IN_W, (bf16*)(wl + LW_IN), r, scr, F.lane, inptr(F, 6) + (size_t)l * D); return; } r -= IT_IN;
    if (r < IT_OUT) { conv_plain(inptr(F, 16) + (size_t)l * D * D, D, D, (bf16*)(wl + LW_OUT), r, scr, F.lane, inptr(F, 14) + (size_t)l * 1024, inptr(F, 15) + (size_t)l * 1024); return; } r -= IT_OUT;
    if (r < IT_GU) { conv_gu(inptr(F, 18) + (size_t)l * D * FF, inptr(F, 19) + (size_t)l * D * FF, (bf16*)(wl + LW_GU2), r, scr, F.lane, inptr(F, 17) + (size_t)l * D); return; } r -= IT_GU;
    conv_plain(inptr(F, 20) + (size_t)l * FF * D, FF, D, (bf16*)(wl + LW_D2), r, scr, F.lane);
}
#define IDLE_CONV_K 4
constexpr int R_IDLE = IDLE_CONV_K * 128 * NWAVES, GU2_BASE = IT_GU + IT_D + IT_IN + IT_OUT;
static_assert(R_IDLE <= IT_GU, "idle-slot items are SwiGLU-2 items");
__device__ __forceinline__ void convert_layer(Frame& F, unsigned char* w, int l) {
    LAS unsigned char* scr = F.lds + RING_OFF + F.wave * 16384;
    const int gw = F.vcu * NWAVES + F.wave, NGW = F.G * NWAVES;
    if (F.G == 256) { for (int q = gw; q < IT_LAYER - R_IDLE; q += NGW) convert_item(F, w, l, q < GU2_BASE ? q : q + R_IDLE, scr); }
    else for (int r = gw; r < IT_LAYER; r += NGW) convert_item(F, w, l, r, scr);
}
__device__ __forceinline__ void p0_prologue(Frame& F) {
    const int gw = F.vcu * NWAVES + F.wave, NGW = F.G * NWAVES;
    unsigned char* w = wsl(F);
    for (int l = 0; l < (OVERLAP_CONV ? 1 : DEPTH); ++l) convert_layer(F, w, l);
    const GAS float* x = (const GAS float*)inptr(F, 0); const GAS float* meta = (const GAS float*)inptr(F, 1);
    GAS bf16* HB = (GAS bf16*)(w + WS_HB); GAS float* SSQ0 = (GAS float*)(w + WS_SSQ); GAS float* SSQM0 = (GAS float*)(w + WS_SSQM);
    for (int m = gw; m < M_REAL + NMETA; m += NGW) {
        const int row = m < M_REAL ? m : META_ROW + (m - M_REAL);
        GAS unsigned long long* hb8 = (GAS unsigned long long*)(HB + (size_t)row * D) + F.lane;
        const GAS f32x4* xr = (const GAS f32x4*)(m < M_REAL ? x + (size_t)m * D : meta + (size_t)(m - M_REAL) * D) + F.lane;
        float ss = 0.f;
#pragma unroll
        for (int j = 0; j < 8; ++j) { const f32x4 v = xr[64 * j]; const unsigned w0 = pk2(v.x, v.y), w1 = pk2(v.z, v.w); hb8[64 * j] = (unsigned long long)w0 | ((unsigned long long)w1 << 32);
            const float a0 = __builtin_bit_cast(float, w0 << 16), a1 = __builtin_bit_cast(float, w0 & 0xffff0000u), a2 = __builtin_bit_cast(float, w1 << 16), a3 = __builtin_bit_cast(float, w1 & 0xffff0000u);
            ss += (a0 * a0 + a1 * a1) + (a2 * a2 + a3 * a3); }
        ss = wave_sum(ss);
        if (m < M_REAL) { if (F.lane < 32) SSQ0[(size_t)m * 32 + F.lane] = F.lane == 0 ? ss : 0.f; }
        else { SSQM0[(m - M_REAL) * 128 + F.lane] = F.lane == 0 ? ss : 0.f; SSQM0[(m - M_REAL) * 128 + 64 + F.lane] = 0.f; }
    }
    if (gw < 48) { const int row = META_BLK0 + 64 + gw; const v4u z = (v4u){0u, 0u, 0u, 0u};
#pragma unroll
        for (int j = 0; j < 2; ++j) { ((GAS v4u*)(w + WS_FQ + (size_t)row * 2048))[F.lane + 64 * j] = z;
            ((GAS v4u*)(w + WS_SQ + (size_t)row * 2048))[F.lane + 64 * j] = z; } }
    {
        const v4u z = (v4u){0u, 0u, 0u, 0u}; constexpr int RB = (META_BLK0 + 64) >> 5;
        GAS v4u* fk = (GAS v4u*)((GAS bf16*)(w + WS_FK) + (size_t)RB * 16 * 2048); GAS v4u* sk = (GAS v4u*)((GAS bf16*)(w + WS_SK) + (size_t)RB * 2 * 2048);
        for (int i = gw * 64 + F.lane; i < 2 * 16 * 256; i += NGW * 64) fk[i] = z;
        for (int i = gw * 64 + F.lane; i < 2 * 2 * 256; i += NGW * 64) sk[i] = z;
        constexpr int G16 = (META_BLK0 + 64) >> 4;
        GAS v4u* fv = (GAS v4u*)((GAS bf16*)(w + WS_FV) + (size_t)G16 * 16 * 1024); GAS v4u* sv = (GAS v4u*)((GAS bf16*)(w + WS_SV) + (size_t)G16 * 2 * 1024);
        for (int i = gw * 64 + F.lane; i < 4 * 16 * 128; i += NGW * 64) fv[i] = z;
        for (int i = gw * 64 + F.lane; i < 4 * 2 * 128; i += NGW * 64) sv[i] = z; }
}
__device__ __forceinline__ void onorm_phase(Frame& F, const float* gf, const float* gs) {
    const int gw = F.vcu * NWAVES + F.wave, NGW = F.G * NWAVES;
    unsigned char* w = wsl(F); const GAS bf16* O = (const GAS bf16*)(w + WS_O); GAS bf16* XN = (GAS bf16*)(w + WS_XN);
    for (int mm = gw; mm < M_REAL + NMETA; mm += NGW) {
        const int m = mm < M_REAL ? mm : META_ROW + (mm - M_REAL);
        const GAS v4u* orow = (const GAS v4u*)(O + (size_t)m * D) + F.lane;
        GAS v4u* xrow = (GAS v4u*)(XN + (size_t)m * D) + F.lane;
        float x[4][8]; float sf = 0.f, ss = 0.f;
#pragma unroll
        for (int j = 0; j < 4; ++j) { const v4u w = orow[64 * j]; const unsigned ww[4] = {w.x, w.y, w.z, w.w};
#pragma unroll
            for (int e = 0; e < 4; ++e) { x[j][2 * e] = __builtin_bit_cast(float, ww[e] << 16); x[j][2 * e + 1] = __builtin_bit_cast(float, ww[e] & 0xffff0000u); }
            float q = 0.f;
#pragma unroll
            for (int e = 0; e < 8; ++e) q += x[j][e] * x[j][e];
            if (j < 2) sf += q; else ss += q; }
        const float rf = 1.0f / sqrtf(wave_sum(sf) * (1.0f / 1024.f) + EPS), rs = 1.0f / sqrtf(wave_sum(ss) * (1.0f / 1024.f) + EPS);
#pragma unroll
        for (int j = 0; j < 4; ++j) { const float* gp = (j < 2 ? gf : gs) + (j & 1) * 512 + 8 * F.lane; const f32x4 g0 = *(const GAS f32x4*)gp, g1 = *(const GAS f32x4*)(gp + 4); const float r = j < 2 ? rf : rs;
            v4u w; w.x = pk2(x[j][0] * r * g0.x, x[j][1] * r * g0.y); w.y = pk2(x[j][2] * r * g0.z, x[j][3] * r * g0.w); w.z = pk2(x[j][4] * r * g1.x, x[j][5] * r * g1.y); w.w = pk2(x[j][6] * r * g1.z, x[j][7] * r * g1.w);
            xrow[64 * j] = w; }
    }
}

constexpr int SK_RED_OFF = 0, SK_TILE_OFF = 65536, SK_RSTD_OFF = SK_TILE_OFF + 4096;
template <class Epi, int NST  >
__device__ __forceinline__ void skinny_phase(Frame& F, const GAS bf16* A, int lda, const GAS bf16* Bt, int K, const Epi& E) {
    constexpr int TC = Epi::TC;
    int lane = F.lane; asm volatile("" : "+v"(lane));
    const int w = F.wave;
    LAS float* red = (LAS float*)(F.lds + RING_OFF + SK_RED_OFF);
    LAS float* tile = (LAS float*)(F.lds + RING_OFF + SK_TILE_OFF);
    const int k0 = w * (NST * 32);
    bool first = true;
    for (int task = F.G - 1 - (int)blockIdx.x; task < E.ntasks(); task += F.G) {
        pg8::f32x4 acc[TC];
        const GAS bf16* bp[TC];
#pragma unroll
        for (int c = 0; c < TC; ++c) { acc[c] = (pg8::f32x4){0.f, 0.f, 0.f, 0.f}; bp[c] = Bt + (size_t)(E.btrow(task, c) + (lane & 15)) * K + k0 + 8 * (lane >> 4); }
        const GAS bf16* ap = A + (size_t)(lane & 15) * lda + k0 + 8 * (lane >> 4);
        bf16x8 av[NST], bv[TC][NST];
#pragma unroll
        for (int j = 0; j < NST; ++j) { av[j] = *(const GAS bf16x8*)(ap + 32 * j);
#pragma unroll
            for (int c = 0; c < TC; ++c) bv[c][j] = *(const GAS bf16x8*)(bp[c] + 32 * j); }
        if (first) {
            if constexpr (Epi::KHALF_SCALE) {
                LAS float* rv = (LAS float*)(F.lds + RING_OFF + SK_RSTD_OFF);
#pragma unroll
                for (int j = 0; j < 2; ++j) { const int row = 2 * w + j; float t = lane < 32 ? E.ssqom[row * 32 + lane] : 0.f;
                    XSUM16(t);
                    if (lane == 0) rv[row] = 1.0f / sqrtf(t * (1.0f / 1024.0f) + EPS); if (lane == 16) rv[16 + row] = 1.0f / sqrtf(t * (1.0f / 1024.0f) + EPS); }
            }
            if constexpr (Epi::NEED_RSTD) {
                LAS float* rv = (LAS float*)(F.lds + RING_OFF + SK_RSTD_OFF);
#pragma unroll
                for (int j = 0; j < 2; ++j) { const int row = 2 * w + j; const float t = wave_sum(E.ssqm[row * 128 + lane] + E.ssqm[row * 128 + 64 + lane]); if (lane == 0) rv[row] = 1.0f / sqrtf(t * (1.0f / D) + EPS); }
            }
            first = false;
        }
#pragma unroll
        for (int j = 0; j < NST; ++j)
#pragma unroll
            for (int c = 0; c < TC; ++c) acc[c] = __builtin_amdgcn_mfma_f32_16x16x32_bf16(av[j], bv[c][j], acc[c], 0, 0, 0);
#pragma unroll
        for (int c = 0; c < TC; ++c)
#pragma unroll
            for (int r = 0; r < 4; ++r) red[((w * TC + c) * 4 + r) * 64 + lane] = acc[c][r];
        __syncthreads();
        for (int e = F.tid; e < TC * 256; e += NWAVES * 64) { float sum = 0.f, sum2 = 0.f;
#pragma unroll
            for (int w2 = 0; w2 < 4; ++w2) { sum += red[w2 * TC * 256 + e]; sum2 += red[(w2 + 4) * TC * 256 + e]; }
            const int ln = e & 63, r = (e >> 6) & 3, c = e >> 8, orow = (ln >> 4) * 4 + r;
            if constexpr (Epi::KHALF_SCALE) { const LAS float* rv = (const LAS float*)(F.lds + RING_OFF + SK_RSTD_OFF); sum = sum * rv[orow] + sum2 * rv[16 + orow]; } else sum += sum2;
            tile[orow * 64 + 16 * c + (ln & 15)] = sum; }
        __syncthreads();
        E.store(F, task, tile);
        if (task + F.G < E.ntasks()) __syncthreads();
    }
}
struct SkGU {
    static constexpr int TC = 4; static constexpr bool NEED_RSTD = true, KHALF_SCALE = false;
    GAS bf16* act; const GAS float* ssqm;
    __device__ __forceinline__ int ntasks() const { return FF / 32; }
    __device__ __forceinline__ int btrow(int t, int c) const { const int p = t >> 2, q = t & 3; return 256 * p + 128 * (c >> 1) + 32 * q + 16 * (c & 1); }
    __device__ __forceinline__ void store(Frame& F, int t, const LAS float* tile) const {
        const int row = F.tid >> 5, col = F.tid & 31; const float r = ((const LAS float*)(F.lds + RING_OFF + SK_RSTD_OFF))[row];
        act[(size_t)(META_ROW + row) * FF + 32 * t + col] = (bf16)f2bf(pg8::silu_mul(tile[row * 64 + col] * r, tile[row * 64 + 32 + col] * r));
    }
};
struct SkRes {
    static constexpr int TC = 1; static constexpr bool NEED_RSTD = false, KHALF_SCALE = false;
    float scale; GAS bf16* hb; GAS float* ssqm;
    __device__ __forceinline__ int ntasks() const { return D / 16; }
    __device__ __forceinline__ int btrow(int t, int) const { return 16 * t; }
    __device__ __forceinline__ void store(Frame& F, int t, const LAS float* tile) const {
        if (F.tid < 256) { const int row = F.tid >> 4, col = F.tid & 15; const size_t off = (size_t)(META_ROW + row) * D + 16 * t + col;
            const unsigned hbits = f2bf(bf2f(hb[off]) + scale * tile[row * 64 + col]); hb[off] = (bf16)hbits; const float v = bf2f((bf16)hbits); float ss = v * v;
            XSUM16(ss);
            if (col == 0) ssqm[row * 128 + t] = ss; }
    }
};
struct SkOut {
    static constexpr int TC = 1; static constexpr bool NEED_RSTD = false, KHALF_SCALE = true;
    float scale; GAS bf16* hb; GAS float* ssqm; const GAS float* ssqom;
    __device__ __forceinline__ int ntasks() const { return D / 16; }
    __device__ __forceinline__ int btrow(int t, int) const { return 16 * t; }
    __device__ __forceinline__ void store(Frame& F, int t, const LAS float* tile) const {
        if (F.tid < 256) { const int row = F.tid >> 4, col = F.tid & 15; const size_t off = (size_t)(META_ROW + row) * D + 16 * t + col;
            const unsigned hbits = f2bf(bf2f(hb[off]) + scale * tile[row * 64 + col]); hb[off] = (bf16)hbits; const float v = bf2f((bf16)hbits); float ss = v * v;
            XSUM16(ss);
            if (col == 0) ssqm[row * 128 + t] = ss; }
    }
};
struct SkIn {
    static constexpr int TC = 4; static constexpr bool NEED_RSTD = true, KHALF_SCALE = false;
    GAS bf16 *fq_, *fk_, *fv_, *sq_, *sk_, *sv_; GAS float* logf; const GAS float *g_fq, *g_fk, *g_sq, *g_sk, *bfg; float qscale; const GAS float* ssqm;
    __device__ __forceinline__ int ntasks() const { return 69; }
    __device__ __forceinline__ int btrow(int t, int c) const { if (t == 68) return 17 * 256 + 16 * c; const int pn = t < 64 ? (t >> 2) : 16, wc = t < 64 ? (t & 3) : (t - 64); return 256 * pn + 128 * (c >> 1) + 32 * wc + 16 * (c & 1); }
    __device__ __forceinline__ void store(Frame& F, int t, const LAS float* tile) const {
        if (t == 68) { if (F.tid < 256) { const int row = F.tid >> 4, hh = F.tid & 15; const float z = tile[row * 64 + hh] * ((const LAS float*)(F.lds + RING_OFF + SK_RSTD_OFF))[row] + bfg[hh];
                logf[(size_t)(META_ROW + row) * 16 + hh] = fminf(z, 0.f) - 0.69314718056f * __builtin_amdgcn_logf(1.0f + __builtin_amdgcn_exp2f(-LOG2E * fabsf(z))); } return; }
        const int pn = t < 64 ? (t >> 2) : 16, wc = t < 64 ? (t & 3) : (t - 64);
        GAS bf16* dst; int pitch, head, knh = 0; const GAS float* gain = nullptr; float sc = 1.f;
        if (pn < 16) { const int seg = pn >> 2; head = (pn & 3) * 4 + wc; pitch = 1024;
            if (seg == 0) { dst = fq_; gain = g_fq; sc = qscale; } else if (seg == 1) { dst = fk_; gain = g_fk; knh = 16; } else if (seg == 2) { dst = fv_; } else { dst = sq_; gain = g_sq; sc = qscale; } }
        else { pitch = 128; head = wc & 1; if (wc < 2) { dst = sk_; gain = g_sk; knh = 2; } else { dst = sv_; } }
        const int row = F.tid >> 5, cp = F.tid & 31; const float rr = ((const LAS float*)(F.lds + RING_OFF + SK_RSTD_OFF))[row];
        float v0 = tile[row * 64 + 2 * cp] * rr, v1 = tile[row * 64 + 2 * cp + 1] * rr;
        if (gain) { float ss = v0 * v0 + v1 * v1;
            XSUM32(ss);
            const float rinv = 1.0f / sqrtf(ss * (1.0f / 64.0f) + EPS); v0 = v0 * rinv * gain[2 * cp] * sc; v1 = v1 * rinv * gain[2 * cp + 1] * sc; }
        if (knh) *(GAS unsigned*)(dst + kfrag_idx(META_ROW + row, knh, head, 2 * cp)) = pk2(v0, v1);
        else if (!gain) { GAS bf16* vp = dst + vfrag_idx(META_ROW + row, pn < 16 ? 16 : 2, head, 2 * cp); const unsigned pw = pk2(v0, v1); vp[0] = (bf16)(pw & 0xffffu); vp[8] = (bf16)(pw >> 16); }
        else *(GAS unsigned*)(dst + (size_t)(META_ROW + row) * pitch + head * 64 + 2 * cp) = pk2(v0, v1);
    }
};

__device__ __forceinline__ void split3(float x, unsigned& h, unsigned& m, unsigned& l) { h = f2bf(x); const float r = x - bf2f((unsigned short)h); m = f2bf(r); const float r2 = r - bf2f((unsigned short)m); l = f2bf(r2); }
__device__ __forceinline__ int crow(int r, int hi) { return (r & 3) + 8 * (r >> 2) + 4 * hi; }
typedef short v4i16_t __attribute__((ext_vector_type(4)));
__device__ __forceinline__ float max3f(float a, float b, float c) { return fmaxf(fmaxf(a, b), c); }
constexpr float ATT_THR = 40.0f;
constexpr int ATT_KV_OFF = 36864;
template <int MODE  >
__device__ __forceinline__ void attn_group(Frame& F, unsigned char* w, int gb, int kvh, int c_lo, int c_hi, bool active, int b  , int h, int i, const float* sinks) {
    const int lane = F.lane, r32 = lane & 31, hi = lane >> 5, wv = F.wave;
    const bool meta = b < 0;
    const int qpos0 = meta ? 96 : 128 + 32 * i;
    const int qrow0 = meta ? META_BLK0 + 96 : b * SEQ + 32 * i;
    const int cd = qpos0 >> 6;
    const int cfirst = (MODE == 0) ? (meta ? 1 : __builtin_amdgcn_readfirstlane(((const volatile LAS int*)(F.lds + RING_OFF + ATT_FC_OFF))[i])) : ((qpos0 - 127) < 128 ? 1 : ((qpos0 - 127) >> 6));
    constexpr int NHK = (MODE == 0) ? 16 : 2;
    const GAS bf16* Qp = (const GAS bf16*)(w + (MODE == 0 ? WS_FQ : WS_SQ)) + (size_t)qrow0 * 1024 + h * 64;
    const GAS bf16* kdma = (const GAS bf16*)(w + (MODE == 0 ? WS_FK : WS_SK)) + ((size_t)(wv >> 2) * NHK + kvh) * 2048 + (wv & 3) * 512 + lane * 8;
    const GAS bf16* vdma = (const GAS bf16*)(w + (MODE == 0 ? WS_FV : WS_SV)) + ((size_t)(wv >> 1) * NHK + kvh) * 1024 + (wv & 1) * 512 + lane * 8;
    LAS unsigned char* kvb = F.lds + RING_OFF + ATT_KV_OFF;
    const float sl2 = (MODE == 1) ? exp2f(-0.5f * (float)(h + 1)) * LOG2E : 0.f;
    const LAS unsigned char* tfp = F.lds + RING_OFF + (hi ? ATT_ZERO_OFF : ATT_TABF_OFF + r32 * 16); const int toff = hi ? 0 : 1;
    v4u mfr = hi ? (v4u){0u, 0u, 0u, 0u} : (v4u){0x3F803F80u, 0x3F80u, 0u, 0u};
    bf16x8 qf[4];
    if (active) {
#pragma unroll
        for (int s = 0; s < 4; ++s) qf[s] = *(const GAS bf16x8*)(Qp + (size_t)r32 * 1024 + 16 * s + 8 * hi);
    } else {
#pragma unroll
        for (int s = 0; s < 4; ++s) qf[s] = (bf16x8){0, 0, 0, 0, 0, 0, 0, 0};
    }
#define CHUNK_ROW(c) ((c) == 1 ? META_BLK0 + 64 : gb * SEQ + 64 * ((c) - 2))
#define KV_DMA(c_) do { const int rowk_ = CHUNK_ROW(c_); LAS unsigned char* d_ = kvb + ((c_) & 1) * 16384 + wv * 1024; \
        __builtin_amdgcn_global_load_lds((const unsigned*)(kdma + (size_t)(rowk_ >> 5) * (NHK * 2048)), (LAS unsigned*)d_, 16, 0, 0); \
        __builtin_amdgcn_global_load_lds((const unsigned*)(vdma + (size_t)(rowk_ >> 4) * (NHK * 1024)), (LAS unsigned*)(d_ + 8192), 16, 0, 0); } while (0)
    float m_run = 0.f, l_run = 0.f; f32x16 o0 = {}, o1 = {};
    const float NEG = -1e30f;
    __syncthreads();
    KV_DMA(c_lo);
    for (int c = c_lo; c <= c_hi; ++c) {
        asm volatile("s_waitcnt vmcnt(0) lgkmcnt(0)" ::: "memory"); __builtin_amdgcn_s_barrier(); __builtin_amdgcn_sched_barrier(0);
        if (c < c_hi) KV_DMA(c + 1);
        if (!(active && c >= cfirst && c <= cd)) continue;
        const LAS unsigned char* cb = kvb + (c & 1) * 16384 + hi * 512 + r32 * 16;
        bf16x8 kf[2][4];
#pragma unroll
        for (int t = 0; t < 2; ++t)
#pragma unroll
            for (int s = 0; s < 4; ++s) kf[t][s] = *(const LAS bf16x8*)(cb + t * 4096 + s * 1024);
        f32x16 p0 = {}, p1 = {};
        bf16x8 ab0, ab1;
        if (MODE == 0) { ab0 = *(const LAS bf16x8*)(tfp + toff * (1024 * c)); ab1 = *(const LAS bf16x8*)(tfp + toff * (1024 * c + 512)); }
        __builtin_amdgcn_s_setprio(1);
#pragma unroll
        for (int s = 0; s < 4; ++s) { p0 = __builtin_amdgcn_mfma_f32_32x32x16_bf16(kf[0][s], qf[s], p0, 0, 0, 0); p1 = __builtin_amdgcn_mfma_f32_32x32x16_bf16(kf[1][s], qf[s], p1, 0, 0, 0); }
        if (MODE == 0) { const bf16x8 mb = __builtin_bit_cast(bf16x8, mfr); p0 = __builtin_amdgcn_mfma_f32_32x32x16_bf16(ab0, mb, p0, 0, 0, 0); p1 = __builtin_amdgcn_mfma_f32_32x32x16_bf16(ab1, mb, p1, 0, 0, 0); }
        __builtin_amdgcn_s_setprio(0);
        bf16x8 vf[4][2];
#pragma unroll
        for (int g = 0; g < 4; ++g)
#pragma unroll
            for (int d = 0; d < 2; ++d) vf[g][d] = *(const LAS bf16x8*)(cb + 8192 + g * 2048 + hi * 512 + d * 512);
        if (MODE == 0) {
            if (c == cd) { const int dq = qpos0 + r32 - 64 * c - 4 * hi;
#pragma unroll
                for (int r = 0; r < 16; ++r) { const int e = (r & 3) + 8 * (r >> 2); if (e > dq) p0[r] = NEG; if (e + 32 > dq) p1[r] = NEG; } }
        } else {
            const float kb0 = (float)(64 * c - qpos0 + 4 * hi) - m_run / sl2;
#pragma unroll
            for (int r = 0; r < 16; ++r) { const float e = (float)((r & 3) + 8 * (r >> 2)); p0[r] = fmaf(sl2, kb0 + e, p0[r]); p1[r] = fmaf(sl2, kb0 + 32.f + e, p1[r]); }
            const int dq = qpos0 + r32 - 64 * c - 4 * hi;
            const int padlim = (c == 1) ? 48 - 4 * hi : -1;
            const bool interior = c != 1 && 64 * c + 63 <= qpos0 && 64 * c > qpos0 + 31 - 128;
            if (!interior) {
#pragma unroll
            for (int r = 0; r < 16; ++r) { const int e = (r & 3) + 8 * (r >> 2);
                if ((unsigned)(dq - e) >= 128u || e < padlim) p0[r] = NEG;
                if ((unsigned)(dq - e - 32) >= 128u || e + 32 < padlim) p1[r] = NEG; } }
        }
        float mx = max3f(p0[0], p0[1], p1[0]);
#pragma unroll
        for (int r = 2; r < 16; r += 2) mx = max3f(mx, p0[r], p0[r + 1]);
#pragma unroll
        for (int r = 1; r < 16; r += 2) mx = max3f(mx, p1[r], (r + 1 < 16) ? p1[r + 1] : p1[r]);
        const bool first = (c == cfirst);
        if (first || __any(mx > ATT_THR)) {
            mx = fmaxf(mx, shx<32>(mx));
            const float dl = first ? fmaxf(mx, -200.f) : fmaxf(mx, 0.f);
            m_run += dl;
            if (MODE == 0) { unsigned h_, m_, l_; split3(-m_run, h_, m_, l_); if (!hi) { mfr.y = 0x3F80u | (h_ << 16); mfr.z = m_ | (l_ << 16); } }
            const float alpha = first ? 0.f : __builtin_amdgcn_exp2f(-dl);
            l_run *= alpha;
#pragma unroll
            for (int r = 0; r < 16; ++r) { p0[r] -= dl; p1[r] -= dl; }
            if (!first) {
#pragma unroll
                for (int r = 0; r < 16; ++r) { o0[r] *= alpha; o1[r] *= alpha; } }
        }
        float rs = 0.f;
#pragma unroll
        for (int r = 0; r < 16; ++r) { p0[r] = __builtin_amdgcn_exp2f(p0[r]); p1[r] = __builtin_amdgcn_exp2f(p1[r]); rs += p0[r] + p1[r]; }
        l_run += rs;
#pragma unroll
        for (int t = 0; t < 2; ++t)
#pragma unroll
            for (int s = 0; s < 2; ++s) {
                const f32x16& pp = t ? p1 : p0;
                v4u wq; wq.x = pg8::cvt_pk_bf16(pp[8 * s + 0], pp[8 * s + 1]); wq.y = pg8::cvt_pk_bf16(pp[8 * s + 2], pp[8 * s + 3]); wq.z = pg8::cvt_pk_bf16(pp[8 * s + 4], pp[8 * s + 5]); wq.w = pg8::cvt_pk_bf16(pp[8 * s + 6], pp[8 * s + 7]);
                const bf16x8 pf = __builtin_bit_cast(bf16x8, wq);
                const bf16x8 v0 = vf[2 * t + s][0], v1 = vf[2 * t + s][1];
                o0 = __builtin_amdgcn_mfma_f32_32x32x16_bf16(v0, pf, o0, 0, 0, 0);
                o1 = __builtin_amdgcn_mfma_f32_32x32x16_bf16(v1, pf, o1, 0, 0, 0);
            }
    }
#undef CHUNK_ROW
#undef KV_DMA
    if (!active) return;
    l_run += shx<32>(l_run);
    if (MODE == 1) l_run += __builtin_amdgcn_exp2f(sinks[h] * LOG2E + sl2 * (float)r32 - m_run);
    float inv = 1.0f / l_run;
    const int qrow0e = launder_u(qrow0), he = launder_u(h);
    int lane_e = lane; asm volatile("" : "+v"(lane_e)); const int r32e = lane_e & 31, hie = lane_e >> 5;
    if (meta && r32e < 16) inv = 0.f;
    GAS bf16* Op = (GAS bf16*)(w + WS_O) + (size_t)(qrow0e + r32e) * D + (MODE == 0 ? 0 : 1024) + he * 64 + 4 * hie;
    GAS float* sqo = meta ? (GAS float*)(w + WS_SSQOM) + (MODE == 0 ? 0 : 16) + he : (GAS float*)(w + WS_SSQO) + (size_t)qrow0e * 32 + (MODE == 0 ? 0 : 16) + he;
    float ss = 0.f;
#pragma unroll
    for (int g = 0; g < 4; ++g) {
        unsigned a[4], c[4];
#pragma unroll
        for (int j = 0; j < 4; ++j) { a[j] = f2bf(o0[4 * g + j] * inv); c[j] = f2bf(o1[4 * g + j] * inv);
            const float v0 = bf2f((bf16)a[j]), v1 = bf2f((bf16)c[j]); ss += v0 * v0 + v1 * v1; }
        *(GAS unsigned long long*)(Op + 8 * g) = (unsigned long long)(a[0] | (a[1] << 16)) | ((unsigned long long)(a[2] | (a[3] << 16)) << 32);
        *(GAS unsigned long long*)(Op + 32 + 8 * g) = (unsigned long long)(c[0] | (c[1] << 16)) | ((unsigned long long)(c[2] | (c[3] << 16)) << 32);
    }
    ss += shx<32>(ss);
    if (hie == 0) { if (!meta) sqo[(size_t)r32e * 32] = ss; else if (r32e >= 16) sqo[(size_t)(r32e - 16) * 32] = ss; }
}
__device__ __forceinline__ void probe_t0(LAS unsigned char* lds) { if (PROBE_CLASS > 50 && (PROBE_BLOCK < 0 || (int)blockIdx.x == PROBE_BLOCK) && my_tid() == 0) *(volatile LAS unsigned long long*)(lds + MISC_OFF + 72) = __builtin_amdgcn_s_memrealtime(); }
__device__ __forceinline__ void probe_t1(LAS unsigned char* lds, int c) { if (PROBE_CLASS == c && (PROBE_BLOCK < 0 || (int)blockIdx.x == PROBE_BLOCK) && my_tid() == 0) { volatile LAS unsigned long long* pa_ = (volatile LAS unsigned long long*)(lds + MISC_OFF + 64); *pa_ = *pa_ + (__builtin_amdgcn_s_memrealtime() - *(volatile LAS unsigned long long*)(lds + MISC_OFF + 72)); } }
__device__ __forceinline__ void attn_phase(Frame& F, const float* sinks, int next_layer  , const float* gq, const float* gk) {
    probe_t0(F.lds);
    unsigned char* w = wsl(F); const GAS float* LOGF = (const GAS float*)(w + WS_LOGF);
    const int bh = F.vcu >> 1, fb = bh >> 4, fh = bh & 15;
    LAS float* tab = (LAS float*)(F.lds + RING_OFF + ATT_TAB_OFF);
    LAS float* wtot = (LAS float*)(F.lds + RING_OFF + ATT_WTOT_OFF);
    { float v[5]; float tsum = 0.f; const int p0 = 5 * F.tid;
#pragma unroll
      for (int j = 0; j < 5; ++j) { const int p = p0 + j; float x = 0.f;
          if (p >= PADN && p < LPOS) { const int row = p < 128 ? META_BLK0 + p : fb * SEQ + p - 128; x = LOGF[(size_t)row * 16 + fh]; }
          tsum += x; v[j] = tsum; }
      float inc = tsum;
#pragma unroll
      for (int o = 1; o < 64; o <<= 1) { const float t = shi(inc, F.lane - o); if (F.lane >= o) inc += t; }
      if (F.lane == 63) wtot[F.wave] = inc;
      __syncthreads();
      float base = inc - tsum;
      for (int w = 0; w < F.wave; ++w) base += wtot[w];
#pragma unroll
      for (int j = 0; j < 5; ++j) { const int p = p0 + j; if (p < LPOS) { const float cv = (p < PADN) ? 1e30f : (base + v[j]) * LOG2E; tab[p] = cv;
          unsigned h_, m_, l_; split3(fmaxf(-cv, -60000.f), h_, m_, l_);
          LAS unsigned* tf = (LAS unsigned*)(F.lds + RING_OFF + ATT_TABF_OFF + p * 16); unsigned one2 = 0x3F803F80u, zz = 0u; asm volatile("" : "+v"(one2), "+v"(zz));
          tf[0] = h_ | (m_ << 16); tf[1] = l_ | (one2 << 16); tf[2] = one2; tf[3] = zz; } }
      if (F.tid < 4) ((LAS unsigned*)(F.lds + RING_OFF + ATT_ZERO_OFF))[F.tid] = 0u;
      __syncthreads();
      if (F.wave == 0) { float mq = fabsf(((const GAS float*)gq)[F.lane]), mk = fabsf(((const GAS float*)gk)[F.lane]);
#define XMAX_(v, O) v = fmaxf(v, shx<O>(v))
          XMAX_(mq, 1); XMAX_(mq, 2); XMAX_(mq, 4); XMAX_(mq, 8); XMAX_(mq, 16); XMAX_(mq, 32); XMAX_(mk, 1); XMAX_(mk, 2); XMAX_(mk, 4); XMAX_(mk, 8); XMAX_(mk, 16); XMAX_(mk, 32);
#undef XMAX_
          const float thr = -(152.0f + 2.0f * (64.0f * QSCALE * mq * mk * 1.02f + 1.0f));
          const int q0pos = 128 + 32 * F.lane, cdl = q0pos >> 6; const float tq = tab[q0pos]; int c = 1;
          while (c < cdl && tq - tab[64 * c + 63] < thr) ++c;
          ((LAS int*)(F.lds + RING_OFF + ATT_FC_OFF))[F.lane] = c; }
      __syncthreads(); }
    probe_t1(F.lds, 51); probe_t0(F.lds);
    {
      const int odd = F.vcu & 1;
      for (int k = 0; k < 4; ++k) { const int g = (k == 0) ? odd : (k == 1) ? 3 - odd : (k == 2) ? 4 + odd : 7 - odd;
          int cf = 1 << 20;
#pragma unroll
          for (int j = 0; j < 8; ++j) cf = min(cf, ((const volatile LAS int*)(F.lds + RING_OFF + ATT_FC_OFF))[8 * g + j]);
          cf = __builtin_amdgcn_readfirstlane(cf);
          attn_group<0>(F, w, fb, fh, cf, (128 + 32 * (8 * g + 7)) >> 6, true, fb, fh, 8 * g + F.wave, sinks); }
      probe_t1(F.lds, 52); probe_t0(F.lds);
      if (F.vcu < 32 && odd == 0) attn_group<0>(F, w, 0, fh, 1, 1, F.wave == 0, -1, fh, 0, sinks); }
    probe_t1(F.lds, 54); probe_t0(F.lds);
    {
      for (int k = 0; k < 4; ++k) { const int T = F.vcu * 4 + k, sb = T >> 7, kvh = (T >> 6) & 1, i = T & 63; const int qp = 128 + 32 * i;
          attn_group<1>(F, w, sb, kvh, (qp - 127) < 128 ? 1 : ((qp - 127) >> 6), qp >> 6, true, sb, 8 * kvh + F.wave, i, sinks); }
      probe_t1(F.lds, 53); probe_t0(F.lds);
      if (F.vcu < 32 && (F.vcu & 1) == 1) attn_group<1>(F, w, 0, (F.vcu >> 1) >> 3, 1, 1, F.wave == 0, -1, F.vcu >> 1, 0, sinks); }
    __syncthreads();
    probe_t1(F.lds, 54);
}

constexpr int PH_PER_LAYER = 7, N_PHASES = 1 + DEPTH * PH_PER_LAYER;
struct Args { const float* in[21]; float* out; unsigned char* ws; int ph_lo, ph_hi, li, pad; };
__global__ void __launch_bounds__(NWAVES * 64, 2) hymba_fwd(Args args) {
    extern __shared__ __attribute__((aligned(16))) unsigned char lds[];
    {
        LAS unsigned char* l0 = (LAS unsigned char*)lds; const int tid = threadIdx.x;
        for (int u = tid; u < (LDS_BYTES - LDSCTL_OFF) / 4; u += NWAVES * 64) ((LAS unsigned*)(l0 + LDSCTL_OFF))[u] = 0u;
        __syncthreads();
        if ((tid & 63) == 0) ((volatile LAS int*)(l0 + WID_OFF))[hw_wave_key()] = tid >> 6;
        volatile LAS unsigned long long* pt = (volatile LAS unsigned long long*)(l0 + PTR_OFF);
#pragma unroll
        for (int k = 0; k < 21; ++k) if (tid == k) pt[k] = (unsigned long long)args.in[k];
        if (tid == 21) pt[21] = (unsigned long long)args.out;
        if (tid == 22) pt[22] = (unsigned long long)args.ws;
        __syncthreads();
#if !MK_PER_PHASE
        (void)xcd_barrier_post((unsigned*)((gu32*)(args.ws + WS_CTL) + CW_BAR), (volatile LAS unsigned*)(l0 + MISC_OFF) + 8);
#endif
    }
    const int lo = args.ph_lo, hi = args.ph_hi;
#define IN(k) (lo <= (k) && (k) < hi)
#define PROBE_T0() if (PROBE_CLASS == 60 && (PROBE_BLOCK < 0 || (int)blockIdx.x == PROBE_BLOCK) && my_tid() == 0) { *(volatile LAS unsigned long long*)((LAS unsigned char*)lds + MISC_OFF + 72) = __builtin_amdgcn_s_memtime(); } else if (PROBE_CLASS >= 0 && (PROBE_BLOCK < 0 || (int)blockIdx.x == PROBE_BLOCK) && my_tid() == 0) { *(volatile LAS unsigned long long*)((LAS unsigned char*)lds + MISC_OFF + 72) = __builtin_amdgcn_s_memrealtime(); }
#define PROBE_T1(c) if (PROBE_CLASS == 60 && (c) == 2 && (PROBE_BLOCK < 0 || (int)blockIdx.x == PROBE_BLOCK) && my_tid() == 0) { volatile LAS unsigned long long* pa_ = (volatile LAS unsigned long long*)((LAS unsigned char*)lds + MISC_OFF + 64); *pa_ = *pa_ + (__builtin_amdgcn_s_memtime() - *(volatile LAS unsigned long long*)((LAS unsigned char*)lds + MISC_OFF + 72)) / 24ull; } else if (PROBE_CLASS == (c) && (PROBE_BLOCK < 0 || (int)blockIdx.x == PROBE_BLOCK) && my_tid() == 0) { volatile LAS unsigned long long* pa_ = (volatile LAS unsigned long long*)((LAS unsigned char*)lds + MISC_OFF + 64); *pa_ = *pa_ + (__builtin_amdgcn_s_memrealtime() - *(volatile LAS unsigned long long*)((LAS unsigned char*)lds + MISC_OFF + 72)); }
#define SEAM(k) do { if (IN(k) && IN((k) + 1)) { PROBE_T0() unsigned char* wsb_ = (unsigned char*)pg8::tab_ptr(22); \
        if (MK_PER_PHASE) { if (my_tid() == 0) __hip_atomic_store((gu32*)(wsb_ + WS_CTL) + CW_TMO, 0xBADBA0u, RLX_AGENT); } \
        else { XcdBarrier bar_; bar_.bar = (unsigned*)((gu32*)(wsb_ + WS_CTL) + CW_BAR); bar_.x = xb_xcc_id(); bar_.st = (volatile LAS unsigned*)((LAS unsigned char*)lds + MISC_OFF) + 8; xcd_barrier(bar_); if (PROBE_CLASS == 50) xcd_barrier(bar_); } PROBE_T1(8) } } while (0)
#define PHASE_BEGIN(k) if (IN(k)) { PROBE_T0() Frame P = make_frame(); \
        unsigned char* w = wsl(P); int ll = l; LAUNDER_S(ll); unsigned char* wl = w + WS_W + (size_t)ll * LW_STRIDE; (void)wl; int bxl = blockIdx.x; LAUNDER_S(bxl);
#define PHASE_END(k, c) PROBE_T1(c) } SEAM(k);
    typedef pg8::StaticOrder SO;
    if (IN(0)) { PROBE_T0() Frame P = make_frame(); p0_prologue(P); PROBE_T1(0) } SEAM(0);
    for (int l = 0; l < DEPTH; ++l) {
        const int pb = 1 + l * PH_PER_LAYER;
#define SSQ(j) ((GAS float*)(w + WS_SSQM) + (size_t)(3 * ll + (j)) * 16 * 128)
#define HBM ((const GAS bf16*)(w + WS_HB) + (size_t)META_ROW * D)
        PHASE_BEGIN(pb + 0) pg8::Gemm g{(const bf16*)(w + WS_HB), (const bf16*)(wl + LW_GU1), M_REAL, N_GU, D}; SO S; S.init(M_REAL, N_GU, P.G, bxl);
            pg8::EpiSwiGLU E{3 * ll + 0}; pg8::gemm_phase<pg8::EpiSwiGLU, SO, true, true>(P.lds + RING_OFF, g, S, E);
            SkGU K2{(GAS bf16*)(w + WS_ACT), SSQ(0)}; skinny_phase<SkGU, D / 256>(P, HBM, D, (const GAS bf16*)(wl + LW_GU1), D, K2); PHASE_END(pb + 0, 2)
        PHASE_BEGIN(pb + 1) pg8::Gemm g{(const bf16*)(w + WS_ACT), (const bf16*)(wl + LW_D1), M_REAL, D, FF}; SO S; S.init(M_REAL, D, P.G, bxl);
            pg8::EpiResAdd E{0.5f, 3 * ll + 1, 0}; pg8::gemm_phase<pg8::EpiResAdd, SO, true, true>(P.lds + RING_OFF, g, S, E);
            SkRes K2{0.5f, (GAS bf16*)(w + WS_HB), SSQ(1)}; skinny_phase<SkRes, FF / 256>(P, (const GAS bf16*)(w + WS_ACT) + (size_t)META_ROW * FF, FF, (const GAS bf16*)(wl + LW_D1), FF, K2); PHASE_END(pb + 1, 3)
        PHASE_BEGIN(pb + 2) pg8::Gemm g{(const bf16*)(w + WS_HB), (const bf16*)(wl + LW_IN), M_REAL, N_IN, D}; SO S; S.init(M_REAL, N_IN, P.G, bxl);
            pg8::EpiInProj E{ll, 3 * ll + 1, QSCALE};
            pg8::gemm_phase<pg8::EpiInProj, SO, true, true>(P.lds + RING_OFF, g, S, E);
            SkIn K2{(GAS bf16*)(w + WS_FQ), (GAS bf16*)(w + WS_FK), (GAS bf16*)(w + WS_FV), (GAS bf16*)(w + WS_SQ), (GAS bf16*)(w + WS_SK), (GAS bf16*)(w + WS_SV), (GAS float*)(w + WS_LOGF), (const GAS float*)(inptr(P, 9) + ll * HD), (const GAS float*)(inptr(P, 10) + ll * HD), (const GAS float*)(inptr(P, 11) + ll * HD), (const GAS float*)(inptr(P, 12) + ll * HD), (const GAS float*)(inptr(P, 8) + ll * NH), QSCALE, SSQ(1)}; skinny_phase<SkIn, D / 256>(P, HBM, D, (const GAS bf16*)(wl + LW_IN), D, K2);
            if (IDLE_CONV_K > 0 && P.G == 256 && bxl >= 128) { __syncthreads(); LAS unsigned char* scr = P.lds + RING_OFF + P.wave * 16384; const int iw = (bxl - 128) * NWAVES + P.wave;
                for (int k = 0; k < IDLE_CONV_K; ++k) convert_item(P, w, ll, GU2_BASE + iw + k * 128 * NWAVES, scr); }
            PHASE_END(pb + 2, 4)
        PHASE_BEGIN(pb + 3) attn_phase(P, inptr(P, 13) + ll * NH, OVERLAP_CONV ? ll + 1 : DEPTH, inptr(P, 9) + ll * HD, inptr(P, 10) + ll * HD); PHASE_END(pb + 3, 5)
        PHASE_BEGIN(pb + 4) pg8::Gemm g{(const bf16*)(w + WS_O), (const bf16*)(wl + LW_OUT), M_REAL, D, D}; SO S; S.init(M_REAL, D, P.G, bxl);
            pg8::EpiOut E{3 * ll + 2}; pg8::gemm_phase<pg8::EpiOut, SO, true, true>(P.lds + RING_OFF, g, S, E);
            SkOut K2{1.0f, (GAS bf16*)(w + WS_HB), SSQ(2), (const GAS float*)(w + WS_SSQOM)}; skinny_phase<SkOut, D / 256>(P, (const GAS bf16*)(w + WS_O) + (size_t)META_ROW * D, D, (const GAS bf16*)(wl + LW_OUT), D, K2); PHASE_END(pb + 4, 7)
        PHASE_BEGIN(pb + 5) pg8::Gemm g{(const bf16*)(w + WS_HB), (const bf16*)(wl + LW_GU2), M_REAL, N_GU, D}; SO S; S.init(M_REAL, N_GU, P.G, bxl);
            pg8::EpiSwiGLU E{3 * ll + 2}; pg8::gemm_phase<pg8::EpiSwiGLU, SO, true, true>(P.lds + RING_OFF, g, S, E);
            if (ll < DEPTH - 1) { SkGU K2{(GAS bf16*)(w + WS_ACT), SSQ(2)}; skinny_phase<SkGU, D / 256>(P, HBM, D, (const GAS bf16*)(wl + LW_GU2), D, K2); } PHASE_END(pb + 5, 2)
        PHASE_BEGIN(pb + 6) pg8::Gemm g{(const bf16*)(w + WS_ACT), (const bf16*)(wl + LW_D2), M_REAL, D, FF}; SO S; S.init(M_REAL, D, P.G, bxl);
            const bool fin = (ll == DEPTH - 1);
            pg8::EpiResAdd E{0.5f, 3 * ll + 3, fin ? 1 : 0}; pg8::gemm_phase<pg8::EpiResAdd, SO, true, true>(P.lds + RING_OFF, g, S, E);
            if (!fin) { SkRes K2{0.5f, (GAS bf16*)(w + WS_HB), SSQ(3)}; skinny_phase<SkRes, FF / 256>(P, (const GAS bf16*)(w + WS_ACT) + (size_t)META_ROW * FF, FF, (const GAS bf16*)(wl + LW_D2), FF, K2); } PHASE_END(pb + 6, 3)
#undef SSQ
#undef HBM
    }
    if (PROBE_CLASS >= 0 && (PROBE_BLOCK < 0 || (int)blockIdx.x == PROBE_BLOCK) && my_tid() == 0) { const unsigned long long t0 = __builtin_amdgcn_s_memrealtime(), dt = *(volatile LAS unsigned long long*)((LAS unsigned char*)lds + MISC_OFF + 64);
        while (__builtin_amdgcn_s_memrealtime() - t0 < dt) __builtin_amdgcn_s_sleep(8); }
#undef IN
#undef SEAM
#undef PHASE_BEGIN
#undef PHASE_END
}

extern "C" void kernel_launch(void* const* d_in, const int* in_sizes, int n_in, void* d_out, int out_size, void* d_ws, size_t ws_size, hipStream_t stream) {
    static int grid = 0;
    if (grid == 0) {
        if (n_in != 21 || in_sizes[0] != M_REAL * D || out_size != M_REAL * D || ws_size < WS_END) { fprintf(stderr, "kernel_launch: unexpected shapes (n_in %d, in0 %d, out %d, ws %zu, need %zu); nothing launched\n", n_in, n_in > 0 ? in_sizes[0] : -1, out_size, ws_size, (size_t)WS_END); grid = -1; return; }
        int dev = 0, cus = 0, per_cu = 0;
        if (hipGetDevice(&dev) != hipSuccess || hipDeviceGetAttribute(&cus, hipDeviceAttributeMultiprocessorCount, dev) != hipSuccess) { fprintf(stderr, "kernel_launch: device query failed\n"); grid = -1; return; }
        if (hipFuncSetAttribute((const void*)hymba_fwd, hipFuncAttributeMaxDynamicSharedMemorySize, LDS_BYTES) != hipSuccess) { fprintf(stderr, "kernel_launch: hipFuncSetAttribute failed\n"); grid = -1; return; }
        if (hipOccupancyMaxActiveBlocksPerMultiprocessor(&per_cu, (const void*)hymba_fwd, NWAVES * 64, LDS_BYTES) != hipSuccess || per_cu < 1) fprintf(stderr, "kernel_launch: note: occupancy query reports %d workgroups per CU\n", per_cu);
        (void)hipGetLastError();
        grid = cus;
        if (grid != 256) fprintf(stderr, "kernel_launch: note: %d CUs (the attention phase's static deal assumes 256)\n", grid);
    }
    if (grid < 0) return;
    if (hipMemsetAsync((char*)d_ws + WS_CTL, 0, CTL_ZERO_BYTES, stream) != hipSuccess) { fprintf(stderr, "kernel_launch: memset failed\n"); return; }
    Args a{};
    for (int i = 0; i < 21; ++i) a.in[i] = (const float*)d_in[i];
    a.out = (float*)d_out; a.ws = (unsigned char*)d_ws; a.li = 0; a.pad = 0;
#if MK_PER_PHASE
    for (int ph = 0; ph < N_PHASES; ++ph) { a.ph_lo = ph; a.ph_hi = ph + 1; hipLaunchKernelGGL(hymba_fwd, dim3(grid), dim3(NWAVES * 64), LDS_BYTES, stream, a); }
#else
    a.ph_lo = 0; a.ph_hi = N_PHASES;
    hipLaunchKernelGGL(hymba_fwd, dim3(grid), dim3(NWAVES * 64), LDS_BYTES, stream, a);
#endif
    const hipError_t le = hipPeekAtLastError();
    if (le != hipSuccess) fprintf(stderr, "kernel_launch: launch failed: %s\n", hipGetErrorName(le));
}
```

```cpp
#include <hip/hip_runtime.h>
#include <cstdio>
#include <cstdint>

#ifndef MK_PER_PHASE
#define MK_PER_PHASE 0
#endif
#ifndef OVERLAP_CONV
#define OVERLAP_CONV 0
#endif
#ifndef PROBE_BLOCK
#define PROBE_BLOCK 0
#endif
#ifndef PROBE_CLASS
#define PROBE_CLASS (-1)
#endif

#define PROBE_ACC_OFF (131072 + 320 + 64)
__device__ __forceinline__ int my_tid();
__device__ __forceinline__ int lane_now() { unsigned z = 0; asm volatile("" : "+v"(z)); return (int)__builtin_amdgcn_mbcnt_hi(~0u, __builtin_amdgcn_mbcnt_lo(~0u, z)); }
template <int O> __device__ __forceinline__ float shx(float v) {
    if constexpr (O < 32) return __builtin_bit_cast(float, __builtin_amdgcn_ds_swizzle(__builtin_bit_cast(int, v), (O << 10) | 0x1f));
    else return __builtin_bit_cast(float, __builtin_amdgcn_ds_bpermute((lane_now() ^ 32) << 2, __builtin_bit_cast(int, v)));
}
__device__ __forceinline__ float shi(float v, int idx) { return __builtin_bit_cast(float, __builtin_amdgcn_ds_bpermute(idx << 2, __builtin_bit_cast(int, v))); }
#define XSUM16(v) do { v += shx<1>(v); v += shx<2>(v); v += shx<4>(v); v += shx<8>(v); } while (0)
#define XSUM32(v) do { XSUM16(v); v += shx<16>(v); } while (0)
#define XSUM64(v) do { XSUM32(v); v += shx<32>(v); } while (0)
namespace pg8 {
#define PG8_LAS __attribute__((address_space(3)))
#define PG8_GAS __attribute__((address_space(1)))
typedef unsigned short bf16_t;
typedef short bf16x8 __attribute__((ext_vector_type(8)));
typedef float f32x4 __attribute__((ext_vector_type(4)));
typedef unsigned u32x4 __attribute__((ext_vector_type(4)));
constexpr int BM = 256, BK = 64, HALF = 128, HTB = HALF * BK * 2  , STAGE_BYTES = 8 * HTB, NXCD = 8, WGM = 8;

__host__ __device__ __forceinline__ int lds_byte(int r, int c) { const int st = (r >> 4) * 2 + (c >> 5), rr = r & 15, cc = c & 31, ob = rr * 64 + cc * 2; return st * 1024 + (ob ^ (((ob >> 9) & 1) << 5)); }
__host__ __device__ __forceinline__ void stage_rc(int b, int& R, int& C) { const int st = b / 1024, sb = b % 1024, swz = sb ^ (((sb >> 9) & 1) << 5); R = (st >> 1) * 16 + swz / 64; C = (st & 1) * 32 + (swz % 64) / 2; }
__host__ __device__ __forceinline__ int perm32(int rho) { const int n = rho >> 4, i = rho & 15; return 8 * (i >> 2) + 4 * n + (i & 3); }

struct Unit { int pm, pn; };
struct Gemm { const bf16_t* A; const bf16_t* Bt; int M, N, K; };

struct StaticOrder {
    int nM, nN, nwg, G, c;
    __host__ __device__ void init(int M, int N, int G_, int c_) { nM = M / BM; nN = N / BM; nwg = nM * nN; G = G_; c = c_; }
    __host__ __device__ bool next(int i, Unit& u) const {
        const long L = (long)i * G + c; if (L >= nwg) return false;
        int wgid = (int)L; { const int q = nwg / NXCD, r = nwg % NXCD, xcd = wgid % NXCD, off = wgid / NXCD; wgid = (xcd < r ? xcd * (q + 1) : r * (q + 1) + (xcd - r) * q) + off; }
        const int nig = WGM * nN, gid = wgid / nig, fm = gid * WGM, gsz = (nM - fm) < WGM ? (nM - fm) : WGM;
        u.pm = fm + ((wgid % nig) % gsz); u.pn = (wgid % nig) / gsz; return true;
    }
    __device__ __forceinline__ void a_ready(const Unit&) const {}
    __device__ __forceinline__ void done(const Unit&) const {}
};

__device__ __forceinline__ unsigned cvt_pk_bf16(float lo, float hi) { unsigned r; asm volatile("v_cvt_pk_bf16_f32 %0, %1, %2" : "=v"(r) : "v"(lo), "v"(hi)); return r; }

template <class Epi, class Sched, bool ALIGN_EPI = false, bool SP2 = false>
__device__ __forceinline__ void gemm_phase(PG8_LAS unsigned char* lds, const Gemm g, const Sched& S, const Epi& E) {
    int tid_l = my_tid(); asm volatile("" : "+v"(tid_l));
    const int tid = tid_l, wid = __builtin_amdgcn_readfirstlane(tid >> 6), lane = tid & 63, wr = wid >> 2, wc = wid & 3, fr = lane & 15, fq = lane >> 4;
    const int K = g.K, nt = K / BK;
    unsigned voffA[2], voffB[2];
#pragma unroll
    for (int i = 0; i < 2; ++i) { int R, C; stage_rc(tid * 16 + i * 8192, R, C); const int Rb = Epi::PERM ? ((R & ~31) + perm32(R & 31)) : R;
        voffA[i] = (unsigned)(R * K + C) * 2u; voffB[i] = (unsigned)(Rb * K + C) * 2u; }
    const size_t kstep = (size_t)(BK * 2);
    const size_t hstep = (size_t)HALF * K * 2;
    const size_t tstep = 2 * hstep;
    const unsigned ldsw = (unsigned)wid * 1024u;
    const int aoff = lds_byte(wr * 64 + fr, fq * 8), boff = lds_byte(wc * 32 + fr, fq * 8);
#define PG8_SA(b, h) (((b) * 2 + (h)) * HTB)
#define PG8_SB(b, h) ((4 + (b) * 2 + (h)) * HTB)
#define PG8_STAGE(bufoff, gbase, voff) do { _Pragma("unroll") for (int _i = 0; _i < 2; ++_i) \
        __builtin_amdgcn_global_load_lds((const unsigned*)((const char*)(gbase) + (voff)[_i]), (PG8_LAS unsigned*)(lds + (bufoff) + ldsw + _i * 8192), 16, 0, 0); } while (0)
#define PG8_LDA(dst, b, h) do { _Pragma("unroll") for (int m = 0; m < 4; ++m) _Pragma("unroll") for (int k = 0; k < 2; ++k) dst[m][k] = *(const PG8_LAS bf16x8*)(lds + PG8_SA(b, h) + aoff + m * 2048 + k * 1024); } while (0)
#define PG8_LDB(dst, b, h) do { _Pragma("unroll") for (int n = 0; n < 2; ++n) _Pragma("unroll") for (int k = 0; k < 2; ++k) dst[n][k] = *(const PG8_LAS bf16x8*)(lds + PG8_SB(b, h) + boff + n * 2048 + k * 1024); } while (0)
#define PG8_MMA(ai, bj, At, Bt) do { __builtin_amdgcn_s_setprio(1); _Pragma("unroll") for (int m = 0; m < 4; ++m) _Pragma("unroll") for (int n = 0; n < 2; ++n) _Pragma("unroll") for (int k = 0; k < 2; ++k) \
        acc[ai][bj][m][n] = __builtin_amdgcn_mfma_f32_16x16x32_bf16(Bt[n][k], At[m][k], acc[ai][bj][m][n], 0, 0, 0); __builtin_amdgcn_s_setprio(0); } while (0)
#define PG8_WAIT_V(n) asm volatile("s_waitcnt vmcnt(" #n ")" ::: "memory")
#define PG8_WAIT_L(n) asm volatile("s_waitcnt lgkmcnt(" #n ")" ::: "memory")
#define PG8_BAR __builtin_amdgcn_s_barrier()
#define PG8_SCHED __builtin_amdgcn_sched_barrier(0)
    Unit cur, nxt; int ui = 0;
    if (!S.next(0, cur)) return;
    f32x4 acc[2][2][4][2];
#pragma unroll
    for (int a = 0; a < 2; ++a)
#pragma unroll
        for (int b = 0; b < 2; ++b)
#pragma unroll
            for (int m = 0; m < 4; ++m)
#pragma unroll
                for (int n = 0; n < 2; ++n) acc[a][b][m][n] = (f32x4){0.f, 0.f, 0.f, 0.f};
    bf16x8 At[4][2], B0[2][2], B1[2][2];
    const char* cA = (const char*)g.A + (size_t)cur.pm * tstep; const char* cB = (const char*)g.Bt + (size_t)cur.pn * tstep;
    S.a_ready(cur);
    if constexpr (SP2) {
        PG8_STAGE(PG8_SB(0, 0), cB, voffB); PG8_STAGE(PG8_SB(0, 1), cB + hstep, voffB); PG8_STAGE(PG8_SA(0, 0), cA, voffA); PG8_STAGE(PG8_SA(0, 1), cA + hstep, voffA);
        if (wr == 1) PG8_BAR;
        PG8_WAIT_V(2); PG8_BAR;
        PG8_STAGE(PG8_SB(1, 0), cB + kstep, voffB); PG8_STAGE(PG8_SA(1, 0), cA + kstep, voffA); PG8_STAGE(PG8_SB(1, 1), cB + hstep + kstep, voffB);
        PG8_WAIT_V(6); PG8_BAR;
    } else {
        PG8_STAGE(PG8_SB(0, 0), cB, voffB); PG8_STAGE(PG8_SA(0, 0), cA, voffA); PG8_STAGE(PG8_SB(0, 1), cB + hstep, voffB); PG8_STAGE(PG8_SA(0, 1), cA + hstep, voffA);
        if (wr == 1) PG8_BAR;
        PG8_WAIT_V(4); PG8_BAR;
        PG8_STAGE(PG8_SB(1, 0), cB + kstep, voffB); PG8_STAGE(PG8_SA(1, 0), cA + kstep, voffA); PG8_STAGE(PG8_SB(1, 1), cB + hstep + kstep, voffB);
        PG8_WAIT_V(6); PG8_BAR;
    }
    for (;;) {
        const bool has_next = S.next(ui + 1, nxt);
        const char* nA = has_next ? (const char*)g.A + (size_t)nxt.pm * tstep : cA; const char* nB = has_next ? (const char*)g.Bt + (size_t)nxt.pn * tstep : cB;
        for (int t = 0; t < nt; t += 2) {
            const bool last = (t == nt - 2);
            const char* a1 = cA + (size_t)(t + 1) * kstep;
            const char* a2 = last ? nA : cA + (size_t)(t + 2) * kstep; const char* b2 = last ? nB : cB + (size_t)(t + 2) * kstep;
            const char* a3 = a2 + kstep; const char* b3 = b2 + kstep;
            if (last && has_next) S.a_ready(nxt);
            if constexpr (Epi::MID) { if (t == nt / 2) E.mid(acc, cur, wr, wc, fr, fq); }
            if constexpr (SP2) {
            PG8_LDB(B0, 0, 0); PG8_LDB(B1, 0, 1); PG8_SCHED; PG8_LDA(At, 0, 0); PG8_STAGE(PG8_SA(1, 1), a1 + hstep, voffA);
            PG8_WAIT_V(8); PG8_WAIT_L(0); PG8_BAR; PG8_MMA(0, 0, At, B0); PG8_MMA(0, 1, At, B1); PG8_BAR; PG8_SCHED;
            PG8_LDA(At, 0, 1); PG8_STAGE(PG8_SB(0, 0), b2, voffB); PG8_STAGE(PG8_SB(0, 1), b2 + hstep, voffB); PG8_STAGE(PG8_SA(0, 0), a2, voffA);
            PG8_WAIT_V(8); PG8_WAIT_L(0); PG8_BAR; PG8_MMA(1, 0, At, B0); PG8_MMA(1, 1, At, B1); PG8_BAR; PG8_SCHED;
            PG8_LDB(B0, 1, 0); PG8_LDB(B1, 1, 1); PG8_SCHED; PG8_LDA(At, 1, 0); PG8_STAGE(PG8_SA(0, 1), a2 + hstep, voffA);
            PG8_WAIT_V(8); PG8_WAIT_L(0); PG8_BAR; PG8_MMA(0, 0, At, B0); PG8_MMA(0, 1, At, B1); PG8_BAR; PG8_SCHED;
            PG8_LDA(At, 1, 1); PG8_STAGE(PG8_SB(1, 0), b3, voffB); PG8_STAGE(PG8_SB(1, 1), b3 + hstep, voffB); PG8_STAGE(PG8_SA(1, 0), a3, voffA);
            PG8_WAIT_V(8); PG8_WAIT_L(0); PG8_BAR; PG8_MMA(1, 0, At, B0); PG8_MMA(1, 1, At, B1); PG8_BAR; PG8_SCHED;
            } else {
            PG8_LDB(B0, 0, 0); PG8_SCHED; PG8_LDA(At, 0, 0); PG8_STAGE(PG8_SA(1, 1), a1 + hstep, voffA);
            PG8_WAIT_L(8); PG8_BAR; PG8_WAIT_L(0); PG8_MMA(0, 0, At, B0); PG8_BAR; PG8_SCHED;
            PG8_LDB(B1, 0, 1); PG8_STAGE(PG8_SB(0, 0), b2, voffB);
            PG8_BAR; PG8_WAIT_L(0); PG8_MMA(0, 1, At, B1); PG8_BAR;
            PG8_LDA(At, 0, 1); PG8_STAGE(PG8_SA(0, 0), a2, voffA);
            PG8_BAR; PG8_WAIT_L(0); PG8_MMA(1, 0, At, B0); PG8_BAR; PG8_SCHED;
            PG8_STAGE(PG8_SB(0, 1), b2 + hstep, voffB);
            PG8_WAIT_V(6); PG8_BAR; PG8_MMA(1, 1, At, B1); PG8_BAR;
            PG8_LDB(B0, 1, 0); PG8_SCHED; PG8_LDA(At, 1, 0); PG8_STAGE(PG8_SA(0, 1), a2 + hstep, voffA);
            PG8_WAIT_L(8); PG8_BAR; PG8_WAIT_L(0); PG8_MMA(0, 0, At, B0); PG8_BAR; PG8_SCHED;
            PG8_LDB(B1, 1, 1); PG8_STAGE(PG8_SB(1, 0), b3, voffB);
            PG8_BAR; PG8_WAIT_L(0); PG8_MMA(0, 1, At, B1); PG8_BAR;
            PG8_LDA(At, 1, 1); PG8_STAGE(PG8_SA(1, 0), a3, voffA);
            PG8_BAR; PG8_WAIT_L(0); PG8_MMA(1, 0, At, B0); PG8_BAR; PG8_SCHED;
            PG8_STAGE(PG8_SB(1, 1), b3 + hstep, voffB);
            PG8_WAIT_V(6); PG8_BAR; PG8_MMA(1, 1, At, B1); PG8_BAR;
            }
        }
        if constexpr (ALIGN_EPI) { if (wr == 0) PG8_BAR; }
        if constexpr (PROBE_CLASS == 20 + Epi::ID) { unsigned long long t0_ = 0; if ((PROBE_BLOCK < 0 || (int)blockIdx.x == PROBE_BLOCK) && tid == 0) t0_ = __builtin_amdgcn_s_memrealtime();
            E(acc, cur, wr, wc, fr, fq); asm volatile("s_waitcnt vmcnt(0)" ::: "memory");
            if ((PROBE_BLOCK < 0 || (int)blockIdx.x == PROBE_BLOCK) && tid == 0) { volatile PG8_LAS unsigned long long* pa_ = (volatile PG8_LAS unsigned long long*)(lds + PROBE_ACC_OFF); *pa_ = *pa_ + (__builtin_amdgcn_s_memrealtime() - t0_); } }
        else if constexpr (!Epi::AFTER_DRAIN) { E(acc, cur, wr, wc, fr, fq); S.done(cur); }
        if (!has_next) break;
#pragma unroll
        for (int a = 0; a < 2; ++a)
#pragma unroll
            for (int b = 0; b < 2; ++b)
#pragma unroll
                for (int m = 0; m < 4; ++m)
#pragma unroll
                    for (int n = 0; n < 2; ++n) acc[a][b][m][n] = (f32x4){0.f, 0.f, 0.f, 0.f};
        cur = nxt; cA = nA; cB = nB; ++ui;
        if constexpr (ALIGN_EPI) { if (wr == 1) PG8_BAR; }
    }
    PG8_WAIT_V(0);
    if constexpr (!ALIGN_EPI) { if (wr == 0) PG8_BAR; }
    PG8_BAR;
#undef PG8_SA
#undef PG8_SB
#undef PG8_STAGE
#undef PG8_LDA
#undef PG8_LDB
#undef PG8_MMA
#undef PG8_WAIT_V
#undef PG8_WAIT_L
#undef PG8_BAR
#undef PG8_SCHED
}
}

constexpr int NWAVES = 8;
constexpr int D = 2048, NB = 8, SEQ = 2048, DEPTH = 4, HD = 64, NH = 16, FF = 5632, NMETA = 16, PADN = 112;
constexpr int M_REAL = NB * SEQ;
constexpr int M_PAD = M_REAL + 128;
constexpr int META_BLK0 = M_REAL;
constexpr int META_ROW = META_BLK0 + PADN;
constexpr int LPOS = SEQ + 128;
constexpr int N_GU = 2 * FF;
constexpr int N_IN = 18 * 256;
constexpr int IN_W = 4368;
constexpr float EPS = 1e-6f;
constexpr float LOG2E = 1.4426950408889634f;
constexpr float QSCALE = 0.125f * LOG2E;

constexpr size_t MiB = 1u << 20;
constexpr int NSLOT = 13;
constexpr size_t WS_CTL = 0, CTL_ZERO_BYTES = 1 * MiB;
constexpr size_t SZ_WGU = (size_t)N_GU * D * 2, SZ_WD = (size_t)D * FF * 2, SZ_WIN = (size_t)N_IN * D * 2, SZ_WOUT = (size_t)D * D * 2;
constexpr size_t LW_GU1 = 0, LW_D1 = LW_GU1 + SZ_WGU, LW_IN = LW_D1 + SZ_WD, LW_OUT = LW_IN + SZ_WIN, LW_GU2 = LW_OUT + SZ_WOUT, LW_D2 = LW_GU2 + SZ_WGU, LW_STRIDE = LW_D2 + SZ_WD;
constexpr size_t WS_W = 1 * MiB;
constexpr size_t WS_XN = WS_W + DEPTH * LW_STRIDE;
constexpr size_t WS_O = WS_XN + (size_t)M_PAD * D * 2;
constexpr size_t WS_ACT = WS_O + (size_t)M_PAD * D * 2;
constexpr size_t SZ_QK = (size_t)M_PAD * 1024 * 2, SZ_KV = (size_t)M_PAD * 128 * 2;
constexpr size_t WS_FQ = WS_ACT + (size_t)M_PAD * FF * 2, WS_FK = WS_FQ + SZ_QK, WS_FV = WS_FK + SZ_QK, WS_SQ = WS_FV + SZ_QK, WS_SK = WS_SQ + SZ_QK, WS_SV = WS_SK + SZ_KV, WS_LOGF = WS_SV + SZ_KV;
constexpr size_t WS_HB = WS_LOGF + (size_t)M_PAD * 16 * 4;
constexpr size_t WS_SSQ = WS_HB + (size_t)M_PAD * D * 2;
constexpr size_t WS_SSQM = WS_SSQ + (size_t)NSLOT * M_REAL * 32 * 4;
constexpr size_t WS_SSQO = WS_SSQM + (size_t)NSLOT * 16 * 128 * 4;
constexpr size_t WS_SSQOM = WS_SSQO + (size_t)M_REAL * 32 * 4;
constexpr size_t WS_END = WS_SSQOM + 16 * 32 * 4;
static_assert(LW_STRIDE % 256 == 0 && WS_XN % 256 == 0 && WS_ACT % 256 == 0 && WS_FQ % 256 == 0 && WS_SK % 256 == 0 && WS_LOGF % 256 == 0 && WS_HB % 256 == 0, "alignment");
constexpr int CW_TMO = 0, CW_BAR = 4096;

constexpr int RING_OFF = 0, RING_BYTES = 131072;
constexpr int LDSCTL_OFF = RING_BYTES, MISC_OFF = LDSCTL_OFF + 320, PTR_OFF = LDSCTL_OFF + 1024;
constexpr int LDS_BYTES = 155648;
constexpr int WID_OFF = LDSCTL_OFF + 1280;
constexpr int RSTD_ID_OFF = LDSCTL_OFF + 1536, RSTD_OFF = LDSCTL_OFF + 2048;
static_assert(RSTD_OFF + 8 * 128 * 4 <= LDS_BYTES, "LDS map");
constexpr int RSTD2_OFF = 148480;
static_assert(RSTD2_OFF + 8 * 128 * 4 <= LDS_BYTES, "LDS map");
constexpr int ATT_TAB_OFF = 139264;
constexpr int ATT_WTOT_OFF = ATT_TAB_OFF + 8704;
constexpr int ATT_FC_OFF = ATT_WTOT_OFF + 64;
constexpr int ATT_TABF_OFF = 0, ATT_ZERO_OFF = 2176 * 16;
constexpr int ATT_VST_OFF = 0, ATT_VST_PITCH = 128, ATT_VST_BYTES = 64 * ATT_VST_PITCH;
static_assert(ATT_VST_OFF + NWAVES * 2 * ATT_VST_BYTES <= RING_BYTES && ATT_FC_OFF + 256 <= RSTD2_OFF && RSTD_OFF + 8 * 128 * 4 <= ATT_TAB_OFF, "attention LDS");

#define GAS __attribute__((address_space(1)))
#define LAS __attribute__((address_space(3)))
typedef unsigned short bf16;
typedef unsigned v4u __attribute__((ext_vector_type(4)));
typedef float f32x4 __attribute__((ext_vector_type(4)));
typedef float f32x16 __attribute__((ext_vector_type(16)));
typedef short bf16x8 __attribute__((ext_vector_type(8)));
typedef GAS unsigned gu32;
#define RLX_AGENT __ATOMIC_RELAXED, __HIP_MEMORY_SCOPE_AGENT
#define LDS_WAIT() asm volatile("s_waitcnt lgkmcnt(0)" ::: "memory")
__device__ __forceinline__ unsigned f2bf(float f) { unsigned u = __builtin_bit_cast(unsigned, f); return (u + 0x7fffu + ((u >> 16) & 1u)) >> 16; }
__device__ __forceinline__ unsigned pk2(float lo, float hi) { return f2bf(lo) | (f2bf(hi) << 16); }
__device__ __forceinline__ float bf2f(unsigned short b) { return __builtin_bit_cast(float, (unsigned)b << 16); }

__device__ __forceinline__ int hw_wave_key() { return (int)(__builtin_amdgcn_s_getreg(((6 - 1) << 11) | 4) & 63u); }
__device__ __forceinline__ int my_tid() {
    extern __shared__ __attribute__((aligned(16))) unsigned char lds_dyn_[];
    const int wave = __builtin_amdgcn_readfirstlane(((const volatile LAS int*)((LAS unsigned char*)lds_dyn_ + WID_OFF))[hw_wave_key()]);
    unsigned zero = 0u; asm volatile("" : "+v"(zero));
    return wave * 64 + (int)__builtin_amdgcn_mbcnt_hi(~0u, __builtin_amdgcn_mbcnt_lo(~0u, zero));
}
__host__ __device__ __forceinline__ size_t kfrag_idx(int row, int nh, int head, int d) { return ((((size_t)(row >> 5) * nh + head) * 8 + (d >> 3)) * 32 + (row & 31)) * 8 + (d & 7); }
__host__ __device__ __forceinline__ size_t vfrag_idx(int row, int nh, int head, int d) { return (((((size_t)(row >> 4) * nh + head) * 2 + ((row >> 2) & 1)) * 64 + d) * 8) + (((row >> 3) & 1) * 4 + (row & 3)); }
namespace pg8 {
__device__ __forceinline__ unsigned long long tab_ptr(int k) {
    extern __shared__ __attribute__((aligned(16))) unsigned char lds_dyn_[];
    const volatile PG8_LAS unsigned* t = (const volatile PG8_LAS unsigned*)((PG8_LAS unsigned char*)lds_dyn_ + PTR_OFF);
    const unsigned lo = __builtin_amdgcn_readfirstlane(t[2 * k]), hi = __builtin_amdgcn_readfirstlane(t[2 * k + 1]);
    return ((unsigned long long)hi << 32) | lo;
}
__device__ __forceinline__ const PG8_LAS float* ensure_rstd(const PG8_GAS float* ssq, int slot, int pm, int wid, int wr, int lane) {
    extern __shared__ __attribute__((aligned(16))) unsigned char lds_dyn_[];
    volatile PG8_LAS unsigned* idw = (volatile PG8_LAS unsigned*)((PG8_LAS unsigned char*)lds_dyn_ + RSTD_ID_OFF) + wid;
    PG8_LAS float* rv = (PG8_LAS float*)((PG8_LAS unsigned char*)lds_dyn_ + RSTD_OFF) + wid * 128;
    const unsigned want = ((unsigned)(slot + 1) << 16) | (unsigned)(pm + 1);
    if ((unsigned)__builtin_amdgcn_readfirstlane(*idw) != want) {
#pragma unroll
        for (int j = 0; j < 2; ++j) { const int row = pm * BM + HALF * j + 64 * wr + lane; const PG8_GAS f32x4* pp = (const PG8_GAS f32x4*)(ssq + (size_t)row * 32); float t = 0.f;
#pragma unroll
            for (int q = 0; q < 8; ++q) { const f32x4 a = pp[q]; t += (a[0] + a[1]) + (a[2] + a[3]); }
            rv[64 * j + lane] = 1.0f / sqrtf(t * (1.0f / 2048.0f) + 1e-6f); }
        if (lane == 0) *idw = want;
        asm volatile("s_waitcnt lgkmcnt(0)" ::: "memory");
    }
    return rv;
}
__device__ __forceinline__ float silu_mul(float g, float u) {
    const float e = __builtin_amdgcn_exp2f(-1.4426950408889634f * g);
    return g * __builtin_amdgcn_rcpf(1.0f + e) * u;
}
struct EpiSwiGLU {
    static constexpr bool PERM = true, AFTER_DRAIN = false, MID = false; static constexpr int ID = 0;
    int slot;
    __device__ __forceinline__ void operator()(const f32x4 (&acc)[2][2][4][2], const Unit& u, int wr, int wc, int fr, int fq) const {
        PG8_GAS unsigned char* w = (PG8_GAS unsigned char*)tab_ptr(22); PG8_GAS bf16_t* O = (PG8_GAS bf16_t*)(w + WS_ACT); constexpr int ldc = FF; const PG8_GAS float* ssq = (const PG8_GAS float*)(w + WS_SSQ) + (size_t)slot * M_REAL * 32;
        const int row0 = u.pm * BM + wr * 64 + fr, col0 = u.pn * HALF + wc * 32 + 8 * fq;
        const PG8_LAS float* rv = ensure_rstd(ssq, slot, u.pm, wr * 4 + wc, wr, fr + 16 * fq);
        float rs[2][4];
#pragma unroll
        for (int ai = 0; ai < 2; ++ai)
#pragma unroll
            for (int m = 0; m < 4; ++m) rs[ai][m] = rv[64 * ai + 16 * m + fr];
#pragma unroll
        for (int ai = 0; ai < 2; ++ai)
#pragma unroll
            for (int m = 0; m < 4; ++m) { PG8_GAS bf16_t* rowp = O + (size_t)(row0 + ai * HALF + m * 16) * ldc + col0;
                const float r = rs[ai][m];
                const f32x4 g0 = acc[ai][0][m][0] * r, g1 = acc[ai][0][m][1] * r, u0 = acc[ai][1][m][0] * r, u1 = acc[ai][1][m][1] * r;
                u32x4 w; w.x = cvt_pk_bf16(silu_mul(g0[0], u0[0]), silu_mul(g0[1], u0[1])); w.y = cvt_pk_bf16(silu_mul(g0[2], u0[2]), silu_mul(g0[3], u0[3]));
                w.z = cvt_pk_bf16(silu_mul(g1[0], u1[0]), silu_mul(g1[1], u1[1])); w.w = cvt_pk_bf16(silu_mul(g1[2], u1[2]), silu_mul(g1[3], u1[3]));
                *(PG8_GAS u32x4*)rowp = w; }
    }
};
struct EpiResAdd {
    static constexpr bool PERM = true, AFTER_DRAIN = false, MID = false; static constexpr int ID = 1;
    float scale; int slot; int fin;
    __device__ __forceinline__ void operator()(const f32x4 (&acc)[2][2][4][2], const Unit& u, int wr, int wc, int fr, int fq) const {
        PG8_GAS unsigned char* w = (PG8_GAS unsigned char*)tab_ptr(22); PG8_GAS bf16_t* hb = (PG8_GAS bf16_t*)(w + WS_HB); PG8_GAS float* out = (PG8_GAS float*)tab_ptr(21);
        PG8_GAS float* ssq = (PG8_GAS float*)(w + WS_SSQ) + (size_t)slot * M_REAL * 32; constexpr int ldc = D;
        const int row0 = u.pm * BM + wr * 64 + fr, col0 = u.pn * BM + wc * 32 + 8 * fq;
        u32x4 bs[2][4][2];
#pragma unroll
        for (int ai = 0; ai < 2; ++ai)
#pragma unroll
            for (int m = 0; m < 4; ++m)
#pragma unroll
                for (int bj = 0; bj < 2; ++bj) bs[ai][m][bj] = *(const PG8_GAS u32x4*)(hb + (size_t)(row0 + ai * HALF + m * 16) * ldc + col0 + bj * HALF);
#pragma unroll
        for (int ai = 0; ai < 2; ++ai)
#pragma unroll
            for (int m = 0; m < 4; ++m) { float ss = 0.f; const size_t off = (size_t)(row0 + ai * HALF + m * 16) * ldc + col0;
#pragma unroll
                for (int bj = 0; bj < 2; ++bj) { const u32x4 b = bs[ai][m][bj]; const unsigned bw[4] = {b.x, b.y, b.z, b.w}; float v[8];
#pragma unroll
                    for (int e = 0; e < 4; ++e) { v[2 * e] = __builtin_bit_cast(float, bw[e] << 16) + scale * acc[ai][bj][m][e >> 1][(2 * e) & 3]; v[2 * e + 1] = __builtin_bit_cast(float, bw[e] & 0xffff0000u) + scale * acc[ai][bj][m][e >> 1][(2 * e + 1) & 3]; }
                    if (fin) { *(PG8_GAS f32x4*)(out + off + bj * HALF) = (f32x4){v[0], v[1], v[2], v[3]}; *(PG8_GAS f32x4*)(out + off + bj * HALF + 4) = (f32x4){v[4], v[5], v[6], v[7]}; }
                    else { u32x4 wv; wv.x = cvt_pk_bf16(v[0], v[1]); wv.y = cvt_pk_bf16(v[2], v[3]); wv.z = cvt_pk_bf16(v[4], v[5]); wv.w = cvt_pk_bf16(v[6], v[7]); *(PG8_GAS u32x4*)(hb + off + bj * HALF) = wv;
                        const unsigned ww[4] = {wv.x, wv.y, wv.z, wv.w};
#pragma unroll
                        for (int e = 0; e < 4; ++e) { const float lo = __builtin_bit_cast(float, ww[e] << 16), hi2 = __builtin_bit_cast(float, ww[e] & 0xffff0000u); ss += lo * lo + hi2 * hi2; } } }
                if (!fin) { ss += shx<16>(ss); ss += shx<32>(ss);
                    if (fq == 0) ssq[(size_t)(row0 + ai * HALF + m * 16) * 32 + u.pn * 4 + wc] = ss; } }
    }
};
__device__ __forceinline__ void ensure_rstd_o(const PG8_GAS float* ssqo, int slot, int pm, int wid, int wr, int lane, const PG8_LAS float*& rs_out, const PG8_LAS float*& ratio_out) {
    extern __shared__ __attribute__((aligned(16))) unsigned char lds_dyn_[];
    volatile PG8_LAS unsigned* idw = (volatile PG8_LAS unsigned*)((PG8_LAS unsigned char*)lds_dyn_ + RSTD_ID_OFF) + wid;
    PG8_LAS float* rv = (PG8_LAS float*)((PG8_LAS unsigned char*)lds_dyn_ + RSTD_OFF) + wid * 128;
    PG8_LAS float* rq = (PG8_LAS float*)((PG8_LAS unsigned char*)lds_dyn_ + RSTD2_OFF) + wid * 128;
    const unsigned want = ((0x4000u | (unsigned)(slot + 1)) << 16) | (unsigned)(pm + 1);
    if ((unsigned)__builtin_amdgcn_readfirstlane(*idw) != want) {
#pragma unroll
        for (int j = 0; j < 2; ++j) { const int row = pm * BM + HALF * j + 64 * wr + lane; const PG8_GAS f32x4* pp = (const PG8_GAS f32x4*)(ssqo + (size_t)row * 32); float tf = 0.f, ts = 0.f;
#pragma unroll
            for (int q = 0; q < 4; ++q) { const f32x4 a = pp[q], b = pp[4 + q]; tf += (a[0] + a[1]) + (a[2] + a[3]); ts += (b[0] + b[1]) + (b[2] + b[3]); }
            const float rf = 1.0f / sqrtf(tf * (1.0f / 1024.0f) + 1e-6f), rs = 1.0f / sqrtf(ts * (1.0f / 1024.0f) + 1e-6f);
            rv[64 * j + lane] = rs; rq[64 * j + lane] = rf / rs; }
        if (lane == 0) *idw = want;
        asm volatile("s_waitcnt lgkmcnt(0)" ::: "memory");
    }
    rs_out = rv; ratio_out = rq;
}
struct EpiOut {
    static constexpr bool PERM = true, AFTER_DRAIN = false, MID = true; static constexpr int ID = 3;
    int slot;
    __device__ __forceinline__ void mid(f32x4 (&acc)[2][2][4][2], const Unit& u, int wr, int wc, int fr, int fq) const {
        PG8_GAS unsigned char* w = (PG8_GAS unsigned char*)tab_ptr(22); const PG8_LAS float *rs, *rq; ensure_rstd_o((const PG8_GAS float*)(w + WS_SSQO), slot, u.pm, wr * 4 + wc, wr, fr + 16 * fq, rs, rq);
#pragma unroll
        for (int ai = 0; ai < 2; ++ai)
#pragma unroll
            for (int m = 0; m < 4; ++m) { const float q = rq[64 * ai + 16 * m + fr];
#pragma unroll
                for (int bj = 0; bj < 2; ++bj)
#pragma unroll
                    for (int n = 0; n < 2; ++n) acc[ai][bj][m][n] = acc[ai][bj][m][n] * q; }
    }
    __device__ __forceinline__ void operator()(const f32x4 (&acc)[2][2][4][2], const Unit& u, int wr, int wc, int fr, int fq) const {
        PG8_GAS unsigned char* w = (PG8_GAS unsigned char*)tab_ptr(22); PG8_GAS bf16_t* hb = (PG8_GAS bf16_t*)(w + WS_HB);
        PG8_GAS float* ssq = (PG8_GAS float*)(w + WS_SSQ) + (size_t)slot * M_REAL * 32; constexpr int ldc = D;
        const PG8_LAS float *rs, *rq; ensure_rstd_o((const PG8_GAS float*)(w + WS_SSQO), slot, u.pm, wr * 4 + wc, wr, fr + 16 * fq, rs, rq);
        const int row0 = u.pm * BM + wr * 64 + fr, col0 = u.pn * BM + wc * 32 + 8 * fq;
        u32x4 bs[2][4][2];
#pragma unroll
        for (int ai = 0; ai < 2; ++ai)
#pragma unroll
            for (int m = 0; m < 4; ++m)
#pragma unroll
                for (int bj = 0; bj < 2; ++bj) bs[ai][m][bj] = *(const PG8_GAS u32x4*)(hb + (size_t)(row0 + ai * HALF + m * 16) * ldc + col0 + bj * HALF);
#pragma unroll
        for (int ai = 0; ai < 2; ++ai)
#pragma unroll
            for (int m = 0; m < 4; ++m) { float ss = 0.f; const size_t off = (size_t)(row0 + ai * HALF + m * 16) * ldc + col0; const float scale = rs[64 * ai + 16 * m + fr];
#pragma unroll
                for (int bj = 0; bj < 2; ++bj) { const u32x4 b = bs[ai][m][bj]; const unsigned bw[4] = {b.x, b.y, b.z, b.w}; float v[8];
#pragma unroll
                    for (int e = 0; e < 4; ++e) { v[2 * e] = __builtin_bit_cast(float, bw[e] << 16) + scale * acc[ai][bj][m][e >> 1][(2 * e) & 3]; v[2 * e + 1] = __builtin_bit_cast(float, bw[e] & 0xffff0000u) + scale * acc[ai][bj][m][e >> 1][(2 * e + 1) & 3]; }
                    u32x4 wv; wv.x = cvt_pk_bf16(v[0], v[1]); wv.y = cvt_pk_bf16(v[2], v[3]); wv.z = cvt_pk_bf16(v[4], v[5]); wv.w = cvt_pk_bf16(v[6], v[7]); *(PG8_GAS u32x4*)(hb + off + bj * HALF) = wv;
                    const unsigned ww[4] = {wv.x, wv.y, wv.z, wv.w};
#pragma unroll
                    for (int e = 0; e < 4; ++e) { const float lo = __builtin_bit_cast(float, ww[e] << 16), hi2 = __builtin_bit_cast(float, ww[e] & 0xffff0000u); ss += lo * lo + hi2 * hi2; } }
                ss += shx<16>(ss); ss += shx<32>(ss);
                if (fq == 0) ssq[(size_t)(row0 + ai * HALF + m * 16) * 32 + u.pn * 4 + wc] = ss; }
    }
};
struct EpiInProj {
    static constexpr bool PERM = true, AFTER_DRAIN = false, MID = false; static constexpr int ID = 2;
    int ll, slot; float qscale;
    __device__ __forceinline__ void operator()(const f32x4 (&acc)[2][2][4][2], const Unit& u, int wr, int wc, int fr, int fq) const {
        PG8_GAS unsigned char* w = (PG8_GAS unsigned char*)tab_ptr(22); const PG8_GAS float* ssq = (const PG8_GAS float*)(w + WS_SSQ) + (size_t)slot * M_REAL * 32;
        PG8_GAS bf16_t *fq_ = (PG8_GAS bf16_t*)(w + WS_FQ), *fk_ = (PG8_GAS bf16_t*)(w + WS_FK), *fv_ = (PG8_GAS bf16_t*)(w + WS_FV), *sq_ = (PG8_GAS bf16_t*)(w + WS_SQ), *sk_ = (PG8_GAS bf16_t*)(w + WS_SK), *sv_ = (PG8_GAS bf16_t*)(w + WS_SV); PG8_GAS float* logf = (PG8_GAS float*)(w + WS_LOGF);
        const PG8_GAS float *g_fq = (const PG8_GAS float*)tab_ptr(9) + ll * HD, *g_fk = (const PG8_GAS float*)tab_ptr(10) + ll * HD, *g_sq = (const PG8_GAS float*)tab_ptr(11) + ll * HD, *g_sk = (const PG8_GAS float*)tab_ptr(12) + ll * HD, *bfg = (const PG8_GAS float*)tab_ptr(8) + ll * NH;
        const int row0 = u.pm * BM + wr * 64 + fr, pn = u.pn;
        if (pn == 17 && wc != 0) return;
        const PG8_LAS float* rv = ensure_rstd(ssq, slot, u.pm, wr * 4 + wc, wr, fr + 16 * fq);
        float rs[2][4];
#pragma unroll
        for (int ai = 0; ai < 2; ++ai)
#pragma unroll
            for (int m = 0; m < 4; ++m) rs[ai][m] = rv[64 * ai + 16 * m + fr];
        if (pn == 17) {
            if (wc != 0) return;
            if (fq < 2) {
                const f32x4 b0 = *(const PG8_GAS f32x4*)(bfg + 8 * fq), b1 = *(const PG8_GAS f32x4*)(bfg + 8 * fq + 4);
#pragma unroll
                for (int ai = 0; ai < 2; ++ai)
#pragma unroll
                    for (int m = 0; m < 4; ++m) { PG8_GAS float* rowp = logf + (size_t)(row0 + ai * HALF + m * 16) * 16 + 8 * fq;
#pragma unroll
                        for (int n = 0; n < 2; ++n) { f32x4 t = acc[ai][0][m][n] * rs[ai][m] + (n ? b1 : b0), o;
#pragma unroll
                            for (int j = 0; j < 4; ++j) o[j] = fminf(t[j], 0.f) - 0.69314718056f * __builtin_amdgcn_logf(1.0f + __builtin_amdgcn_exp2f(-1.4426950408889634f * fabsf(t[j])));
                            *(PG8_GAS f32x4*)(rowp + 4 * n) = o; } }
            }
            return;
        }
        PG8_GAS bf16_t* dst; int pitch, head, knh = 0; const PG8_GAS float* gain = nullptr; float sc = 1.f;
        if (pn < 16) { const int seg = pn >> 2; head = (pn & 3) * 4 + wc; pitch = 1024;
            if (seg == 0) { dst = fq_; gain = g_fq; sc = qscale; } else if (seg == 1) { dst = fk_; gain = g_fk; knh = 16; } else if (seg == 2) { dst = fv_; } else { dst = sq_; gain = g_sq; sc = qscale; } }
        else { pitch = 128; head = wc & 1; if (wc < 2) { dst = sk_; gain = g_sk; knh = 2; } else { dst = sv_; } }
        const int col0 = head * 64 + 8 * fq;
        if (gain) {
            f32x4 gv[2][2];
#pragma unroll
            for (int bj = 0; bj < 2; ++bj)
#pragma unroll
                for (int n = 0; n < 2; ++n) gv[bj][n] = *(const PG8_GAS f32x4*)(gain + 32 * bj + 8 * fq + 4 * n) * sc;
#pragma unroll
            for (int ai = 0; ai < 2; ++ai)
#pragma unroll
                for (int m = 0; m < 4; ++m) {
                    float ss = 0.f;
#pragma unroll
                    for (int bj = 0; bj < 2; ++bj)
#pragma unroll
                        for (int n = 0; n < 2; ++n) { const f32x4 x = acc[ai][bj][m][n]; ss += (x[0] * x[0] + x[1] * x[1]) + (x[2] * x[2] + x[3] * x[3]); }
                    ss += shx<16>(ss); ss += shx<32>(ss);
                    const float rinv = rs[ai][m] / sqrtf(ss * (1.0f / 64.0f) * rs[ai][m] * rs[ai][m] + 1e-6f);
                    const int row = row0 + ai * HALF + m * 16;
                    PG8_GAS bf16_t* rowp = dst + (size_t)row * pitch + col0;
#pragma unroll
                    for (int bj = 0; bj < 2; ++bj) { const f32x4 v0 = acc[ai][bj][m][0] * rinv * gv[bj][0], v1 = acc[ai][bj][m][1] * rinv * gv[bj][1];
                        u32x4 w; w.x = cvt_pk_bf16(v0[0], v0[1]); w.y = cvt_pk_bf16(v0[2], v0[3]); w.z = cvt_pk_bf16(v1[0], v1[1]); w.w = cvt_pk_bf16(v1[2], v1[3]);
                        if (knh) *(PG8_GAS u32x4*)(dst + kfrag_idx(row, knh, head, 32 * bj + 8 * fq)) = w;
                        else *(PG8_GAS u32x4*)(rowp + 32 * bj) = w; }
                }
        } else {
#pragma unroll
            for (int ai = 0; ai < 2; ++ai)
#pragma unroll
                for (int m = 0; m < 4; ++m) { const int row = row0 + ai * HALF + m * 16; const int vnh = (pn < 16) ? 16 : 2;
#pragma unroll
                    for (int bj = 0; bj < 2; ++bj) { const f32x4 v0 = acc[ai][bj][m][0] * rs[ai][m], v1 = acc[ai][bj][m][1] * rs[ai][m];
                        const unsigned wv[4] = {cvt_pk_bf16(v0[0], v0[1]), cvt_pk_bf16(v0[2], v0[3]), cvt_pk_bf16(v1[0], v1[1]), cvt_pk_bf16(v1[2], v1[3])};
                        PG8_GAS bf16_t* vp = dst + vfrag_idx(row, vnh, head, 32 * bj + 8 * fq);
#pragma unroll
                        for (int e = 0; e < 4; ++e) { vp[16 * e] = (bf16_t)(wv[e] & 0xffffu); vp[16 * e + 8] = (bf16_t)(wv[e] >> 16); } } }
        }
    }
};

}

#define XB_TMO      128
#define XB_XCNT(j)  (256  + 64 * (j))
#define XB_XSUB(j)  (1280 + 64 * (j))
#define XB_XGEN(j)  (2304 + 64 * (j))
#define XB_TOP      3328
#define XB_TOPGEN   3392
#define XCD_BAR_WORDS 3456
#define XB_SPIN_CAP (1u << 18)
__device__ __forceinline__ unsigned xb_ld(unsigned* p)              { return __hip_atomic_load(p, __ATOMIC_RELAXED, __HIP_MEMORY_SCOPE_AGENT); }
__device__ __forceinline__ unsigned xb_add(unsigned* p, unsigned v) { return __hip_atomic_fetch_add(p, v, __ATOMIC_RELAXED, __HIP_MEMORY_SCOPE_AGENT); }
__device__ __forceinline__ unsigned xb_xcc_id() { return (unsigned)__builtin_amdgcn_s_getreg((3 << 11) | 20) & 0xFu; }
#define XB_SPIN(cond, bar) do { unsigned _sp = 0; while (cond) { __builtin_amdgcn_s_sleep(1); \
    if ((++_sp & 255u) == 0u) { if (xb_ld(&(bar)[XB_TMO])) break; if (_sp > XB_SPIN_CAP) { atomicAdd(&(bar)[XB_TMO], 1u); break; } } } } while (0)
struct XcdBarrier { unsigned* bar; unsigned x; volatile LAS unsigned* st; };
__device__ __forceinline__ XcdBarrier xcd_barrier_post(unsigned* bar, volatile LAS unsigned* st) {
    XcdBarrier b; b.bar = bar; b.x = xb_xcc_id(); b.st = st;
    if (threadIdx.x == 0) (void)xb_add(&bar[XB_XCNT(b.x)], 1u);
    return b;
}
__device__ __forceinline__ void xcd_barrier_complete(unsigned* bar, unsigned x, unsigned& nloc, unsigned& nx) {
    const unsigned G = gridDim.x * gridDim.y * gridDim.z;
    unsigned sum, cnt, mine, sp = 0u;
    for (;;) {
        sum = 0u; cnt = 0u; mine = 0u;
#pragma unroll
        for (unsigned j = 0; j < 16; ++j) { const unsigned c = xb_ld(&bar[XB_XCNT(j)]); sum += c; cnt += (c > 0u) ? 1u : 0u; mine = (j == x) ? c : mine; }
        if (sum == G) break;
        __builtin_amdgcn_s_sleep(1);
        if ((++sp & 255u) == 0u) { if (xb_ld(&bar[XB_TMO])) break; if (sp > XB_SPIN_CAP) { atomicAdd(&bar[XB_TMO], 1u); break; } }
    }
    nloc = mine > 0u ? mine : 1u; nx = cnt > 0u ? cnt : 1u;
}
__device__ __forceinline__ void xcd_barrier(const XcdBarrier& b) {
    asm volatile("s_waitcnt vmcnt(0)" ::: "memory");
    __syncthreads();
    if (my_tid() == 0) {
        unsigned* bar = b.bar;
        __builtin_amdgcn_s_waitcnt(0);
        unsigned nloc = b.st[0], nx = b.st[1];
        if (nloc == 0u) { xcd_barrier_complete(bar, b.x, nloc, nx); b.st[0] = nloc; b.st[1] = nx; }
        const unsigned old = xb_add(&bar[XB_XSUB(b.x)], 1u);
        const unsigned gen = old / nloc;
        if (old + 1u == (gen + 1u) * nloc) {
            __builtin_amdgcn_fence(__ATOMIC_RELEASE, "agent");
            asm volatile("s_waitcnt vmcnt(0)" ::: "memory");
            const unsigned og = xb_add(&bar[XB_TOP], 1u);
            const unsigned tg = og / nx;
            if (og + 1u == (tg + 1u) * nx) xb_add(&bar[XB_TOPGEN], 1u);
            else XB_SPIN(xb_ld(&bar[XB_TOPGEN]) == tg, bar);
            __builtin_amdgcn_fence(__ATOMIC_ACQUIRE, "agent");
            xb_add(&bar[XB_XGEN(b.x)], 1u);
            asm volatile("s_waitcnt vmcnt(0)" ::: "memory");
        } else {
            XB_SPIN(xb_ld(&bar[XB_XGEN(b.x)]) == gen, bar);
            __builtin_amdgcn_fence(__ATOMIC_ACQUIRE, "agent");
            asm volatile("s_waitcnt vmcnt(0)" ::: "memory");
        }
    }
    __syncthreads();
}

struct Frame {
    LAS unsigned char* lds;
    volatile LAS unsigned* MISC;
    int tid, lane, wave;
    int vcu, G;
    unsigned char* ws;
};
__device__ __forceinline__ int launder_u(int x) { asm volatile("" : "+v"(x)); return __builtin_amdgcn_readfirstlane(x); }
#define LAUNDER_S(x) ((x) = launder_u(x))
__device__ __forceinline__ const float* inptr(const Frame& F, int k) {
    const volatile LAS unsigned* t = (const volatile LAS unsigned*)(F.lds + PTR_OFF);
    const unsigned lo = __builtin_amdgcn_readfirstlane(t[2 * k]), hi = __builtin_amdgcn_readfirstlane(t[2 * k + 1]);
    return (const float*)(((unsigned long long)hi << 32) | lo);
}
__device__ __forceinline__ unsigned char* wsl(const Frame& F) { const unsigned long long p = (unsigned long long)F.ws; const unsigned lo = (unsigned)launder_u((int)(unsigned)p), hi = (unsigned)launder_u((int)(unsigned)(p >> 32)); return (unsigned char*)(((unsigned long long)hi << 32) | lo); }
__device__ __forceinline__ Frame make_frame() {
    extern __shared__ __attribute__((aligned(16))) unsigned char lds_dyn_[];
    Frame F;
    F.lds = (LAS unsigned char*)lds_dyn_;
    F.MISC = (volatile LAS unsigned*)(F.lds + MISC_OFF);
    int t = my_tid(); asm volatile("" : "+v"(t));
    F.tid = t; F.lane = t & 63; F.wave = __builtin_amdgcn_readfirstlane(t >> 6);
    const int g = launder_u((int)gridDim.x), bx = launder_u((int)blockIdx.x);
    F.G = g; F.vcu = (g % 8 == 0) ? (bx % 8) * (g / 8) + bx / 8 : bx;
    F.ws = (unsigned char*)pg8::tab_ptr(22);
    return F;
}
__device__ __forceinline__ float wave_sum(float v) {
    XSUM64(v);
    return v;
}

constexpr int TP_PITCH = 144;
__device__ __forceinline__ void transpose_item64(const float* Wf, int Nsrc, int ca, int nva, int cb, int nvb, int K, bf16* WTf, int drow0, int k0, LAS unsigned char* scr, int lane, const float* gainf = nullptr) {
    const GAS float* W = (const GAS float*)Wf; GAS bf16* WT = (GAS bf16*)WTf;
    const int sub = (lane >> 3) & 1, c4 = 4 * (lane & 7), g = lane >> 4, nl = 32 * sub + c4;
    const bool ok = c4 < (sub ? nvb : nva);
    const GAS float* src = W + (size_t)(k0 + 2 * g) * Nsrc + (sub ? cb : ca) + c4;
    f32x4 v[16];
#pragma unroll
    for (int i = 0; i < 16; ++i) v[i] = ok ? *(const GAS f32x4*)(src + (size_t)(8 * (i >> 1) + (i & 1)) * Nsrc) : (f32x4){0.f, 0.f, 0.f, 0.f};
    if (gainf) { const GAS float* gp = (const GAS float*)gainf + k0 + 2 * g;
#pragma unroll
        for (int i = 0; i < 16; ++i) v[i] = v[i] * gp[8 * (i >> 1) + (i & 1)]; }
#pragma unroll
    for (int m = 0; m < 8; ++m)
#pragma unroll
        for (int j = 0; j < 4; ++j) *(LAS unsigned*)(scr + (nl + j) * TP_PITCH + (8 * m + 2 * g) * 2) = pk2(v[2 * m][j], v[2 * m + 1][j]);
    LDS_WAIT(); asm volatile("" ::: "memory");
#pragma unroll
    for (int t = 0; t < 8; ++t) { const int id = lane + 64 * t, n = id >> 3, c = id & 7;
        const v4u o = *(const LAS v4u*)(scr + n * TP_PITCH + 16 * c);
        *(GAS v4u*)(WT + (size_t)(drow0 + n) * K + k0 + 8 * c) = o; }
    LDS_WAIT(); asm volatile("" ::: "memory");
}
constexpr int IT_GU = (D / 64) * (N_GU / 64), IT_D = (FF / 64) * (D / 64), IT_IN = (D / 64) * (N_IN / 64), IT_OUT = (D / 64) * (D / 64);
constexpr int IT_LAYER = 2 * IT_GU + 2 * IT_D + IT_IN + IT_OUT;
__device__ __forceinline__ void conv_gu(const float* Wg, const float* Wu, bf16* WT, int r, LAS unsigned char* scr, int lane, const float* gain) {
    constexpr int nrg = N_GU / 64; const int kb = r / nrg, rg = r % nrg, p = rg >> 2, q = rg & 3; const int c0 = 128 * p + 64 * (q & 1);
    transpose_item64(q < 2 ? Wg : Wu, FF, c0, 32, c0 + 32, 32, D, WT, 64 * rg, 64 * kb, scr, lane, gain);
}
__device__ __forceinline__ void conv_plain(const float* W, int K, int N, bf16* WT, int r, LAS unsigned char* scr, int lane, const float* gain_lo = nullptr, const float* gain_hi = nullptr) {
    const int nrg = N / 64, kb = r / nrg, rg = r % nrg;
    const float* gain = gain_lo ? (64 * kb < 1024 ? gain_lo : gain_hi - 1024) : nullptr;
    transpose_item64(W, N, 64 * rg, 32, 64 * rg + 32, 32, K, WT, 64 * rg, 64 * kb, scr, lane, gain);
}
__device__ __forceinline__ int in_src_col(int pn, int wc, int bj) {
    if (pn < 16) { const int seg = pn >> 2, base = seg == 0 ? 0 : seg == 1 ? 1024 : seg == 2 ? 2048 : 3088; return base + 256 * (pn & 3) + 64 * wc + 32 * bj; }
    return (wc < 2 ? 4112 + 64 * wc : 4240 + 64 * (wc - 2)) + 32 * bj;
}
__device__ __forceinline__ void conv_in(const float* W, bf16* WT, int r, LAS unsigned char* scr, int lane, const float* gain) {
    constexpr int nrg = N_IN / 64; const int kb = r / nrg, rg = r % nrg, pn = rg >> 2, q = rg & 3, bj = q >> 1, wc0 = 2 * (q & 1);
    int ca, cb, nva = 32, nvb = 32;
    if (pn < 17) { ca = in_src_col(pn, wc0, bj); cb = in_src_col(pn, wc0 + 1, bj); }
    else { ca = 3072; cb = 3072; nva = (q == 0) ? 16 : 0; nvb = 0; }
    transpose_item64(W, IN_W, ca, nva, cb, nvb, D, WT, 64 * rg, 64 * kb, scr, lane, gain);
}
__device__ __forceinline__ void convert_item(Frame& F, unsigned char* w, int l, int r, LAS unsigned char* scr) {
    unsigned char* wl = w + WS_W + (size_t)l * LW_STRIDE;
    if (r < IT_GU) { conv_gu(inptr(F, 3) + (size_t)l * D * FF, inptr(F, 4) + (size_t)l * D * FF, (bf16*)(wl + LW_GU1), r, scr, F.lane, inptr(F, 2) + (size_t)l * D); return; } r -= IT_GU;
    if (r < IT_D) { conv_plain(inptr(F, 5) + (size_t)l * FF * D, FF, D, (bf16*)(wl + LW_D1), r, scr, F.lane); return; } r -= IT_D;
    if (r < IT_IN) { conv_in(inptr(F, 7) + (size_t)l * D * IN_W, (bf16*)(wl + LW_IN), r, scr, F.lane, inptr(F, 6) + (size_t)l * D); return; } r -= IT_IN;
    if (r < IT_OUT) { conv_plain(inptr(F, 16) + (size_t)l * D * D, D, D, (bf16*)(wl + LW_OUT), r, scr, F.lane, inptr(F, 14) + (size_t)l * 1024, inptr(F, 15) + (size_t)l * 1024); return; } r -= IT_OUT;
    if (r < IT_GU) { conv_gu(inptr(F, 18) + (size_t)l * D * FF, inptr(F, 19) + (size_t)l * D * FF, (bf16*)(wl + LW_GU2), r, scr, F.lane, inptr(F, 17) + (size_t)l * D); return; } r -= IT_GU;
    conv_plain(inptr(F, 20) + (size_t)l * FF * D, FF, D, (bf16*)(wl + LW_D2), r, scr, F.lane);
}
#define IDLE_CONV_K 4
constexpr int R_IDLE = IDLE_CONV_K * 128 * NWAVES, GU2_BASE = IT_GU + IT_D + IT_IN + IT_OUT;
static_assert(R_IDLE <= IT_GU, "idle-slot items are SwiGLU-2 items");
__device__ __forceinline__ void convert_layer(Frame& F, unsigned char* w, int l) {
    LAS unsigned char* scr = F.lds + RING_OFF + F.wave * 16384;
    const int gw = F.vcu * NWAVES + F.wave, NGW = F.G * NWAVES;
    if (F.G == 256) { for (int q = gw; q < IT_LAYER - R_IDLE; q += NGW) convert_item(F, w, l, q < GU2_BASE ? q : q + R_IDLE, scr); }
    else for (int r = gw; r < IT_LAYER; r += NGW) convert_item(F, w, l, r, scr);
}
__device__ __forceinline__ void p0_prologue(Frame& F) {
    const int gw = F.vcu * NWAVES + F.wave, NGW = F.G * NWAVES;
    unsigned char* w = wsl(F);
    for (int l = 0; l < (OVERLAP_CONV ? 1 : DEPTH); ++l) convert_layer(F, w, l);
    const GAS float* x = (const GAS float*)inptr(F, 0); const GAS float* meta = (const GAS float*)inptr(F, 1);
    GAS bf16* HB = (GAS bf16*)(w + WS_HB); GAS float* SSQ0 = (GAS float*)(w + WS_SSQ); GAS float* SSQM0 = (GAS float*)(w + WS_SSQM);
    for (int m = gw; m < M_REAL + NMETA; m += NGW) {
        const int row = m < M_REAL ? m : META_ROW + (m - M_REAL);
        GAS unsigned long long* hb8 = (GAS unsigned long long*)(HB + (size_t)row * D) + F.lane;
        const GAS f32x4* xr = (const GAS f32x4*)(m < M_REAL ? x + (size_t)m * D : meta + (size_t)(m - M_REAL) * D) + F.lane;
        float ss = 0.f;
#pragma unroll
        for (int j = 0; j < 8; ++j) { const f32x4 v = xr[64 * j]; const unsigned w0 = pk2(v.x, v.y), w1 = pk2(v.z, v.w); hb8[64 * j] = (unsigned long long)w0 | ((unsigned long long)w1 << 32);
            const float a0 = __builtin_bit_cast(float, w0 << 16), a1 = __builtin_bit_cast(float, w0 & 0xffff0000u), a2 = __builtin_bit_cast(float, w1 << 16), a3 = __builtin_bit_cast(float, w1 & 0xffff0000u);
            ss += (a0 * a0 + a1 * a1) + (a2 * a2 + a3 * a3); }
        ss = wave_sum(ss);
        if (m < M_REAL) { if (F.lane < 32) SSQ0[(size_t)m * 32 + F.lane] = F.lane == 0 ? ss : 0.f; }
        else { SSQM0[(m - M_REAL) * 128 + F.lane] = F.lane == 0 ? ss : 0.f; SSQM0[(m - M_REAL) * 128 + 64 + F.lane] = 0.f; }
    }
    if (gw < 48) { const int row = META_BLK0 + 64 + gw; const v4u z = (v4u){0u, 0u, 0u, 0u};
#pragma unroll
        for (int j = 0; j < 2; ++j) { ((GAS v4u*)(w + WS_FQ + (size_t)row * 2048))[F.lane + 64 * j] = z;
            ((GAS v4u*)(w + WS_SQ + (size_t)row * 2048))[F.lane + 64 * j] = z; } }
    {
        const v4u z = (v4u){0u, 0u, 0u, 0u}; constexpr int RB = (META_BLK0 + 64) >> 5;
        GAS v4u* fk = (GAS v4u*)((GAS bf16*)(w + WS_FK) + (size_t)RB * 16 * 2048); GAS v4u* sk = (GAS v4u*)((GAS bf16*)(w + WS_SK) + (size_t)RB * 2 * 2048);
        for (int i = gw * 64 + F.lane; i < 2 * 16 * 256; i += NGW * 64) fk[i] = z;
        for (int i = gw * 64 + F.lane; i < 2 * 2 * 256; i += NGW * 64) sk[i] = z;
        constexpr int G16 = (META_BLK0 + 64) >> 4;
        GAS v4u* fv = (GAS v4u*)((GAS bf16*)(w + WS_FV) + (size_t)G16 * 16 * 1024); GAS v4u* sv = (GAS v4u*)((GAS bf16*)(w + WS_SV) + (size_t)G16 * 2 * 1024);
        for (int i = gw * 64 + F.lane; i < 4 * 16 * 128; i += NGW * 64) fv[i] = z;
        for (int i = gw * 64 + F.lane; i < 4 * 2 * 128; i += NGW * 64) sv[i] = z; }
}
__device__ __forceinline__ void onorm_phase(Frame& F, const float* gf, const float* gs) {
    const int gw = F.vcu * NWAVES + F.wave, NGW = F.G * NWAVES;
    unsigned char* w = wsl(F); const GAS bf16* O = (const GAS bf16*)(w + WS_O); GAS bf16* XN = (GAS bf16*)(w + WS_XN);
    for (int mm = gw; mm < M_REAL + NMETA; mm += NGW) {
        const int m = mm < M_REAL ? mm : META_ROW + (mm - M_REAL);
        const GAS v4u* orow = (const GAS v4u*)(O + (size_t)m * D) + F.lane;
        GAS v4u* xrow = (GAS v4u*)(XN + (size_t)m * D) + F.lane;
        float x[4][8]; float sf = 0.f, ss = 0.f;
#pragma unroll
        for (int j = 0; j < 4; ++j) { const v4u w = orow[64 * j]; const unsigned ww[4] = {w.x, w.y, w.z, w.w};
#pragma unroll
            for (int e = 0; e < 4; ++e) { x[j][2 * e] = __builtin_bit_cast(float, ww[e] << 16); x[j][2 * e + 1] = __builtin_bit_cast(float, ww[e] & 0xffff0000u); }
            float q = 0.f;
#pragma unroll
            for (int e = 0; e < 8; ++e) q += x[j][e] * x[j][e];
            if (j < 2) sf += q; else ss += q; }
        const float rf = 1.0f / sqrtf(wave_sum(sf) * (1.0f / 1024.f) + EPS), rs = 1.0f / sqrtf(wave_sum(ss) * (1.0f / 1024.f) + EPS);
#pragma unroll
        for (int j = 0; j < 4; ++j) { const float* gp = (j < 2 ? gf : gs) + (j & 1) * 512 + 8 * F.lane; const f32x4 g0 = *(const GAS f32x4*)gp, g1 = *(const GAS f32x4*)(gp + 4); const float r = j < 2 ? rf : rs;
            v4u w; w.x = pk2(x[j][0] * r * g0.x, x[j][1] * r * g0.y); w.y = pk2(x[j][2] * r * g0.z, x[j][3] * r * g0.w); w.z = pk2(x[j][4] * r * g1.x, x[j][5] * r * g1.y); w.w = pk2(x[j][6] * r * g1.z, x[j][7] * r * g1.w);
            xrow[64 * j] = w; }
    }
}

constexpr int SK_RED_OFF = 0, SK_TILE_OFF = 65536, SK_RSTD_OFF = SK_TILE_OFF + 4096;
template <class Epi, int NST  >
__device__ __forceinline__ void skinny_phase(Frame& F, const GAS bf16* A, int lda, const GAS bf16* Bt, int K, const Epi& E) {
    constexpr int TC = Epi::TC;
    int lane = F.lane; asm volatile("" : "+v"(lane));
    const int w = F.wave;
    LAS float* red = (LAS float*)(F.lds + RING_OFF + SK_RED_OFF);
    LAS float* tile = (LAS float*)(F.lds + RING_OFF + SK_TILE_OFF);
    const int k0 = w * (NST * 32);
    bool first = true;
    for (int task = F.G - 1 - (int)blockIdx.x; task < E.ntasks(); task += F.G) {
        pg8::f32x4 acc[TC];
        const GAS bf16* bp[TC];
#pragma unroll
        for (int c = 0; c < TC; ++c) { acc[c] = (pg8::f32x4){0.f, 0.f, 0.f, 0.f}; bp[c] = Bt + (size_t)(E.btrow(task, c) + (lane & 15)) * K + k0 + 8 * (lane >> 4); }
        const GAS bf16* ap = A + (size_t)(lane & 15) * lda + k0 + 8 * (lane >> 4);
        bf16x8 av[NST], bv[TC][NST];
#pragma unroll
        for (int j = 0; j < NST; ++j) { av[j] = *(const GAS bf16x8*)(ap + 32 * j);
#pragma unroll
            for (int c = 0; c < TC; ++c) bv[c][j] = *(const GAS bf16x8*)(bp[c] + 32 * j); }
        if (first) {
            if constexpr (Epi::KHALF_SCALE) {
                LAS float* rv = (LAS float*)(F.lds + RING_OFF + SK_RSTD_OFF);
#pragma unroll
                for (int j = 0; j < 2; ++j) { const int row = 2 * w + j; float t = lane < 32 ? E.ssqom[row * 32 + lane] : 0.f;
                    XSUM16(t);
                    if (lane == 0) rv[row] = 1.0f / sqrtf(t * (1.0f / 1024.0f) + EPS); if (lane == 16) rv[16 + row] = 1.0f / sqrtf(t * (1.0f / 1024.0f) + EPS); }
            }
            if constexpr (Epi::NEED_RSTD) {
                LAS float* rv = (LAS float*)(F.lds + RING_OFF + SK_RSTD_OFF);
#pragma unroll
                for (int j = 0; j < 2; ++j) { const int row = 2 * w + j; const float t = wave_sum(E.ssqm[row * 128 + lane] + E.ssqm[row * 128 + 64 + lane]); if (lane == 0) rv[row] = 1.0f / sqrtf(t * (1.0f / D) + EPS); }
            }
            first = false;
        }
#pragma unroll
        for (int j = 0; j < NST; ++j)
#pragma unroll
            for (int c = 0; c < TC; ++c) acc[c] = __builtin_amdgcn_mfma_f32_16x16x32_bf16(av[j], bv[c][j], acc[c], 0, 0, 0);
#pragma unroll
        for (int c = 0; c < TC; ++c)
#pragma unroll
            for (int r = 0; r < 4; ++r) red[((w * TC + c) * 4 + r) * 64 + lane] = acc[c][r];
        __syncthreads();
        for (int e = F.tid; e < TC * 256; e += NWAVES * 64) { float sum = 0.f, sum2 = 0.f;
#pragma unroll
            for (int w2 = 0; w2 < 4; ++w2) { sum += red[w2 * TC * 256 + e]; sum2 += red[(w2 + 4) * TC * 256 + e]; }
            const int ln = e & 63, r = (e >> 6) & 3, c = e >> 8, orow = (ln >> 4) * 4 + r;
            if constexpr (Epi::KHALF_SCALE) { const LAS float* rv = (const LAS float*)(F.lds + RING_OFF + SK_RSTD_OFF); sum = sum * rv[orow] + sum2 * rv[16 + orow]; } else sum += sum2;
            tile[orow * 64 + 16 * c + (ln & 15)] = sum; }
        __syncthreads();
        E.store(F, task, tile);
        if (task + F.G < E.ntasks()) __syncthreads();
    }
}
struct SkGU {
    static constexpr int TC = 4; static constexpr bool NEED_RSTD = true, KHALF_SCALE = false;
    GAS bf16* act; const GAS float* ssqm;
    __device__ __forceinline__ int ntasks() const { return FF / 32; }
    __device__ __forceinline__ int btrow(int t, int c) const { const int p = t >> 2, q = t & 3; return 256 * p + 128 * (c >> 1) + 32 * q + 16 * (c & 1); }
    __device__ __forceinline__ void store(Frame& F, int t, const LAS float* tile) const {
        const int row = F.tid >> 5, col = F.tid & 31; const float r = ((const LAS float*)(F.lds + RING_OFF + SK_RSTD_OFF))[row];
        act[(size_t)(META_ROW + row) * FF + 32 * t + col] = (bf16)f2bf(pg8::silu_mul(tile[row * 64 + col] * r, tile[row * 64 + 32 + col] * r));
    }
};
struct SkRes {
    static constexpr int TC = 1; static constexpr bool NEED_RSTD = false, KHALF_SCALE = false;
    float scale; GAS bf16* hb; GAS float* ssqm;
    __device__ __forceinline__ int ntasks() const { return D / 16; }
    __device__ __forceinline__ int btrow(int t, int) const { return 16 * t; }
    __device__ __forceinline__ void store(Frame& F, int t, const LAS float* tile) const {
        if (F.tid < 256) { const int row = F.tid >> 4, col = F.tid & 15; const size_t off = (size_t)(META_ROW + row) * D + 16 * t + col;
            const unsigned hbits = f2bf(bf2f(hb[off]) + scale * tile[row * 64 + col]); hb[off] = (bf16)hbits; const float v = bf2f((bf16)hbits); float ss = v * v;
            XSUM16(ss);
            if (col == 0) ssqm[row * 128 + t] = ss; }
    }
};
struct SkOut {
    static constexpr int TC = 1; static constexpr bool NEED_RSTD = false, KHALF_SCALE = true;
    float scale; GAS bf16* hb; GAS float* ssqm; const GAS float* ssqom;
    __device__ __forceinline__ int ntasks() const { return D / 16; }
    __device__ __forceinline__ int btrow(int t, int) const { return 16 * t; }
    __device__ __forceinline__ void store(Frame& F, int t, const LAS float* tile) const {
        if (F.tid < 256) { const int row = F.tid >> 4, col = F.tid & 15; const size_t off = (size_t)(META_ROW + row) * D + 16 * t + col;
            const unsigned hbits = f2bf(bf2f(hb[off]) + scale * tile[row * 64 + col]); hb[off] = (bf16)hbits; const float v = bf2f((bf16)hbits); float ss = v * v;
            XSUM16(ss);
            if (col == 0) ssqm[row * 128 + t] = ss; }
    }
};
struct SkIn {
    static constexpr int TC = 4; static constexpr bool NEED_RSTD = true, KHALF_SCALE = false;
    GAS bf16 *fq_, *fk_, *fv_, *sq_, *sk_, *sv_; GAS float* logf; const GAS float *g_fq, *g_fk, *g_sq, *g_sk, *bfg; float qscale; const GAS float* ssqm;
    __device__ __forceinline__ int ntasks() const { return 69; }
    __device__ __forceinline__ int btrow(int t, int c) const { if (t == 68) return 17 * 256 + 16 * c; const int pn = t < 64 ? (t >> 2) : 16, wc = t < 64 ? (t & 3) : (t - 64); return 256 * pn + 128 * (c >> 1) + 32 * wc + 16 * (c & 1); }
    __device__ __forceinline__ void store(Frame& F, int t, const LAS float* tile) const {
        if (t == 68) { if (F.tid < 256) { const int row = F.tid >> 4, hh = F.tid & 15; const float z = tile[row * 64 + hh] * ((const LAS float*)(F.lds + RING_OFF + SK_RSTD_OFF))[row] + bfg[hh];
                logf[(size_t)(META_ROW + row) * 16 + hh] = fminf(z, 0.f) - 0.69314718056f * __builtin_amdgcn_logf(1.0f + __builtin_amdgcn_exp2f(-LOG2E * fabsf(z))); } return; }
        const int pn = t < 64 ? (t >> 2) : 16, wc = t < 64 ? (t & 3) : (t - 64);
        GAS bf16* dst; int pitch, head, knh = 0; const GAS float* gain = nullptr; float sc = 1.f;
        if (pn < 16) { const int seg = pn >> 2; head = (pn & 3) * 4 + wc; pitch = 1024;
            if (seg == 0) { dst = fq_; gain = g_fq; sc = qscale; } else if (seg == 1) { dst = fk_; gain = g_fk; knh = 16; } else if (seg == 2) { dst = fv_; } else { dst = sq_; gain = g_sq; sc = qscale; } }
        else { pitch = 128; head = wc & 1; if (wc < 2) { dst = sk_; gain = g_sk; knh = 2; } else { dst = sv_; } }
        const int row = F.tid >> 5, cp = F.tid & 31; const float rr = ((const LAS float*)(F.lds + RING_OFF + SK_RSTD_OFF))[row];
        float v0 = tile[row * 64 + 2 * cp] * rr, v1 = tile[row * 64 + 2 * cp + 1] * rr;
        if (gain) { float ss = v0 * v0 + v1 * v1;
            XSUM32(ss);
            const float rinv = 1.0f / sqrtf(ss * (1.0f / 64.0f) + EPS); v0 = v0 * rinv * gain[2 * cp] * sc; v1 = v1 * rinv * gain[2 * cp + 1] * sc; }
        if (knh) *(GAS unsigned*)(dst + kfrag_idx(META_ROW + row, knh, head, 2 * cp)) = pk2(v0, v1);
        else if (!gain) { GAS bf16* vp = dst + vfrag_idx(META_ROW + row, pn < 16 ? 16 : 2, head, 2 * cp); const unsigned pw = pk2(v0, v1); vp[0] = (bf16)(pw & 0xffffu); vp[8] = (bf16)(pw >> 16); }
        else *(GAS unsigned*)(dst + (size_t)(META_ROW + row) * pitch + head * 64 + 2 * cp) = pk2(v0, v1);
    }
};

__device__ __forceinline__ void split3(float x, unsigned& h, unsigned& m, unsigned& l) { h = f2bf(x); const float r = x - bf2f((unsigned short)h); m = f2bf(r); const float r2 = r - bf2f((unsigned short)m); l = f2bf(r2); }
__device__ __forceinline__ int crow(int r, int hi) { return (r & 3) + 8 * (r >> 2) + 4 * hi; }
typedef short v4i16_t __attribute__((ext_vector_type(4)));
__device__ __forceinline__ float max3f(float a, float b, float c) { return fmaxf(fmaxf(a, b), c); }
constexpr float ATT_THR = 40.0f;
constexpr int ATT_KV_OFF = 36864;
template <int MODE>
__device__ __forceinline__ void kv_dma(Frame& F, unsigned char* w, int gb, int kvh, int c, int image) {
    constexpr int NHK = (MODE == 0) ? 16 : 2; const int wv = F.wave, lane = F.lane; const int rowk = (c == 1) ? META_BLK0 + 64 : gb * SEQ + 64 * (c - 2);
    const GAS bf16* kp = (const GAS bf16*)(w + (MODE == 0 ? WS_FK : WS_SK)) + ((size_t)((rowk >> 5) + (wv >> 2)) * NHK + kvh) * 2048 + (wv & 3) * 512 + lane * 8;
    const GAS bf16* vp = (const GAS bf16*)(w + (MODE == 0 ? WS_FV : WS_SV)) + ((size_t)((rowk >> 4) + (wv >> 1)) * NHK + kvh) * 1024 + (wv & 1) * 512 + lane * 8;
    LAS unsigned char* d = F.lds + RING_OFF + ATT_KV_OFF + image * 16384 + wv * 1024;
    __builtin_amdgcn_global_load_lds((const unsigned*)kp, (LAS unsigned*)d, 16, 0, 0); __builtin_amdgcn_global_load_lds((const unsigned*)vp, (LAS unsigned*)(d + 8192), 16, 0, 0);
}
template <int MODE  , int RES = 0>
__device__ __forceinline__ void attn_group(Frame& F, unsigned char* w, int gb, int kvh, int c_lo, int c_hi, bool active, int b  , int h, int i, const float* sinks, int res_c0 = 0) {
    const int lane = F.lane, r32 = lane & 31, hi = lane >> 5, wv = F.wave;
    const bool meta = b < 0;
    const int qpos0 = meta ? 96 : 128 + 32 * i;
    const int qrow0 = meta ? META_BLK0 + 96 : b * SEQ + 32 * i;
    const int cd = qpos0 >> 6;
    const int cfirst = (MODE == 0) ? (meta ? 1 : __builtin_amdgcn_readfirstlane(((const volatile LAS int*)(F.lds + RING_OFF + ATT_FC_OFF))[i])) : ((qpos0 - 127) < 128 ? 1 : ((qpos0 - 127) >> 6));
    constexpr int NHK = (MODE == 0) ? 16 : 2;
    const GAS bf16* Qp = (const GAS bf16*)(w + (MODE == 0 ? WS_FQ : WS_SQ)) + (size_t)qrow0 * 1024 + h * 64;
    const GAS bf16* kdma = (const GAS bf16*)(w + (MODE == 0 ? WS_FK : WS_SK)) + ((size_t)(wv >> 2) * NHK + kvh) * 2048 + (wv & 3) * 512 + lane * 8;
    const GAS bf16* vdma = (const GAS bf16*)(w + (MODE == 0 ? WS_FV : WS_SV)) + ((size_t)(wv >> 1) * NHK + kvh) * 1024 + (wv & 1) * 512 + lane * 8;
    LAS unsigned char* kvb = F.lds + RING_OFF + ATT_KV_OFF;
    const float sl2 = (MODE == 1) ? exp2f(-0.5f * (float)(h + 1)) * LOG2E : 0.f;
    const LAS unsigned char* tfp = F.lds + RING_OFF + (hi ? ATT_ZERO_OFF : ATT_TABF_OFF + r32 * 16); const int toff = hi ? 0 : 1;
    v4u mfr = hi ? (v4u){0u, 0u, 0u, 0u} : (v4u){0x3F803F80u, 0x3F80u, 0u, 0u};
    bf16x8 qf[4];
    if (active) {
#pragma unroll
        for (int s = 0; s < 4; ++s) qf[s] = *(const GAS bf16x8*)(Qp + (size_t)r32 * 1024 + 16 * s + 8 * hi);
    } else {
#pragma unroll
        for (int s = 0; s < 4; ++s) qf[s] = (bf16x8){0, 0, 0, 0, 0, 0, 0, 0};
    }
#define CHUNK_ROW(c) ((c) == 1 ? META_BLK0 + 64 : gb * SEQ + 64 * ((c) - 2))
#define KV_DMA(c_) do { const int rowk_ = CHUNK_ROW(c_); LAS unsigned char* d_ = kvb + ((c_) & 1) * 16384 + wv * 1024; \
        __builtin_amdgcn_global_load_lds((const unsigned*)(kdma + (size_t)(rowk_ >> 5) * (NHK * 2048)), (LAS unsigned*)d_, 16, 0, 0); \
        __builtin_amdgcn_global_load_lds((const unsigned*)(vdma + (size_t)(rowk_ >> 4) * (NHK * 1024)), (LAS unsigned*)(d_ + 8192), 16, 0, 0); } while (0)
    float m_run = 0.f, l_run = 0.f; f32x16 o0 = {}, o1 = {};
    const float NEG = -1e30f;
    if (!RES) { __syncthreads();
        KV_DMA(c_lo); }
    for (int c = c_lo; c <= c_hi; ++c) {
        if (!RES) { asm volatile("s_waitcnt vmcnt(0) lgkmcnt(0)" ::: "memory"); __builtin_amdgcn_s_barrier(); __builtin_amdgcn_sched_barrier(0);
            if (c < c_hi) KV_DMA(c + 1); }
        if (!(active && c >= cfirst && c <= cd)) continue;
        const LAS unsigned char* cb = kvb + (RES ? (c - res_c0) : (c & 1)) * 16384 + hi * 512 + r32 * 16;
        bf16x8 kf[2][4];
#pragma unroll
        for (int t = 0; t < 2; ++t)
#pragma unroll
            for (int s = 0; s < 4; ++s) kf[t][s] = *(const LAS bf16x8*)(cb + t * 4096 + s * 1024);
        f32x16 p0 = {}, p1 = {};
        bf16x8 ab0, ab1;
        if (MODE == 0) { ab0 = *(const LAS bf16x8*)(tfp + toff * (1024 * c)); ab1 = *(const LAS bf16x8*)(tfp + toff * (1024 * c + 512)); }
        __builtin_amdgcn_s_setprio(1);
#pragma unroll
        for (int s = 0; s < 4; ++s) { p0 = __builtin_amdgcn_mfma_f32_32x32x16_bf16(kf[0][s], qf[s], p0, 0, 0, 0); p1 = __builtin_amdgcn_mfma_f32_32x32x16_bf16(kf[1][s], qf[s], p1, 0, 0, 0); }
        if (MODE == 0) { const bf16x8 mb = __builtin_bit_cast(bf16x8, mfr); p0 = __builtin_amdgcn_mfma_f32_32x32x16_bf16(ab0, mb, p0, 0, 0, 0); p1 = __builtin_amdgcn_mfma_f32_32x32x16_bf16(ab1, mb, p1, 0, 0, 0); }
        __builtin_amdgcn_s_setprio(0);
        bf16x8 vf[4][2];
#pragma unroll
        for (int g = 0; g < 4; ++g)
#pragma unroll
            for (int d = 0; d < 2; ++d) vf[g][d] = *(const LAS bf16x8*)(cb + 8192 + g * 2048 + hi * 512 + d * 512);
        if (MODE == 0) {
            if (c == cd) { const int dq = qpos0 + r32 - 64 * c - 4 * hi;
#pragma unroll
                for (int r = 0; r < 16; ++r) { const int e = (r & 3) + 8 * (r >> 2); if (e > dq) p0[r] = NEG; if (e + 32 > dq) p1[r] = NEG; } }
        } else {
            const float kb0 = (float)(64 * c - qpos0 + 4 * hi) - m_run / sl2;
#pragma unroll
            for (int r = 0; r < 16; ++r) { const float e = (float)((r & 3) + 8 * (r >> 2)); p0[r] = fmaf(sl2, kb0 + e, p0[r]); p1[r] = fmaf(sl2, kb0 + 32.f + e, p1[r]); }
            const int dq = qpos0 + r32 - 64 * c - 4 * hi;
            const int padlim = (c == 1) ? 48 - 4 * hi : -1;
            const bool interior = c != 1 && 64 * c + 63 <= qpos0 && 64 * c > qpos0 + 31 - 128;
            if (!interior) {
#pragma unroll
            for (int r = 0; r < 16; ++r) { const int e = (r & 3) + 8 * (r >> 2);
                if ((unsigned)(dq - e) >= 128u || e < padlim) p0[r] = NEG;
                if ((unsigned)(dq - e - 32) >= 128u || e + 32 < padlim) p1[r] = NEG; } }
        }
        float mx = max3f(p0[0], p0[1], p1[0]);
#pragma unroll
        for (int r = 2; r < 16; r += 2) mx = max3f(mx, p0[r], p0[r + 1]);
#pragma unroll
        for (int r = 1; r < 16; r += 2) mx = max3f(mx, p1[r], (r + 1 < 16) ? p1[r + 1] : p1[r]);
        const bool first = (c == cfirst);
        if (first || __any(mx > ATT_THR)) {
            mx = fmaxf(mx, shx<32>(mx));
            const float dl = first ? fmaxf(mx, -200.f) : fmaxf(mx, 0.f);
            m_run += dl;
            if (MODE == 0) { unsigned h_, m_, l_; split3(-m_run, h_, m_, l_); if (!hi) { mfr.y = 0x3F80u | (h_ << 16); mfr.z = m_ | (l_ << 16); } }
            const float alpha = first ? 0.f : __builtin_amdgcn_exp2f(-dl);
            l_run *= alpha;
#pragma unroll
            for (int r = 0; r < 16; ++r) { p0[r] -= dl; p1[r] -= dl; }
            if (!first) {
#pragma unroll
                for (int r = 0; r < 16; ++r) { o0[r] *= alpha; o1[r] *= alpha; } }
        }
        float rs = 0.f;
#pragma unroll
        for (int r = 0; r < 16; ++r) { p0[r] = __builtin_amdgcn_exp2f(p0[r]); p1[r] = __builtin_amdgcn_exp2f(p1[r]); rs += p0[r] + p1[r]; }
        l_run += rs;
#pragma unroll
        for (int t = 0; t < 2; ++t)
#pragma unroll
            for (int s = 0; s < 2; ++s) {
                const f32x16& pp = t ? p1 : p0;
                v4u wq; wq.x = pg8::cvt_pk_bf16(pp[8 * s + 0], pp[8 * s + 1]); wq.y = pg8::cvt_pk_bf16(pp[8 * s + 2], pp[8 * s + 3]); wq.z = pg8::cvt_pk_bf16(pp[8 * s + 4], pp[8 * s + 5]); wq.w = pg8::cvt_pk_bf16(pp[8 * s + 6], pp[8 * s + 7]);
                const bf16x8 pf = __builtin_bit_cast(bf16x8, wq);
                const bf16x8 v0 = vf[2 * t + s][0], v1 = vf[2 * t + s][1];
                o0 = __builtin_amdgcn_mfma_f32_32x32x16_bf16(v0, pf, o0, 0, 0, 0);
                o1 = __builtin_amdgcn_mfma_f32_32x32x16_bf16(v1, pf, o1, 0, 0, 0);
            }
    }
#undef CHUNK_ROW
#undef KV_DMA
    if (!active) return;
    l_run += shx<32>(l_run);
    if (MODE == 1) l_run += __builtin_amdgcn_exp2f(sinks[h] * LOG2E + sl2 * (float)r32 - m_run);
    float inv = 1.0f / l_run;
    const int qrow0e = launder_u(qrow0), he = launder_u(h);
    int lane_e = lane; asm volatile("" : "+v"(lane_e)); const int r32e = lane_e & 31, hie = lane_e >> 5;
    if (meta && r32e < 16) inv = 0.f;
    GAS bf16* Op = (GAS bf16*)(w + WS_O) + (size_t)(qrow0e + r32e) * D + (MODE == 0 ? 0 : 1024) + he * 64 + 4 * hie;
    GAS float* sqo = meta ? (GAS float*)(w + WS_SSQOM) + (MODE == 0 ? 0 : 16) + he : (GAS float*)(w + WS_SSQO) + (size_t)qrow0e * 32 + (MODE == 0 ? 0 : 16) + he;
    float ss = 0.f;
#pragma unroll
    for (int g = 0; g < 4; ++g) {
        unsigned a[4], c[4];
#pragma unroll
        for (int j = 0; j < 4; ++j) { a[j] = f2bf(o0[4 * g + j] * inv); c[j] = f2bf(o1[4 * g + j] * inv);
            const float v0 = bf2f((bf16)a[j]), v1 = bf2f((bf16)c[j]); ss += v0 * v0 + v1 * v1; }
        *(GAS unsigned long long*)(Op + 8 * g) = (unsigned long long)(a[0] | (a[1] << 16)) | ((unsigned long long)(a[2] | (a[3] << 16)) << 32);
        *(GAS unsigned long long*)(Op + 32 + 8 * g) = (unsigned long long)(c[0] | (c[1] << 16)) | ((unsigned long long)(c[2] | (c[3] << 16)) << 32);
    }
    ss += shx<32>(ss);
    if (hie == 0) { if (!meta) sqo[(size_t)r32e * 32] = ss; else if (r32e >= 16) sqo[(size_t)(r32e - 16) * 32] = ss; }
}
__device__ __forceinline__ void probe_t0(LAS unsigned char* lds) { if (PROBE_CLASS > 50 && (PROBE_BLOCK < 0 || (int)blockIdx.x == PROBE_BLOCK) && my_tid() == 0) *(volatile LAS unsigned long long*)(lds + MISC_OFF + 72) = __builtin_amdgcn_s_memrealtime(); }
__device__ __forceinline__ void probe_t1(LAS unsigned char* lds, int c) { if (PROBE_CLASS == c && (PROBE_BLOCK < 0 || (int)blockIdx.x == PROBE_BLOCK) && my_tid() == 0) { volatile LAS unsigned long long* pa_ = (volatile LAS unsigned long long*)(lds + MISC_OFF + 64); *pa_ = *pa_ + (__builtin_amdgcn_s_memrealtime() - *(volatile LAS unsigned long long*)(lds + MISC_OFF + 72)); } }
__device__ __forceinline__ void attn_phase(Frame& F, const float* sinks, int next_layer  , const float* gq, const float* gk) {
    probe_t0(F.lds);
    unsigned char* w = wsl(F); const GAS float* LOGF = (const GAS float*)(w + WS_LOGF);
    const int bh = F.vcu >> 1, fb = bh >> 4, fh = bh & 15;
    LAS float* tab = (LAS float*)(F.lds + RING_OFF + ATT_TAB_OFF);
    LAS float* wtot = (LAS float*)(F.lds + RING_OFF + ATT_WTOT_OFF);
    { float v[5]; float tsum = 0.f; const int p0 = 5 * F.tid;
#pragma unroll
      for (int j = 0; j < 5; ++j) { const int p = p0 + j; float x = 0.f;
          if (p >= PADN && p < LPOS) { const int row = p < 128 ? META_BLK0 + p : fb * SEQ + p - 128; x = LOGF[(size_t)row * 16 + fh]; }
          tsum += x; v[j] = tsum; }
      float inc = tsum;
#pragma unroll
      for (int o = 1; o < 64; o <<= 1) { const float t = shi(inc, F.lane - o); if (F.lane >= o) inc += t; }
      if (F.lane == 63) wtot[F.wave] = inc;
      __syncthreads();
      float base = inc - tsum;
      for (int w = 0; w < F.wave; ++w) base += wtot[w];
#pragma unroll
      for (int j = 0; j < 5; ++j) { const int p = p0 + j; if (p < LPOS) { const float cv = (p < PADN) ? 1e30f : (base + v[j]) * LOG2E; tab[p] = cv;
          unsigned h_, m_, l_; split3(fmaxf(-cv, -60000.f), h_, m_, l_);
          LAS unsigned* tf = (LAS unsigned*)(F.lds + RING_OFF + ATT_TABF_OFF + p * 16); unsigned one2 = 0x3F803F80u, zz = 0u; asm volatile("" : "+v"(one2), "+v"(zz));
          tf[0] = h_ | (m_ << 16); tf[1] = l_ | (one2 << 16); tf[2] = one2; tf[3] = zz; } }
      if (F.tid < 4) ((LAS unsigned*)(F.lds + RING_OFF + ATT_ZERO_OFF))[F.tid] = 0u;
      __syncthreads();
      if (F.wave == 0) { float mq = fabsf(((const GAS float*)gq)[F.lane]), mk = fabsf(((const GAS float*)gk)[F.lane]);
#define XMAX_(v, O) v = fmaxf(v, shx<O>(v))
          XMAX_(mq, 1); XMAX_(mq, 2); XMAX_(mq, 4); XMAX_(mq, 8); XMAX_(mq, 16); XMAX_(mq, 32); XMAX_(mk, 1); XMAX_(mk, 2); XMAX_(mk, 4); XMAX_(mk, 8); XMAX_(mk, 16); XMAX_(mk, 32);
#undef XMAX_
          const float thr = -(152.0f + 2.0f * (64.0f * QSCALE * mq * mk * 1.02f + 1.0f));
          const int q0pos = 128 + 32 * F.lane, cdl = q0pos >> 6; const float tq = tab[q0pos]; int c = 1;
          while (c < cdl && tq - tab[64 * c + 63] < thr) ++c;
          ((LAS int*)(F.lds + RING_OFF + ATT_FC_OFF))[F.lane] = c; }
      __syncthreads(); }
    probe_t1(F.lds, 51); probe_t0(F.lds);
    {
      const int odd = F.vcu & 1;
      for (int k = 0; k < 4; ++k) { const int g = (k == 0) ? odd : (k == 1) ? 3 - odd : (k == 2) ? 4 + odd : 7 - odd;
          int cf = 1 << 20;
#pragma unroll
          for (int j = 0; j < 8; ++j) cf = min(cf, ((const volatile LAS int*)(F.lds + RING_OFF + ATT_FC_OFF))[8 * g + j]);
          cf = __builtin_amdgcn_readfirstlane(cf);
          attn_group<0>(F, w, fb, fh, cf, (128 + 32 * (8 * g + 7)) >> 6, true, fb, fh, 8 * g + F.wave, sinks); }
      probe_t1(F.lds, 52); probe_t0(F.lds);
      if (F.vcu < 32 && odd == 0) attn_group<0>(F, w, 0, fh, 1, 1, F.wave == 0, -1, fh, 0, sinks); }
    probe_t1(F.lds, 54); probe_t0(F.lds);
    {
      { const int T0 = F.vcu * 4, sb = T0 >> 7, kvh = (T0 >> 6) & 1, i0 = T0 & 63, m = 1 + (i0 >> 2); const int u_lo = (i0 == 0) ? 1 : 2 * m - 2, u_hi = 2 * m + 1;
        __syncthreads();
        for (int c = u_lo; c <= u_hi; ++c) kv_dma<1>(F, w, sb, kvh, c, c - u_lo);
        asm volatile("s_waitcnt vmcnt(0)" ::: "memory"); __syncthreads();
        for (int k = 0; k < 4; ++k) { const int i = i0 + k, qp = 128 + 32 * i;
            attn_group<1, 1>(F, w, sb, kvh, (qp - 127) < 128 ? 1 : ((qp - 127) >> 6), qp >> 6, true, sb, 8 * kvh + F.wave, i, sinks, u_lo); } }
      probe_t1(F.lds, 53); probe_t0(F.lds);
      if (F.vcu < 32 && (F.vcu & 1) == 1) attn_group<1>(F, w, 0, (F.vcu >> 1) >> 3, 1, 1, F.wave == 0, -1, F.vcu >> 1, 0, sinks); }
    __syncthreads();
    probe_t1(F.lds, 54);
}

constexpr int PH_PER_LAYER = 7, N_PHASES = 1 + DEPTH * PH_PER_LAYER;
struct Args { const float* in[21]; float* out; unsigned char* ws; int ph_lo, ph_hi, li, pad; };
__global__ void __launch_bounds__(NWAVES * 64, 2) hymba_fwd(Args args) {
    extern __shared__ __attribute__((aligned(16))) unsigned char lds[];
    {
        LAS unsigned char* l0 = (LAS unsigned char*)lds; const int tid = threadIdx.x;
        for (int u = tid; u < (LDS_BYTES - LDSCTL_OFF) / 4; u += NWAVES * 64) ((LAS unsigned*)(l0 + LDSCTL_OFF))[u] = 0u;
        __syncthreads();
        if ((tid & 63) == 0) ((volatile LAS int*)(l0 + WID_OFF))[hw_wave_key()] = tid >> 6;
        volatile LAS unsigned long long* pt = (volatile LAS unsigned long long*)(l0 + PTR_OFF);
#pragma unroll
        for (int k = 0; k < 21; ++k) if (tid == k) pt[k] = (unsigned long long)args.in[k];
        if (tid == 21) pt[21] = (unsigned long long)args.out;
        if (tid == 22) pt[22] = (unsigned long long)args.ws;
        __syncthreads();
#if !MK_PER_PHASE
        (void)xcd_barrier_post((unsigned*)((gu32*)(args.ws + WS_CTL) + CW_BAR), (volatile LAS unsigned*)(l0 + MISC_OFF) + 8);
#endif
    }
    const int lo = args.ph_lo, hi = args.ph_hi;
#define IN(k) (lo <= (k) && (k) < hi)
#define PROBE_T0() if (PROBE_CLASS == 60 && (PROBE_BLOCK < 0 || (int)blockIdx.x == PROBE_BLOCK) && my_tid() == 0) { *(volatile LAS unsigned long long*)((LAS unsigned char*)lds + MISC_OFF + 72) = __builtin_amdgcn_s_memtime(); } else if (PROBE_CLASS >= 0 && (PROBE_BLOCK < 0 || (int)blockIdx.x == PROBE_BLOCK) && my_tid() == 0) { *(volatile LAS unsigned long long*)((LAS unsigned char*)lds + MISC_OFF + 72) = __builtin_amdgcn_s_memrealtime(); }
#define PROBE_T1(c) if (PROBE_CLASS == 60 && (c) == 2 && (PROBE_BLOCK < 0 || (int)blockIdx.x == PROBE_BLOCK) && my_tid() == 0) { volatile LAS unsigned long long* pa_ = (volatile LAS unsigned long long*)((LAS unsigned char*)lds + MISC_OFF + 64); *pa_ = *pa_ + (__builtin_amdgcn_s_memtime() - *(volatile LAS unsigned long long*)((LAS unsigned char*)lds + MISC_OFF + 72)) / 24ull; } else if (PROBE_CLASS == (c) && (PROBE_BLOCK < 0 || (int)blockIdx.x == PROBE_BLOCK) && my_tid() == 0) { volatile LAS unsigned long long* pa_ = (volatile LAS unsigned long long*)((LAS unsigned char*)lds + MISC_OFF + 64); *pa_ = *pa_ + (__builtin_amdgcn_s_memrealtime() - *(volatile LAS unsigned long long*)((LAS unsigned char*)lds + MISC_OFF + 72)); }
#define SEAM(k) do { if (IN(k) && IN((k) + 1)) { PROBE_T0() unsigned char* wsb_ = (unsigned char*)pg8::tab_ptr(22); \
        if (MK_PER_PHASE) { if (my_tid() == 0) __hip_atomic_store((gu32*)(wsb_ + WS_CTL) + CW_TMO, 0xBADBA0u, RLX_AGENT); } \
        else { XcdBarrier bar_; bar_.bar = (unsigned*)((gu32*)(wsb_ + WS_CTL) + CW_BAR); bar_.x = xb_xcc_id(); bar_.st = (volatile LAS unsigned*)((LAS unsigned char*)lds + MISC_OFF) + 8; xcd_barrier(bar_); if (PROBE_CLASS == 50) xcd_barrier(bar_); } PROBE_T1(8) } } while (0)
#define PHASE_BEGIN(k) if (IN(k)) { PROBE_T0() Frame P = make_frame(); \
        unsigned char* w = wsl(P); int ll = l; LAUNDER_S(ll); unsigned char* wl = w + WS_W + (size_t)ll * LW_STRIDE; (void)wl; int bxl = blockIdx.x; LAUNDER_S(bxl);
#define PHASE_END(k, c) PROBE_T1(c) } SEAM(k);
    typedef pg8::StaticOrder SO;
    if (IN(0)) { PROBE_T0() Frame P = make_frame(); p0_prologue(P); PROBE_T1(0) } SEAM(0);
    for (int l = 0; l < DEPTH; ++l) {
        const int pb = 1 + l * PH_PER_LAYER;
#define SSQ(j) ((GAS float*)(w + WS_SSQM) + (size_t)(3 * ll + (j)) * 16 * 128)
#define HBM ((const GAS bf16*)(w + WS_HB) + (size_t)META_ROW * D)
        PHASE_BEGIN(pb + 0) pg8::Gemm g{(const bf16*)(w + WS_HB), (const bf16*)(wl + LW_GU1), M_REAL, N_GU, D}; SO S; S.init(M_REAL, N_GU, P.G, bxl);
            pg8::EpiSwiGLU E{3 * ll + 0}; pg8::gemm_phase<pg8::EpiSwiGLU, SO, true, true>(P.lds + RING_OFF, g, S, E);
            SkGU K2{(GAS bf16*)(w + WS_ACT), SSQ(0)}; skinny_phase<SkGU, D / 256>(P, HBM, D, (const GAS bf16*)(wl + LW_GU1), D, K2); PHASE_END(pb + 0, 2)
        PHASE_BEGIN(pb + 1) pg8::Gemm g{(const bf16*)(w + WS_ACT), (const bf16*)(wl + LW_D1), M_REAL, D, FF}; SO S; S.init(M_REAL, D, P.G, bxl);
            pg8::EpiResAdd E{0.5f, 3 * ll + 1, 0}; pg8::gemm_phase<pg8::EpiResAdd, SO, true, true>(P.lds + RING_OFF, g, S, E);
            SkRes K2{0.5f, (GAS bf16*)(w + WS_HB), SSQ(1)}; skinny_phase<SkRes, FF / 256>(P, (const GAS bf16*)(w + WS_ACT) + (size_t)META_ROW * FF, FF, (const GAS bf16*)(wl + LW_D1), FF, K2); PHASE_END(pb + 1, 3)
        PHASE_BEGIN(pb + 2) pg8::Gemm g{(const bf16*)(w + WS_HB), (const bf16*)(wl + LW_IN), M_REAL, N_IN, D}; SO S; S.init(M_REAL, N_IN, P.G, bxl);
            pg8::EpiInProj E{ll, 3 * ll + 1, QSCALE};
            pg8::gemm_phase<pg8::EpiInProj, SO, true, true>(P.lds + RING_OFF, g, S, E);
            SkIn K2{(GAS bf16*)(w + WS_FQ), (GAS bf16*)(w + WS_FK), (GAS bf16*)(w + WS_FV), (GAS bf16*)(w + WS_SQ), (GAS bf16*)(w + WS_SK), (GAS bf16*)(w + WS_SV), (GAS float*)(w + WS_LOGF), (const GAS float*)(inptr(P, 9) + ll * HD), (const GAS float*)(inptr(P, 10) + ll * HD), (const GAS float*)(inptr(P, 11) + ll * HD), (const GAS float*)(inptr(P, 12) + ll * HD), (const GAS float*)(inptr(P, 8) + ll * NH), QSCALE, SSQ(1)}; skinny_phase<SkIn, D / 256>(P, HBM, D, (const GAS bf16*)(wl + LW_IN), D, K2);
            if (IDLE_CONV_K > 0 && P.G == 256 && bxl >= 128) { __syncthreads(); LAS unsigned char* scr = P.lds + RING_OFF + P.wave * 16384; const int iw = (bxl - 128) * NWAVES + P.wave;
                for (int k = 0; k < IDLE_CONV_K; ++k) convert_item(P, w, ll, GU2_BASE + iw + k * 128 * NWAVES, scr); }
            PHASE_END(pb + 2, 4)
        PHASE_BEGIN(pb + 3) attn_phase(P, inptr(P, 13) + ll * NH, OVERLAP_CONV ? ll + 1 : DEPTH, inptr(P, 9) + ll * HD, inptr(P, 10) + ll * HD); PHASE_END(pb + 3, 5)
        PHASE_BEGIN(pb + 4) pg8::Gemm g{(const bf16*)(w + WS_O), (const bf16*)(wl + LW_OUT), M_REAL, D, D}; SO S; S.init(M_REAL, D, P.G, bxl);
            pg8::EpiOut E{3 * ll + 2}; pg8::gemm_phase<pg8::EpiOut, SO, true, true>(P.lds + RING_OFF, g, S, E);
            SkOut K2{1.0f, (GAS bf16*)(w + WS_HB), SSQ(2), (const GAS float*)(w + WS_SSQOM)}; skinny_phase<SkOut, D / 256>(P, (const GAS bf16*)(w + WS_O) + (size_t)META_ROW * D, D, (const GAS bf16*)(wl + LW_OUT), D, K2); PHASE_END(pb + 4, 7)
        PHASE_BEGIN(pb + 5) pg8::Gemm g{(const bf16*)(w + WS_HB), (const bf16*)(wl + LW_GU2), M_REAL, N_GU, D}; SO S; S.init(M_REAL, N_GU, P.G, bxl);
            pg8::EpiSwiGLU E{3 * ll + 2}; pg8::gemm_phase<pg8::EpiSwiGLU, SO, true, true>(P.lds + RING_OFF, g, S, E);
            if (ll < DEPTH - 1) { SkGU K2{(GAS bf16*)(w + WS_ACT), SSQ(2)}; skinny_phase<SkGU, D / 256>(P, HBM, D, (const GAS bf16*)(wl + LW_GU2), D, K2); } PHASE_END(pb + 5, 2)
        PHASE_BEGIN(pb + 6) pg8::Gemm g{(const bf16*)(w + WS_ACT), (const bf16*)(wl + LW_D2), M_REAL, D, FF}; SO S; S.init(M_REAL, D, P.G, bxl);
            const bool fin = (ll == DEPTH - 1);
            pg8::EpiResAdd E{0.5f, 3 * ll + 3, fin ? 1 : 0}; pg8::gemm_phase<pg8::EpiResAdd, SO, true, true>(P.lds + RING_OFF, g, S, E);
            if (!fin) { SkRes K2{0.5f, (GAS bf16*)(w + WS_HB), SSQ(3)}; skinny_phase<SkRes, FF / 256>(P, (const GAS bf16*)(w + WS_ACT) + (size_t)META_ROW * FF, FF, (const GAS bf16*)(wl + LW_D2), FF, K2); } PHASE_END(pb + 6, 3)
#undef SSQ
#undef HBM
    }
    if (PROBE_CLASS >= 0 && (PROBE_BLOCK < 0 || (int)blockIdx.x == PROBE_BLOCK) && my_tid() == 0) { const unsigned long long t0 = __builtin_amdgcn_s_memrealtime(), dt = *(volatile LAS unsigned long long*)((LAS unsigned char*)lds + MISC_OFF + 64);
        while (__builtin_amdgcn_s_memrealtime() - t0 < dt) __builtin_amdgcn_s_sleep(8); }
#undef IN
#undef SEAM
#undef PHASE_BEGIN
#undef PHASE_END
}

extern "C" void kernel_launch(void* const* d_in, const int* in_sizes, int n_in, void* d_out, int out_size, void* d_ws, size_t ws_size, hipStream_t stream) {
    static int grid = 0;
    if (grid == 0) {
        if (n_in != 21 || in_sizes[0] != M_REAL * D || out_size != M_REAL * D || ws_size < WS_END) { fprintf(stderr, "kernel_launch: unexpected shapes (n_in %d, in0 %d, out %d, ws %zu, need %zu); nothing launched\n", n_in, n_in > 0 ? in_sizes[0] : -1, out_size, ws_size, (size_t)WS_END); grid = -1; return; }
        int dev = 0, cus = 0, per_cu = 0;
        if (hipGetDevice(&dev) != hipSuccess || hipDeviceGetAttribute(&cus, hipDeviceAttributeMultiprocessorCount, dev) != hipSuccess) { fprintf(stderr, "kernel_launch: device query failed\n"); grid = -1; return; }
        if (hipFuncSetAttribute((const void*)hymba_fwd, hipFuncAttributeMaxDynamicSharedMemorySize, LDS_BYTES) != hipSuccess) { fprintf(stderr, "kernel_launch: hipFuncSetAttribute failed\n"); grid = -1; return; }
        if (hipOccupancyMaxActiveBlocksPerMultiprocessor(&per_cu, (const void*)hymba_fwd, NWAVES * 64, LDS_BYTES) != hipSuccess || per_cu < 1) fprintf(stderr, "kernel_launch: note: occupancy query reports %d workgroups per CU\n", per_cu);
        (void)hipGetLastError();
        grid = cus;
        if (grid != 256) fprintf(stderr, "kernel_launch: note: %d CUs (the attention phase's static deal assumes 256)\n", grid);
    }
    if (grid < 0) return;
    if (hipMemsetAsync((char*)d_ws + WS_CTL, 0, CTL_ZERO_BYTES, stream) != hipSuccess) { fprintf(stderr, "kernel_launch: memset failed\n"); return; }
    Args a{};
    for (int i = 0; i < 21; ++i) a.in[i] = (const float*)d_in[i];
    a.out = (float*)d_out; a.ws = (unsigned char*)d_ws; a.li = 0; a.pad = 0;
#if MK_PER_PHASE
    for (int ph = 0; ph < N_PHASES; ++ph) { a.ph_lo = ph; a.ph_hi = ph + 1; hipLaunchKernelGGL(hymba_fwd, dim3(grid), dim3(NWAVES * 64), LDS_BYTES, stream, a); }
#else
    a.ph_lo = 0; a.ph_hi = N_PHASES;
    hipLaunchKernelGGL(hymba_fwd, dim3(grid), dim3(NWAVES * 64), LDS_BYTES, stream, a);
#endif
    const hipError_t le = hipPeekAtLastError();
    if (le != hipSuccess) fprintf(stderr, "kernel_launch: launch failed: %s\n", hipGetErrorName(le));
}
```

```cpp
#include <hip/hip_runtime.h>
#include <cstdio>
#include <cstdint>

#ifndef MK_PER_PHASE
#define MK_PER_PHASE 0
#endif
#ifndef OVERLAP_CONV
#define OVERLAP_CONV 0
#endif
#ifndef PROBE_BLOCK
#define PROBE_BLOCK 0
#endif
#ifndef PROBE_CLASS
#define PROBE_CLASS (-1)
#endif

#define PROBE_ACC_OFF (131072 + 320 + 64)
__device__ __forceinline__ int my_tid();
__device__ __forceinline__ int lane_now() { unsigned z = 0; asm volatile("" : "+v"(z)); return (int)__builtin_amdgcn_mbcnt_hi(~0u, __builtin_amdgcn_mbcnt_lo(~0u, z)); }
template <int O> __device__ __forceinline__ float shx(float v) {
    if constexpr (O < 32) return __builtin_bit_cast(float, __builtin_amdgcn_ds_swizzle(__builtin_bit_cast(int, v), (O << 10) | 0x1f));
    else return __builtin_bit_cast(float, __builtin_amdgcn_ds_bpermute((lane_now() ^ 32) << 2, __builtin_bit_cast(int, v)));
}
__device__ __forceinline__ float shi(float v, int idx) { return __builtin_bit_cast(float, __builtin_amdgcn_ds_bpermute(idx << 2, __builtin_bit_cast(int, v))); }
#define XSUM16(v) do { v += shx<1>(v); v += shx<2>(v); v += shx<4>(v); v += shx<8>(v); } while (0)
#define XSUM32(v) do { XSUM16(v); v += shx<16>(v); } while (0)
#define XSUM64(v) do { XSUM32(v); v += shx<32>(v); } while (0)
namespace pg8 {
#define PG8_LAS __attribute__((address_space(3)))
#define PG8_GAS __attribute__((address_space(1)))
typedef unsigned short bf16_t;
typedef short bf16x8 __attribute__((ext_vector_type(8)));
typedef float f32x4 __attribute__((ext_vector_type(4)));
typedef unsigned u32x4 __attribute__((ext_vector_type(4)));
constexpr int BM = 256, BK = 64, HALF = 128, HTB = HALF * BK * 2  , STAGE_BYTES = 8 * HTB, NXCD = 8, WGM = 8;

__host__ __device__ __forceinline__ int lds_byte(int r, int c) { const int st = (r >> 4) * 2 + (c >> 5), rr = r & 15, cc = c & 31, ob = rr * 64 + cc * 2; return st * 1024 + (ob ^ (((ob >> 9) & 1) << 5)); }
__host__ __device__ __forceinline__ void stage_rc(int b, int& R, int& C) { const int st = b / 1024, sb = b % 1024, swz = sb ^ (((sb >> 9) & 1) << 5); R = (st >> 1) * 16 + swz / 64; C = (st & 1) * 32 + (swz % 64) / 2; }
__host__ __device__ __forceinline__ int perm32(int rho) { const int n = rho >> 4, i = rho & 15; return 8 * (i >> 2) + 4 * n + (i & 3); }

struct Unit { int pm, pn; };
struct Gemm { const bf16_t* A; const bf16_t* Bt; int M, N, K; };

struct StaticOrder {
    int nM, nN, nwg, G, c;
    __host__ __device__ void init(int M, int N, int G_, int c_) { nM = M / BM; nN = N / BM; nwg = nM * nN; G = G_; c = c_; }
    __host__ __device__ bool next(int i, Unit& u) const {
        const long L = (long)i * G + c; if (L >= nwg) return false;
        int wgid = (int)L; { const int q = nwg / NXCD, r = nwg % NXCD, xcd = wgid % NXCD, off = wgid / NXCD; wgid = (xcd < r ? xcd * (q + 1) : r * (q + 1) + (xcd - r) * q) + off; }
        const int nig = WGM * nN, gid = wgid / nig, fm = gid * WGM, gsz = (nM - fm) < WGM ? (nM - fm) : WGM;
        u.pm = fm + ((wgid % nig) % gsz); u.pn = (wgid % nig) / gsz; return true;
    }
    __device__ __forceinline__ void a_ready(const Unit&) const {}
    __device__ __forceinline__ void done(const Unit&) const {}
};

__device__ __forceinline__ unsigned cvt_pk_bf16(float lo, float hi) { unsigned r; asm volatile("v_cvt_pk_bf16_f32 %0, %1, %2" : "=v"(r) : "v"(lo), "v"(hi)); return r; }

template <class Epi, class Sched, bool ALIGN_EPI = false, bool SP2 = false>
__device__ __forceinline__ void gemm_phase(PG8_LAS unsigned char* lds, const Gemm g, const Sched& S, const Epi& E) {
    int tid_l = my_tid(); asm volatile("" : "+v"(tid_l));
    const int tid = tid_l, wid = __builtin_amdgcn_readfirstlane(tid >> 6), lane = tid & 63, wr = wid >> 2, wc = wid & 3, fr = lane & 15, fq = lane >> 4;
    const int K = g.K, nt = K / BK;
    unsigned voffA[2], voffB[2];
#pragma unroll
    for (int i = 0; i < 2; ++i) { int R, C; stage_rc(tid * 16 + i * 8192, R, C); const int Rb = Epi::PERM ? ((R & ~31) + perm32(R & 31)) : R;
        voffA[i] = (unsigned)(R * K + C) * 2u; voffB[i] = (unsigned)(Rb * K + C) * 2u; }
    const size_t kstep = (size_t)(BK * 2);
    const size_t hstep = (size_t)HALF * K * 2;
    const size_t tstep = 2 * hstep;
    const unsigned ldsw = (unsigned)wid * 1024u;
    const int aoff = lds_byte(wr * 64 + fr, fq * 8), boff = lds_byte(wc * 32 + fr, fq * 8);
#define PG8_SA(b, h) (((b) * 2 + (h)) * HTB)
#define PG8_SB(b, h) ((4 + (b) * 2 + (h)) * HTB)
#define PG8_STAGE(bufoff, gbase, voff) do { _Pragma("unroll") for (int _i = 0; _i < 2; ++_i) \
        __builtin_amdgcn_global_load_lds((const unsigned*)((const char*)(gbase) + (voff)[_i]), (PG8_LAS unsigned*)(lds + (bufoff) + ldsw + _i * 8192), 16, 0, 0); } while (0)
#define PG8_LDA(dst, b, h) do { _Pragma("unroll") for (int m = 0; m < 4; ++m) _Pragma("unroll") for (int k = 0; k < 2; ++k) dst[m][k] = *(const PG8_LAS bf16x8*)(lds + PG8_SA(b, h) + aoff + m * 2048 + k * 1024); } while (0)
#define PG8_LDB(dst, b, h) do { _Pragma("unroll") for (int n = 0; n < 2; ++n) _Pragma("unroll") for (int k = 0; k < 2; ++k) dst[n][k] = *(const PG8_LAS bf16x8*)(lds + PG8_SB(b, h) + boff + n * 2048 + k * 1024); } while (0)
#define PG8_MMA(ai, bj, At, Bt) do { __builtin_amdgcn_s_setprio(1); _Pragma("unroll") for (int m = 0; m < 4; ++m) _Pragma("unroll") for (int n = 0; n < 2; ++n) _Pragma("unroll") for (int k = 0; k < 2; ++k) \
        acc[ai][bj][m][n] = __builtin_amdgcn_mfma_f32_16x16x32_bf16(Bt[n][k], At[m][k], acc[ai][bj][m][n], 0, 0, 0); __builtin_amdgcn_s_setprio(0); } while (0)
#define PG8_WAIT_V(n) asm volatile("s_waitcnt vmcnt(" #n ")" ::: "memory")
#define PG8_WAIT_L(n) asm volatile("s_waitcnt lgkmcnt(" #n ")" ::: "memory")
#define PG8_BAR __builtin_amdgcn_s_barrier()
#define PG8_SCHED __builtin_amdgcn_sched_barrier(0)
    Unit cur, nxt; int ui = 0;
    if (!S.next(0, cur)) return;
    f32x4 acc[2][2][4][2];
#pragma unroll
    for (int a = 0; a < 2; ++a)
#pragma unroll
        for (int b = 0; b < 2; ++b)
#pragma unroll
            for (int m = 0; m < 4; ++m)
#pragma unroll
                for (int n = 0; n < 2; ++n) acc[a][b][m][n] = (f32x4){0.f, 0.f, 0.f, 0.f};
    bf16x8 At[4][2], B0[2][2], B1[2][2];
    const char* cA = (const char*)g.A + (size_t)cur.pm * tstep; const char* cB = (const char*)g.Bt + (size_t)cur.pn * tstep;
    S.a_ready(cur);
    if constexpr (SP2) {
        PG8_STAGE(PG8_SB(0, 0), cB, voffB); PG8_STAGE(PG8_SB(0, 1), cB + hstep, voffB); PG8_STAGE(PG8_SA(0, 0), cA, voffA); PG8_STAGE(PG8_SA(0, 1), cA + hstep, voffA);
        if (wr == 1) PG8_BAR;
        PG8_WAIT_V(2); PG8_BAR;
        PG8_STAGE(PG8_SB(1, 0), cB + kstep, voffB); PG8_STAGE(PG8_SA(1, 0), cA + kstep, voffA); PG8_STAGE(PG8_SB(1, 1), cB + hstep + kstep, voffB);
        PG8_WAIT_V(6); PG8_BAR;
    } else {
        PG8_STAGE(PG8_SB(0, 0), cB, voffB); PG8_STAGE(PG8_SA(0, 0), cA, voffA); PG8_STAGE(PG8_SB(0, 1), cB + hstep, voffB); PG8_STAGE(PG8_SA(0, 1), cA + hstep, voffA);
        if (wr == 1) PG8_BAR;
        PG8_WAIT_V(4); PG8_BAR;
        PG8_STAGE(PG8_SB(1, 0), cB + kstep, voffB); PG8_STAGE(PG8_SA(1, 0), cA + kstep, voffA); PG8_STAGE(PG8_SB(1, 1), cB + hstep + kstep, voffB);
        PG8_WAIT_V(6); PG8_BAR;
    }
    for (;;) {
        const bool has_next = S.next(ui + 1, nxt);
        const char* nA = has_next ? (const char*)g.A + (size_t)nxt.pm * tstep : cA; const char* nB = has_next ? (const char*)g.Bt + (size_t)nxt.pn * tstep : cB;
        for (int t = 0; t < nt; t += 2) {
            const bool last = (t == nt - 2);
            const char* a1 = cA + (size_t)(t + 1) * kstep;
            const char* a2 = last ? nA : cA + (size_t)(t + 2) * kstep; const char* b2 = last ? nB : cB + (size_t)(t + 2) * kstep;
            const char* a3 = a2 + kstep; const char* b3 = b2 + kstep;
            if (last && has_next) S.a_ready(nxt);
            if constexpr (Epi::MID) { if (t == nt / 2) E.mid(acc, cur, wr, wc, fr, fq); }
            if constexpr (SP2) {
            PG8_LDB(B0, 0, 0); PG8_LDB(B1, 0, 1); PG8_SCHED; PG8_LDA(At, 0, 0); PG8_STAGE(PG8_SA(1, 1), a1 + hstep, voffA);
            PG8_WAIT_V(8); PG8_WAIT_L(0); PG8_BAR; PG8_MMA(0, 0, At, B0); PG8_MMA(0, 1, At, B1); PG8_BAR; PG8_SCHED;
            PG8_LDA(At, 0, 1); PG8_STAGE(PG8_SB(0, 0), b2, voffB); PG8_STAGE(PG8_SB(0, 1), b2 + hstep, voffB); PG8_STAGE(PG8_SA(0, 0), a2, voffA);
            PG8_WAIT_V(8); PG8_WAIT_L(0); PG8_BAR; PG8_MMA(1, 0, At, B0); PG8_MMA(1, 1, At, B1); PG8_BAR; PG8_SCHED;
            PG8_LDB(B0, 1, 0); PG8_LDB(B1, 1, 1); PG8_SCHED; PG8_LDA(At, 1, 0); PG8_STAGE(PG8_SA(0, 1), a2 + hstep, voffA);
            PG8_WAIT_V(8); PG8_WAIT_L(0); PG8_BAR; PG8_MMA(0, 0, At, B0); PG8_MMA(0, 1, At, B1); PG8_BAR; PG8_SCHED;
            PG8_LDA(At, 1, 1); PG8_STAGE(PG8_SB(1, 0), b3, voffB); PG8_STAGE(PG8_SB(1, 1), b3 + hstep, voffB); PG8_STAGE(PG8_SA(1, 0), a3, voffA);
            PG8_WAIT_V(8); PG8_WAIT_L(0); PG8_BAR; PG8_MMA(1, 0, At, B0); PG8_MMA(1, 1, At, B1); PG8_BAR; PG8_SCHED;
            } else {
            PG8_LDB(B0, 0, 0); PG8_SCHED; PG8_LDA(At, 0, 0); PG8_STAGE(PG8_SA(1, 1), a1 + hstep, voffA);
            PG8_WAIT_L(8); PG8_BAR; PG8_WAIT_L(0); PG8_MMA(0, 0, At, B0); PG8_BAR; PG8_SCHED;
            PG8_LDB(B1, 0, 1); PG8_STAGE(PG8_SB(0, 0), b2, voffB);
            PG8_BAR; PG8_WAIT_L(0); PG8_MMA(0, 1, At, B1); PG8_BAR;
            PG8_LDA(At, 0, 1); PG8_STAGE(PG8_SA(0, 0), a2, voffA);
            PG8_BAR; PG8_WAIT_L(0); PG8_MMA(1, 0, At, B0); PG8_BAR; PG8_SCHED;
            PG8_STAGE(PG8_SB(0, 1), b2 + hstep, voffB);
            PG8_WAIT_V(6); PG8_BAR; PG8_MMA(1, 1, At, B1); PG8_BAR;
            PG8_LDB(B0, 1, 0); PG8_SCHED; PG8_LDA(At, 1, 0); PG8_STAGE(PG8_SA(0, 1), a2 + hstep, voffA);
            PG8_WAIT_L(8); PG8_BAR; PG8_WAIT_L(0); PG8_MMA(0, 0, At, B0); PG8_BAR; PG8_SCHED;
            PG8_LDB(B1, 1, 1); PG8_STAGE(PG8_SB(1, 0), b3, voffB);
            PG8_BAR; PG8_WAIT_L(0); PG8_MMA(0, 1, At, B1); PG8_BAR;
            PG8_LDA(At, 1, 1); PG8_STAGE(PG8_SA(1, 0), a3, voffA);
            PG8_BAR; PG8_WAIT_L(0); PG8_MMA(1, 0, At, B0); PG8_BAR; PG8_SCHED;
            PG8_STAGE(PG8_SB(1, 1), b3 + hstep, voffB);
            PG8_WAIT_V(6); PG8_BAR; PG8_MMA(1, 1, At, B1); PG8_BAR;
            }
        }
        if constexpr (ALIGN_EPI) { if (wr == 0) PG8_BAR; }
        if constexpr (PROBE_CLASS == 20 + Epi::ID) { unsigned long long t0_ = 0; if ((PROBE_BLOCK < 0 || (int)blockIdx.x == PROBE_BLOCK) && tid == 0) t0_ = __builtin_amdgcn_s_memrealtime();
            E(acc, cur, wr, wc, fr, fq); asm volatile("s_waitcnt vmcnt(0)" ::: "memory");
            if ((PROBE_BLOCK < 0 || (int)blockIdx.x == PROBE_BLOCK) && tid == 0) { volatile PG8_LAS unsigned long long* pa_ = (volatile PG8_LAS unsigned long long*)(lds + PROBE_ACC_OFF); *pa_ = *pa_ + (__builtin_amdgcn_s_memrealtime() - t0_); } }
        else if constexpr (!Epi::AFTER_DRAIN) { E(acc, cur, wr, wc, fr, fq); S.done(cur); }
        if (!has_next) break;
#pragma unroll
        for (int a = 0; a < 2; ++a)
#pragma unroll
            for (int b = 0; b < 2; ++b)
#pragma unroll
                for (int m = 0; m < 4; ++m)
#pragma unroll
                    for (int n = 0; n < 2; ++n) acc[a][b][m][n] = (f32x4){0.f, 0.f, 0.f, 0.f};
        cur = nxt; cA = nA; cB = nB; ++ui;
        if constexpr (ALIGN_EPI) { if (wr == 1) PG8_BAR; }
    }
    PG8_WAIT_V(0);
    if constexpr (!ALIGN_EPI) { if (wr == 0) PG8_BAR; }
    PG8_BAR;
#undef PG8_SA
#undef PG8_SB
#undef PG8_STAGE
#undef PG8_LDA
#undef PG8_LDB
#undef PG8_MMA
#undef PG8_WAIT_V
#undef PG8_WAIT_L
#undef PG8_BAR
#undef PG8_SCHED
}
}

constexpr int NWAVES = 8;
constexpr int D = 2048, NB = 8, SEQ = 2048, DEPTH = 4, HD = 64, NH = 16, FF = 5632, NMETA = 16, PADN = 112;
constexpr int M_REAL = NB * SEQ;
constexpr int M_PAD = M_REAL + 128;
constexpr int META_BLK0 = M_REAL;
constexpr int META_ROW = META_BLK0 + PADN;
constexpr int LPOS = SEQ + 128;
constexpr int N_GU = 2 * FF;
constexpr int N_IN = 18 * 256;
constexpr int IN_W = 4368;
constexpr float EPS = 1e-6f;
constexpr float LOG2E = 1.4426950408889634f;
constexpr float QSCALE = 0.125f * LOG2E;

constexpr size_t MiB = 1u << 20;
constexpr int NSLOT = 13;
constexpr size_t WS_CTL = 0, CTL_ZERO_BYTES = 1 * MiB;
constexpr size_t SZ_WGU = (size_t)N_GU * D * 2, SZ_WD = (size_t)D * FF * 2, SZ_WIN = (size_t)N_IN * D * 2, SZ_WOUT = (size_t)D * D * 2;
constexpr size_t LW_GU1 = 0, LW_D1 = LW_GU1 + SZ_WGU, LW_IN = LW_D1 + SZ_WD, LW_OUT = LW_IN + SZ_WIN, LW_GU2 = LW_OUT + SZ_WOUT, LW_D2 = LW_GU2 + SZ_WGU, LW_STRIDE = LW_D2 + SZ_WD;
constexpr size_t WS_W = 1 * MiB;
constexpr size_t WS_XN = WS_W + DEPTH * LW_STRIDE;
constexpr size_t WS_O = WS_XN + (size_t)M_PAD * D * 2;
constexpr size_t WS_ACT = WS_O + (size_t)M_PAD * D * 2;
constexpr size_t SZ_QK = (size_t)M_PAD * 1024 * 2, SZ_KV = (size_t)M_PAD * 128 * 2;
constexpr size_t WS_FQ = WS_ACT + (size_t)M_PAD * FF * 2, WS_FK = WS_FQ + SZ_QK, WS_FV = WS_FK + SZ_QK, WS_SQ = WS_FV + SZ_QK, WS_SK = WS_SQ + SZ_QK, WS_SV = WS_SK + SZ_KV, WS_LOGF = WS_SV + SZ_KV;
constexpr size_t WS_HB = WS_LOGF + (size_t)M_PAD * 16 * 4;
constexpr size_t WS_SSQ = WS_HB + (size_t)M_PAD * D * 2;
constexpr size_t WS_SSQM = WS_SSQ + (size_t)NSLOT * M_REAL * 32 * 4;
constexpr size_t WS_SSQO = WS_SSQM + (size_t)NSLOT * 16 * 128 * 4;
constexpr size_t WS_SSQOM = WS_SSQO + (size_t)M_REAL * 32 * 4;
constexpr size_t WS_END = WS_SSQOM + 16 * 32 * 4;
static_assert(LW_STRIDE % 256 == 0 && WS_XN % 256 == 0 && WS_ACT % 256 == 0 && WS_FQ % 256 == 0 && WS_SK % 256 == 0 && WS_LOGF % 256 == 0 && WS_HB % 256 == 0, "alignment");
constexpr int CW_TMO = 0, CW_BAR = 4096;

constexpr int RING_OFF = 0, RING_BYTES = 131072;
constexpr int LDSCTL_OFF = RING_BYTES, MISC_OFF = LDSCTL_OFF + 320, PTR_OFF = LDSCTL_OFF + 1024;
constexpr int LDS_BYTES = 155648;
constexpr int WID_OFF = LDSCTL_OFF + 1280;
constexpr int RSTD_ID_OFF = LDSCTL_OFF + 1536, RSTD_OFF = LDSCTL_OFF + 2048;
static_assert(RSTD_OFF + 8 * 128 * 4 <= LDS_BYTES, "LDS map");
constexpr int RSTD2_OFF = 148480;
static_assert(RSTD2_OFF + 8 * 128 * 4 <= LDS_BYTES, "LDS map");
constexpr int ATT_TAB_OFF = 139264;
constexpr int ATT_WTOT_OFF = ATT_TAB_OFF + 8704;
constexpr int ATT_FC_OFF = ATT_WTOT_OFF + 64;
constexpr int ATT_TABF_OFF = 0, ATT_ZERO_OFF = 2176 * 16;
constexpr int ATT_VST_OFF = 0, ATT_VST_PITCH = 128, ATT_VST_BYTES = 64 * ATT_VST_PITCH;
static_assert(ATT_VST_OFF + NWAVES * 2 * ATT_VST_BYTES <= RING_BYTES && ATT_FC_OFF + 256 <= RSTD2_OFF && RSTD_OFF + 8 * 128 * 4 <= ATT_TAB_OFF, "attention LDS");

#define GAS __attribute__((address_space(1)))
#define LAS __attribute__((address_space(3)))
typedef unsigned short bf16;
typedef unsigned v4u __attribute__((ext_vector_type(4)));
typedef float f32x4 __attribute__((ext_vector_type(4)));
typedef float f32x16 __attribute__((ext_vector_type(16)));
typedef short bf16x8 __attribute__((ext_vector_type(8)));
typedef GAS unsigned gu32;
#define RLX_AGENT __ATOMIC_RELAXED, __HIP_MEMORY_SCOPE_AGENT
#define LDS_WAIT() asm volatile("s_waitcnt lgkmcnt(0)" ::: "memory")
__device__ __forceinline__ unsigned f2bf(float f) { unsigned u = __builtin_bit_cast(unsigned, f); return (u + 0x7fffu + ((u >> 16) & 1u)) >> 16; }
__device__ __forceinline__ unsigned pk2(float lo, float hi) { return f2bf(lo) | (f2bf(hi) << 16); }
__device__ __forceinline__ float bf2f(unsigned short b) { return __builtin_bit_cast(float, (unsigned)b << 16); }

__device__ __forceinline__ int hw_wave_key() { return (int)(__builtin_amdgcn_s_getreg(((6 - 1) << 11) | 4) & 63u); }
__device__ __forceinline__ int my_tid() {
    extern __shared__ __attribute__((aligned(16))) unsigned char lds_dyn_[];
    const int wave = __builtin_amdgcn_readfirstlane(((const volatile LAS int*)((LAS unsigned char*)lds_dyn_ + WID_OFF))[hw_wave_key()]);
    unsigned zero = 0u; asm volatile("" : "+v"(zero));
    return wave * 64 + (int)__builtin_amdgcn_mbcnt_hi(~0u, __builtin_amdgcn_mbcnt_lo(~0u, zero));
}
__host__ __device__ __forceinline__ size_t kfrag_idx(int row, int nh, int head, int d) { return ((((size_t)(row >> 5) * nh + head) * 8 + (d >> 3)) * 32 + (row & 31)) * 8 + (d & 7); }
__host__ __device__ __forceinline__ size_t vfrag_idx(int row, int nh, int head, int d) { return (((((size_t)(row >> 4) * nh + head) * 2 + ((row >> 2) & 1)) * 64 + d) * 8) + (((row >> 3) & 1) * 4 + (row & 3)); }
namespace pg8 {
__device__ __forceinline__ unsigned long long tab_ptr(int k) {
    extern __shared__ __attribute__((aligned(16))) unsigned char lds_dyn_[];
    const volatile PG8_LAS unsigned* t = (const volatile PG8_LAS unsigned*)((PG8_LAS unsigned char*)lds_dyn_ + PTR_OFF);
    const unsigned lo = __builtin_amdgcn_readfirstlane(t[2 * k]), hi = __builtin_amdgcn_readfirstlane(t[2 * k + 1]);
    return ((unsigned long long)hi << 32) | lo;
}
__device__ __forceinline__ const PG8_LAS float* ensure_rstd(const PG8_GAS float* ssq, int slot, int pm, int wid, int wr, int lane) {
    extern __shared__ __attribute__((aligned(16))) unsigned char lds_dyn_[];
    volatile PG8_LAS unsigned* idw = (volatile PG8_LAS unsigned*)((PG8_LAS unsigned char*)lds_dyn_ + RSTD_ID_OFF) + wid;
    PG8_LAS float* rv = (PG8_LAS float*)((PG8_LAS unsigned char*)lds_dyn_ + RSTD_OFF) + wid * 128;
    const unsigned want = ((unsigned)(slot + 1) << 16) | (unsigned)(pm + 1);
    if ((unsigned)__builtin_amdgcn_readfirstlane(*idw) != want) {
#pragma unroll
        for (int j = 0; j < 2; ++j) { const int row = pm * BM + HALF * j + 64 * wr + lane; const PG8_GAS f32x4* pp = (const PG8_GAS f32x4*)(ssq + (size_t)row * 32); float t = 0.f;
#pragma unroll
            for (int q = 0; q < 8; ++q) { const f32x4 a = pp[q]; t += (a[0] + a[1]) + (a[2] + a[3]); }
            rv[64 * j + lane] = 1.0f / sqrtf(t * (1.0f / 2048.0f) + 1e-6f); }
        if (lane == 0) *idw = want;
        asm volatile("s_waitcnt lgkmcnt(0)" ::: "memory");
    }
    return rv;
}
__device__ __forceinline__ float silu_mul(float g, float u) {
    const float e = __builtin_amdgcn_exp2f(-1.4426950408889634f * g);
    return g * __builtin_amdgcn_rcpf(1.0f + e) * u;
}
struct EpiSwiGLU {
    static constexpr bool PERM = true, AFTER_DRAIN = false, MID = false; static constexpr int ID = 0;
    int slot;
    __device__ __forceinline__ void operator()(const f32x4 (&acc)[2][2][4][2], const Unit& u, int wr, int wc, int fr, int fq) const {
        PG8_GAS unsigned char* w = (PG8_GAS unsigned char*)tab_ptr(22); PG8_GAS bf16_t* O = (PG8_GAS bf16_t*)(w + WS_ACT); constexpr int ldc = FF; const PG8_GAS float* ssq = (const PG8_GAS float*)(w + WS_SSQ) + (size_t)slot * M_REAL * 32;
        const int row0 = u.pm * BM + wr * 64 + fr, col0 = u.pn * HALF + wc * 32 + 8 * fq;
        const PG8_LAS float* rv = ensure_rstd(ssq, slot, u.pm, wr * 4 + wc, wr, fr + 16 * fq);
        float rs[2][4];
#pragma unroll
        for (int ai = 0; ai < 2; ++ai)
#pragma unroll
            for (int m = 0; m < 4; ++m) rs[ai][m] = rv[64 * ai + 16 * m + fr];
#pragma unroll
        for (int ai = 0; ai < 2; ++ai)
#pragma unroll
            for (int m = 0; m < 4; ++m) { PG8_GAS bf16_t* rowp = O + (size_t)(row0 + ai * HALF + m * 16) * ldc + col0;
                const float r = rs[ai][m];
                const f32x4 g0 = acc[ai][0][m][0] * r, g1 = acc[ai][0][m][1] * r, u0 = acc[ai][1][m][0] * r, u1 = acc[ai][1][m][1] * r;
                u32x4 w; w.x = cvt_pk_bf16(silu_mul(g0[0], u0[0]), silu_mul(g0[1], u0[1])); w.y = cvt_pk_bf16(silu_mul(g0[2], u0[2]), silu_mul(g0[3], u0[3]));
                w.z = cvt_pk_bf16(silu_mul(g1[0], u1[0]), silu_mul(g1[1], u1[1])); w.w = cvt_pk_bf16(silu_mul(g1[2], u1[2]), silu_mul(g1[3], u1[3]));
                *(PG8_GAS u32x4*)rowp = w; }
    }
};
struct EpiResAdd {
    static constexpr bool PERM = true, AFTER_DRAIN = false, MID = false; static constexpr int ID = 1;
    float scale; int slot; int fin;
    __device__ __forceinline__ void operator()(const f32x4 (&acc)[2][2][4][2], const Unit& u, int wr, int wc, int fr, int fq) const {
        PG8_GAS unsigned char* w = (PG8_GAS unsigned char*)tab_ptr(22); PG8_GAS bf16_t* hb = (PG8_GAS bf16_t*)(w + WS_HB); PG8_GAS float* out = (PG8_GAS float*)tab_ptr(21);
        PG8_GAS float* ssq = (PG8_GAS float*)(w + WS_SSQ) + (size_t)slot * M_REAL * 32; constexpr int ldc = D;
        const int row0 = u.pm * BM + wr * 64 + fr, col0 = u.pn * BM + wc * 32 + 8 * fq;
        u32x4 bs[2][4][2];
#pragma unroll
        for (int ai = 0; ai < 2; ++ai)
#pragma unroll
            for (int m = 0; m < 4; ++m)
#pragma unroll
                for (int bj = 0; bj < 2; ++bj) bs[ai][m][bj] = *(const PG8_GAS u32x4*)(hb + (size_t)(row0 + ai * HALF + m * 16) * ldc + col0 + bj * HALF);
#pragma unroll
        for (int ai = 0; ai < 2; ++ai)
#pragma unroll
            for (int m = 0; m < 4; ++m) { float ss = 0.f; const size_t off = (size_t)(row0 + ai * HALF + m * 16) * ldc + col0;
#pragma unroll
                for (int bj = 0; bj < 2; ++bj) { const u32x4 b = bs[ai][m][bj]; const unsigned bw[4] = {b.x, b.y, b.z, b.w}; float v[8];
#pragma unroll
                    for (int e = 0; e < 4; ++e) { v[2 * e] = __builtin_bit_cast(float, bw[e] << 16) + scale * acc[ai][bj][m][e >> 1][(2 * e) & 3]; v[2 * e + 1] = __builtin_bit_cast(float, bw[e] & 0xffff0000u) + scale * acc[ai][bj][m][e >> 1][(2 * e + 1) & 3]; }
                    if (fin) { *(PG8_GAS f32x4*)(out + off + bj * HALF) = (f32x4){v[0], v[1], v[2], v[3]}; *(PG8_GAS f32x4*)(out + off + bj * HALF + 4) = (f32x4){v[4], v[5], v[6], v[7]}; }
                    else { u32x4 wv; wv.x = cvt_pk_bf16(v[0], v[1]); wv.y = cvt_pk_bf16(v[2], v[3]); wv.z = cvt_pk_bf16(v[4], v[5]); wv.w = cvt_pk_bf16(v[6], v[7]); *(PG8_GAS u32x4*)(hb + off + bj * HALF) = wv;
                        const unsigned ww[4] = {wv.x, wv.y, wv.z, wv.w};
#pragma unroll
                        for (int e = 0; e < 4; ++e) { const float lo = __builtin_bit_cast(float, ww[e] << 16), hi2 = __builtin_bit_cast(float, ww[e] & 0xffff0000u); ss += lo * lo + hi2 * hi2; } } }
                if (!fin) { ss += shx<16>(ss); ss += shx<32>(ss);
                    if (fq == 0) ssq[(size_t)(row0 + ai * HALF + m * 16) * 32 + u.pn * 4 + wc] = ss; } }
    }
};
__device__ __forceinline__ void ensure_rstd_o(const PG8_GAS float* ssqo, int slot, int pm, int wid, int wr, int lane, const PG8_LAS float*& rs_out, const PG8_LAS float*& ratio_out) {
    extern __shared__ __attribute__((aligned(16))) unsigned char lds_dyn_[];
    volatile PG8_LAS unsigned* idw = (volatile PG8_LAS unsigned*)((PG8_LAS unsigned char*)lds_dyn_ + RSTD_ID_OFF) + wid;
    PG8_LAS float* rv = (PG8_LAS float*)((PG8_LAS unsigned char*)lds_dyn_ + RSTD_OFF) + wid * 128;
    PG8_LAS float* rq = (PG8_LAS float*)((PG8_LAS unsigned char*)lds_dyn_ + RSTD2_OFF) + wid * 128;
    const unsigned want = ((0x4000u | (unsigned)(slot + 1)) << 16) | (unsigned)(pm + 1);
    if ((unsigned)__builtin_amdgcn_readfirstlane(*idw) != want) {
#pragma unroll
        for (int j = 0; j < 2; ++j) { const int row = pm * BM + HALF * j + 64 * wr + lane; const PG8_GAS f32x4* pp = (const PG8_GAS f32x4*)(ssqo + (size_t)row * 32); float tf = 0.f, ts = 0.f;
#pragma unroll
            for (int q = 0; q < 4; ++q) { const f32x4 a = pp[q], b = pp[4 + q]; tf += (a[0] + a[1]) + (a[2] + a[3]); ts += (b[0] + b[1]) + (b[2] + b[3]); }
            const float rf = 1.0f / sqrtf(tf * (1.0f / 1024.0f) + 1e-6f), rs = 1.0f / sqrtf(ts * (1.0f / 1024.0f) + 1e-6f);
            rv[64 * j + lane] = rs; rq[64 * j + lane] = rf / rs; }
        if (lane == 0) *idw = want;
        asm volatile("s_waitcnt lgkmcnt(0)" ::: "memory");
    }
    rs_out = rv; ratio_out = rq;
}
struct EpiOut {
    static constexpr bool PERM = true, AFTER_DRAIN = false, MID = true; static constexpr int ID = 3;
    int slot;
    __device__ __forceinline__ void mid(f32x4 (&acc)[2][2][4][2], const Unit& u, int wr, int wc, int fr, int fq) const {
        PG8_GAS unsigned char* w = (PG8_GAS unsigned char*)tab_ptr(22); const PG8_LAS float *rs, *rq; ensure_rstd_o((const PG8_GAS float*)(w + WS_SSQO), slot, u.pm, wr * 4 + wc, wr, fr + 16 * fq, rs, rq);
#pragma unroll
        for (int ai = 0; ai < 2; ++ai)
#pragma unroll
            for (int m = 0; m < 4; ++m) { const float q = rq[64 * ai + 16 * m + fr];
#pragma unroll
                for (int bj = 0; bj < 2; ++bj)
#pragma unroll
                    for (int n = 0; n < 2; ++n) acc[ai][bj][m][n] = acc[ai][bj][m][n] * q; }
    }
    __device__ __forceinline__ void operator()(const f32x4 (&acc)[2][2][4][2], const Unit& u, int wr, int wc, int fr, int fq) const {
        PG8_GAS unsigned char* w = (PG8_GAS unsigned char*)tab_ptr(22); PG8_GAS bf16_t* hb = (PG8_GAS bf16_t*)(w + WS_HB);
        PG8_GAS float* ssq = (PG8_GAS float*)(w + WS_SSQ) + (size_t)slot * M_REAL * 32; constexpr int ldc = D;
        const PG8_LAS float *rs, *rq; ensure_rstd_o((const PG8_GAS float*)(w + WS_SSQO), slot, u.pm, wr * 4 + wc, wr, fr + 16 * fq, rs, rq);
        const int row0 = u.pm * BM + wr * 64 + fr, col0 = u.pn * BM + wc * 32 + 8 * fq;
        u32x4 bs[2][4][2];
#pragma unroll
        for (int ai = 0; ai < 2; ++ai)
#pragma unroll
            for (int m = 0; m < 4; ++m)
#pragma unroll
                for (int bj = 0; bj < 2; ++bj) bs[ai][m][bj] = *(const PG8_GAS u32x4*)(hb + (size_t)(row0 + ai * HALF + m * 16) * ldc + col0 + bj * HALF);
#pragma unroll
        for (int ai = 0; ai < 2; ++ai)
#pragma unroll
            for (int m = 0; m < 4; ++m) { float ss = 0.f; const size_t off = (size_t)(row0 + ai * HALF + m * 16) * ldc + col0; const float scale = rs[64 * ai + 16 * m + fr];
#pragma unroll
                for (int bj = 0; bj < 2; ++bj) { const u32x4 b = bs[ai][m][bj]; const unsigned bw[4] = {b.x, b.y, b.z, b.w}; float v[8];
#pragma unroll
                    for (int e = 0; e < 4; ++e) { v[2 * e] = __builtin_bit_cast(float, bw[e] << 16) + scale * acc[ai][bj][m][e >> 1][(2 * e) & 3]; v[2 * e + 1] = __builtin_bit_cast(float, bw[e] & 0xffff0000u) + scale * acc[ai][bj][m][e >> 1][(2 * e + 1) & 3]; }
                    u32x4 wv; wv.x = cvt_pk_bf16(v[0], v[1]); wv.y = cvt_pk_bf16(v[2], v[3]); wv.z = cvt_pk_bf16(v[4], v[5]); wv.w = cvt_pk_bf16(v[6], v[7]); *(PG8_GAS u32x4*)(hb + off + bj * HALF) = wv;
                    const unsigned ww[4] = {wv.x, wv.y, wv.z, wv.w};
#pragma unroll
                    for (int e = 0; e < 4; ++e) { const float lo = __builtin_bit_cast(float, ww[e] << 16), hi2 = __builtin_bit_cast(float, ww[e] & 0xffff0000u); ss += lo * lo + hi2 * hi2; } }
                ss += shx<16>(ss); ss += shx<32>(ss);
                if (fq == 0) ssq[(size_t)(row0 + ai * HALF + m * 16) * 32 + u.pn * 4 + wc] = ss; }
    }
};
struct EpiInProj {
    static constexpr bool PERM = true, AFTER_DRAIN = false, MID = false; static constexpr int ID = 2;
    int ll, slot; float qscale;
    __device__ __forceinline__ void operator()(const f32x4 (&acc)[2][2][4][2], const Unit& u, int wr, int wc, int fr, int fq) const {
        PG8_GAS unsigned char* w = (PG8_GAS unsigned char*)tab_ptr(22); const PG8_GAS float* ssq = (const PG8_GAS float*)(w + WS_SSQ) + (size_t)slot * M_REAL * 32;
        PG8_GAS bf16_t *fq_ = (PG8_GAS bf16_t*)(w + WS_FQ), *fk_ = (PG8_GAS bf16_t*)(w + WS_FK), *fv_ = (PG8_GAS bf16_t*)(w + WS_FV), *sq_ = (PG8_GAS bf16_t*)(w + WS_SQ), *sk_ = (PG8_GAS bf16_t*)(w + WS_SK), *sv_ = (PG8_GAS bf16_t*)(w + WS_SV); PG8_GAS float* logf = (PG8_GAS float*)(w + WS_LOGF);
        const PG8_GAS float *g_fq = (const PG8_GAS float*)tab_ptr(9) + ll * HD, *g_fk = (const PG8_GAS float*)tab_ptr(10) + ll * HD, *g_sq = (const PG8_GAS float*)tab_ptr(11) + ll * HD, *g_sk = (const PG8_GAS float*)tab_ptr(12) + ll * HD, *bfg = (const PG8_GAS float*)tab_ptr(8) + ll * NH;
        const int row0 = u.pm * BM + wr * 64 + fr, pn = u.pn;
        if (pn == 17 && wc != 0) return;
        const PG8_LAS float* rv = ensure_rstd(ssq, slot, u.pm, wr * 4 + wc, wr, fr + 16 * fq);
        float rs[2][4];
#pragma unroll
        for (int ai = 0; ai < 2; ++ai)
#pragma unroll
            for (int m = 0; m < 4; ++m) rs[ai][m] = rv[64 * ai + 16 * m + fr];
        if (pn == 17) {
            if (wc != 0) return;
            if (fq < 2) {
                const f32x4 b0 = *(const PG8_GAS f32x4*)(bfg + 8 * fq), b1 = *(const PG8_GAS f32x4*)(bfg + 8 * fq + 4);
#pragma unroll
                for (int ai = 0; ai < 2; ++ai)
#pragma unroll
                    for (int m = 0; m < 4; ++m) { PG8_GAS float* rowp = logf + (size_t)(row0 + ai * HALF + m * 16) * 16 + 8 * fq;
#pragma unroll
                        for (int n = 0; n < 2; ++n) { f32x4 t = acc[ai][0][m][n] * rs[ai][m] + (n ? b1 : b0), o;
#pragma unroll
                            for (int j = 0; j < 4; ++j) o[j] = fminf(t[j], 0.f) - 0.69314718056f * __builtin_amdgcn_logf(1.0f + __builtin_amdgcn_exp2f(-1.4426950408889634f * fabsf(t[j])));
                            *(PG8_GAS f32x4*)(rowp + 4 * n) = o; } }
            }
            return;
        }
        PG8_GAS bf16_t* dst; int pitch, head, knh = 0; const PG8_GAS float* gain = nullptr; float sc = 1.f;
        if (pn < 16) { const int seg = pn >> 2; head = (pn & 3) * 4 + wc; pitch = 1024;
            if (seg == 0) { dst = fq_; gain = g_fq; sc = qscale; } else if (seg == 1) { dst = fk_; gain = g_fk; knh = 16; } else if (seg == 2) { dst = fv_; } else { dst = sq_; gain = g_sq; sc = qscale; } }
        else { pitch = 128; head = wc & 1; if (wc < 2) { dst = sk_; gain = g_sk; knh = 2; } else { dst = sv_; } }
        const int col0 = head * 64 + 8 * fq;
        if (gain) {
            f32x4 gv[2][2];
#pragma unroll
            for (int bj = 0; bj < 2; ++bj)
#pragma unroll
                for (int n = 0; n < 2; ++n) gv[bj][n] = *(const PG8_GAS f32x4*)(gain + 32 * bj + 8 * fq + 4 * n) * sc;
#pragma unroll
            for (int ai = 0; ai < 2; ++ai)
#pragma unroll
                for (int m = 0; m < 4; ++m) {
                    float ss = 0.f;
#pragma unroll
                    for (int bj = 0; bj < 2; ++bj)
#pragma unroll
                        for (int n = 0; n < 2; ++n) { const f32x4 x = acc[ai][bj][m][n]; ss += (x[0] * x[0] + x[1] * x[1]) + (x[2] * x[2] + x[3] * x[3]); }
                    ss += shx<16>(ss); ss += shx<32>(ss);
                    const float rinv = rs[ai][m] / sqrtf(ss * (1.0f / 64.0f) * rs[ai][m] * rs[ai][m] + 1e-6f);
                    const int row = row0 + ai * HALF + m * 16;
                    PG8_GAS bf16_t* rowp = dst + (size_t)row * pitch + col0;
#pragma unroll
                    for (int bj = 0; bj < 2; ++bj) { const f32x4 v0 = acc[ai][bj][m][0] * rinv * gv[bj][0], v1 = acc[ai][bj][m][1] * rinv * gv[bj][1];
                        u32x4 w; w.x = cvt_pk_bf16(v0[0], v0[1]); w.y = cvt_pk_bf16(v0[2], v0[3]); w.z = cvt_pk_bf16(v1[0], v1[1]); w.w = cvt_pk_bf16(v1[2], v1[3]);
                        if (knh) *(PG8_GAS u32x4*)(dst + kfrag_idx(row, knh, head, 32 * bj + 8 * fq)) = w;
                        else *(PG8_GAS u32x4*)(rowp + 32 * bj) = w; }
                }
        } else {
#pragma unroll
            for (int ai = 0; ai < 2; ++ai)
#pragma unroll
                for (int m = 0; m < 4; ++m) { const int row = row0 + ai * HALF + m * 16; const int vnh = (pn < 16) ? 16 : 2;
#pragma unroll
                    for (int bj = 0; bj < 2; ++bj) { const f32x4 v0 = acc[ai][bj][m][0] * rs[ai][m], v1 = acc[ai][bj][m][1] * rs[ai][m];
                        const unsigned wv[4] = {cvt_pk_bf16(v0[0], v0[1]), cvt_pk_bf16(v0[2], v0[3]), cvt_pk_bf16(v1[0], v1[1]), cvt_pk_bf16(v1[2], v1[3])};
                        PG8_GAS bf16_t* vp = dst + vfrag_idx(row, vnh, head, 32 * bj + 8 * fq);
#pragma unroll
                        for (int e = 0; e < 4; ++e) { vp[16 * e] = (bf16_t)(wv[e] & 0xffffu); vp[16 * e + 8] = (bf16_t)(wv[e] >> 16); } } }
        }
    }
};

}

#define XB_TMO      128
#define XB_XCNT(j)  (256  + 64 * (j))
#define XB_XSUB(j)  (1280 + 64 * (j))
#define XB_XGEN(j)  (2304 + 64 * (j))
#define XB_TOP      3328
#define XB_TOPGEN   3392
#define XCD_BAR_WORDS 3456
#define XB_SPIN_CAP (1u << 18)
__device__ __forceinline__ unsigned xb_ld(unsigned* p)              { return __hip_atomic_load(p, __ATOMIC_RELAXED, __HIP_MEMORY_SCOPE_AGENT); }
__device__ __forceinline__ unsigned xb_add(unsigned* p, unsigned v) { return __hip_atomic_fetch_add(p, v, __ATOMIC_RELAXED, __HIP_MEMORY_SCOPE_AGENT); }
__device__ __forceinline__ unsigned xb_xcc_id() { return (unsigned)__builtin_amdgcn_s_getreg((3 << 11) | 20) & 0xFu; }
#define XB_SPIN(cond, bar) do { unsigned _sp = 0; while (cond) { __builtin_amdgcn_s_sleep(1); \
    if ((++_sp & 255u) == 0u) { if (xb_ld(&(bar)[XB_TMO])) break; if (_sp > XB_SPIN_CAP) { atomicAdd(&(bar)[XB_TMO], 1u); break; } } } } while (0)
struct XcdBarrier { unsigned* bar; unsigned x; volatile LAS unsigned* st; };
__device__ __forceinline__ XcdBarrier xcd_barrier_post(unsigned* bar, volatile LAS unsigned* st) {
    XcdBarrier b; b.bar = bar; b.x = xb_xcc_id(); b.st = st;
    if (threadIdx.x == 0) (void)xb_add(&bar[XB_XCNT(b.x)], 1u);
    return b;
}
__device__ __forceinline__ void xcd_barrier_complete(unsigned* bar, unsigned x, unsigned& nloc, unsigned& nx) {
    const unsigned G = gridDim.x * gridDim.y * gridDim.z;
    unsigned sum, cnt, mine, sp = 0u;
    for (;;) {
        sum = 0u; cnt = 0u; mine = 0u;
#pragma unroll
        for (unsigned j = 0; j < 16; ++j) { const unsigned c = xb_ld(&bar[XB_XCNT(j)]); sum += c; cnt += (c > 0u) ? 1u : 0u; mine = (j == x) ? c : mine; }
        if (sum == G) break;
        __builtin_amdgcn_s_sleep(1);
        if ((++sp & 255u) == 0u) { if (xb_ld(&bar[XB_TMO])) break; if (sp > XB_SPIN_CAP) { atomicAdd(&bar[XB_TMO], 1u); break; } }
    }
    nloc = mine > 0u ? mine : 1u; nx = cnt > 0u ? cnt : 1u;
}
__device__ __forceinline__ void xcd_barrier(const XcdBarrier& b) {
    asm volatile("s_waitcnt vmcnt(0)" ::: "memory");
    __syncthreads();
    if (my_tid() == 0) {
        unsigned* bar = b.bar;
        __builtin_amdgcn_s_waitcnt(0);
        unsigned nloc = b.st[0], nx = b.st[1];
        if (nloc == 0u) { xcd_barrier_complete(bar, b.x, nloc, nx); b.st[0] = nloc; b.st[1] = nx; }
        const unsigned old = xb_add(&bar[XB_XSUB(b.x)], 1u);
        const unsigned gen = old / nloc;
        if (old + 1u == (gen + 1u) * nloc) {
            __builtin_amdgcn_fence(__ATOMIC_RELEASE, "agent");
            asm volatile("s_waitcnt vmcnt(0)" ::: "memory");
            const unsigned og = xb_add(&bar[XB_TOP], 1u);
            const unsigned tg = og / nx;
            if (og + 1u == (tg + 1u) * nx) xb_add(&bar[XB_TOPGEN], 1u);
            else XB_SPIN(xb_ld(&bar[XB_TOPGEN]) == tg, bar);
            __builtin_amdgcn_fence(__ATOMIC_ACQUIRE, "agent");
            xb_add(&bar[XB_XGEN(b.x)], 1u);
            asm volatile("s_waitcnt vmcnt(0)" ::: "memory");
        } else {
            XB_SPIN(xb_ld(&bar[XB_XGEN(b.x)]) == gen, bar);
            __builtin_amdgcn_fence(__ATOMIC_ACQUIRE, "agent");
            asm volatile("s_waitcnt vmcnt(0)" ::: "memory");
        }
    }
    __syncthreads();
}

struct Frame {
    LAS unsigned char* lds;
    volatile LAS unsigned* MISC;
    int tid, lane, wave;
    int vcu, G;
    unsigned char* ws;
};
__device__ __forceinline__ int launder_u(int x) { asm volatile("" : "+v"(x)); return __builtin_amdgcn_readfirstlane(x); }
#define LAUNDER_S(x) ((x) = launder_u(x))
__device__ __forceinline__ const float* inptr(const Frame& F, int k) {
    const volatile LAS unsigned* t = (const volatile LAS unsigned*)(F.lds + PTR_OFF);
    const unsigned lo = __builtin_amdgcn_readfirstlane(t[2 * k]), hi = __builtin_amdgcn_readfirstlane(t[2 * k + 1]);
    return (const float*)(((unsigned long long)hi << 32) | lo);
}
__device__ __forceinline__ unsigned char* wsl(const Frame& F) { const unsigned long long p = (unsigned long long)F.ws; const unsigned lo = (unsigned)launder_u((int)(unsigned)p), hi = (unsigned)launder_u((int)(unsigned)(p >> 32)); return (unsigned char*)(((unsigned long long)hi << 32) | lo); }
__device__ __forceinline__ Frame make_frame() {
    extern __shared__ __attribute__((aligned(16))) unsigned char lds_dyn_[];
    Frame F;
    F.lds = (LAS unsigned char*)lds_dyn_;
    F.MISC = (volatile LAS unsigned*)(F.lds + MISC_OFF);
    int t = my_tid(); asm volatile("" : "+v"(t));
    F.tid = t; F.lane = t & 63; F.wave = __builtin_amdgcn_readfirstlane(t >> 6);
    const int g = launder_u((int)gridDim.x), bx = launder_u((int)blockIdx.x);
    F.G = g; F.vcu = (g % 8 == 0) ? (bx % 8) * (g / 8) + bx / 8 : bx;
    F.ws = (unsigned char*)pg8::tab_ptr(22);
    return F;
}
__device__ __forceinline__ float wave_sum(float v) {
    XSUM64(v);
    return v;
}

constexpr int TP_PITCH = 144;
__device__ __forceinline__ void transpose_item64(const float* Wf, int Nsrc, int ca, int nva, int cb, int nvb, int K, bf16* WTf, int drow0, int k0, LAS unsigned char* scr, int lane, const float* gainf = nullptr) {
    const GAS float* W = (const GAS float*)Wf; GAS bf16* WT = (GAS bf16*)WTf;
    const int sub = (lane >> 3) & 1, c4 = 4 * (lane & 7), g = lane >> 4, nl = 32 * sub + c4;
    const bool ok = c4 < (sub ? nvb : nva);
    const GAS float* src = W + (size_t)(k0 + 2 * g) * Nsrc + (sub ? cb : ca) + c4;
    f32x4 v[16];
#pragma unroll
    for (int i = 0; i < 16; ++i) v[i] = ok ? *(const GAS f32x4*)(src + (size_t)(8 * (i >> 1) + (i & 1)) * Nsrc) : (f32x4){0.f, 0.f, 0.f, 0.f};
    if (gainf) { const GAS float* gp = (const GAS float*)gainf + k0 + 2 * g;
#pragma unroll
        for (int i = 0; i < 16; ++i) v[i] = v[i] * gp[8 * (i >> 1) + (i & 1)]; }
#pragma unroll
    for (int m = 0; m < 8; ++m)
#pragma unroll
        for (int j = 0; j < 4; ++j) *(LAS unsigned*)(scr + (nl + j) * TP_PITCH + (8 * m + 2 * g) * 2) = pk2(v[2 * m][j], v[2 * m + 1][j]);
    LDS_WAIT(); asm volatile("" ::: "memory");
#pragma unroll
    for (int t = 0; t < 8; ++t) { const int id = lane + 64 * t, n = id >> 3, c = id & 7;
        const v4u o = *(const LAS v4u*)(scr + n * TP_PITCH + 16 * c);
        *(GAS v4u*)(WT + (size_t)(drow0 + n) * K + k0 + 8 * c) = o; }
    LDS_WAIT(); asm volatile("" ::: "memory");
}
constexpr int IT_GU = (D / 64) * (N_GU / 64), IT_D = (FF / 64) * (D / 64), IT_IN = (D / 64) * (N_IN / 64), IT_OUT = (D / 64) * (D / 64);
constexpr int IT_LAYER = 2 * IT_GU + 2 * IT_D + IT_IN + IT_OUT;
__device__ __forceinline__ void conv_gu(const float* Wg, const float* Wu, bf16* WT, int r, LAS unsigned char* scr, int lane, const float* gain) {
    constexpr int nrg = N_GU / 64; const int kb = r / nrg, rg = r % nrg, p = rg >> 2, q = rg & 3; const int c0 = 128 * p + 64 * (q & 1);
    transpose_item64(q < 2 ? Wg : Wu, FF, c0, 32, c0 + 32, 32, D, WT, 64 * rg, 64 * kb, scr, lane, gain);
}
__device__ __forceinline__ void conv_plain(const float* W, int K, int N, bf16* WT, int r, LAS unsigned char* scr, int lane, const float* gain_lo = nullptr, const float* gain_hi = nullptr) {
    const int nrg = N / 64, kb = r / nrg, rg = r % nrg;
    const float* gain = gain_lo ? (64 * kb < 1024 ? gain_lo : gain_hi - 1024) : nullptr;
    transpose_item64(W, N, 64 * rg, 32, 64 * rg + 32, 32, K, WT, 64 * rg, 64 * kb, scr, lane, gain);
}
__device__ __forceinline__ int in_src_col(int pn, int wc, int bj) {
    if (pn < 16) { const int seg = pn >> 2, base = seg == 0 ? 0 : seg == 1 ? 1024 : seg == 2 ? 2048 : 3088; return base + 256 * (pn & 3) + 64 * wc + 32 * bj; }
    return (wc < 2 ? 4112 + 64 * wc : 4240 + 64 * (wc - 2)) + 32 * bj;
}
__device__ __forceinline__ void conv_in(const float* W, bf16* WT, int r, LAS unsigned char* scr, int lane, const float* gain) {
    constexpr int nrg = N_IN / 64; const int kb = r / nrg, rg = r % nrg, pn = rg >> 2, q = rg & 3, bj = q >> 1, wc0 = 2 * (q & 1);
    int ca, cb, nva = 32, nvb = 32;
    if (pn < 17) { ca = in_src_col(pn, wc0, bj); cb = in_src_col(pn, wc0 + 1, bj); }
    else { ca = 3072; cb = 3072; nva = (q == 0) ? 16 : 0; nvb = 0; }
    transpose_item64(W, IN_W, ca, nva, cb, nvb, D, WT, 64 * rg, 64 * kb, scr, lane, gain);
}
__device__ __forceinline__ void convert_item(Frame& F, unsigned char* w, int l, int r, LAS unsigned char* scr) {
    unsigned char* wl = w + WS_W + (size_t)l * LW_STRIDE;
    if (r < IT_GU) { conv_gu(inptr(F, 3) + (size_t)l * D * FF, inptr(F, 4) + (size_t)l * D * FF, (bf16*)(wl + LW_GU1), r, scr, F.lane, inptr(F, 2) + (size_t)l * D); return; } r -= IT_GU;
    if (r < IT_D) { conv_plain(inptr(F, 5) + (size_t)l * FF * D, FF, D, (bf16*)(wl + LW_D1), r, scr, F.lane); return; } r -= IT_D;
    if (r < IT_IN) { conv_in(inptr(F, 7) + (size_t)l * D * IN_W, (bf16*)(wl + LW_IN), r, scr, F.lane, inptr(F, 6) + (size_t)l * D); return; } r -= IT_IN;
    if (r < IT_OUT) { conv_plain(inptr(F, 16) + (size_t)l * D * D, D, D, (bf16*)(wl + LW_OUT), r, scr, F.lane, inptr(F, 14) + (size_t)l * 1024, inptr(F, 15) + (size_t)l * 1024); return; } r -= IT_OUT;
    if (r < IT_GU) { conv_gu(inptr(F, 18) + (size_t)l * D * FF, inptr(F, 19) + (size_t)l * D * FF, (bf16*)(wl + LW_GU2), r, scr, F.lane, inptr(F, 17) + (size_t)l * D); return; } r -= IT_GU;
    conv_plain(inptr(F, 20) + (size_t)l * FF * D, FF, D, (bf16*)(wl + LW_D2), r, scr, F.lane);
}
#define IDLE_CONV_K 4
constexpr int R_IDLE = IDLE_CONV_K * 128 * NWAVES, GU2_BASE = IT_GU + IT_D + IT_IN + IT_OUT;
static_assert(R_IDLE <= IT_GU, "idle-slot items are SwiGLU-2 items");
__device__ __forceinline__ void convert_layer(Frame& F, unsigned char* w, int l) {
    LAS unsigned char* scr = F.lds + RING_OFF + F.wave * 16384;
    const int gw = F.vcu * NWAVES + F.wave, NGW = F.G * NWAVES;
    if (F.G == 256) { for (int q = gw; q < IT_LAYER - R_IDLE; q += NGW) convert_item(F, w, l, q < GU2_BASE ? q : q + R_IDLE, scr); }
    else for (int r = gw; r < IT_LAYER; r += NGW) convert_item(F, w, l, r, scr);
}
__device__ __forceinline__ void p0_prologue(Frame& F) {
    const int gw = F.vcu * NWAVES + F.wave, NGW = F.G * NWAVES;
    unsigned char* w = wsl(F);
    for (int l = 0; l < (OVERLAP_CONV ? 1 : DEPTH); ++l) convert_layer(F, w, l);
    const GAS float* x = (const GAS float*)inptr(F, 0); const GAS float* meta = (const GAS float*)inptr(F, 1);
    GAS bf16* HB = (GAS bf16*)(w + WS_HB); GAS float* SSQ0 = (GAS float*)(w + WS_SSQ); GAS float* SSQM0 = (GAS float*)(w + WS_SSQM);
    for (int m = gw; m < M_REAL + NMETA; m += NGW) {
        const int row = m < M_REAL ? m : META_ROW + (m - M_REAL);
        GAS unsigned long long* hb8 = (GAS unsigned long long*)(HB + (size_t)row * D) + F.lane;
        const GAS f32x4* xr = (const GAS f32x4*)(m < M_REAL ? x + (size_t)m * D : meta + (size_t)(m - M_REAL) * D) + F.lane;
        float ss = 0.f;
#pragma unroll
        for (int j = 0; j < 8; ++j) { const f32x4 v = xr[64 * j]; const unsigned w0 = pk2(v.x, v.y), w1 = pk2(v.z, v.w); hb8[64 * j] = (unsigned long long)w0 | ((unsigned long long)w1 << 32);
            const float a0 = __builtin_bit_cast(float, w0 << 16), a1 = __builtin_bit_cast(float, w0 & 0xffff0000u), a2 = __builtin_bit_cast(float, w1 << 16), a3 = __builtin_bit_cast(float, w1 & 0xffff0000u);
            ss += (a0 * a0 + a1 * a1) + (a2 * a2 + a3 * a3); }
        ss = wave_sum(ss);
        if (m < M_REAL) { if (F.lane < 32) SSQ0[(size_t)m * 32 + F.lane] = F.lane == 0 ? ss : 0.f; }
        else { SSQM0[(m - M_REAL) * 128 + F.lane] = F.lane == 0 ? ss : 0.f; SSQM0[(m - M_REAL) * 128 + 64 + F.lane] = 0.f; }
    }
    if (gw < 48) { const int row = META_BLK0 + 64 + gw; const v4u z = (v4u){0u, 0u, 0u, 0u};
#pragma unroll
        for (int j = 0; j < 2; ++j) { ((GAS v4u*)(w + WS_FQ + (size_t)row * 2048))[F.lane + 64 * j] = z;
            ((GAS v4u*)(w + WS_SQ + (size_t)row * 2048))[F.lane + 64 * j] = z; } }
    {
        const v4u z = (v4u){0u, 0u, 0u, 0u}; constexpr int RB = (META_BLK0 + 64) >> 5;
        GAS v4u* fk = (GAS v4u*)((GAS bf16*)(w + WS_FK) + (size_t)RB * 16 * 2048); GAS v4u* sk = (GAS v4u*)((GAS bf16*)(w + WS_SK) + (size_t)RB * 2 * 2048);
        for (int i = gw * 64 + F.lane; i < 2 * 16 * 256; i += NGW * 64) fk[i] = z;
        for (int i = gw * 64 + F.lane; i < 2 * 2 * 256; i += NGW * 64) sk[i] = z;
        constexpr int G16 = (META_BLK0 + 64) >> 4;
        GAS v4u* fv = (GAS v4u*)((GAS bf16*)(w + WS_FV) + (size_t)G16 * 16 * 1024); GAS v4u* sv = (GAS v4u*)((GAS bf16*)(w + WS_SV) + (size_t)G16 * 2 * 1024);
        for (int i = gw * 64 + F.lane; i < 4 * 16 * 128; i += NGW * 64) fv[i] = z;
        for (int i = gw * 64 + F.lane; i < 4 * 2 * 128; i += NGW * 64) sv[i] = z; }
}
__device__ __forceinline__ void onorm_phase(Frame& F, const float* gf, const float* gs) {
    const int gw = F.vcu * NWAVES + F.wave, NGW = F.G * NWAVES;
    unsigned char* w = wsl(F); const GAS bf16* O = (const GAS bf16*)(w + WS_O); GAS bf16* XN = (GAS bf16*)(w + WS_XN);
    for (int mm = gw; mm < M_REAL + NMETA; mm += NGW) {
        const int m = mm < M_REAL ? mm : META_ROW + (mm - M_REAL);
        const GAS v4u* orow = (const GAS v4u*)(O + (size_t)m * D) + F.lane;
        GAS v4u* xrow = (GAS v4u*)(XN + (size_t)m * D) + F.lane;
        float x[4][8]; float sf = 0.f, ss = 0.f;
#pragma unroll
        for (int j = 0; j < 4; ++j) { const v4u w = orow[64 * j]; const unsigned ww[4] = {w.x, w.y, w.z, w.w};
#pragma unroll
            for (int e = 0; e < 4; ++e) { x[j][2 * e] = __builtin_bit_cast(float, ww[e] << 16); x[j][2 * e + 1] = __builtin_bit_cast(float, ww[e] & 0xffff0000u); }
            float q = 0.f;
#pragma unroll
            for (int e = 0; e < 8; ++e) q += x[j][e] * x[j][e];
            if (j < 2) sf += q; else ss += q; }
        const float rf = 1.0f / sqrtf(wave_sum(sf) * (1.0f / 1024.f) + EPS), rs = 1.0f / sqrtf(wave_sum(ss) * (1.0f / 1024.f) + EPS);
#pragma unroll
        for (int j = 0; j < 4; ++j) { const float* gp = (j < 2 ? gf : gs) + (j & 1) * 512 + 8 * F.lane; const f32x4 g0 = *(const GAS f32x4*)gp, g1 = *(const GAS f32x4*)(gp + 4); const float r = j < 2 ? rf : rs;
            v4u w; w.x = pk2(x[j][0] * r * g0.x, x[j][1] * r * g0.y); w.y = pk2(x[j][2] * r * g0.z, x[j][3] * r * g0.w); w.z = pk2(x[j][4] * r * g1.x, x[j][5] * r * g1.y); w.w = pk2(x[j][6] * r * g1.z, x[j][7] * r * g1.w);
            xrow[64 * j] = w; }
    }
}

constexpr int SK_RED_OFF = 0, SK_TILE_OFF = 65536, SK_RSTD_OFF = SK_TILE_OFF + 4096;
template <class Epi, int NST  >
__device__ __forceinline__ void skinny_phase(Frame& F, const GAS bf16* A, int lda, const GAS bf16* Bt, int K, const Epi& E) {
    constexpr int TC = Epi::TC;
    int lane = F.lane; asm volatile("" : "+v"(lane));
    const int w = F.wave;
    LAS float* red = (LAS float*)(F.lds + RING_OFF + SK_RED_OFF);
    LAS float* tile = (LAS float*)(F.lds + RING_OFF + SK_TILE_OFF);
    const int k0 = w * (NST * 32);
    bool first = true;
    for (int task = F.G - 1 - (int)blockIdx.x; task < E.ntasks(); task += F.G) {
        pg8::f32x4 acc[TC];
        const GAS bf16* bp[TC];
#pragma unroll
        for (int c = 0; c < TC; ++c) { acc[c] = (pg8::f32x4){0.f, 0.f, 0.f, 0.f}; bp[c] = Bt + (size_t)(E.btrow(task, c) + (lane & 15)) * K + k0 + 8 * (lane >> 4); }
        const GAS bf16* ap = A + (size_t)(lane & 15) * lda + k0 + 8 * (lane >> 4);
        bf16x8 av[NST], bv[TC][NST];
#pragma unroll
        for (int j = 0; j < NST; ++j) { av[j] = *(const GAS bf16x8*)(ap + 32 * j);
#pragma unroll
            for (int c = 0; c < TC; ++c) bv[c][j] = *(const GAS bf16x8*)(bp[c] + 32 * j); }
        if (first) {
            if constexpr (Epi::KHALF_SCALE) {
                LAS float* rv = (LAS float*)(F.lds + RING_OFF + SK_RSTD_OFF);
#pragma unroll
                for (int j = 0; j < 2; ++j) { const int row = 2 * w + j; float t = lane < 32 ? E.ssqom[row * 32 + lane] : 0.f;
                    XSUM16(t);
                    if (lane == 0) rv[row] = 1.0f / sqrtf(t * (1.0f / 1024.0f) + EPS); if (lane == 16) rv[16 + row] = 1.0f / sqrtf(t * (1.0f / 1024.0f) + EPS); }
            }
            if constexpr (Epi::NEED_RSTD) {
                LAS float* rv = (LAS float*)(F.lds + RING_OFF + SK_RSTD_OFF);
#pragma unroll
                for (int j = 0; j < 2; ++j) { const int row = 2 * w + j; const float t = wave_sum(E.ssqm[row * 128 + lane] + E.ssqm[row * 128 + 64 + lane]); if (lane == 0) rv[row] = 1.0f / sqrtf(t * (1.0f / D) + EPS); }
            }
            first = false;
        }
#pragma unroll
        for (int j = 0; j < NST; ++j)
#pragma unroll
            for (int c = 0; c < TC; ++c) acc[c] = __builtin_amdgcn_mfma_f32_16x16x32_bf16(av[j], bv[c][j], acc[c], 0, 0, 0);
#pragma unroll
        for (int c = 0; c < TC; ++c)
#pragma unroll
            for (int r = 0; r < 4; ++r) red[((w * TC + c) * 4 + r) * 64 + lane] = acc[c][r];
        __syncthreads();
        for (int e = F.tid; e < TC * 256; e += NWAVES * 64) { float sum = 0.f, sum2 = 0.f;
#pragma unroll
            for (int w2 = 0; w2 < 4; ++w2) { sum += red[w2 * TC * 256 + e]; sum2 += red[(w2 + 4) * TC * 256 + e]; }
            const int ln = e & 63, r = (e >> 6) & 3, c = e >> 8, orow = (ln >> 4) * 4 + r;
            if constexpr (Epi::KHALF_SCALE) { const LAS float* rv = (const LAS float*)(F.lds + RING_OFF + SK_RSTD_OFF); sum = sum * rv[orow] + sum2 * rv[16 + orow]; } else sum += sum2;
            tile[orow * 64 + 16 * c + (ln & 15)] = sum; }
        __syncthreads();
        E.store(F, task, tile);
        if (task + F.G < E.ntasks()) __syncthreads();
    }
}
struct SkGU {
    static constexpr int TC = 4; static constexpr bool NEED_RSTD = true, KHALF_SCALE = false;
    GAS bf16* act; const GAS float* ssqm;
    __device__ __forceinline__ int ntasks() const { return FF / 32; }
    __device__ __forceinline__ int btrow(int t, int c) const { const int p = t >> 2, q = t & 3; return 256 * p + 128 * (c >> 1) + 32 * q + 16 * (c & 1); }
    __device__ __forceinline__ void store(Frame& F, int t, const LAS float* tile) const {
        const int row = F.tid >> 5, col = F.tid & 31; const float r = ((const LAS float*)(F.lds + RING_OFF + SK_RSTD_OFF))[row];
        act[(size_t)(META_ROW + row) * FF + 32 * t + col] = (bf16)f2bf(pg8::silu_mul(tile[row * 64 + col] * r, tile[row * 64 + 32 + col] * r));
    }
};
struct SkRes {
    static constexpr int TC = 1; static constexpr bool NEED_RSTD = false, KHALF_SCALE = false;
    float scale; GAS bf16* hb; GAS float* ssqm;
    __device__ __forceinline__ int ntasks() const { return D / 16; }
    __device__ __forceinline__ int btrow(int t, int) const { return 16 * t; }
    __device__ __forceinline__ void store(Frame& F, int t, const LAS float* tile) const {
        if (F.tid < 256) { const int row = F.tid >> 4, col = F.tid & 15; const size_t off = (size_t)(META_ROW + row) * D + 16 * t + col;
            const unsigned hbits = f2bf(bf2f(hb[off]) + scale * tile[row * 64 + col]); hb[off] = (bf16)hbits; const float v = bf2f((bf16)hbits); float ss = v * v;
            XSUM16(ss);
            if (col == 0) ssqm[row * 128 + t] = ss; }
    }
};
struct SkOut {
    static constexpr int TC = 1; static constexpr bool NEED_RSTD = false, KHALF_SCALE = true;
    float scale; GAS bf16* hb; GAS float* ssqm; const GAS float* ssqom;
    __device__ __forceinline__ int ntasks() const { return D / 16; }
    __device__ __forceinline__ int btrow(int t, int) const { return 16 * t; }
    __device__ __forceinline__ void store(Frame& F, int t, const LAS float* tile) const {
        if (F.tid < 256) { const int row = F.tid >> 4, col = F.tid & 15; const size_t off = (size_t)(META_ROW + row) * D + 16 * t + col;
            const unsigned hbits = f2bf(bf2f(hb[off]) + scale * tile[row * 64 + col]); hb[off] = (bf16)hbits; const float v = bf2f((bf16)hbits); float ss = v * v;
            XSUM16(ss);
            if (col == 0) ssqm[row * 128 + t] = ss; }
    }
};
struct SkIn {
    static constexpr int TC = 4; static constexpr bool NEED_RSTD = true, KHALF_SCALE = false;
    GAS bf16 *fq_, *fk_, *fv_, *sq_, *sk_, *sv_; GAS float* logf; const GAS float *g_fq, *g_fk, *g_sq, *g_sk, *bfg; float qscale; const GAS float* ssqm;
    __device__ __forceinline__ int ntasks() const { return 69; }
    __device__ __forceinline__ int btrow(int t, int c) const { if (t == 68) return 17 * 256 + 16 * c; const int pn = t < 64 ? (t >> 2) : 16, wc = t < 64 ? (t & 3) : (t - 64); return 256 * pn + 128 * (c >> 1) + 32 * wc + 16 * (c & 1); }
    __device__ __forceinline__ void store(Frame& F, int t, const LAS float* tile) const {
        if (t == 68) { if (F.tid < 256) { const int row = F.tid >> 4, hh = F.tid & 15; const float z = tile[row * 64 + hh] * ((const LAS float*)(F.lds + RING_OFF + SK_RSTD_OFF))[row] + bfg[hh];
                logf[(size_t)(META_ROW + row) * 16 + hh] = fminf(z, 0.f) - 0.69314718056f * __builtin_amdgcn_logf(1.0f + __builtin_amdgcn_exp2f(-LOG2E * fabsf(z))); } return; }
        const int pn = t < 64 ? (t >> 2) : 16, wc = t < 64 ? (t & 3) : (t - 64);
        GAS bf16* dst; int pitch, head, knh = 0; const GAS float* gain = nullptr; float sc = 1.f;
        if (pn < 16) { const int seg = pn >> 2; head = (pn & 3) * 4 + wc; pitch = 1024;
            if (seg == 0) { dst = fq_; gain = g_fq; sc = qscale; } else if (seg == 1) { dst = fk_; gain = g_fk; knh = 16; } else if (seg == 2) { dst = fv_; } else { dst = sq_; gain = g_sq; sc = qscale; } }
        else { pitch = 128; head = wc & 1; if (wc < 2) { dst = sk_; gain = g_sk; knh = 2; } else { dst = sv_; } }
        const int row = F.tid >> 5, cp = F.tid & 31; const float rr = ((const LAS float*)(F.lds + RING_OFF + SK_RSTD_OFF))[row];
        float v0 = tile[row * 64 + 2 * cp] * rr, v1 = tile[row * 64 + 2 * cp + 1] * rr;
        if (gain) { float ss = v0 * v0 + v1 * v1;
            XSUM32(ss);
            const float rinv = 1.0f / sqrtf(ss * (1.0f / 64.0f) + EPS); v0 = v0 * rinv * gain[2 * cp] * sc; v1 = v1 * rinv * gain[2 * cp + 1] * sc; }
        if (knh) *(GAS unsigned*)(dst + kfrag_idx(META_ROW + row, knh, head, 2 * cp)) = pk2(v0, v1);
        else if (!gain) { GAS bf16* vp = dst + vfrag_idx(META_ROW + row, pn < 16 ? 16 : 2, head, 2 * cp); const unsigned pw = pk2(v0, v1); vp[0] = (bf16)(pw & 0xffffu); vp[8] = (bf16)(pw >> 16); }
        else *(GAS unsigned*)(dst + (size_t)(META_ROW + row) * pitch + head * 64 + 2 * cp) = pk2(v0, v1);
    }
};

__device__ __forceinline__ void split3(float x, unsigned& h, unsigned& m, unsigned& l) { h = f2bf(x); const float r = x - bf2f((unsigned short)h); m = f2bf(r); const float r2 = r - bf2f((unsigned short)m); l = f2bf(r2); }
__device__ __forceinline__ int crow(int r, int hi) { return (r & 3) + 8 * (r >> 2) + 4 * hi; }
typedef short v4i16_t __attribute__((ext_vector_type(4)));
__device__ __forceinline__ float max3f(float a, float b, float c) { return fmaxf(fmaxf(a, b), c); }
constexpr float ATT_THR = 40.0f;
constexpr int ATT_KV_OFF = 36864;
template <int MODE>
__device__ __forceinline__ void kv_dma(Frame& F, unsigned char* w, int gb, int kvh, int c, int image) {
    constexpr int NHK = (MODE == 0) ? 16 : 2; const int wv = F.wave, lane = F.lane; const int rowk = (c == 1) ? META_BLK0 + 64 : gb * SEQ + 64 * (c - 2);
    const GAS bf16* kp = (const GAS bf16*)(w + (MODE == 0 ? WS_FK : WS_SK)) + ((size_t)((rowk >> 5) + (wv >> 2)) * NHK + kvh) * 2048 + (wv & 3) * 512 + lane * 8;
    const GAS bf16* vp = (const GAS bf16*)(w + (MODE == 0 ? WS_FV : WS_SV)) + ((size_t)((rowk >> 4) + (wv >> 1)) * NHK + kvh) * 1024 + (wv & 1) * 512 + lane * 8;
    LAS unsigned char* d = F.lds + RING_OFF + ATT_KV_OFF + image * 16384 + wv * 1024;
    __builtin_amdgcn_global_load_lds((const unsigned*)kp, (LAS unsigned*)d, 16, 0, 0); __builtin_amdgcn_global_load_lds((const unsigned*)vp, (LAS unsigned*)(d + 8192), 16, 0, 0);
}
template <int MODE  , int RES = 0>
__device__ __forceinline__ void attn_group(Frame& F, unsigned char* w, int gb, int kvh, int c_lo, int c_hi, bool active, int b  , int h, int i, const float* sinks, int res_c0 = 0) {
    const int lane = F.lane, r32 = lane & 31, hi = lane >> 5, wv = F.wave;
    const bool meta = b < 0;
    const int qpos0 = meta ? 96 : 128 + 32 * i;
    const int qrow0 = meta ? META_BLK0 + 96 : b * SEQ + 32 * i;
    const int cd = qpos0 >> 6;
    const int cfirst = (MODE == 0) ? (meta ? 1 : __builtin_amdgcn_readfirstlane(((const volatile LAS int*)(F.lds + RING_OFF + ATT_FC_OFF))[i])) : ((qpos0 - 127) < 128 ? 1 : ((qpos0 - 127) >> 6));
    constexpr int NHK = (MODE == 0) ? 16 : 2;
    const GAS bf16* Qp = (const GAS bf16*)(w + (MODE == 0 ? WS_FQ : WS_SQ)) + (size_t)qrow0 * 1024 + h * 64;
    const GAS bf16* kdma = (const GAS bf16*)(w + (MODE == 0 ? WS_FK : WS_SK)) + ((size_t)(wv >> 2) * NHK + kvh) * 2048 + (wv & 3) * 512 + lane * 8;
    const GAS bf16* vdma = (const GAS bf16*)(w + (MODE == 0 ? WS_FV : WS_SV)) + ((size_t)(wv >> 1) * NHK + kvh) * 1024 + (wv & 1) * 512 + lane * 8;
    LAS unsigned char* kvb = F.lds + RING_OFF + ATT_KV_OFF;
    const float sl2 = (MODE == 1) ? exp2f(-0.5f * (float)(h + 1)) * LOG2E : 0.f;
    const LAS unsigned char* tfp = F.lds + RING_OFF + (hi ? ATT_ZERO_OFF : ATT_TABF_OFF + r32 * 16); const int toff = hi ? 0 : 1;
    v4u mfr = hi ? (v4u){0u, 0u, 0u, 0u} : (v4u){0x3F803F80u, 0x3F80u, 0u, 0u};
    bf16x8 qf[4];
    if (active) {
#pragma unroll
        for (int s = 0; s < 4; ++s) qf[s] = *(const GAS bf16x8*)(Qp + (size_t)r32 * 1024 + 16 * s + 8 * hi);
    } else {
#pragma unroll
        for (int s = 0; s < 4; ++s) qf[s] = (bf16x8){0, 0, 0, 0, 0, 0, 0, 0};
    }
#define CHUNK_ROW(c) ((c) == 1 ? META_BLK0 + 64 : gb * SEQ + 64 * ((c) - 2))
#define KV_DMA(c_) do { const int rowk_ = CHUNK_ROW(c_); LAS unsigned char* d_ = kvb + ((c_) & 1) * 16384 + wv * 1024; \
        __builtin_amdgcn_global_load_lds((const unsigned*)(kdma + (size_t)(rowk_ >> 5) * (NHK * 2048)), (LAS unsigned*)d_, 16, 0, 0); \
        __builtin_amdgcn_global_load_lds((const unsigned*)(vdma + (size_t)(rowk_ >> 4) * (NHK * 1024)), (LAS unsigned*)(d_ + 8192), 16, 0, 0); } while (0)
    float m_run = 0.f, l_run = 0.f; f32x16 o0 = {}, o1 = {};
    const float NEG = -1e30f;
    if (!RES) { __syncthreads();
        KV_DMA(c_lo); }
    for (int c = c_lo; c <= c_hi; ++c) {
        if (!RES) { asm volatile("s_waitcnt vmcnt(0) lgkmcnt(0)" ::: "memory"); __builtin_amdgcn_s_barrier(); __builtin_amdgcn_sched_barrier(0);
            if (c < c_hi) KV_DMA(c + 1); }
        if (!(active && c >= cfirst && c <= cd)) continue;
        const LAS unsigned char* cb = kvb + (RES ? (c - res_c0) : (c & 1)) * 16384 + hi * 512 + r32 * 16;
        bf16x8 kf[2][4];
#pragma unroll
        for (int t = 0; t < 2; ++t)
#pragma unroll
            for (int s = 0; s < 4; ++s) kf[t][s] = *(const LAS bf16x8*)(cb + t * 4096 + s * 1024);
        f32x16 p0 = {}, p1 = {};
        bf16x8 ab0, ab1;
        if (MODE == 0) { ab0 = *(const LAS bf16x8*)(tfp + toff * (1024 * c)); ab1 = *(const LAS bf16x8*)(tfp + toff * (1024 * c + 512)); }
        __builtin_amdgcn_s_setprio(1);
#pragma unroll
        for (int s = 0; s < 4; ++s) { p0 = __builtin_amdgcn_mfma_f32_32x32x16_bf16(kf[0][s], qf[s], p0, 0, 0, 0); p1 = __builtin_amdgcn_mfma_f32_32x32x16_bf16(kf[1][s], qf[s], p1, 0, 0, 0); }
        if (MODE == 0) { const bf16x8 mb = __builtin_bit_cast(bf16x8, mfr); p0 = __builtin_amdgcn_mfma_f32_32x32x16_bf16(ab0, mb, p0, 0, 0, 0); p1 = __builtin_amdgcn_mfma_f32_32x32x16_bf16(ab1, mb, p1, 0, 0, 0); }
        __builtin_amdgcn_s_setprio(0);
        bf16x8 vf[4][2];
#pragma unroll
        for (int g = 0; g < 4; ++g)
#pragma unroll
            for (int d = 0; d < 2; ++d) vf[g][d] = *(const LAS bf16x8*)(cb + 8192 + g * 2048 + hi * 512 + d * 512);
        if (MODE == 0) {
            if (c == cd) { const int dq = qpos0 + r32 - 64 * c - 4 * hi;
#pragma unroll
                for (int r = 0; r < 16; ++r) { const int e = (r & 3) + 8 * (r >> 2); if (e > dq) p0[r] = NEG; if (e + 32 > dq) p1[r] = NEG; } }
        } else {
            const float kb0 = (float)(64 * c - qpos0 + 4 * hi) - m_run / sl2;
#pragma unroll
            for (int r = 0; r < 16; ++r) { const float e = (float)((r & 3) + 8 * (r >> 2)); p0[r] = fmaf(sl2, kb0 + e, p0[r]); p1[r] = fmaf(sl2, kb0 + 32.f + e, p1[r]); }
            const int dq = qpos0 + r32 - 64 * c - 4 * hi;
            const int padlim = (c == 1) ? 48 - 4 * hi : -1;
            const bool interior = c != 1 && 64 * c + 63 <= qpos0 && 64 * c > qpos0 + 31 - 128;
            if (!interior) {
#pragma unroll
            for (int r = 0; r < 16; ++r) { const int e = (r & 3) + 8 * (r >> 2);
                if ((unsigned)(dq - e) >= 128u || e < padlim) p0[r] = NEG;
                if ((unsigned)(dq - e - 32) >= 128u || e + 32 < padlim) p1[r] = NEG; } }
        }
        float mx = max3f(p0[0], p0[1], p1[0]);
#pragma unroll
        for (int r = 2; r < 16; r += 2) mx = max3f(mx, p0[r], p0[r + 1]);
#pragma unroll
        for (int r = 1; r < 16; r += 2) mx = max3f(mx, p1[r], (r + 1 < 16) ? p1[r + 1] : p1[r]);
        const bool first = (c == cfirst);
        if (first || __any(mx > ATT_THR)) {
            mx = fmaxf(mx, shx<32>(mx));
            const float dl = first ? fmaxf(mx, -200.f) : fmaxf(mx, 0.f);
            m_run += dl;
            if (MODE == 0) { unsigned h_, m_, l_; split3(-m_run, h_, m_, l_); if (!hi) { mfr.y = 0x3F80u | (h_ << 16); mfr.z = m_ | (l_ << 16); } }
            const float alpha = first ? 0.f : __builtin_amdgcn_exp2f(-dl);
            l_run *= alpha;
#pragma unroll
            for (int r = 0; r < 16; ++r) { p0[r] -= dl; p1[r] -= dl; }
            if (!first) {
#pragma unroll
                for (int r = 0; r < 16; ++r) { o0[r] *= alpha; o1[r] *= alpha; } }
        }
        float rs = 0.f;
#pragma unroll
        for (int r = 0; r < 16; ++r) { p0[r] = __builtin_amdgcn_exp2f(p0[r]); p1[r] = __builtin_amdgcn_exp2f(p1[r]); rs += p0[r] + p1[r]; }
        l_run += rs;
#pragma unroll
        for (int t = 0; t < 2; ++t)
#pragma unroll
            for (int s = 0; s < 2; ++s) {
                const f32x16& pp = t ? p1 : p0;
                v4u wq; wq.x = pg8::cvt_pk_bf16(pp[8 * s + 0], pp[8 * s + 1]); wq.y = pg8::cvt_pk_bf16(pp[8 * s + 2], pp[8 * s + 3]); wq.z = pg8::cvt_pk_bf16(pp[8 * s + 4], pp[8 * s + 5]); wq.w = pg8::cvt_pk_bf16(pp[8 * s + 6], pp[8 * s + 7]);
                const bf16x8 pf = __builtin_bit_cast(bf16x8, wq);
                const bf16x8 v0 = vf[2 * t + s][0], v1 = vf[2 * t + s][1];
                o0 = __builtin_amdgcn_mfma_f32_32x32x16_bf16(v0, pf, o0, 0, 0, 0);
                o1 = __builtin_amdgcn_mfma_f32_32x32x16_bf16(v1, pf, o1, 0, 0, 0);
            }
    }
#undef CHUNK_ROW
#undef KV_DMA
    if (!active) return;
    l_run += shx<32>(l_run);
    if (MODE == 1) l_run += __builtin_amdgcn_exp2f(sinks[h] * LOG2E + sl2 * (float)r32 - m_run);
    float inv = 1.0f / l_run;
    const int qrow0e = launder_u(qrow0), he = launder_u(h);
    int lane_e = lane; asm volatile("" : "+v"(lane_e)); const int r32e = lane_e & 31, hie = lane_e >> 5;
    if (meta && r32e < 16) inv = 0.f;
    GAS bf16* Op = (GAS bf16*)(w + WS_O) + (size_t)(qrow0e + r32e) * D + (MODE == 0 ? 0 : 1024) + he * 64 + 4 * hie;
    GAS float* sqo = meta ? (GAS float*)(w + WS_SSQOM) + (MODE == 0 ? 0 : 16) + he : (GAS float*)(w + WS_SSQO) + (size_t)qrow0e * 32 + (MODE == 0 ? 0 : 16) + he;
    float ss = 0.f;
#pragma unroll
    for (int g = 0; g < 4; ++g) {
        unsigned a[4], c[4];
#pragma unroll
        for (int j = 0; j < 4; ++j) { a[j] = f2bf(o0[4 * g + j] * inv); c[j] = f2bf(o1[4 * g + j] * inv);
            const float v0 = bf2f((bf16)a[j]), v1 = bf2f((bf16)c[j]); ss += v0 * v0 + v1 * v1; }
        *(GAS unsigned long long*)(Op + 8 * g) = (unsigned long long)(a[0] | (a[1] << 16)) | ((unsigned long long)(a[2] | (a[3] << 16)) << 32);
        *(GAS unsigned long long*)(Op + 32 + 8 * g) = (unsigned long long)(c[0] | (c[1] << 16)) | ((unsigned long long)(c[2] | (c[3] << 16)) << 32);
    }
    ss += shx<32>(ss);
    if (hie == 0) { if (!meta) sqo[(size_t)r32e * 32] = ss; else if (r32e >= 16) sqo[(size_t)(r32e - 16) * 32] = ss; }
}
__device__ __forceinline__ void probe_t0(LAS unsigned char* lds) { if (PROBE_CLASS > 50 && (PROBE_BLOCK < 0 || (int)blockIdx.x == PROBE_BLOCK) && my_tid() == 0) *(volatile LAS unsigned long long*)(lds + MISC_OFF + 72) = __builtin_amdgcn_s_memrealtime(); }
__device__ __forceinline__ void probe_t1(LAS unsigned char* lds, int c) { if (PROBE_CLASS == c && (PROBE_BLOCK < 0 || (int)blockIdx.x == PROBE_BLOCK) && my_tid() == 0) { volatile LAS unsigned long long* pa_ = (volatile LAS unsigned long long*)(lds + MISC_OFF + 64); *pa_ = *pa_ + (__builtin_amdgcn_s_memrealtime() - *(volatile LAS unsigned long long*)(lds + MISC_OFF + 72)); } }
__device__ __forceinline__ void attn_phase(Frame& F, const float* sinks, int next_layer  , const float* gq, const float* gk) {
    probe_t0(F.lds);
    unsigned char* w = wsl(F); const GAS float* LOGF = (const GAS float*)(w + WS_LOGF);
    const int bh = F.vcu >> 1, fb = bh >> 4, fh = bh & 15;
    LAS float* tab = (LAS float*)(F.lds + RING_OFF + ATT_TAB_OFF);
    LAS float* wtot = (LAS float*)(F.lds + RING_OFF + ATT_WTOT_OFF);
    float x5[5];
#pragma unroll
    for (int j = 0; j < 5; ++j) { const int p = 5 * F.tid + j; x5[j] = 0.f;
        if (p >= PADN && p < LPOS) { const int row = p < 128 ? META_BLK0 + p : fb * SEQ + p - 128; x5[j] = LOGF[(size_t)row * 16 + fh]; } }
    {
      { const int T0 = F.vcu * 4, sb = T0 >> 7, kvh = (T0 >> 6) & 1, i0 = T0 & 63, m = 1 + (i0 >> 2); const int u_lo = (i0 == 0) ? 1 : 2 * m - 2, u_hi = 2 * m + 1;
        for (int c = u_lo; c <= u_hi; ++c) kv_dma<1>(F, w, sb, kvh, c, c - u_lo);
        asm volatile("s_waitcnt vmcnt(0)" ::: "memory"); __syncthreads();
        for (int k = 0; k < 4; ++k) { const int i = i0 + k, qp = 128 + 32 * i;
            attn_group<1, 1>(F, w, sb, kvh, (qp - 127) < 128 ? 1 : ((qp - 127) >> 6), qp >> 6, true, sb, 8 * kvh + F.wave, i, sinks, u_lo); } }
      probe_t1(F.lds, 53); probe_t0(F.lds);
      if (F.vcu < 32 && (F.vcu & 1) == 1) attn_group<1>(F, w, 0, (F.vcu >> 1) >> 3, 1, 1, F.wave == 0, -1, F.vcu >> 1, 0, sinks); }
    probe_t1(F.lds, 54); probe_t0(F.lds);
    { float v[5]; float tsum = 0.f; const int p0 = 5 * F.tid;
#pragma unroll
      for (int j = 0; j < 5; ++j) { tsum += x5[j]; v[j] = tsum; }
      float inc = tsum;
#pragma unroll
      for (int o = 1; o < 64; o <<= 1) { const float t = shi(inc, F.lane - o); if (F.lane >= o) inc += t; }
      if (F.lane == 63) wtot[F.wave] = inc;
      __syncthreads();
      float base = inc - tsum;
      for (int w = 0; w < F.wave; ++w) base += wtot[w];
#pragma unroll
      for (int j = 0; j < 5; ++j) { const int p = p0 + j; if (p < LPOS) { const float cv = (p < PADN) ? 1e30f : (base + v[j]) * LOG2E; tab[p] = cv;
          unsigned h_, m_, l_; split3(fmaxf(-cv, -60000.f), h_, m_, l_);
          LAS unsigned* tf = (LAS unsigned*)(F.lds + RING_OFF + ATT_TABF_OFF + p * 16); unsigned one2 = 0x3F803F80u, zz = 0u; asm volatile("" : "+v"(one2), "+v"(zz));
          tf[0] = h_ | (m_ << 16); tf[1] = l_ | (one2 << 16); tf[2] = one2; tf[3] = zz; } }
      if (F.tid < 4) ((LAS unsigned*)(F.lds + RING_OFF + ATT_ZERO_OFF))[F.tid] = 0u;
      __syncthreads();
      if (F.wave == 0) { float mq = fabsf(((const GAS float*)gq)[F.lane]), mk = fabsf(((const GAS float*)gk)[F.lane]);
#define XMAX_(v, O) v = fmaxf(v, shx<O>(v))
          XMAX_(mq, 1); XMAX_(mq, 2); XMAX_(mq, 4); XMAX_(mq, 8); XMAX_(mq, 16); XMAX_(mq, 32); XMAX_(mk, 1); XMAX_(mk, 2); XMAX_(mk, 4); XMAX_(mk, 8); XMAX_(mk, 16); XMAX_(mk, 32);
#undef XMAX_
          const float thr = -(152.0f + 2.0f * (64.0f * QSCALE * mq * mk * 1.02f + 1.0f));
          const int q0pos = 128 + 32 * F.lane, cdl = q0pos >> 6; const float tq = tab[q0pos];
          int lo = 1, hi = cdl;
#pragma unroll 1
          for (int it = 0; it < 6; ++it) { const int mid = (lo + hi) >> 1; const bool far = (lo < hi) && (tq - tab[64 * mid + 63] < thr); if (lo < hi) { if (far) lo = mid + 1; else hi = mid; } }
          ((LAS int*)(F.lds + RING_OFF + ATT_FC_OFF))[F.lane] = lo; }
      __syncthreads(); }
    probe_t1(F.lds, 51); probe_t0(F.lds);
    {
      const int odd = F.vcu & 1;
      for (int k = 0; k < 4; ++k) { const int g = (k == 0) ? odd : (k == 1) ? 3 - odd : (k == 2) ? 4 + odd : 7 - odd;
          int cf = 1 << 20;
#pragma unroll
          for (int j = 0; j < 8; ++j) cf = min(cf, ((const volatile LAS int*)(F.lds + RING_OFF + ATT_FC_OFF))[8 * g + j]);
          cf = __builtin_amdgcn_readfirstlane(cf);
          attn_group<0>(F, w, fb, fh, cf, (128 + 32 * (8 * g + 7)) >> 6, true, fb, fh, 8 * g + F.wave, sinks); }
      probe_t1(F.lds, 52); probe_t0(F.lds);
      if (F.vcu < 32 && odd == 0) attn_group<0>(F, w, 0, fh, 1, 1, F.wave == 0, -1, fh, 0, sinks); }
    __syncthreads();
    probe_t1(F.lds, 54);
}

constexpr int PH_PER_LAYER = 7, N_PHASES = 1 + DEPTH * PH_PER_LAYER;
struct Args { const float* in[21]; float* out; unsigned char* ws; int ph_lo, ph_hi, li, pad; };
__global__ void __launch_bounds__(NWAVES * 64, 2) hymba_fwd(Args args) {
    extern __shared__ __attribute__((aligned(16))) unsigned char lds[];
    {
        LAS unsigned char* l0 = (LAS unsigned char*)lds; const int tid = threadIdx.x;
        for (int u = tid; u < (LDS_BYTES - LDSCTL_OFF) / 4; u += NWAVES * 64) ((LAS unsigned*)(l0 + LDSCTL_OFF))[u] = 0u;
        __syncthreads();
        if ((tid & 63) == 0) ((volatile LAS int*)(l0 + WID_OFF))[hw_wave_key()] = tid >> 6;
        volatile LAS unsigned long long* pt = (volatile LAS unsigned long long*)(l0 + PTR_OFF);
#pragma unroll
        for (int k = 0; k < 21; ++k) if (tid == k) pt[k] = (unsigned long long)args.in[k];
        if (tid == 21) pt[21] = (unsigned long long)args.out;
        if (tid == 22) pt[22] = (unsigned long long)args.ws;
        __syncthreads();
#if !MK_PER_PHASE
        (void)xcd_barrier_post((unsigned*)((gu32*)(args.ws + WS_CTL) + CW_BAR), (volatile LAS unsigned*)(l0 + MISC_OFF) + 8);
#endif
    }
    const int lo = args.ph_lo, hi = args.ph_hi;
#define IN(k) (lo <= (k) && (k) < hi)
#define PROBE_T0() if (PROBE_CLASS == 60 && (PROBE_BLOCK < 0 || (int)blockIdx.x == PROBE_BLOCK) && my_tid() == 0) { *(volatile LAS unsigned long long*)((LAS unsigned char*)lds + MISC_OFF + 72) = __builtin_amdgcn_s_memtime(); } else if (PROBE_CLASS >= 0 && (PROBE_BLOCK < 0 || (int)blockIdx.x == PROBE_BLOCK) && my_tid() == 0) { *(volatile LAS unsigned long long*)((LAS unsigned char*)lds + MISC_OFF + 72) = __builtin_amdgcn_s_memrealtime(); }
#define PROBE_T1(c) if (PROBE_CLASS == 60 && (c) == 2 && (PROBE_BLOCK < 0 || (int)blockIdx.x == PROBE_BLOCK) && my_tid() == 0) { volatile LAS unsigned long long* pa_ = (volatile LAS unsigned long long*)((LAS unsigned char*)lds + MISC_OFF + 64); *pa_ = *pa_ + (__builtin_amdgcn_s_memtime() - *(volatile LAS unsigned long long*)((LAS unsigned char*)lds + MISC_OFF + 72)) / 24ull; } else if (PROBE_CLASS == (c) && (PROBE_BLOCK < 0 || (int)blockIdx.x == PROBE_BLOCK) && my_tid() == 0) { volatile LAS unsigned long long* pa_ = (volatile LAS unsigned long long*)((LAS unsigned char*)lds + MISC_OFF + 64); *pa_ = *pa_ + (__builtin_amdgcn_s_memrealtime() - *(volatile LAS unsigned long long*)((LAS unsigned char*)lds + MISC_OFF + 72)); }
#define SEAM(k) do { if (IN(k) && IN((k) + 1)) { PROBE_T0() unsigned char* wsb_ = (unsigned char*)pg8::tab_ptr(22); \
        if (MK_PER_PHASE) { if (my_tid() == 0) __hip_atomic_store((gu32*)(wsb_ + WS_CTL) + CW_TMO, 0xBADBA0u, RLX_AGENT); } \
        else { XcdBarrier bar_; bar_.bar = (unsigned*)((gu32*)(wsb_ + WS_CTL) + CW_BAR); bar_.x = xb_xcc_id(); bar_.st = (volatile LAS unsigned*)((LAS unsigned char*)lds + MISC_OFF) + 8; xcd_barrier(bar_); if (PROBE_CLASS == 50) xcd_barrier(bar_); } PROBE_T1(8) } } while (0)
#define PHASE_BEGIN(k) if (IN(k)) { PROBE_T0() Frame P = make_frame(); \
        unsigned char* w = wsl(P); int ll = l; LAUNDER_S(ll); unsigned char* wl = w + WS_W + (size_t)ll * LW_STRIDE; (void)wl; int bxl = blockIdx.x; LAUNDER_S(bxl);
#define PHASE_END(k, c) PROBE_T1(c) } SEAM(k);
    typedef pg8::StaticOrder SO;
    if (IN(0)) { PROBE_T0() Frame P = make_frame(); p0_prologue(P); PROBE_T1(0) } SEAM(0);
    for (int l = 0; l < DEPTH; ++l) {
        const int pb = 1 + l * PH_PER_LAYER;
#define SSQ(j) ((GAS float*)(w + WS_SSQM) + (size_t)(3 * ll + (j)) * 16 * 128)
#define HBM ((const GAS bf16*)(w + WS_HB) + (size_t)META_ROW * D)
        PHASE_BEGIN(pb + 0) pg8::Gemm g{(const bf16*)(w + WS_HB), (const bf16*)(wl + LW_GU1), M_REAL, N_GU, D}; SO S; S.init(M_REAL, N_GU, P.G, bxl);
            pg8::EpiSwiGLU E{3 * ll + 0}; pg8::gemm_phase<pg8::EpiSwiGLU, SO, true, true>(P.lds + RING_OFF, g, S, E);
            SkGU K2{(GAS bf16*)(w + WS_ACT), SSQ(0)}; skinny_phase<SkGU, D / 256>(P, HBM, D, (const GAS bf16*)(wl + LW_GU1), D, K2); PHASE_END(pb + 0, 2)
        PHASE_BEGIN(pb + 1) pg8::Gemm g{(const bf16*)(w + WS_ACT), (const bf16*)(wl + LW_D1), M_REAL, D, FF}; SO S; S.init(M_REAL, D, P.G, bxl);
            pg8::EpiResAdd E{0.5f, 3 * ll + 1, 0}; pg8::gemm_phase<pg8::EpiResAdd, SO, true, true>(P.lds + RING_OFF, g, S, E);
            SkRes K2{0.5f, (GAS bf16*)(w + WS_HB), SSQ(1)}; skinny_phase<SkRes, FF / 256>(P, (const GAS bf16*)(w + WS_ACT) + (size_t)META_ROW * FF, FF, (const GAS bf16*)(wl + LW_D1), FF, K2); PHASE_END(pb + 1, 3)
        PHASE_BEGIN(pb + 2) pg8::Gemm g{(const bf16*)(w + WS_HB), (const bf16*)(wl + LW_IN), M_REAL, N_IN, D}; SO S; S.init(M_REAL, N_IN, P.G, bxl);
            pg8::EpiInProj E{ll, 3 * ll + 1, QSCALE};
            pg8::gemm_phase<pg8::EpiInProj, SO, true, true>(P.lds + RING_OFF, g, S, E);
            SkIn K2{(GAS bf16*)(w + WS_FQ), (GAS bf16*)(w + WS_FK), (GAS bf16*)(w + WS_FV), (GAS bf16*)(w + WS_SQ), (GAS bf16*)(w + WS_SK), (GAS bf16*)(w + WS_SV), (GAS float*)(w + WS_LOGF), (const GAS float*)(inptr(P, 9) + ll * HD), (const GAS float*)(inptr(P, 10) + ll * HD), (const GAS float*)(inptr(P, 11) + ll * HD), (const GAS float*)(inptr(P, 12) + ll * HD), (const GAS float*)(inptr(P, 8) + ll * NH), QSCALE, SSQ(1)}; skinny_phase<SkIn, D / 256>(P, HBM, D, (const GAS bf16*)(wl + LW_IN), D, K2);
            if (IDLE_CONV_K > 0 && P.G == 256 && bxl >= 128) { __syncthreads(); LAS unsigned char* scr = P.lds + RING_OFF + P.wave * 16384; const int iw = (bxl - 128) * NWAVES + P.wave;
                for (int k = 0; k < IDLE_CONV_K; ++k) convert_item(P, w, ll, GU2_BASE + iw + k * 128 * NWAVES, scr); }
            PHASE_END(pb + 2, 4)
        PHASE_BEGIN(pb + 3) attn_phase(P, inptr(P, 13) + ll * NH, OVERLAP_CONV ? ll + 1 : DEPTH, inptr(P, 9) + ll * HD, inptr(P, 10) + ll * HD); PHASE_END(pb + 3, 5)
        PHASE_BEGIN(pb + 4) pg8::Gemm g{(const bf16*)(w + WS_O), (const bf16*)(wl + LW_OUT), M_REAL, D, D}; SO S; S.init(M_REAL, D, P.G, bxl);
            pg8::EpiOut E{3 * ll + 2}; pg8::gemm_phase<pg8::EpiOut, SO, true, true>(P.lds + RING_OFF, g, S, E);
            SkOut K2{1.0f, (GAS bf16*)(w + WS_HB), SSQ(2), (const GAS float*)(w + WS_SSQOM)}; skinny_phase<SkOut, D / 256>(P, (const GAS bf16*)(w + WS_O) + (size_t)META_ROW * D, D, (const GAS bf16*)(wl + LW_OUT), D, K2); PHASE_END(pb + 4, 7)
        PHASE_BEGIN(pb + 5) pg8::Gemm g{(const bf16*)(w + WS_HB), (const bf16*)(wl + LW_GU2), M_REAL, N_GU, D}; SO S; S.init(M_REAL, N_GU, P.G, bxl);
            pg8::EpiSwiGLU E{3 * ll + 2}; pg8::gemm_phase<pg8::EpiSwiGLU, SO, true, true>(P.lds + RING_OFF, g, S, E);
            if (ll < DEPTH - 1) { SkGU K2{(GAS bf16*)(w + WS_ACT), SSQ(2)}; skinny_phase<SkGU, D / 256>(P, HBM, D, (const GAS bf16*)(wl + LW_GU2), D, K2); } PHASE_END(pb + 5, 2)
        PHASE_BEGIN(pb + 6) pg8::Gemm g{(const bf16*)(w + WS_ACT), (const bf16*)(wl + LW_D2), M_REAL, D, FF}; SO S; S.init(M_REAL, D, P.G, bxl);
            const bool fin = (ll == DEPTH - 1);
            pg8::EpiResAdd E{0.5f, 3 * ll + 3, fin ? 1 : 0}; pg8::gemm_phase<pg8::EpiResAdd, SO, true, true>(P.lds + RING_OFF, g, S, E);
            if (!fin) { SkRes K2{0.5f, (GAS bf16*)(w + WS_HB), SSQ(3)}; skinny_phase<SkRes, FF / 256>(P, (const GAS bf16*)(w + WS_ACT) + (size_t)META_ROW * FF, FF, (const GAS bf16*)(wl + LW_D2), FF, K2); } PHASE_END(pb + 6, 3)
#undef SSQ
#undef HBM
    }
    if (PROBE_CLASS >= 0 && (PROBE_BLOCK < 0 || (int)blockIdx.x == PROBE_BLOCK) && my_tid() == 0) { const unsigned long long t0 = __builtin_amdgcn_s_memrealtime(), dt = *(volatile LAS unsigned long long*)((LAS unsigned char*)lds + MISC_OFF + 64);
        while (__builtin_amdgcn_s_memrealtime() - t0 < dt) __builtin_amdgcn_s_sleep(8); }
#undef IN
#undef SEAM
#undef PHASE_BEGIN
#undef PHASE_END
}

extern "C" void kernel_launch(void* const* d_in, const int* in_sizes, int n_in, void* d_out, int out_size, void* d_ws, size_t ws_size, hipStream_t stream) {
    static int grid = 0;
    if (grid == 0) {
        if (n_in != 21 || in_sizes[0] != M_REAL * D || out_size != M_REAL * D || ws_size < WS_END) { fprintf(stderr, "kernel_launch: unexpected shapes (n_in %d, in0 %d, out %d, ws %zu, need %zu); nothing launched\n", n_in, n_in > 0 ? in_sizes[0] : -1, out_size, ws_size, (size_t)WS_END); grid = -1; return; }
        int dev = 0, cus = 0, per_cu = 0;
        if (hipGetDevice(&dev) != hipSuccess || hipDeviceGetAttribute(&cus, hipDeviceAttributeMultiprocessorCount, dev) != hipSuccess) { fprintf(stderr, "kernel_launch: device query failed\n"); grid = -1; return; }
        if (hipFuncSetAttribute((const void*)hymba_fwd, hipFuncAttributeMaxDynamicSharedMemorySize, LDS_BYTES) != hipSuccess) { fprintf(stderr, "kernel_launch: hipFuncSetAttribute failed\n"); grid = -1; return; }
        if (hipOccupancyMaxActiveBlocksPerMultiprocessor(&per_cu, (const void*)hymba_fwd, NWAVES * 64, LDS_BYTES) != hipSuccess || per_cu < 1) fprintf(stderr, "kernel_launch: note: occupancy query reports %d workgroups per CU\n", per_cu);
        (void)hipGetLastError();
        grid = cus;
        if (grid != 256) fprintf(stderr, "kernel_launch: note: %d CUs (the attention phase's static deal assumes 256)\n", grid);
    }
    if (grid < 0) return;
    if (hipMemsetAsync((char*)d_ws + WS_CTL, 0, CTL_ZERO_BYTES, stream) != hipSuccess) { fprintf(stderr, "kernel_launch: memset failed\n"); return; }
    Args a{};
    for (int i = 0; i < 21; ++i) a.in[i] = (const float*)d_in[i];
    a.out = (float*)d_out; a.ws = (unsigned char*)d_ws; a.li = 0; a.pad = 0;
#if MK_PER_PHASE
    for (int ph = 0; ph < N_PHASES; ++ph) { a.ph_lo = ph; a.ph_hi = ph + 1; hipLaunchKernelGGL(hymba_fwd, dim3(grid), dim3(NWAVES * 64), LDS_BYTES, stream, a); }
#else
    a.ph_lo = 0; a.ph_hi = N_PHASES;
    hipLaunchKernelGGL(hymba_fwd, dim3(grid), dim3(NWAVES * 64), LDS_BYTES, stream, a);
#endif
    const hipError_t le = hipPeekAtLastError();
    if (le != hipSuccess) fprintf(stderr, "kernel_launch: launch failed: %s\n", hipGetErrorName(le));
}
```

```cpp
#include <hip/hip_runtime.h>
#include <cstdio>
#include <cstdint>

#ifndef MK_PER_PHASE
#define MK_PER_PHASE 0
#endif
#ifndef OVERLAP_CONV
#define OVERLAP_CONV 0
#endif
#ifndef PROBE_BLOCK
#define PROBE_BLOCK 0
#endif
#ifndef PROBE_CLASS
#define PROBE_CLASS (-1)
#endif

#define PROBE_ACC_OFF (131072 + 320 + 64)
__device__ __forceinline__ int my_tid();
__device__ __forceinline__ int lane_now() { unsigned z = 0; asm volatile("" : "+v"(z)); return (int)__builtin_amdgcn_mbcnt_hi(~0u, __builtin_amdgcn_mbcnt_lo(~0u, z)); }
template <int O> __device__ __forceinline__ float shx(float v) {
    if constexpr (O < 32) return __builtin_bit_cast(float, __builtin_amdgcn_ds_swizzle(__builtin_bit_cast(int, v), (O << 10) | 0x1f));
    else return __builtin_bit_cast(float, __builtin_amdgcn_ds_bpermute((lane_now() ^ 32) << 2, __builtin_bit_cast(int, v)));
}
__device__ __forceinline__ float shi(float v, int idx) { return __builtin_bit_cast(float, __builtin_amdgcn_ds_bpermute(idx << 2, __builtin_bit_cast(int, v))); }
#define XSUM16(v) do { v += shx<1>(v); v += shx<2>(v); v += shx<4>(v); v += shx<8>(v); } while (0)
#define XSUM32(v) do { XSUM16(v); v += shx<16>(v); } while (0)
#define XSUM64(v) do { XSUM32(v); v += shx<32>(v); } while (0)
namespace pg8 {
#define PG8_LAS __attribute__((address_space(3)))
#define PG8_GAS __attribute__((address_space(1)))
typedef unsigned short bf16_t;
typedef short bf16x8 __attribute__((ext_vector_type(8)));
typedef float f32x4 __attribute__((ext_vector_type(4)));
typedef unsigned u32x4 __attribute__((ext_vector_type(4)));
constexpr int BM = 256, BK = 64, HALF = 128, HTB = HALF * BK * 2  , STAGE_BYTES = 8 * HTB, NXCD = 8, WGM = 8;

__host__ __device__ __forceinline__ int lds_byte(int r, int c) { const int st = (r >> 4) * 2 + (c >> 5), rr = r & 15, cc = c & 31, ob = rr * 64 + cc * 2; return st * 1024 + (ob ^ (((ob >> 9) & 1) << 5)); }
__host__ __device__ __forceinline__ void stage_rc(int b, int& R, int& C) { const int st = b / 1024, sb = b % 1024, swz = sb ^ (((sb >> 9) & 1) << 5); R = (st >> 1) * 16 + swz / 64; C = (st & 1) * 32 + (swz % 64) / 2; }
__host__ __device__ __forceinline__ int perm32(int rho) { const int n = rho >> 4, i = rho & 15; return 8 * (i >> 2) + 4 * n + (i & 3); }

struct Unit { int pm, pn; };
struct Gemm { const bf16_t* A; const bf16_t* Bt; int M, N, K; };

struct StaticOrder {
    int nM, nN, nwg, G, c;
    __host__ __device__ void init(int M, int N, int G_, int c_) { nM = M / BM; nN = N / BM; nwg = nM * nN; G = G_; c = c_; }
    __host__ __device__ bool next(int i, Unit& u) const {
        const long L = (long)i * G + c; if (L >= nwg) return false;
        int wgid = (int)L; { const int q = nwg / NXCD, r = nwg % NXCD, xcd = wgid % NXCD, off = wgid / NXCD; wgid = (xcd < r ? xcd * (q + 1) : r * (q + 1) + (xcd - r) * q) + off; }
        const int nig = WGM * nN, gid = wgid / nig, fm = gid * WGM, gsz = (nM - fm) < WGM ? (nM - fm) : WGM;
        u.pm = fm + ((wgid % nig) % gsz); u.pn = (wgid % nig) / gsz; return true;
    }
    __device__ __forceinline__ void a_ready(const Unit&) const {}
    __device__ __forceinline__ void done(const Unit&) const {}
};

__device__ __forceinline__ unsigned cvt_pk_bf16(float lo, float hi) { unsigned r; asm volatile("v_cvt_pk_bf16_f32 %0, %1, %2" : "=v"(r) : "v"(lo), "v"(hi)); return r; }

template <class Epi, class Sched, bool ALIGN_EPI = false, bool SP2 = false>
__device__ __forceinline__ void gemm_phase(PG8_LAS unsigned char* lds, const Gemm g, const Sched& S, const Epi& E) {
    int tid_l = my_tid(); asm volatile("" : "+v"(tid_l));
    const int tid = tid_l, wid = __builtin_amdgcn_readfirstlane(tid >> 6), lane = tid & 63, wr = wid >> 2, wc = wid & 3, fr = lane & 15, fq = lane >> 4;
    const int K = g.K, nt = K / BK;
    unsigned voffA[2], voffB[2];
#pragma unroll
    for (int i = 0; i < 2; ++i) { int R, C; stage_rc(tid * 16 + i * 8192, R, C); const int Rb = Epi::PERM ? ((R & ~31) + perm32(R & 31)) : R;
        voffA[i] = (unsigned)(R * K + C) * 2u; voffB[i] = (unsigned)(Rb * K + C) * 2u; }
    const size_t kstep = (size_t)(BK * 2);
    const size_t hstep = (size_t)HALF * K * 2;
    const size_t tstep = 2 * hstep;
    const unsigned ldsw = (unsigned)wid * 1024u;
    const int aoff = lds_byte(wr * 64 + fr, fq * 8), boff = lds_byte(wc * 32 + fr, fq * 8);
#define PG8_SA(b, h) (((b) * 2 + (h)) * HTB)
#define PG8_SB(b, h) ((4 + (b) * 2 + (h)) * HTB)
#define PG8_STAGE(bufoff, gbase, voff) do { _Pragma("unroll") for (int _i = 0; _i < 2; ++_i) \
        __builtin_amdgcn_global_load_lds((const unsigned*)((const char*)(gbase) + (voff)[_i]), (PG8_LAS unsigned*)(lds + (bufoff) + ldsw + _i * 8192), 16, 0, 0); } while (0)
#define PG8_LDA(dst, b, h) do { _Pragma("unroll") for (int m = 0; m < 4; ++m) _Pragma("unroll") for (int k = 0; k < 2; ++k) dst[m][k] = *(const PG8_LAS bf16x8*)(lds + PG8_SA(b, h) + aoff + m * 2048 + k * 1024); } while (0)
#define PG8_LDB(dst, b, h) do { _Pragma("unroll") for (int n = 0; n < 2; ++n) _Pragma("unroll") for (int k = 0; k < 2; ++k) dst[n][k] = *(const PG8_LAS bf16x8*)(lds + PG8_SB(b, h) + boff + n * 2048 + k * 1024); } while (0)
#define PG8_MMA(ai, bj, At, Bt) do { __builtin_amdgcn_s_setprio(1); _Pragma("unroll") for (int m = 0; m < 4; ++m) _Pragma("unroll") for (int n = 0; n < 2; ++n) _Pragma("unroll") for (int k = 0; k < 2; ++k) \
        acc[ai][bj][m][n] = __builtin_amdgcn_mfma_f32_16x16x32_bf16(Bt[n][k], At[m][k], acc[ai][bj][m][n], 0, 0, 0); __builtin_amdgcn_s_setprio(0); } while (0)
#define PG8_WAIT_V(n) asm volatile("s_waitcnt vmcnt(" #n ")" ::: "memory")
#define PG8_WAIT_L(n) asm volatile("s_waitcnt lgkmcnt(" #n ")" ::: "memory")
#define PG8_BAR __builtin_amdgcn_s_barrier()
#define PG8_SCHED __builtin_amdgcn_sched_barrier(0)
    Unit cur, nxt; int ui = 0;
    if (!S.next(0, cur)) return;
    f32x4 acc[2][2][4][2];
#pragma unroll
    for (int a = 0; a < 2; ++a)
#pragma unroll
        for (int b = 0; b < 2; ++b)
#pragma unroll
            for (int m = 0; m < 4; ++m)
#pragma unroll
                for (int n = 0; n < 2; ++n) acc[a][b][m][n] = (f32x4){0.f, 0.f, 0.f, 0.f};
    bf16x8 At[4][2], B0[2][2], B1[2][2];
    const char* cA = (const char*)g.A + (size_t)cur.pm * tstep; const char* cB = (const char*)g.Bt + (size_t)cur.pn * tstep;
    S.a_ready(cur);
    if constexpr (SP2) {
        PG8_STAGE(PG8_SB(0, 0), cB, voffB); PG8_STAGE(PG8_SB(0, 1), cB + hstep, voffB); PG8_STAGE(PG8_SA(0, 0), cA, voffA); PG8_STAGE(PG8_SA(0, 1), cA + hstep, voffA);
        if (wr == 1) PG8_BAR;
        PG8_WAIT_V(2); PG8_BAR;
        PG8_STAGE(PG8_SB(1, 0), cB + kstep, voffB); PG8_STAGE(PG8_SA(1, 0), cA + kstep, voffA); PG8_STAGE(PG8_SB(1, 1), cB + hstep + kstep, voffB);
        PG8_WAIT_V(6); PG8_BAR;
    } else {
        PG8_STAGE(PG8_SB(0, 0), cB, voffB); PG8_STAGE(PG8_SA(0, 0), cA, voffA); PG8_STAGE(PG8_SB(0, 1), cB + hstep, voffB); PG8_STAGE(PG8_SA(0, 1), cA + hstep, voffA);
        if (wr == 1) PG8_BAR;
        PG8_WAIT_V(4); PG8_BAR;
        PG8_STAGE(PG8_SB(1, 0), cB + kstep, voffB); PG8_STAGE(PG8_SA(1, 0), cA + kstep, voffA); PG8_STAGE(PG8_SB(1, 1), cB + hstep + kstep, voffB);
        PG8_WAIT_V(6); PG8_BAR;
    }
    for (;;) {
        const bool has_next = S.next(ui + 1, nxt);
        const char* nA = has_next ? (const char*)g.A + (size_t)nxt.pm * tstep : cA; const char* nB = has_next ? (const char*)g.Bt + (size_t)nxt.pn * tstep : cB;
        for (int t = 0; t < nt; t += 2) {
            const bool last = (t == nt - 2);
            const char* a1 = cA + (size_t)(t + 1) * kstep;
            const char* a2 = last ? nA : cA + (size_t)(t + 2) * kstep; const char* b2 = last ? nB : cB + (size_t)(t + 2) * kstep;
            const char* a3 = a2 + kstep; const char* b3 = b2 + kstep;
            if (last && has_next) S.a_ready(nxt);
            if constexpr (Epi::MID) { if (t == nt / 2) E.mid(acc, cur, wr, wc, fr, fq); }
            if constexpr (SP2) {
            PG8_LDB(B0, 0, 0); PG8_LDB(B1, 0, 1); PG8_SCHED; PG8_LDA(At, 0, 0); PG8_STAGE(PG8_SA(1, 1), a1 + hstep, voffA);
            PG8_WAIT_V(8); PG8_WAIT_L(0); PG8_BAR; PG8_MMA(0, 0, At, B0); PG8_MMA(0, 1, At, B1); PG8_BAR; PG8_SCHED;
            PG8_LDA(At, 0, 1); PG8_STAGE(PG8_SB(0, 0), b2, voffB); PG8_STAGE(PG8_SB(0, 1), b2 + hstep, voffB); PG8_STAGE(PG8_SA(0, 0), a2, voffA);
            PG8_WAIT_V(8); PG8_WAIT_L(0); PG8_BAR; PG8_MMA(1, 0, At, B0); PG8_MMA(1, 1, At, B1); PG8_BAR; PG8_SCHED;
            PG8_LDB(B0, 1, 0); PG8_LDB(B1, 1, 1); PG8_SCHED; PG8_LDA(At, 1, 0); PG8_STAGE(PG8_SA(0, 1), a2 + hstep, voffA);
            PG8_WAIT_V(8); PG8_WAIT_L(0); PG8_BAR; PG8_MMA(0, 0, At, B0); PG8_MMA(0, 1, At, B1); PG8_BAR; PG8_SCHED;
            PG8_LDA(At, 1, 1); PG8_STAGE(PG8_SB(1, 0), b3, voffB); PG8_STAGE(PG8_SB(1, 1), b3 + hstep, voffB); PG8_STAGE(PG8_SA(1, 0), a3, voffA);
            PG8_WAIT_V(8); PG8_WAIT_L(0); PG8_BAR; PG8_MMA(1, 0, At, B0); PG8_MMA(1, 1, At, B1); PG8_BAR; PG8_SCHED;
            } else {
            PG8_LDB(B0, 0, 0); PG8_SCHED; PG8_LDA(At, 0, 0); PG8_STAGE(PG8_SA(1, 1), a1 + hstep, voffA);
            PG8_WAIT_L(8); PG8_BAR; PG8_WAIT_L(0); PG8_MMA(0, 0, At, B0); PG8_BAR; PG8_SCHED;
            PG8_LDB(B1, 0, 1); PG8_STAGE(PG8_SB(0, 0), b2, voffB);
            PG8_BAR; PG8_WAIT_L(0); PG8_MMA(0, 1, At, B1); PG8_BAR;
            PG8_LDA(At, 0, 1); PG8_STAGE(PG8_SA(0, 0), a2, voffA);
            PG8_BAR; PG8_WAIT_L(0); PG8_MMA(1, 0, At, B0); PG8_BAR; PG8_SCHED;
            PG8_STAGE(PG8_SB(0, 1), b2 + hstep, voffB);
            PG8_WAIT_V(6); PG8_BAR; PG8_MMA(1, 1, At, B1); PG8_BAR;
            PG8_LDB(B0, 1, 0); PG8_SCHED; PG8_LDA(At, 1, 0); PG8_STAGE(PG8_SA(0, 1), a2 + hstep, voffA);
            PG8_WAIT_L(8); PG8_BAR; PG8_WAIT_L(0); PG8_MMA(0, 0, At, B0); PG8_BAR; PG8_SCHED;
            PG8_LDB(B1, 1, 1); PG8_STAGE(PG8_SB(1, 0), b3, voffB);
            PG8_BAR; PG8_WAIT_L(0); PG8_MMA(0, 1, At, B1); PG8_BAR;
            PG8_LDA(At, 1, 1); PG8_STAGE(PG8_SA(1, 0), a3, voffA);
            PG8_BAR; PG8_WAIT_L(0); PG8_MMA(1, 0, At, B0); PG8_BAR; PG8_SCHED;
            PG8_STAGE(PG8_SB(1, 1), b3 + hstep, voffB);
            PG8_WAIT_V(6); PG8_BAR; PG8_MMA(1, 1, At, B1); PG8_BAR;
            }
        }
        if constexpr (ALIGN_EPI) { if (wr == 0) PG8_BAR; }
        if constexpr (PROBE_CLASS == 20 + Epi::ID) { unsigned long long t0_ = 0; if ((PROBE_BLOCK < 0 || (int)blockIdx.x == PROBE_BLOCK) && tid == 0) t0_ = __builtin_amdgcn_s_memrealtime();
            E(acc, cur, wr, wc, fr, fq); asm volatile("s_waitcnt vmcnt(0)" ::: "memory");
            if ((PROBE_BLOCK < 0 || (int)blockIdx.x == PROBE_BLOCK) && tid == 0) { volatile PG8_LAS unsigned long long* pa_ = (volatile PG8_LAS unsigned long long*)(lds + PROBE_ACC_OFF); *pa_ = *pa_ + (__builtin_amdgcn_s_memrealtime() - t0_); } }
        else if constexpr (!Epi::AFTER_DRAIN) { E(acc, cur, wr, wc, fr, fq); S.done(cur); }
        if (!has_next) break;
#pragma unroll
        for (int a = 0; a < 2; ++a)
#pragma unroll
            for (int b = 0; b < 2; ++b)
#pragma unroll
                for (int m = 0; m < 4; ++m)
#pragma unroll
                    for (int n = 0; n < 2; ++n) acc[a][b][m][n] = (f32x4){0.f, 0.f, 0.f, 0.f};
        cur = nxt; cA = nA; cB = nB; ++ui;
        if constexpr (ALIGN_EPI) { if (wr == 1) PG8_BAR; }
    }
    PG8_WAIT_V(0);
    if constexpr (!ALIGN_EPI) { if (wr == 0) PG8_BAR; }
    PG8_BAR;
#undef PG8_SA
#undef PG8_SB
#undef PG8_STAGE
#undef PG8_LDA
#undef PG8_LDB
#undef PG8_MMA
#undef PG8_WAIT_V
#undef PG8_WAIT_L
#undef PG8_BAR
#undef PG8_SCHED
}
}

constexpr int NWAVES = 8;
constexpr int D = 2048, NB = 8, SEQ = 2048, DEPTH = 4, HD = 64, NH = 16, FF = 5632, NMETA = 16, PADN = 112;
constexpr int M_REAL = NB * SEQ;
constexpr int M_PAD = M_REAL + 128;
constexpr int META_BLK0 = M_REAL;
constexpr int META_ROW = META_BLK0 + PADN;
constexpr int LPOS = SEQ + 128;
constexpr int N_GU = 2 * FF;
constexpr int N_IN = 18 * 256;
constexpr int IN_W = 4368;
constexpr float EPS = 1e-6f;
constexpr float LOG2E = 1.4426950408889634f;
constexpr float QSCALE = 0.125f * LOG2E;

constexpr size_t MiB = 1u << 20;
constexpr int NSLOT = 13;
constexpr size_t WS_CTL = 0, CTL_ZERO_BYTES = 1 * MiB;
constexpr size_t SZ_WGU = (size_t)N_GU * D * 2, SZ_WD = (size_t)D * FF * 2, SZ_WIN = (size_t)N_IN * D * 2, SZ_WOUT = (size_t)D * D * 2;
constexpr size_t LW_GU1 = 0, LW_D1 = LW_GU1 + SZ_WGU, LW_IN = LW_D1 + SZ_WD, LW_OUT = LW_IN + SZ_WIN, LW_GU2 = LW_OUT + SZ_WOUT, LW_D2 = LW_GU2 + SZ_WGU, LW_STRIDE = LW_D2 + SZ_WD;
constexpr size_t WS_W = 1 * MiB;
constexpr size_t WS_XN = WS_W + DEPTH * LW_STRIDE;
constexpr size_t WS_O = WS_XN + (size_t)M_PAD * D * 2;
constexpr size_t WS_ACT = WS_O + (size_t)M_PAD * D * 2;
constexpr size_t SZ_QK = (size_t)M_PAD * 1024 * 2, SZ_KV = (size_t)M_PAD * 128 * 2;
constexpr size_t WS_FQ = WS_ACT + (size_t)M_PAD * FF * 2, WS_FK = WS_FQ + SZ_QK, WS_FV = WS_FK + SZ_QK, WS_SQ = WS_FV + SZ_QK, WS_SK = WS_SQ + SZ_QK, WS_SV = WS_SK + SZ_KV, WS_LOGF = WS_SV + SZ_KV;
constexpr size_t WS_HB = WS_LOGF + (size_t)M_PAD * 16 * 4;
constexpr size_t WS_SSQ = WS_HB + (size_t)M_PAD * D * 2;
constexpr size_t WS_SSQM = WS_SSQ + (size_t)NSLOT * M_REAL * 32 * 4;
constexpr size_t WS_SSQO = WS_SSQM + (size_t)NSLOT * 16 * 128 * 4;
constexpr size_t WS_SSQOM = WS_SSQO + (size_t)M_REAL * 32 * 4;
constexpr size_t WS_END = WS_SSQOM + 16 * 32 * 4;
static_assert(LW_STRIDE % 256 == 0 && WS_XN % 256 == 0 && WS_ACT % 256 == 0 && WS_FQ % 256 == 0 && WS_SK % 256 == 0 && WS_LOGF % 256 == 0 && WS_HB % 256 == 0, "alignment");
constexpr int CW_TMO = 0, CW_BAR = 4096;

constexpr int RING_OFF = 0, RING_BYTES = 131072;
constexpr int LDSCTL_OFF = RING_BYTES, MISC_OFF = LDSCTL_OFF + 320, PTR_OFF = LDSCTL_OFF + 1024;
constexpr int LDS_BYTES = 155648;
constexpr int WID_OFF = LDSCTL_OFF + 1280;
constexpr int RSTD_ID_OFF = LDSCTL_OFF + 1536, RSTD_OFF = LDSCTL_OFF + 2048;
static_assert(RSTD_OFF + 8 * 128 * 4 <= LDS_BYTES, "LDS map");
constexpr int RSTD2_OFF = 148480;
static_assert(RSTD2_OFF + 8 * 128 * 4 <= LDS_BYTES, "LDS map");
constexpr int ATT_TAB_OFF = 139264;
constexpr int ATT_WTOT_OFF = ATT_TAB_OFF + 8704;
constexpr int ATT_FC_OFF = ATT_WTOT_OFF + 64;
constexpr int ATT_TABF_OFF = 0, ATT_ZERO_OFF = 2176 * 16;
constexpr int ATT_VST_OFF = 0, ATT_VST_PITCH = 128, ATT_VST_BYTES = 64 * ATT_VST_PITCH;
static_assert(ATT_VST_OFF + NWAVES * 2 * ATT_VST_BYTES <= RING_BYTES && ATT_FC_OFF + 256 <= RSTD2_OFF && RSTD_OFF + 8 * 128 * 4 <= ATT_TAB_OFF, "attention LDS");

#define GAS __attribute__((address_space(1)))
#define LAS __attribute__((address_space(3)))
typedef unsigned short bf16;
typedef unsigned v4u __attribute__((ext_vector_type(4)));
typedef float f32x4 __attribute__((ext_vector_type(4)));
typedef float f32x16 __attribute__((ext_vector_type(16)));
typedef short bf16x8 __attribute__((ext_vector_type(8)));
typedef GAS unsigned gu32;
#define RLX_AGENT __ATOMIC_RELAXED, __HIP_MEMORY_SCOPE_AGENT
#define LDS_WAIT() asm volatile("s_waitcnt lgkmcnt(0)" ::: "memory")
__device__ __forceinline__ unsigned f2bf(float f) { unsigned u = __builtin_bit_cast(unsigned, f); return (u + 0x7fffu + ((u >> 16) & 1u)) >> 16; }
__device__ __forceinline__ unsigned pk2(float lo, float hi) { return f2bf(lo) | (f2bf(hi) << 16); }
__device__ __forceinline__ float bf2f(unsigned short b) { return __builtin_bit_cast(float, (unsigned)b << 16); }

__device__ __forceinline__ int hw_wave_key() { return (int)(__builtin_amdgcn_s_getreg(((6 - 1) << 11) | 4) & 63u); }
__device__ __forceinline__ int my_tid() {
    extern __shared__ __attribute__((aligned(16))) unsigned char lds_dyn_[];
    const int wave = __builtin_amdgcn_readfirstlane(((const volatile LAS int*)((LAS unsigned char*)lds_dyn_ + WID_OFF))[hw_wave_key()]);
    unsigned zero = 0u; asm volatile("" : "+v"(zero));
    return wave * 64 + (int)__builtin_amdgcn_mbcnt_hi(~0u, __builtin_amdgcn_mbcnt_lo(~0u, zero));
}
__host__ __device__ __forceinline__ size_t kfrag_idx(int row, int nh, int head, int d) { return ((((size_t)(row >> 5) * nh + head) * 8 + (d >> 3)) * 32 + (row & 31)) * 8 + (d & 7); }
__host__ __device__ __forceinline__ size_t vfrag_idx(int row, int nh, int head, int d) { return (((((size_t)(row >> 4) * nh + head) * 2 + ((row >> 2) & 1)) * 64 + d) * 8) + (((row >> 3) & 1) * 4 + (row & 3)); }
namespace pg8 {
__device__ __forceinline__ unsigned long long tab_ptr(int k) {
    extern __shared__ __attribute__((aligned(16))) unsigned char lds_dyn_[];
    const volatile PG8_LAS unsigned* t = (const volatile PG8_LAS unsigned*)((PG8_LAS unsigned char*)lds_dyn_ + PTR_OFF);
    const unsigned lo = __builtin_amdgcn_readfirstlane(t[2 * k]), hi = __builtin_amdgcn_readfirstlane(t[2 * k + 1]);
    return ((unsigned long long)hi << 32) | lo;
}
__device__ __forceinline__ const PG8_LAS float* ensure_rstd(const PG8_GAS float* ssq, int slot, int pm, int wid, int wr, int lane) {
    extern __shared__ __attribute__((aligned(16))) unsigned char lds_dyn_[];
    volatile PG8_LAS unsigned* idw = (volatile PG8_LAS unsigned*)((PG8_LAS unsigned char*)lds_dyn_ + RSTD_ID_OFF) + wid;
    PG8_LAS float* rv = (PG8_LAS float*)((PG8_LAS unsigned char*)lds_dyn_ + RSTD_OFF) + wid * 128;
    const unsigned want = ((unsigned)(slot + 1) << 16) | (unsigned)(pm + 1);
    if ((unsigned)__builtin_amdgcn_readfirstlane(*idw) != want) {
#pragma unroll
        for (int j = 0; j < 2; ++j) { const int row = pm * BM + HALF * j + 64 * wr + lane; const PG8_GAS f32x4* pp = (const PG8_GAS f32x4*)(ssq + (size_t)row * 32); float t = 0.f;
#pragma unroll
            for (int q = 0; q < 8; ++q) { const f32x4 a = pp[q]; t += (a[0] + a[1]) + (a[2] + a[3]); }
            rv[64 * j + lane] = 1.0f / sqrtf(t * (1.0f / 2048.0f) + 1e-6f); }
        if (lane == 0) *idw = want;
        asm volatile("s_waitcnt lgkmcnt(0)" ::: "memory");
    }
    return rv;
}
__device__ __forceinline__ float silu_mul(float g, float u) {
    const float e = __builtin_amdgcn_exp2f(-1.4426950408889634f * g);
    return g * __builtin_amdgcn_rcpf(1.0f + e) * u;
}
struct EpiSwiGLU {
    static constexpr bool PERM = true, AFTER_DRAIN = false, MID = false; static constexpr int ID = 0;
    int slot;
    __device__ __forceinline__ void operator()(const f32x4 (&acc)[2][2][4][2], const Unit& u, int wr, int wc, int fr, int fq) const {
        PG8_GAS unsigned char* w = (PG8_GAS unsigned char*)tab_ptr(22); PG8_GAS bf16_t* O = (PG8_GAS bf16_t*)(w + WS_ACT); constexpr int ldc = FF; const PG8_GAS float* ssq = (const PG8_GAS float*)(w + WS_SSQ) + (size_t)slot * M_REAL * 32;
        const int row0 = u.pm * BM + wr * 64 + fr, col0 = u.pn * HALF + wc * 32 + 8 * fq;
        const PG8_LAS float* rv = ensure_rstd(ssq, slot, u.pm, wr * 4 + wc, wr, fr + 16 * fq);
        float rs[2][4];
#pragma unroll
        for (int ai = 0; ai < 2; ++ai)
#pragma unroll
            for (int m = 0; m < 4; ++m) rs[ai][m] = rv[64 * ai + 16 * m + fr];
#pragma unroll
        for (int ai = 0; ai < 2; ++ai)
#pragma unroll
            for (int m = 0; m < 4; ++m) { PG8_GAS bf16_t* rowp = O + (size_t)(row0 + ai * HALF + m * 16) * ldc + col0;
                const float r = rs[ai][m];
                const f32x4 g0 = acc[ai][0][m][0] * r, g1 = acc[ai][0][m][1] * r, u0 = acc[ai][1][m][0] * r, u1 = acc[ai][1][m][1] * r;
                u32x4 w; w.x = cvt_pk_bf16(silu_mul(g0[0], u0[0]), silu_mul(g0[1], u0[1])); w.y = cvt_pk_bf16(silu_mul(g0[2], u0[2]), silu_mul(g0[3], u0[3]));
                w.z = cvt_pk_bf16(silu_mul(g1[0], u1[0]), silu_mul(g1[1], u1[1])); w.w = cvt_pk_bf16(silu_mul(g1[2], u1[2]), silu_mul(g1[3], u1[3]));
                *(PG8_GAS u32x4*)rowp = w; }
    }
};
struct EpiResAdd {
    static constexpr bool PERM = true, AFTER_DRAIN = false, MID = false; static constexpr int ID = 1;
    float scale; int slot; int fin;
    __device__ __forceinline__ void operator()(const f32x4 (&acc)[2][2][4][2], const Unit& u, int wr, int wc, int fr, int fq) const {
        PG8_GAS unsigned char* w = (PG8_GAS unsigned char*)tab_ptr(22); PG8_GAS bf16_t* hb = (PG8_GAS bf16_t*)(w + WS_HB); PG8_GAS float* out = (PG8_GAS float*)tab_ptr(21);
        PG8_GAS float* ssq = (PG8_GAS float*)(w + WS_SSQ) + (size_t)slot * M_REAL * 32; constexpr int ldc = D;
        const int row0 = u.pm * BM + wr * 64 + fr, col0 = u.pn * BM + wc * 32 + 8 * fq;
        u32x4 bs[2][4][2];
#pragma unroll
        for (int ai = 0; ai < 2; ++ai)
#pragma unroll
            for (int m = 0; m < 4; ++m)
#pragma unroll
                for (int bj = 0; bj < 2; ++bj) bs[ai][m][bj] = *(const PG8_GAS u32x4*)(hb + (size_t)(row0 + ai * HALF + m * 16) * ldc + col0 + bj * HALF);
#pragma unroll
        for (int ai = 0; ai < 2; ++ai)
#pragma unroll
            for (int m = 0; m < 4; ++m) { float ss = 0.f; const size_t off = (size_t)(row0 + ai * HALF + m * 16) * ldc + col0;
#pragma unroll
                for (int bj = 0; bj < 2; ++bj) { const u32x4 b = bs[ai][m][bj]; const unsigned bw[4] = {b.x, b.y, b.z, b.w}; float v[8];
#pragma unroll
                    for (int e = 0; e < 4; ++e) { v[2 * e] = __builtin_bit_cast(float, bw[e] << 16) + scale * acc[ai][bj][m][e >> 1][(2 * e) & 3]; v[2 * e + 1] = __builtin_bit_cast(float, bw[e] & 0xffff0000u) + scale * acc[ai][bj][m][e >> 1][(2 * e + 1) & 3]; }
                    if (fin) { *(PG8_GAS f32x4*)(out + off + bj * HALF) = (f32x4){v[0], v[1], v[2], v[3]}; *(PG8_GAS f32x4*)(out + off + bj * HALF + 4) = (f32x4){v[4], v[5], v[6], v[7]}; }
                    else { u32x4 wv; wv.x = cvt_pk_bf16(v[0], v[1]); wv.y = cvt_pk_bf16(v[2], v[3]); wv.z = cvt_pk_bf16(v[4], v[5]); wv.w = cvt_pk_bf16(v[6], v[7]); *(PG8_GAS u32x4*)(hb + off + bj * HALF) = wv;
                        const unsigned ww[4] = {wv.x, wv.y, wv.z, wv.w};
#pragma unroll
                        for (int e = 0; e < 4; ++e) { const float lo = __builtin_bit_cast(float, ww[e] << 16), hi2 = __builtin_bit_cast(float, ww[e] & 0xffff0000u); ss += lo * lo + hi2 * hi2; } } }
                if (!fin) { ss += shx<16>(ss); ss += shx<32>(ss);
                    if (fq == 0) ssq[(size_t)(row0 + ai * HALF + m * 16) * 32 + u.pn * 4 + wc] = ss; } }
    }
};
__device__ __forceinline__ void ensure_rstd_o(const PG8_GAS float* ssqo, int slot, int pm, int wid, int wr, int lane, const PG8_LAS float*& rs_out, const PG8_LAS float*& ratio_out) {
    extern __shared__ __attribute__((aligned(16))) unsigned char lds_dyn_[];
    volatile PG8_LAS unsigned* idw = (volatile PG8_LAS unsigned*)((PG8_LAS unsigned char*)lds_dyn_ + RSTD_ID_OFF) + wid;
    PG8_LAS float* rv = (PG8_LAS float*)((PG8_LAS unsigned char*)lds_dyn_ + RSTD_OFF) + wid * 128;
    PG8_LAS float* rq = (PG8_LAS float*)((PG8_LAS unsigned char*)lds_dyn_ + RSTD2_OFF) + wid * 128;
    const unsigned want = ((0x4000u | (unsigned)(slot + 1)) << 16) | (unsigned)(pm + 1);
    if ((unsigned)__builtin_amdgcn_readfirstlane(*idw) != want) {
#pragma unroll
        for (int j = 0; j < 2; ++j) { const int row = pm * BM + HALF * j + 64 * wr + lane; const PG8_GAS f32x4* pp = (const PG8_GAS f32x4*)(ssqo + (size_t)row * 32); float tf = 0.f, ts = 0.f;
#pragma unroll
            for (int q = 0; q < 4; ++q) { const f32x4 a = pp[q], b = pp[4 + q]; tf += (a[0] + a[1]) + (a[2] + a[3]); ts += (b[0] + b[1]) + (b[2] + b[3]); }
            const float rf = 1.0f / sqrtf(tf * (1.0f / 1024.0f) + 1e-6f), rs = 1.0f / sqrtf(ts * (1.0f / 1024.0f) + 1e-6f);
            rv[64 * j + lane] = rs; rq[64 * j + lane] = rf / rs; }
        if (lane == 0) *idw = want;
        asm volatile("s_waitcnt lgkmcnt(0)" ::: "memory");
    }
    rs_out = rv; ratio_out = rq;
}
struct EpiOut {
    static constexpr bool PERM = true, AFTER_DRAIN = false, MID = true; static constexpr int ID = 3;
    int slot;
    __device__ __forceinline__ void mid(f32x4 (&acc)[2][2][4][2], const Unit& u, int wr, int wc, int fr, int fq) const {
        PG8_GAS unsigned char* w = (PG8_GAS unsigned char*)tab_ptr(22); const PG8_LAS float *rs, *rq; ensure_rstd_o((const PG8_GAS float*)(w + WS_SSQO), slot, u.pm, wr * 4 + wc, wr, fr + 16 * fq, rs, rq);
#pragma unroll
        for (int ai = 0; ai < 2; ++ai)
#pragma unroll
            for (int m = 0; m < 4; ++m) { const float q = rq[64 * ai + 16 * m + fr];
#pragma unroll
                for (int bj = 0; bj < 2; ++bj)
#pragma unroll
                    for (int n = 0; n < 2; ++n) acc[ai][bj][m][n] = acc[ai][bj][m][n] * q; }
    }
    __device__ __forceinline__ void operator()(const f32x4 (&acc)[2][2][4][2], const Unit& u, int wr, int wc, int fr, int fq) const {
        PG8_GAS unsigned char* w = (PG8_GAS unsigned char*)tab_ptr(22); PG8_GAS bf16_t* hb = (PG8_GAS bf16_t*)(w + WS_HB);
        PG8_GAS float* ssq = (PG8_GAS float*)(w + WS_SSQ) + (size_t)slot * M_REAL * 32; constexpr int ldc = D;
        const PG8_LAS float *rs, *rq; ensure_rstd_o((const PG8_GAS float*)(w + WS_SSQO), slot, u.pm, wr * 4 + wc, wr, fr + 16 * fq, rs, rq);
        const int row0 = u.pm * BM + wr * 64 + fr, col0 = u.pn * BM + wc * 32 + 8 * fq;
        u32x4 bs[2][4][2];
#pragma unroll
        for (int ai = 0; ai < 2; ++ai)
#pragma unroll
            for (int m = 0; m < 4; ++m)
#pragma unroll
                for (int bj = 0; bj < 2; ++bj) bs[ai][m][bj] = *(const PG8_GAS u32x4*)(hb + (size_t)(row0 + ai * HALF + m * 16) * ldc + col0 + bj * HALF);
#pragma unroll
        for (int ai = 0; ai < 2; ++ai)
#pragma unroll
            for (int m = 0; m < 4; ++m) { float ss = 0.f; const size_t off = (size_t)(row0 + ai * HALF + m * 16) * ldc + col0; const float scale = rs[64 * ai + 16 * m + fr];
#pragma unroll
                for (int bj = 0; bj < 2; ++bj) { const u32x4 b = bs[ai][m][bj]; const unsigned bw[4] = {b.x, b.y, b.z, b.w}; float v[8];
#pragma unroll
                    for (int e = 0; e < 4; ++e) { v[2 * e] = __builtin_bit_cast(float, bw[e] << 16) + scale * acc[ai][bj][m][e >> 1][(2 * e) & 3]; v[2 * e + 1] = __builtin_bit_cast(float, bw[e] & 0xffff0000u) + scale * acc[ai][bj][m][e >> 1][(2 * e + 1) & 3]; }
                    u32x4 wv; wv.x = cvt_pk_bf16(v[0], v[1]); wv.y = cvt_pk_bf16(v[2], v[3]); wv.z = cvt_pk_bf16(v[4], v[5]); wv.w = cvt_pk_bf16(v[6], v[7]); *(PG8_GAS u32x4*)(hb + off + bj * HALF) = wv;
                    const unsigned ww[4] = {wv.x, wv.y, wv.z, wv.w};
#pragma unroll
                    for (int e = 0; e < 4; ++e) { const float lo = __builtin_bit_cast(float, ww[e] << 16), hi2 = __builtin_bit_cast(float, ww[e] & 0xffff0000u); ss += lo * lo + hi2 * hi2; } }
                ss += shx<16>(ss); ss += shx<32>(ss);
                if (fq == 0) ssq[(size_t)(row0 + ai * HALF + m * 16) * 32 + u.pn * 4 + wc] = ss; }
    }
};
struct EpiInProj {
    static constexpr bool PERM = true, AFTER_DRAIN = false, MID = false; static constexpr int ID = 2;
    int ll, slot; float qscale;
    __device__ __forceinline__ void operator()(const f32x4 (&acc)[2][2][4][2], const Unit& u, int wr, int wc, int fr, int fq) const {
        PG8_GAS unsigned char* w = (PG8_GAS unsigned char*)tab_ptr(22); const PG8_GAS float* ssq = (const PG8_GAS float*)(w + WS_SSQ) + (size_t)slot * M_REAL * 32;
        PG8_GAS bf16_t *fq_ = (PG8_GAS bf16_t*)(w + WS_FQ), *fk_ = (PG8_GAS bf16_t*)(w + WS_FK), *fv_ = (PG8_GAS bf16_t*)(w + WS_FV), *sq_ = (PG8_GAS bf16_t*)(w + WS_SQ), *sk_ = (PG8_GAS bf16_t*)(w + WS_SK), *sv_ = (PG8_GAS bf16_t*)(w + WS_SV); PG8_GAS float* logf = (PG8_GAS float*)(w + WS_LOGF);
        const PG8_GAS float *g_fq = (const PG8_GAS float*)tab_ptr(9) + ll * HD, *g_fk = (const PG8_GAS float*)tab_ptr(10) + ll * HD, *g_sq = (const PG8_GAS float*)tab_ptr(11) + ll * HD, *g_sk = (const PG8_GAS float*)tab_ptr(12) + ll * HD, *bfg = (const PG8_GAS float*)tab_ptr(8) + ll * NH;
        const int row0 = u.pm * BM + wr * 64 + fr, pn = u.pn;
        if (pn == 17 && wc != 0) return;
        const PG8_LAS float* rv = ensure_rstd(ssq, slot, u.pm, wr * 4 + wc, wr, fr + 16 * fq);
        float rs[2][4];
#pragma unroll
        for (int ai = 0; ai < 2; ++ai)
#pragma unroll
            for (int m = 0; m < 4; ++m) rs[ai][m] = rv[64 * ai + 16 * m + fr];
        if (pn == 17) {
            if (wc != 0) return;
            if (fq < 2) {
                const f32x4 b0 = *(const PG8_GAS f32x4*)(bfg + 8 * fq), b1 = *(const PG8_GAS f32x4*)(bfg + 8 * fq + 4);
#pragma unroll
                for (int ai = 0; ai < 2; ++ai)
#pragma unroll
                    for (int m = 0; m < 4; ++m) { PG8_GAS float* rowp = logf + (size_t)(row0 + ai * HALF + m * 16) * 16 + 8 * fq;
#pragma unroll
                        for (int n = 0; n < 2; ++n) { f32x4 t = acc[ai][0][m][n] * rs[ai][m] + (n ? b1 : b0), o;
#pragma unroll
                            for (int j = 0; j < 4; ++j) o[j] = fminf(t[j], 0.f) - 0.69314718056f * __builtin_amdgcn_logf(1.0f + __builtin_amdgcn_exp2f(-1.4426950408889634f * fabsf(t[j])));
                            *(PG8_GAS f32x4*)(rowp + 4 * n) = o; } }
            }
            return;
        }
        PG8_GAS bf16_t* dst; int pitch, head, knh = 0; const PG8_GAS float* gain = nullptr; float sc = 1.f;
        if (pn < 16) { const int seg = pn >> 2; head = (pn & 3) * 4 + wc; pitch = 1024;
            if (seg == 0) { dst = fq_; gain = g_fq; sc = qscale; } else if (seg == 1) { dst = fk_; gain = g_fk; knh = 16; } else if (seg == 2) { dst = fv_; } else { dst = sq_; gain = g_sq; sc = qscale; } }
        else { pitch = 128; head = wc & 1; if (wc < 2) { dst = sk_; gain = g_sk; knh = 2; } else { dst = sv_; } }
        const int col0 = head * 64 + 8 * fq;
        if (gain) {
            f32x4 gv[2][2];
#pragma unroll
            for (int bj = 0; bj < 2; ++bj)
#pragma unroll
                for (int n = 0; n < 2; ++n) gv[bj][n] = *(const PG8_GAS f32x4*)(gain + 32 * bj + 8 * fq + 4 * n) * sc;
#pragma unroll
            for (int ai = 0; ai < 2; ++ai)
#pragma unroll
                for (int m = 0; m < 4; ++m) {
                    float ss = 0.f;
#pragma unroll
                    for (int bj = 0; bj < 2; ++bj)
#pragma unroll
                        for (int n = 0; n < 2; ++n) { const f32x4 x = acc[ai][bj][m][n]; ss += (x[0] * x[0] + x[1] * x[1]) + (x[2] * x[2] + x[3] * x[3]); }
                    ss += shx<16>(ss); ss += shx<32>(ss);
                    const float rinv = rs[ai][m] / sqrtf(ss * (1.0f / 64.0f) * rs[ai][m] * rs[ai][m] + 1e-6f);
                    const int row = row0 + ai * HALF + m * 16;
                    PG8_GAS bf16_t* rowp = dst + (size_t)row * pitch + col0;
#pragma unroll
                    for (int bj = 0; bj < 2; ++bj) { const f32x4 v0 = acc[ai][bj][m][0] * rinv * gv[bj][0], v1 = acc[ai][bj][m][1] * rinv * gv[bj][1];
                        u32x4 w; w.x = cvt_pk_bf16(v0[0], v0[1]); w.y = cvt_pk_bf16(v0[2], v0[3]); w.z = cvt_pk_bf16(v1[0], v1[1]); w.w = cvt_pk_bf16(v1[2], v1[3]);
                        if (knh) *(PG8_GAS u32x4*)(dst + kfrag_idx(row, knh, head, 32 * bj + 8 * fq)) = w;
                        else *(PG8_GAS u32x4*)(rowp + 32 * bj) = w; }
                }
        } else {
#pragma unroll
            for (int ai = 0; ai < 2; ++ai)
#pragma unroll
                for (int m = 0; m < 4; ++m) { const int row = row0 + ai * HALF + m * 16; const int vnh = (pn < 16) ? 16 : 2;
#pragma unroll
                    for (int bj = 0; bj < 2; ++bj) { const f32x4 v0 = acc[ai][bj][m][0] * rs[ai][m], v1 = acc[ai][bj][m][1] * rs[ai][m];
                        const unsigned wv[4] = {cvt_pk_bf16(v0[0], v0[1]), cvt_pk_bf16(v0[2], v0[3]), cvt_pk_bf16(v1[0], v1[1]), cvt_pk_bf16(v1[2], v1[3])};
                        PG8_GAS bf16_t* vp = dst + vfrag_idx(row, vnh, head, 32 * bj + 8 * fq);
#pragma unroll
                        for (int e = 0; e < 4; ++e) { vp[16 * e] = (bf16_t)(wv[e] & 0xffffu); vp[16 * e + 8] = (bf16_t)(wv[e] >> 16); } } }
        }
    }
};

}

#define XB_TMO      128
#define XB_XCNT(j)  (256  + 64 * (j))
#define XB_XSUB(j)  (1280 + 64 * (j))
#define XB_XGEN(j)  (2304 + 64 * (j))
#define XB_TOP      3328
#define XB_TOPGEN   3392
#define XCD_BAR_WORDS 3456
#define XB_SPIN_CAP (1u << 18)
__device__ __forceinline__ unsigned xb_ld(unsigned* p)              { return __hip_atomic_load(p, __ATOMIC_RELAXED, __HIP_MEMORY_SCOPE_AGENT); }
__device__ __forceinline__ unsigned xb_add(unsigned* p, unsigned v) { return __hip_atomic_fetch_add(p, v, __ATOMIC_RELAXED, __HIP_MEMORY_SCOPE_AGENT); }
__device__ __forceinline__ unsigned xb_xcc_id() { return (unsigned)__builtin_amdgcn_s_getreg((3 << 11) | 20) & 0xFu; }
#define XB_SPIN(cond, bar) do { unsigned _sp = 0; while (cond) { __builtin_amdgcn_s_sleep(1); \
    if ((++_sp & 255u) == 0u) { if (xb_ld(&(bar)[XB_TMO])) break; if (_sp > XB_SPIN_CAP) { atomicAdd(&(bar)[XB_TMO], 1u); break; } } } } while (0)
struct XcdBarrier { unsigned* bar; unsigned x; volatile LAS unsigned* st; };
__device__ __forceinline__ XcdBarrier xcd_barrier_post(unsigned* bar, volatile LAS unsigned* st) {
    XcdBarrier b; b.bar = bar; b.x = xb_xcc_id(); b.st = st;
    if (threadIdx.x == 0) (void)xb_add(&bar[XB_XCNT(b.x)], 1u);
    return b;
}
__device__ __forceinline__ void xcd_barrier_complete(unsigned* bar, unsigned x, unsigned& nloc, unsigned& nx) {
    const unsigned G = gridDim.x * gridDim.y * gridDim.z;
    unsigned sum, cnt, mine, sp = 0u;
    for (;;) {
        sum = 0u; cnt = 0u; mine = 0u;
#pragma unroll
        for (unsigned j = 0; j < 16; ++j) { const unsigned c = xb_ld(&bar[XB_XCNT(j)]); sum += c; cnt += (c > 0u) ? 1u : 0u; mine = (j == x) ? c : mine; }
        if (sum == G) break;
        __builtin_amdgcn_s_sleep(1);
        if ((++sp & 255u) == 0u) { if (xb_ld(&bar[XB_TMO])) break; if (sp > XB_SPIN_CAP) { atomicAdd(&bar[XB_TMO], 1u); break; } }
    }
    nloc = mine > 0u ? mine : 1u; nx = cnt > 0u ? cnt : 1u;
}
__device__ __forceinline__ void xcd_barrier(const XcdBarrier& b) {
    asm volatile("s_waitcnt vmcnt(0)" ::: "memory");
    __syncthreads();
    if (my_tid() == 0) {
        unsigned* bar = b.bar;
        __builtin_amdgcn_s_waitcnt(0);
        unsigned nloc = b.st[0], nx = b.st[1];
        if (nloc == 0u) { xcd_barrier_complete(bar, b.x, nloc, nx); b.st[0] = nloc; b.st[1] = nx; }
        const unsigned old = xb_add(&bar[XB_XSUB(b.x)], 1u);
        const unsigned gen = old / nloc;
        if (old + 1u == (gen + 1u) * nloc) {
            __builtin_amdgcn_fence(__ATOMIC_RELEASE, "agent");
            asm volatile("s_waitcnt vmcnt(0)" ::: "memory");
            const unsigned og = xb_add(&bar[XB_TOP], 1u);
            const unsigned tg = og / nx;
            if (og + 1u == (tg + 1u) * nx) xb_add(&bar[XB_TOPGEN], 1u);
            else XB_SPIN(xb_ld(&bar[XB_TOPGEN]) == tg, bar);
            __builtin_amdgcn_fence(__ATOMIC_ACQUIRE, "agent");
            xb_add(&bar[XB_XGEN(b.x)], 1u);
            asm volatile("s_waitcnt vmcnt(0)" ::: "memory");
        } else {
            XB_SPIN(xb_ld(&bar[XB_XGEN(b.x)]) == gen, bar);
            __builtin_amdgcn_fence(__ATOMIC_ACQUIRE, "agent");
            asm volatile("s_waitcnt vmcnt(0)" ::: "memory");
        }
    }
    __syncthreads();
}

struct Frame {
    LAS unsigned char* lds;
    volatile LAS unsigned* MISC;
    int tid, lane, wave;
    int vcu, G;
    unsigned char* ws;
};
__device__ __forceinline__ int launder_u(int x) { asm volatile("" : "+v"(x)); return __builtin_amdgcn_readfirstlane(x); }
#define LAUNDER_S(x) ((x) = launder_u(x))
__device__ __forceinline__ const float* inptr(const Frame& F, int k) {
    const volatile LAS unsigned* t = (const volatile LAS unsigned*)(F.lds + PTR_OFF);
    const unsigned lo = __builtin_amdgcn_readfirstlane(t[2 * k]), hi = __builtin_amdgcn_readfirstlane(t[2 * k + 1]);
    return (const float*)(((unsigned long long)hi << 32) | lo);
}
__device__ __forceinline__ unsigned char* wsl(const Frame& F) { const unsigned long long p = (unsigned long long)F.ws; const unsigned lo = (unsigned)launder_u((int)(unsigned)p), hi = (unsigned)launder_u((int)(unsigned)(p >> 32)); return (unsigned char*)(((unsigned long long)hi << 32) | lo); }
__device__ __forceinline__ Frame make_frame() {
    extern __shared__ __attribute__((aligned(16))) unsigned char lds_dyn_[];
    Frame F;
    F.lds = (LAS unsigned char*)lds_dyn_;
    F.MISC = (volatile LAS unsigned*)(F.lds + MISC_OFF);
    int t = my_tid(); asm volatile("" : "+v"(t));
    F.tid = t; F.lane = t & 63; F.wave = __builtin_amdgcn_readfirstlane(t >> 6);
    const int g = launder_u((int)gridDim.x), bx = launder_u((int)blockIdx.x);
    F.G = g; F.vcu = (g % 8 == 0) ? (bx % 8) * (g / 8) + bx / 8 : bx;
    F.ws = (unsigned char*)pg8::tab_ptr(22);
    return F;
}
__device__ __forceinline__ float wave_sum(float v) {
    XSUM64(v);
    return v;
}

constexpr int TP_PITCH = 144;
__device__ __forceinline__ void transpose_item64(const float* Wf, int Nsrc, int ca, int nva, int cb, int nvb, int K, bf16* WTf, int drow0, int k0, LAS unsigned char* scr, int lane, const float* gainf = nullptr) {
    const GAS float* W = (const GAS float*)Wf; GAS bf16* WT = (GAS bf16*)WTf;
    const int sub = (lane >> 3) & 1, c4 = 4 * (lane & 7), g = lane >> 4, nl = 32 * sub + c4;
    const bool ok = c4 < (sub ? nvb : nva);
    const GAS float* src = W + (size_t)(k0 + 2 * g) * Nsrc + (sub ? cb : ca) + c4;
    f32x4 v[16];
#pragma unroll
    for (int i = 0; i < 16; ++i) v[i] = ok ? *(const GAS f32x4*)(src + (size_t)(8 * (i >> 1) + (i & 1)) * Nsrc) : (f32x4){0.f, 0.f, 0.f, 0.f};
    if (gainf) { const GAS float* gp = (const GAS float*)gainf + k0 + 2 * g;
#pragma unroll
        for (int i = 0; i < 16; ++i) v[i] = v[i] * gp[8 * (i >> 1) + (i & 1)]; }
#pragma unroll
    for (int m = 0; m < 8; ++m)
#pragma unroll
        for (int j = 0; j < 4; ++j) *(LAS unsigned*)(scr + (nl + j) * TP_PITCH + (8 * m + 2 * g) * 2) = pk2(v[2 * m][j], v[2 * m + 1][j]);
    LDS_WAIT(); asm volatile("" ::: "memory");
#pragma unroll
    for (int t = 0; t < 8; ++t) { const int id = lane + 64 * t, n = id >> 3, c = id & 7;
        const v4u o = *(const LAS v4u*)(scr + n * TP_PITCH + 16 * c);
        *(GAS v4u*)(WT + (size_t)(drow0 + n) * K + k0 + 8 * c) = o; }
    LDS_WAIT(); asm volatile("" ::: "memory");
}
constexpr int IT_GU = (D / 64) * (N_GU / 64), IT_D = (FF / 64) * (D / 64), IT_IN = (D / 64) * (N_IN / 64), IT_OUT = (D / 64) * (D / 64);
constexpr int IT_LAYER = 2 * IT_GU + 2 * IT_D + IT_IN + IT_OUT;
__device__ __forceinline__ void conv_gu(const float* Wg, const float* Wu, bf16* WT, int r, LAS unsigned char* scr, int lane, const float* gain) {
    constexpr int nrg = N_GU / 64; const int kb = r / nrg, rg = r % nrg, p = rg >> 2, q = rg & 3; const int c0 = 128 * p + 64 * (q & 1);
    transpose_item64(q < 2 ? Wg : Wu, FF, c0, 32, c0 + 32, 32, D, WT, 64 * rg, 64 * kb, scr, lane, gain);
}
__device__ __forceinline__ void conv_plain(const float* W, int K, int N, bf16* WT, int r, LAS unsigned char* scr, int lane, const float* gain_lo = nullptr, const float* gain_hi = nullptr) {
    const int nrg = N / 64, kb = r / nrg, rg = r % nrg;
    const float* gain = gain_lo ? (64 * kb < 1024 ? gain_lo : gain_hi - 1024) : nullptr;
    transpose_item64(W, N, 64 * rg, 32, 64 * rg + 32, 32, K, WT, 64 * rg, 64 * kb, scr, lane, gain);
}
__device__ __forceinline__ int in_src_col(int pn, int wc, int bj) {
    if (pn < 16) { const int seg = pn >> 2, base = seg == 0 ? 0 : seg == 1 ? 1024 : seg == 2 ? 2048 : 3088; return base + 256 * (pn & 3) + 64 * wc + 32 * bj; }
    return (wc < 2 ? 4112 + 64 * wc : 4240 + 64 * (wc - 2)) + 32 * bj;
}
__device__ __forceinline__ void conv_in(const float* W, bf16* WT, int r, LAS unsigned char* scr, int lane, const float* gain) {
    constexpr int nrg = N_IN / 64; const int kb = r / nrg, rg = r % nrg, pn = rg >> 2, q = rg & 3, bj = q >> 1, wc0 = 2 * (q & 1);
    int ca, cb, nva = 32, nvb = 32;
    if (pn < 17) { ca = in_src_col(pn, wc0, bj); cb = in_src_col(pn, wc0 + 1, bj); }
    else { ca = 3072; cb = 3072; nva = (q == 0) ? 16 : 0; nvb = 0; }
    transpose_item64(W, IN_W, ca, nva, cb, nvb, D, WT, 64 * rg, 64 * kb, scr, lane, gain);
}
__device__ __forceinline__ void convert_item(Frame& F, unsigned char* w, int l, int r, LAS unsigned char* scr) {
    unsigned char* wl = w + WS_W + (size_t)l * LW_STRIDE;
    if (r < IT_GU) { conv_gu(inptr(F, 3) + (size_t)l * D * FF, inptr(F, 4) + (size_t)l * D * FF, (bf16*)(wl + LW_GU1), r, scr, F.lane, inptr(F, 2) + (size_t)l * D); return; } r -= IT_GU;
    if (r < IT_D) { conv_plain(inptr(F, 5) + (size_t)l * FF * D, FF, D, (bf16*)(wl + LW_D1), r, scr, F.lane); return; } r -= IT_D;
    if (r < IT_IN) { conv_in(inptr(F, 7) + (size_t)l * D * IN_W, (bf16*)(wl + LW_IN), r, scr, F.lane, inptr(F, 6) + (size_t)l * D); return; } r -= IT_IN;
    if (r < IT_OUT) { conv_plain(inptr(F, 16) + (size_t)l * D * D, D, D, (bf16*)(wl + LW_OUT), r, scr, F.lane, inptr(F, 14) + (size_t)l * 1024, inptr(F, 15) + (size_t)l * 1024); return; } r -= IT_OUT;
    if (r < IT_GU) { conv_gu(inptr(F, 18) + (size_t)l * D * FF, inptr(F, 19) + (size_t)l * D * FF, (bf16*)(wl + LW_GU2), r, scr, F.lane, inptr(F, 17) + (size_t)l * D); return; } r -= IT_GU;
    conv_plain(inptr(F, 20) + (size_t)l * FF * D, FF, D, (bf16*)(wl + LW_D2), r, scr, F.lane);
}
#define IDLE_CONV_K 4
constexpr int R_IDLE = IDLE_CONV_K * 128 * NWAVES, GU2_BASE = IT_GU + IT_D + IT_IN + IT_OUT;
static_assert(R_IDLE <= IT_GU, "idle-slot items are SwiGLU-2 items");
__device__ __forceinline__ void convert_layer(Frame& F, unsigned char* w, int l) {
    LAS unsigned char* scr = F.lds + RING_OFF + F.wave * 16384;
    const int gw = F.vcu * NWAVES + F.wave, NGW = F.G * NWAVES;
    if (F.G == 256) { for (int q = gw; q < IT_LAYER - R_IDLE; q += NGW) convert_item(F, w, l, q < GU2_BASE ? q : q + R_IDLE, scr); }
    else for (int r = gw; r < IT_LAYER; r += NGW) convert_item(F, w, l, r, scr);
}
__device__ __forceinline__ void p0_prologue(Frame& F) {
    const int gw = F.vcu * NWAVES + F.wave, NGW = F.G * NWAVES;
    unsigned char* w = wsl(F);
    for (int l = 0; l < (OVERLAP_CONV ? 1 : DEPTH); ++l) convert_layer(F, w, l);
    const GAS float* x = (const GAS float*)inptr(F, 0); const GAS float* meta = (const GAS float*)inptr(F, 1);
    GAS bf16* HB = (GAS bf16*)(w + WS_HB); GAS float* SSQ0 = (GAS float*)(w + WS_SSQ); GAS float* SSQM0 = (GAS float*)(w + WS_SSQM);
    for (int m = gw; m < M_REAL + NMETA; m += NGW) {
        const int row = m < M_REAL ? m : META_ROW + (m - M_REAL);
        GAS unsigned long long* hb8 = (GAS unsigned long long*)(HB + (size_t)row * D) + F.lane;
        const GAS f32x4* xr = (const GAS f32x4*)(m < M_REAL ? x + (size_t)m * D : meta + (size_t)(m - M_REAL) * D) + F.lane;
        float ss = 0.f;
#pragma unroll
        for (int j = 0; j < 8; ++j) { const f32x4 v = xr[64 * j]; const unsigned w0 = pk2(v.x, v.y), w1 = pk2(v.z, v.w); hb8[64 * j] = (unsigned long long)w0 | ((unsigned long long)w1 << 32);
            const float a0 = __builtin_bit_cast(float, w0 << 16), a1 = __builtin_bit_cast(float, w0 & 0xffff0000u), a2 = __builtin_bit_cast(float, w1 << 16), a3 = __builtin_bit_cast(float, w1 & 0xffff0000u);
            ss += (a0 * a0 + a1 * a1) + (a2 * a2 + a3 * a3); }
        ss = wave_sum(ss);
        if (m < M_REAL) { if (F.lane < 32) SSQ0[(size_t)m * 32 + F.lane] = F.lane == 0 ? ss : 0.f; }
        else { SSQM0[(m - M_REAL) * 128 + F.lane] = F.lane == 0 ? ss : 0.f; SSQM0[(m - M_REAL) * 128 + 64 + F.lane] = 0.f; }
    }
    if (gw < 48) { const int row = META_BLK0 + 64 + gw; const v4u z = (v4u){0u, 0u, 0u, 0u};
#pragma unroll
        for (int j = 0; j < 2; ++j) { ((GAS v4u*)(w + WS_FQ + (size_t)row * 2048))[F.lane + 64 * j] = z;
            ((GAS v4u*)(w + WS_SQ + (size_t)row * 2048))[F.lane + 64 * j] = z; } }
    {
        const v4u z = (v4u){0u, 0u, 0u, 0u}; constexpr int RB = (META_BLK0 + 64) >> 5;
        GAS v4u* fk = (GAS v4u*)((GAS bf16*)(w + WS_FK) + (size_t)RB * 16 * 2048); GAS v4u* sk = (GAS v4u*)((GAS bf16*)(w + WS_SK) + (size_t)RB * 2 * 2048);
        for (int i = gw * 64 + F.lane; i < 2 * 16 * 256; i += NGW * 64) fk[i] = z;
        for (int i = gw * 64 + F.lane; i < 2 * 2 * 256; i += NGW * 64) sk[i] = z;
        constexpr int G16 = (META_BLK0 + 64) >> 4;
        GAS v4u* fv = (GAS v4u*)((GAS bf16*)(w + WS_FV) + (size_t)G16 * 16 * 1024); GAS v4u* sv = (GAS v4u*)((GAS bf16*)(w + WS_SV) + (size_t)G16 * 2 * 1024);
        for (int i = gw * 64 + F.lane; i < 4 * 16 * 128; i += NGW * 64) fv[i] = z;
        for (int i = gw * 64 + F.lane; i < 4 * 2 * 128; i += NGW * 64) sv[i] = z; }
}
__device__ __forceinline__ void onorm_phase(Frame& F, const float* gf, const float* gs) {
    const int gw = F.vcu * NWAVES + F.wave, NGW = F.G * NWAVES;
    unsigned char* w = wsl(F); const GAS bf16* O = (const GAS bf16*)(w + WS_O); GAS bf16* XN = (GAS bf16*)(w + WS_XN);
    for (int mm = gw; mm < M_REAL + NMETA; mm += NGW) {
        const int m = mm < M_REAL ? mm : META_ROW + (mm - M_REAL);
        const GAS v4u* orow = (const GAS v4u*)(O + (size_t)m * D) + F.lane;
        GAS v4u* xrow = (GAS v4u*)(XN + (size_t)m * D) + F.lane;
        float x[4][8]; float sf = 0.f, ss = 0.f;
#pragma unroll
        for (int j = 0; j < 4; ++j) { const v4u w = orow[64 * j]; const unsigned ww[4] = {w.x, w.y, w.z, w.w};
#pragma unroll
            for (int e = 0; e < 4; ++e) { x[j][2 * e] = __builtin_bit_cast(float, ww[e] << 16); x[j][2 * e + 1] = __builtin_bit_cast(float, ww[e] & 0xffff0000u); }
            float q = 0.f;
#pragma unroll
            for (int e = 0; e < 8; ++e) q += x[j][e] * x[j][e];
            if (j < 2) sf += q; else ss += q; }
        const float rf = 1.0f / sqrtf(wave_sum(sf) * (1.0f / 1024.f) + EPS), rs = 1.0f / sqrtf(wave_sum(ss) * (1.0f / 1024.f) + EPS);
#pragma unroll
        for (int j = 0; j < 4; ++j) { const float* gp = (j < 2 ? gf : gs) + (j & 1) * 512 + 8 * F.lane; const f32x4 g0 = *(const GAS f32x4*)gp, g1 = *(const GAS f32x4*)(gp + 4); const float r = j < 2 ? rf : rs;
            v4u w; w.x = pk2(x[j][0] * r * g0.x, x[j][1] * r * g0.y); w.y = pk2(x[j][2] * r * g0.z, x[j][3] * r * g0.w); w.z = pk2(x[j][4] * r * g1.x, x[j][5] * r * g1.y); w.w = pk2(x[j][6] * r * g1.z, x[j][7] * r * g1.w);
            xrow[64 * j] = w; }
    }
}

constexpr int SK_RED_OFF = 0, SK_TILE_OFF = 65536, SK_RSTD_OFF = SK_TILE_OFF + 4096;
template <class Epi, int NST  >
__device__ __forceinline__ void skinny_phase(Frame& F, const GAS bf16* A, int lda, const GAS bf16* Bt, int K, const Epi& E) {
    constexpr int TC = Epi::TC;
    int lane = F.lane; asm volatile("" : "+v"(lane));
    const int w = F.wave;
    LAS float* red = (LAS float*)(F.lds + RING_OFF + SK_RED_OFF);
    LAS float* tile = (LAS float*)(F.lds + RING_OFF + SK_TILE_OFF);
    const int k0 = w * (NST * 32);
    bool first = true;
    for (int task = F.G - 1 - (int)blockIdx.x; task < E.ntasks(); task += F.G) {
        pg8::f32x4 acc[TC];
        const GAS bf16* bp[TC];
#pragma unroll
        for (int c = 0; c < TC; ++c) { acc[c] = (pg8::f32x4){0.f, 0.f, 0.f, 0.f}; bp[c] = Bt + (size_t)(E.btrow(task, c) + (lane & 15)) * K + k0 + 8 * (lane >> 4); }
        const GAS bf16* ap = A + (size_t)(lane & 15) * lda + k0 + 8 * (lane >> 4);
        bf16x8 av[NST], bv[TC][NST];
#pragma unroll
        for (int j = 0; j < NST; ++j) { av[j] = *(const GAS bf16x8*)(ap + 32 * j);
#pragma unroll
            for (int c = 0; c < TC; ++c) bv[c][j] = *(const GAS bf16x8*)(bp[c] + 32 * j); }
        if (first) {
            if constexpr (Epi::KHALF_SCALE) {
                LAS float* rv = (LAS float*)(F.lds + RING_OFF + SK_RSTD_OFF);
#pragma unroll
                for (int j = 0; j < 2; ++j) { const int row = 2 * w + j; float t = lane < 32 ? E.ssqom[row * 32 + lane] : 0.f;
                    XSUM16(t);
                    if (lane == 0) rv[row] = 1.0f / sqrtf(t * (1.0f / 1024.0f) + EPS); if (lane == 16) rv[16 + row] = 1.0f / sqrtf(t * (1.0f / 1024.0f) + EPS); }
            }
            if constexpr (Epi::NEED_RSTD) {
                LAS float* rv = (LAS float*)(F.lds + RING_OFF + SK_RSTD_OFF);
#pragma unroll
                for (int j = 0; j < 2; ++j) { const int row = 2 * w + j; const float t = wave_sum(E.ssqm[row * 128 + lane] + E.ssqm[row * 128 + 64 + lane]); if (lane == 0) rv[row] = 1.0f / sqrtf(t * (1.0f / D) + EPS); }
            }
            first = false;
        }
#pragma unroll
        for (int j = 0; j < NST; ++j)
#pragma unroll
            for (int c = 0; c < TC; ++c) acc[c] = __builtin_amdgcn_mfma_f32_16x16x32_bf16(av[j], bv[c][j], acc[c], 0, 0, 0);
#pragma unroll
        for (int c = 0; c < TC; ++c)
#pragma unroll
            for (int r = 0; r < 4; ++r) red[((w * TC + c) * 4 + r) * 64 + lane] = acc[c][r];
        __syncthreads();
        for (int e = F.tid; e < TC * 256; e += NWAVES * 64) { float sum = 0.f, sum2 = 0.f;
#pragma unroll
            for (int w2 = 0; w2 < 4; ++w2) { sum += red[w2 * TC * 256 + e]; sum2 += red[(w2 + 4) * TC * 256 + e]; }
            const int ln = e & 63, r = (e >> 6) & 3, c = e >> 8, orow = (ln >> 4) * 4 + r;
            if constexpr (Epi::KHALF_SCALE) { const LAS float* rv = (const LAS float*)(F.lds + RING_OFF + SK_RSTD_OFF); sum = sum * rv[orow] + sum2 * rv[16 + orow]; } else sum += sum2;
            tile[orow * 64 + 16 * c + (ln & 15)] = sum; }
        __syncthreads();
        E.store(F, task, tile);
        if (task + F.G < E.ntasks()) __syncthreads();
    }
}
struct SkGU {
    static constexpr int TC = 4; static constexpr bool NEED_RSTD = true, KHALF_SCALE = false;
    GAS bf16* act; const GAS float* ssqm;
    __device__ __forceinline__ int ntasks() const { return FF / 32; }
    __device__ __forceinline__ int btrow(int t, int c) const { const int p = t >> 2, q = t & 3; return 256 * p + 128 * (c >> 1) + 32 * q + 16 * (c & 1); }
    __device__ __forceinline__ void store(Frame& F, int t, const LAS float* tile) const {
        const int row = F.tid >> 5, col = F.tid & 31; const float r = ((const LAS float*)(F.lds + RING_OFF + SK_RSTD_OFF))[row];
        act[(size_t)(META_ROW + row) * FF + 32 * t + col] = (bf16)f2bf(pg8::silu_mul(tile[row * 64 + col] * r, tile[row * 64 + 32 + col] * r));
    }
};
struct SkRes {
    static constexpr int TC = 1; static constexpr bool NEED_RSTD = false, KHALF_SCALE = false;
    float scale; GAS bf16* hb; GAS float* ssqm;
    __device__ __forceinline__ int ntasks() const { return D / 16; }
    __device__ __forceinline__ int btrow(int t, int) const { return 16 * t; }
    __device__ __forceinline__ void store(Frame& F, int t, const LAS float* tile) const {
        if (F.tid < 256) { const int row = F.tid >> 4, col = F.tid & 15; const size_t off = (size_t)(META_ROW + row) * D + 16 * t + col;
            const unsigned hbits = f2bf(bf2f(hb[off]) + scale * tile[row * 64 + col]); hb[off] = (bf16)hbits; const float v = bf2f((bf16)hbits); float ss = v * v;
            XSUM16(ss);
            if (col == 0) ssqm[row * 128 + t] = ss; }
    }
};
struct SkOut {
    static constexpr int TC = 1; static constexpr bool NEED_RSTD = false, KHALF_SCALE = true;
    float scale; GAS bf16* hb; GAS float* ssqm; const GAS float* ssqom;
    __device__ __forceinline__ int ntasks() const { return D / 16; }
    __device__ __forceinline__ int btrow(int t, int) const { return 16 * t; }
    __device__ __forceinline__ void store(Frame& F, int t, const LAS float* tile) const {
        if (F.tid < 256) { const int row = F.tid >> 4, col = F.tid & 15; const size_t off = (size_t)(META_ROW + row) * D + 16 * t + col;
            const unsigned hbits = f2bf(bf2f(hb[off]) + scale * tile[row * 64 + col]); hb[off] = (bf16)hbits; const float v = bf2f((bf16)hbits); float ss = v * v;
            XSUM16(ss);
            if (col == 0) ssqm[row * 128 + t] = ss; }
    }
};
struct SkIn {
    static constexpr int TC = 4; static constexpr bool NEED_RSTD = true, KHALF_SCALE = false;
    GAS bf16 *fq_, *fk_, *fv_, *sq_, *sk_, *sv_; GAS float* logf; const GAS float *g_fq, *g_fk, *g_sq, *g_sk, *bfg; float qscale; const GAS float* ssqm;
    __device__ __forceinline__ int ntasks() const { return 69; }
    __device__ __forceinline__ int btrow(int t, int c) const { if (t == 68) return 17 * 256 + 16 * c; const int pn = t < 64 ? (t >> 2) : 16, wc = t < 64 ? (t & 3) : (t - 64); return 256 * pn + 128 * (c >> 1) + 32 * wc + 16 * (c & 1); }
    __device__ __forceinline__ void store(Frame& F, int t, const LAS float* tile) const {
        if (t == 68) { if (F.tid < 256) { const int row = F.tid >> 4, hh = F.tid & 15; const float z = tile[row * 64 + hh] * ((const LAS float*)(F.lds + RING_OFF + SK_RSTD_OFF))[row] + bfg[hh];
                logf[(size_t)(META_ROW + row) * 16 + hh] = fminf(z, 0.f) - 0.69314718056f * __builtin_amdgcn_logf(1.0f + __builtin_amdgcn_exp2f(-LOG2E * fabsf(z))); } return; }
        const int pn = t < 64 ? (t >> 2) : 16, wc = t < 64 ? (t & 3) : (t - 64);
        GAS bf16* dst; int pitch, head, knh = 0; const GAS float* gain = nullptr; float sc = 1.f;
        if (pn < 16) { const int seg = pn >> 2; head = (pn & 3) * 4 + wc; pitch = 1024;
            if (seg == 0) { dst = fq_; gain = g_fq; sc = qscale; } else if (seg == 1) { dst = fk_; gain = g_fk; knh = 16; } else if (seg == 2) { dst = fv_; } else { dst = sq_; gain = g_sq; sc = qscale; } }
        else { pitch = 128; head = wc & 1; if (wc < 2) { dst = sk_; gain = g_sk; knh = 2; } else { dst = sv_; } }
        const int row = F.tid >> 5, cp = F.tid & 31; const float rr = ((const LAS float*)(F.lds + RING_OFF + SK_RSTD_OFF))[row];
        float v0 = tile[row * 64 + 2 * cp] * rr, v1 = tile[row * 64 + 2 * cp + 1] * rr;
        if (gain) { float ss = v0 * v0 + v1 * v1;
            XSUM32(ss);
            const float rinv = 1.0f / sqrtf(ss * (1.0f / 64.0f) + EPS); v0 = v0 * rinv * gain[2 * cp] * sc; v1 = v1 * rinv * gain[2 * cp + 1] * sc; }
        if (knh) *(GAS unsigned*)(dst + kfrag_idx(META_ROW + row, knh, head, 2 * cp)) = pk2(v0, v1);
        else if (!gain) { GAS bf16* vp = dst + vfrag_idx(META_ROW + row, pn < 16 ? 16 : 2, head, 2 * cp); const unsigned pw = pk2(v0, v1); vp[0] = (bf16)(pw & 0xffffu); vp[8] = (bf16)(pw >> 16); }
        else *(GAS unsigned*)(dst + (size_t)(META_ROW + row) * pitch + head * 64 + 2 * cp) = pk2(v0, v1);
    }
};

__device__ __forceinline__ void split3(float x, unsigned& h, unsigned& m, unsigned& l) { h = f2bf(x); const float r = x - bf2f((unsigned short)h); m = f2bf(r); const float r2 = r - bf2f((unsigned short)m); l = f2bf(r2); }
__device__ __forceinline__ int crow(int r, int hi) { return (r & 3) + 8 * (r >> 2) + 4 * hi; }
typedef short v4i16_t __attribute__((ext_vector_type(4)));
__device__ __forceinline__ float max3f(float a, float b, float c) { return fmaxf(fmaxf(a, b), c); }
constexpr float ATT_THR = 40.0f;
constexpr int ATT_KV_OFF = 36864;
template <int MODE>
__device__ __forceinline__ void kv_dma(Frame& F, unsigned char* w, int gb, int kvh, int c, int image) {
    constexpr int NHK = (MODE == 0) ? 16 : 2; const int wv = F.wave, lane = F.lane; const int rowk = (c == 1) ? META_BLK0 + 64 : gb * SEQ + 64 * (c - 2);
    const GAS bf16* kp = (const GAS bf16*)(w + (MODE == 0 ? WS_FK : WS_SK)) + ((size_t)((rowk >> 5) + (wv >> 2)) * NHK + kvh) * 2048 + (wv & 3) * 512 + lane * 8;
    const GAS bf16* vp = (const GAS bf16*)(w + (MODE == 0 ? WS_FV : WS_SV)) + ((size_t)((rowk >> 4) + (wv >> 1)) * NHK + kvh) * 1024 + (wv & 1) * 512 + lane * 8;
    LAS unsigned char* d = F.lds + RING_OFF + ATT_KV_OFF + image * 16384 + wv * 1024;
    __builtin_amdgcn_global_load_lds((const unsigned*)kp, (LAS unsigned*)d, 16, 0, 0); __builtin_amdgcn_global_load_lds((const unsigned*)vp, (LAS unsigned*)(d + 8192), 16, 0, 0);
}
template <int MODE  , int RES = 0>
__device__ __forceinline__ void attn_group(Frame& F, unsigned char* w, int gb, int kvh, int c_lo, int c_hi, bool active, int b  , int h, int i, const float* sinks, int res_c0 = 0) {
    const int lane = F.lane, r32 = lane & 31, hi = lane >> 5, wv = F.wave;
    const bool meta = b < 0;
    const int qpos0 = meta ? 96 : 128 + 32 * i;
    const int qrow0 = meta ? META_BLK0 + 96 : b * SEQ + 32 * i;
    const int cd = qpos0 >> 6;
    const int cfirst = (MODE == 0) ? (meta ? 1 : __builtin_amdgcn_readfirstlane(((const volatile LAS int*)(F.lds + RING_OFF + ATT_FC_OFF))[i])) : ((qpos0 - 127) < 128 ? 1 : ((qpos0 - 127) >> 6));
    constexpr int NHK = (MODE == 0) ? 16 : 2;
    const GAS bf16* Qp = (const GAS bf16*)(w + (MODE == 0 ? WS_FQ : WS_SQ)) + (size_t)qrow0 * 1024 + h * 64;
    const GAS bf16* kdma = (const GAS bf16*)(w + (MODE == 0 ? WS_FK : WS_SK)) + ((size_t)(wv >> 2) * NHK + kvh) * 2048 + (wv & 3) * 512 + lane * 8;
    const GAS bf16* vdma = (const GAS bf16*)(w + (MODE == 0 ? WS_FV : WS_SV)) + ((size_t)(wv >> 1) * NHK + kvh) * 1024 + (wv & 1) * 512 + lane * 8;
    LAS unsigned char* kvb = F.lds + RING_OFF + ATT_KV_OFF;
    const float sl2 = (MODE == 1) ? exp2f(-0.5f * (float)(h + 1)) * LOG2E : 0.f;
    const LAS unsigned char* tfp = F.lds + RING_OFF + (hi ? ATT_ZERO_OFF : ATT_TABF_OFF + r32 * 16); const int toff = hi ? 0 : 1;
    v4u mfr = hi ? (v4u){0u, 0u, 0u, 0u} : (v4u){0x3F803F80u, 0x3F80u, 0u, 0u};
    bf16x8 qf[4];
    if (active) {
#pragma unroll
        for (int s = 0; s < 4; ++s) qf[s] = *(const GAS bf16x8*)(Qp + (size_t)r32 * 1024 + 16 * s + 8 * hi);
    } else {
#pragma unroll
        for (int s = 0; s < 4; ++s) qf[s] = (bf16x8){0, 0, 0, 0, 0, 0, 0, 0};
    }
#define CHUNK_ROW(c) ((c) == 1 ? META_BLK0 + 64 : gb * SEQ + 64 * ((c) - 2))
#define KV_DMA(c_) do { const int rowk_ = CHUNK_ROW(c_); LAS unsigned char* d_ = kvb + ((c_) & 1) * 16384 + wv * 1024; \
        __builtin_amdgcn_global_load_lds((const unsigned*)(kdma + (size_t)(rowk_ >> 5) * (NHK * 2048)), (LAS unsigned*)d_, 16, 0, 0); \
        __builtin_amdgcn_global_load_lds((const unsigned*)(vdma + (size_t)(rowk_ >> 4) * (NHK * 1024)), (LAS unsigned*)(d_ + 8192), 16, 0, 0); } while (0)
    float m_run = 0.f, l_run = 0.f; f32x16 o0 = {}, o1 = {};
    const float NEG = -1e30f;
    if (!RES) { __syncthreads();
        KV_DMA(c_lo); }
    for (int c = c_lo; c <= c_hi; ++c) {
        if (!RES) { asm volatile("s_waitcnt vmcnt(0) lgkmcnt(0)" ::: "memory"); __builtin_amdgcn_s_barrier(); __builtin_amdgcn_sched_barrier(0);
            if (c < c_hi) KV_DMA(c + 1); }
        if (!(active && c >= cfirst && c <= cd)) continue;
        const LAS unsigned char* cb = kvb + (RES ? (c - res_c0) : (c & 1)) * 16384 + hi * 512 + r32 * 16;
        bf16x8 kf[2][4];
#pragma unroll
        for (int t = 0; t < 2; ++t)
#pragma unroll
            for (int s = 0; s < 4; ++s) kf[t][s] = *(const LAS bf16x8*)(cb + t * 4096 + s * 1024);
        f32x16 p0 = {}, p1 = {};
        bf16x8 ab0, ab1;
        if (MODE == 0) { ab0 = *(const LAS bf16x8*)(tfp + toff * (1024 * c)); ab1 = *(const LAS bf16x8*)(tfp + toff * (1024 * c + 512)); }
        __builtin_amdgcn_s_setprio(1);
#pragma unroll
        for (int s = 0; s < 4; ++s) { p0 = __builtin_amdgcn_mfma_f32_32x32x16_bf16(kf[0][s], qf[s], p0, 0, 0, 0); p1 = __builtin_amdgcn_mfma_f32_32x32x16_bf16(kf[1][s], qf[s], p1, 0, 0, 0); }
        if (MODE == 0) { const bf16x8 mb = __builtin_bit_cast(bf16x8, mfr); p0 = __builtin_amdgcn_mfma_f32_32x32x16_bf16(ab0, mb, p0, 0, 0, 0); p1 = __builtin_amdgcn_mfma_f32_32x32x16_bf16(ab1, mb, p1, 0, 0, 0); }
        __builtin_amdgcn_s_setprio(0);
        bf16x8 vf[4][2];
#pragma unroll
        for (int g = 0; g < 4; ++g)
#pragma unroll
            for (int d = 0; d < 2; ++d) vf[g][d] = *(const LAS bf16x8*)(cb + 8192 + g * 2048 + hi * 512 + d * 512);
        if (MODE == 0) {
            if (c == cd) { const int dq = qpos0 + r32 - 64 * c - 4 * hi;
#pragma unroll
                for (int r = 0; r < 16; ++r) { const int e = (r & 3) + 8 * (r >> 2); if (e > dq) p0[r] = NEG; if (e + 32 > dq) p1[r] = NEG; } }
        } else {
            const float kb0 = (float)(64 * c - qpos0 + 4 * hi) - m_run / sl2;
#pragma unroll
            for (int r = 0; r < 16; ++r) { const float e = (float)((r & 3) + 8 * (r >> 2)); p0[r] = fmaf(sl2, kb0 + e, p0[r]); p1[r] = fmaf(sl2, kb0 + 32.f + e, p1[r]); }
            const int dq = qpos0 + r32 - 64 * c - 4 * hi;
            const int padlim = (c == 1) ? 48 - 4 * hi : -1;
            const bool interior = c != 1 && 64 * c + 63 <= qpos0 && 64 * c > qpos0 + 31 - 128;
            if (!interior) {
#pragma unroll
            for (int r = 0; r < 16; ++r) { const int e = (r & 3) + 8 * (r >> 2);
                if ((unsigned)(dq - e) >= 128u || e < padlim) p0[r] = NEG;
                if ((unsigned)(dq - e - 32) >= 128u || e + 32 < padlim) p1[r] = NEG; } }
        }
        float mx = max3f(p0[0], p0[1], p1[0]);
#pragma unroll
        for (int r = 2; r < 16; r += 2) mx = max3f(mx, p0[r], p0[r + 1]);
#pragma unroll
        for (int r = 1; r < 16; r += 2) mx = max3f(mx, p1[r], (r + 1 < 16) ? p1[r + 1] : p1[r]);
        const bool first = (c == cfirst);
        if (first || __any(mx > ATT_THR)) {
            mx = fmaxf(mx, shx<32>(mx));
            const float dl = first ? fmaxf(mx, -200.f) : fmaxf(mx, 0.f);
            m_run += dl;
            if (MODE == 0) { unsigned h_, m_, l_; split3(-m_run, h_, m_, l_); if (!hi) { mfr.y = 0x3F80u | (h_ << 16); mfr.z = m_ | (l_ << 16); } }
            const float alpha = first ? 0.f : __builtin_amdgcn_exp2f(-dl);
            l_run *= alpha;
#pragma unroll
            for (int r = 0; r < 16; ++r) { p0[r] -= dl; p1[r] -= dl; }
            if (!first) {
#pragma unroll
                for (int r = 0; r < 16; ++r) { o0[r] *= alpha; o1[r] *= alpha; } }
        }
        float rs = 0.f;
#pragma unroll
        for (int r = 0; r < 16; ++r) { p0[r] = __builtin_amdgcn_exp2f(p0[r]); p1[r] = __builtin_amdgcn_exp2f(p1[r]); rs += p0[r] + p1[r]; }
        l_run += rs;
#pragma unroll
        for (int t = 0; t < 2; ++t)
#pragma unroll
            for (int s = 0; s < 2; ++s) {
                const f32x16& pp = t ? p1 : p0;
                v4u wq; wq.x = pg8::cvt_pk_bf16(pp[8 * s + 0], pp[8 * s + 1]); wq.y = pg8::cvt_pk_bf16(pp[8 * s + 2], pp[8 * s + 3]); wq.z = pg8::cvt_pk_bf16(pp[8 * s + 4], pp[8 * s + 5]); wq.w = pg8::cvt_pk_bf16(pp[8 * s + 6], pp[8 * s + 7]);
                const bf16x8 pf = __builtin_bit_cast(bf16x8, wq);
                const bf16x8 v0 = vf[2 * t + s][0], v1 = vf[2 * t + s][1];
                o0 = __builtin_amdgcn_mfma_f32_32x32x16_bf16(v0, pf, o0, 0, 0, 0);
                o1 = __builtin_amdgcn_mfma_f32_32x32x16_bf16(v1, pf, o1, 0, 0, 0);
            }
    }
#undef CHUNK_ROW
#undef KV_DMA
    if (!active) return;
    l_run += shx<32>(l_run);
    if (MODE == 1) l_run += __builtin_amdgcn_exp2f(sinks[h] * LOG2E + sl2 * (float)r32 - m_run);
    float inv = 1.0f / l_run;
    const int qrow0e = launder_u(qrow0), he = launder_u(h);
    int lane_e = lane; asm volatile("" : "+v"(lane_e)); const int r32e = lane_e & 31, hie = lane_e >> 5;
    if (meta && r32e < 16) inv = 0.f;
    GAS bf16* Op = (GAS bf16*)(w + WS_O) + (size_t)(qrow0e + r32e) * D + (MODE == 0 ? 0 : 1024) + he * 64 + 4 * hie;
    GAS float* sqo = meta ? (GAS float*)(w + WS_SSQOM) + (MODE == 0 ? 0 : 16) + he : (GAS float*)(w + WS_SSQO) + (size_t)qrow0e * 32 + (MODE == 0 ? 0 : 16) + he;
    float ss = 0.f;
#pragma unroll
    for (int g = 0; g < 4; ++g) {
        unsigned a[4], c[4];
#pragma unroll
        for (int j = 0; j < 4; ++j) { a[j] = f2bf(o0[4 * g + j] * inv); c[j] = f2bf(o1[4 * g + j] * inv);
            const float v0 = bf2f((bf16)a[j]), v1 = bf2f((bf16)c[j]); ss += v0 * v0 + v1 * v1; }
        *(GAS unsigned long long*)(Op + 8 * g) = (unsigned long long)(a[0] | (a[1] << 16)) | ((unsigned long long)(a[2] | (a[3] << 16)) << 32);
        *(GAS unsigned long long*)(Op + 32 + 8 * g) = (unsigned long long)(c[0] | (c[1] << 16)) | ((unsigned long long)(c[2] | (c[3] << 16)) << 32);
    }
    ss += shx<32>(ss);
    if (hie == 0) { if (!meta) sqo[(size_t)r32e * 32] = ss; else if (r32e >= 16) sqo[(size_t)(r32e - 16) * 32] = ss; }
}
__device__ __forceinline__ void probe_t0(LAS unsigned char* lds) { if (PROBE_CLASS > 50 && (PROBE_BLOCK < 0 || (int)blockIdx.x == PROBE_BLOCK) && my_tid() == 0) *(volatile LAS unsigned long long*)(lds + MISC_OFF + 72) = __builtin_amdgcn_s_memrealtime(); }
__device__ __forceinline__ void probe_t1(LAS unsigned char* lds, int c) { if (PROBE_CLASS == c && (PROBE_BLOCK < 0 || (int)blockIdx.x == PROBE_BLOCK) && my_tid() == 0) { volatile LAS unsigned long long* pa_ = (volatile LAS unsigned long long*)(lds + MISC_OFF + 64); *pa_ = *pa_ + (__builtin_amdgcn_s_memrealtime() - *(volatile LAS unsigned long long*)(lds + MISC_OFF + 72)); } }
__device__ __forceinline__ void attn_phase(Frame& F, const float* sinks, int next_layer  , const float* gq, const float* gk) {
    probe_t0(F.lds);
    unsigned char* w = wsl(F); const GAS float* LOGF = (const GAS float*)(w + WS_LOGF);
    const int bh = F.vcu >> 1, fb = bh >> 4, fh = bh & 15;
    LAS float* tab = (LAS float*)(F.lds + RING_OFF + ATT_TAB_OFF);
    LAS float* wtot = (LAS float*)(F.lds + RING_OFF + ATT_WTOT_OFF);
    float x5[5];
#pragma unroll
    for (int j = 0; j < 5; ++j) { const int p = 5 * F.tid + j; x5[j] = 0.f;
        if (p >= PADN && p < LPOS) { const int row = p < 128 ? META_BLK0 + p : fb * SEQ + p - 128; x5[j] = LOGF[(size_t)row * 16 + fh]; } }
    {
      { const int T0 = F.vcu * 4, sb = T0 >> 7, kvh = (T0 >> 6) & 1, i0 = T0 & 63, m = 1 + (i0 >> 2); const int u_lo = (i0 == 0) ? 1 : 2 * m - 2, u_hi = 2 * m + 1;
        for (int c = u_lo; c <= u_hi; ++c) kv_dma<1>(F, w, sb, kvh, c, c - u_lo);
        asm volatile("s_waitcnt vmcnt(0)" ::: "memory"); __syncthreads();
        for (int k = 0; k < 4; ++k) { const int i = i0 + k, qp = 128 + 32 * i;
            attn_group<1, 1>(F, w, sb, kvh, (qp - 127) < 128 ? 1 : ((qp - 127) >> 6), qp >> 6, true, sb, 8 * kvh + F.wave, i, sinks, u_lo); } }
      probe_t1(F.lds, 53); probe_t0(F.lds);
      if (F.vcu < 32 && (F.vcu & 1) == 1) attn_group<1>(F, w, 0, (F.vcu >> 1) >> 3, 1, 1, F.wave == 0, -1, F.vcu >> 1, 0, sinks); }
    probe_t1(F.lds, 54); probe_t0(F.lds);
    { float v[5]; float tsum = 0.f; const int p0 = 5 * F.tid;
#pragma unroll
      for (int j = 0; j < 5; ++j) { tsum += x5[j]; v[j] = tsum; }
      float inc = tsum;
#pragma unroll
      for (int o = 1; o < 64; o <<= 1) { const float t = shi(inc, F.lane - o); if (F.lane >= o) inc += t; }
      if (F.lane == 63) wtot[F.wave] = inc;
      __syncthreads();
      float base = inc - tsum;
      for (int w = 0; w < F.wave; ++w) base += wtot[w];
#pragma unroll
      for (int j = 0; j < 5; ++j) { const int p = p0 + j; if (p < LPOS) { const float cv = (p < PADN) ? 1e30f : (base + v[j]) * LOG2E; tab[p] = cv;
          unsigned h_, m_, l_; split3(fmaxf(-cv, -60000.f), h_, m_, l_);
          LAS unsigned* tf = (LAS unsigned*)(F.lds + RING_OFF + ATT_TABF_OFF + p * 16); unsigned one2 = 0x3F803F80u, zz = 0u; asm volatile("" : "+v"(one2), "+v"(zz));
          tf[0] = h_ | (m_ << 16); tf[1] = l_ | (one2 << 16); tf[2] = one2; tf[3] = zz; } }
      if (F.tid < 4) ((LAS unsigned*)(F.lds + RING_OFF + ATT_ZERO_OFF))[F.tid] = 0u;
      __syncthreads();
      if (F.wave == 0) { float mq = fabsf(((const GAS float*)gq)[F.lane]), mk = fabsf(((const GAS float*)gk)[F.lane]);
#define XMAX_(v, O) v = fmaxf(v, shx<O>(v))
          XMAX_(mq, 1); XMAX_(mq, 2); XMAX_(mq, 4); XMAX_(mq, 8); XMAX_(mq, 16); XMAX_(mq, 32); XMAX_(mk, 1); XMAX_(mk, 2); XMAX_(mk, 4); XMAX_(mk, 8); XMAX_(mk, 16); XMAX_(mk, 32);
#undef XMAX_
          const float thr = -(80.0f + 2.0f * (64.0f * QSCALE * mq * mk * 1.02f + 1.0f));
          const int q0pos = 128 + 32 * F.lane, cdl = q0pos >> 6; const float tq = tab[q0pos];
          int lo = 1, hi = cdl;
#pragma unroll 1
          for (int it = 0; it < 6; ++it) { const int mid = (lo + hi) >> 1; const bool far = (lo < hi) && (tq - tab[64 * mid + 63] < thr); if (lo < hi) { if (far) lo = mid + 1; else hi = mid; } }
          ((LAS int*)(F.lds + RING_OFF + ATT_FC_OFF))[F.lane] = lo; }
      __syncthreads(); }
    probe_t1(F.lds, 51); probe_t0(F.lds);
    {
      const int odd = F.vcu & 1;
      for (int k = 0; k < 4; ++k) { const int g = (k == 0) ? odd : (k == 1) ? 3 - odd : (k == 2) ? 4 + odd : 7 - odd;
          int cf = 1 << 20;
#pragma unroll
          for (int j = 0; j < 8; ++j) cf = min(cf, ((const volatile LAS int*)(F.lds + RING_OFF + ATT_FC_OFF))[8 * g + j]);
          cf = __builtin_amdgcn_readfirstlane(cf);
          attn_group<0>(F, w, fb, fh, cf, (128 + 32 * (8 * g + 7)) >> 6, true, fb, fh, 8 * g + F.wave, sinks); }
      probe_t1(F.lds, 52); probe_t0(F.lds);
      if (F.vcu < 32 && odd == 0) attn_group<0>(F, w, 0, fh, 1, 1, F.wave == 0, -1, fh, 0, sinks); }
    __syncthreads();
    probe_t1(F.lds, 54);
}

constexpr int PH_PER_LAYER = 7, N_PHASES = 1 + DEPTH * PH_PER_LAYER;
struct Args { const float* in[21]; float* out; unsigned char* ws; int ph_lo, ph_hi, li, pad; };
__global__ void __launch_bounds__(NWAVES * 64, 2) hymba_fwd(Args args) {
    extern __shared__ __attribute__((aligned(16))) unsigned char lds[];
    {
        LAS unsigned char* l0 = (LAS unsigned char*)lds; const int tid = threadIdx.x;
        for (int u = tid; u < (LDS_BYTES - LDSCTL_OFF) / 4; u += NWAVES * 64) ((LAS unsigned*)(l0 + LDSCTL_OFF))[u] = 0u;
        __syncthreads();
        if ((tid & 63) == 0) ((volatile LAS int*)(l0 + WID_OFF))[hw_wave_key()] = tid >> 6;
        volatile LAS unsigned long long* pt = (volatile LAS unsigned long long*)(l0 + PTR_OFF);
#pragma unroll
        for (int k = 0; k < 21; ++k) if (tid == k) pt[k] = (unsigned long long)args.in[k];
        if (tid == 21) pt[21] = (unsigned long long)args.out;
        if (tid == 22) pt[22] = (unsigned long long)args.ws;
        __syncthreads();
#if !MK_PER_PHASE
        (void)xcd_barrier_post((unsigned*)((gu32*)(args.ws + WS_CTL) + CW_BAR), (volatile LAS unsigned*)(l0 + MISC_OFF) + 8);
#endif
    }
    const int lo = args.ph_lo, hi = args.ph_hi;
#define IN(k) (lo <= (k) && (k) < hi)
#define PROBE_T0() if (PROBE_CLASS == 60 && (PROBE_BLOCK < 0 || (int)blockIdx.x == PROBE_BLOCK) && my_tid() == 0) { *(volatile LAS unsigned long long*)((LAS unsigned char*)lds + MISC_OFF + 72) = __builtin_amdgcn_s_memtime(); } else if (PROBE_CLASS >= 0 && (PROBE_BLOCK < 0 || (int)blockIdx.x == PROBE_BLOCK) && my_tid() == 0) { *(volatile LAS unsigned long long*)((LAS unsigned char*)lds + MISC_OFF + 72) = __builtin_amdgcn_s_memrealtime(); }
#define PROBE_T1(c) if (PROBE_CLASS == 60 && (c) == 2 && (PROBE_BLOCK < 0 || (int)blockIdx.x == PROBE_BLOCK) && my_tid() == 0) { volatile LAS unsigned long long* pa_ = (volatile LAS unsigned long long*)((LAS unsigned char*)lds + MISC_OFF + 64); *pa_ = *pa_ + (__builtin_amdgcn_s_memtime() - *(volatile LAS unsigned long long*)((LAS unsigned char*)lds + MISC_OFF + 72)) / 24ull; } else if (PROBE_CLASS == (c) && (PROBE_BLOCK < 0 || (int)blockIdx.x == PROBE_BLOCK) && my_tid() == 0) { volatile LAS unsigned long long* pa_ = (volatile LAS unsigned long long*)((LAS unsigned char*)lds + MISC_OFF + 64); *pa_ = *pa_ + (__builtin_amdgcn_s_memrealtime() - *(volatile LAS unsigned long long*)((LAS unsigned char*)lds + MISC_OFF + 72)); }
#define SEAM(k) do { if (IN(k) && IN((k) + 1)) { PROBE_T0() unsigned char* wsb_ = (unsigned char*)pg8::tab_ptr(22); \
        if (MK_PER_PHASE) { if (my_tid() == 0) __hip_atomic_store((gu32*)(wsb_ + WS_CTL) + CW_TMO, 0xBADBA0u, RLX_AGENT); } \
        else { XcdBarrier bar_; bar_.bar = (unsigned*)((gu32*)(wsb_ + WS_CTL) + CW_BAR); bar_.x = xb_xcc_id(); bar_.st = (volatile LAS unsigned*)((LAS unsigned char*)lds + MISC_OFF) + 8; xcd_barrier(bar_); if (PROBE_CLASS == 50) xcd_barrier(bar_); } PROBE_T1(8) } } while (0)
#define PHASE_BEGIN(k) if (IN(k)) { PROBE_T0() Frame P = make_frame(); \
        unsigned char* w = wsl(P); int ll = l; LAUNDER_S(ll); unsigned char* wl = w + WS_W + (size_t)ll * LW_STRIDE; (void)wl; int bxl = blockIdx.x; LAUNDER_S(bxl);
#define PHASE_END(k, c) PROBE_T1(c) } SEAM(k);
    typedef pg8::StaticOrder SO;
    if (IN(0)) { PROBE_T0() Frame P = make_frame(); p0_prologue(P); PROBE_T1(0) } SEAM(0);
    for (int l = 0; l < DEPTH; ++l) {
        const int pb = 1 + l * PH_PER_LAYER;
#define SSQ(j) ((GAS float*)(w + WS_SSQM) + (size_t)(3 * ll + (j)) * 16 * 128)
#define HBM ((const GAS bf16*)(w + WS_HB) + (size_t)META_ROW * D)
        PHASE_BEGIN(pb + 0) pg8::Gemm g{(const bf16*)(w + WS_HB), (const bf16*)(wl + LW_GU1), M_REAL, N_GU, D}; SO S; S.init(M_REAL, N_GU, P.G, bxl);
            pg8::EpiSwiGLU E{3 * ll + 0}; pg8::gemm_phase<pg8::EpiSwiGLU, SO, true, true>(P.lds + RING_OFF, g, S, E);
            SkGU K2{(GAS bf16*)(w + WS_ACT), SSQ(0)}; skinny_phase<SkGU, D / 256>(P, HBM, D, (const GAS bf16*)(wl + LW_GU1), D, K2); PHASE_END(pb + 0, 2)
        PHASE_BEGIN(pb + 1) pg8::Gemm g{(const bf16*)(w + WS_ACT), (const bf16*)(wl + LW_D1), M_REAL, D, FF}; SO S; S.init(M_REAL, D, P.G, bxl);
            pg8::EpiResAdd E{0.5f, 3 * ll + 1, 0}; pg8::gemm_phase<pg8::EpiResAdd, SO, true, true>(P.lds + RING_OFF, g, S, E);
            SkRes K2{0.5f, (GAS bf16*)(w + WS_HB), SSQ(1)}; skinny_phase<SkRes, FF / 256>(P, (const GAS bf16*)(w + WS_ACT) + (size_t)META_ROW * FF, FF, (const GAS bf16*)(wl + LW_D1), FF, K2); PHASE_END(pb + 1, 3)
        PHASE_BEGIN(pb + 2) pg8::Gemm g{(const bf16*)(w + WS_HB), (const bf16*)(wl + LW_IN), M_REAL, N_IN, D}; SO S; S.init(M_REAL, N_IN, P.G, bxl);
            pg8::EpiInProj E{ll, 3 * ll + 1, QSCALE};
            pg8::gemm_phase<pg8::EpiInProj, SO, true, true>(P.lds + RING_OFF, g, S, E);
            SkIn K2{(GAS bf16*)(w + WS_FQ), (GAS bf16*)(w + WS_FK), (GAS bf16*)(w + WS_FV), (GAS bf16*)(w + WS_SQ), (GAS bf16*)(w + WS_SK), (GAS bf16*)(w + WS_SV), (GAS float*)(w + WS_LOGF), (const GAS float*)(inptr(P, 9) + ll * HD), (const GAS float*)(inptr(P, 10) + ll * HD), (const GAS float*)(inptr(P, 11) + ll * HD), (const GAS float*)(inptr(P, 12) + ll * HD), (const GAS float*)(inptr(P, 8) + ll * NH), QSCALE, SSQ(1)}; skinny_phase<SkIn, D / 256>(P, HBM, D, (const GAS bf16*)(wl + LW_IN), D, K2);
            if (IDLE_CONV_K > 0 && P.G == 256 && bxl >= 128) { __syncthreads(); LAS unsigned char* scr = P.lds + RING_OFF + P.wave * 16384; const int iw = (bxl - 128) * NWAVES + P.wave;
                for (int k = 0; k < IDLE_CONV_K; ++k) convert_item(P, w, ll, GU2_BASE + iw + k * 128 * NWAVES, scr); }
            PHASE_END(pb + 2, 4)
        PHASE_BEGIN(pb + 3) attn_phase(P, inptr(P, 13) + ll * NH, OVERLAP_CONV ? ll + 1 : DEPTH, inptr(P, 9) + ll * HD, inptr(P, 10) + ll * HD); PHASE_END(pb + 3, 5)
        PHASE_BEGIN(pb + 4) pg8::Gemm g{(const bf16*)(w + WS_O), (const bf16*)(wl + LW_OUT), M_REAL, D, D}; SO S; S.init(M_REAL, D, P.G, bxl);
            pg8::EpiOut E{3 * ll + 2}; pg8::gemm_phase<pg8::EpiOut, SO, true, true>(P.lds + RING_OFF, g, S, E);
            SkOut K2{1.0f, (GAS bf16*)(w + WS_HB), SSQ(2), (const GAS float*)(w + WS_SSQOM)}; skinny_phase<SkOut, D / 256>(P, (const GAS bf16*)(w + WS_O) + (size_t)META_ROW * D, D, (const GAS bf16*)(wl + LW_OUT), D, K2); PHASE_END(pb + 4, 7)
        PHASE_BEGIN(pb + 5) pg8::Gemm g{(const bf16*)(w + WS_HB), (const bf16*)(wl + LW_GU2), M_REAL, N_GU, D}; SO S; S.init(M_REAL, N_GU, P.G, bxl);
            pg8::EpiSwiGLU E{3 * ll + 2}; pg8::gemm_phase<pg8::EpiSwiGLU, SO, true, true>(P.lds + RING_OFF, g, S, E);
            if (ll < DEPTH - 1) { SkGU K2{(GAS bf16*)(w + WS_ACT), SSQ(2)}; skinny_phase<SkGU, D / 256>(P, HBM, D, (const GAS bf16*)(wl + LW_GU2), D, K2); } PHASE_END(pb + 5, 2)
        PHASE_BEGIN(pb + 6) pg8::Gemm g{(const bf16*)(w + WS_ACT), (const bf16*)(wl + LW_D2), M_REAL, D, FF}; SO S; S.init(M_REAL, D, P.G, bxl);
            const bool fin = (ll == DEPTH - 1);
            pg8::EpiResAdd E{0.5f, 3 * ll + 3, fin ? 1 : 0}; pg8::gemm_phase<pg8::EpiResAdd, SO, true, true>(P.lds + RING_OFF, g, S, E);
            if (!fin) { SkRes K2{0.5f, (GAS bf16*)(w + WS_HB), SSQ(3)}; skinny_phase<SkRes, FF / 256>(P, (const GAS bf16*)(w + WS_ACT) + (size_t)META_ROW * FF, FF, (const GAS bf16*)(wl + LW_D2), FF, K2); } PHASE_END(pb + 6, 3)
#undef SSQ
#undef HBM
    }
    if (PROBE_CLASS >= 0 && (PROBE_BLOCK < 0 || (int)blockIdx.x == PROBE_BLOCK) && my_tid() == 0) { const unsigned long long t0 = __builtin_amdgcn_s_memrealtime(), dt = *(volatile LAS unsigned long long*)((LAS unsigned char*)lds + MISC_OFF + 64);
        while (__builtin_amdgcn_s_memrealtime() - t0 < dt) __builtin_amdgcn_s_sleep(8); }
#undef IN
#undef SEAM
#undef PHASE_BEGIN
#undef PHASE_END
}

extern "C" void kernel_launch(void* const* d_in, const int* in_sizes, int n_in, void* d_out, int out_size, void* d_ws, size_t ws_size, hipStream_t stream) {
    static int grid = 0;
    if (grid == 0) {
        if (n_in != 21 || in_sizes[0] != M_REAL * D || out_size != M_REAL * D || ws_size < WS_END) { fprintf(stderr, "kernel_launch: unexpected shapes (n_in %d, in0 %d, out %d, ws %zu, need %zu); nothing launched\n", n_in, n_in > 0 ? in_sizes[0] : -1, out_size, ws_size, (size_t)WS_END); grid = -1; return; }
        int dev = 0, cus = 0, per_cu = 0;
        if (hipGetDevice(&dev) != hipSuccess || hipDeviceGetAttribute(&cus, hipDeviceAttributeMultiprocessorCount, dev) != hipSuccess) { fprintf(stderr, "kernel_launch: device query failed\n"); grid = -1; return; }
        if (hipFuncSetAttribute((const void*)hymba_fwd, hipFuncAttributeMaxDynamicSharedMemorySize, LDS_BYTES) != hipSuccess) { fprintf(stderr, "kernel_launch: hipFuncSetAttribute failed\n"); grid = -1; return; }
        if (hipOccupancyMaxActiveBlocksPerMultiprocessor(&per_cu, (const void*)hymba_fwd, NWAVES * 64, LDS_BYTES) != hipSuccess || per_cu < 1) fprintf(stderr, "kernel_launch: note: occupancy query reports %d workgroups per CU\n", per_cu);
        (void)hipGetLastError();
        grid = cus;
        if (grid != 256) fprintf(stderr, "kernel_launch: note: %d CUs (the attention phase's static deal assumes 256)\n", grid);
    }
    if (grid < 0) return;
    if (hipMemsetAsync((char*)d_ws + WS_CTL, 0, CTL_ZERO_BYTES, stream) != hipSuccess) { fprintf(stderr, "kernel_launch: memset failed\n"); return; }
    Args a{};
    for (int i = 0; i < 21; ++i) a.in[i] = (const float*)d_in[i];
    a.out = (float*)d_out; a.ws = (unsigned char*)d_ws; a.li = 0; a.pad = 0;
#if MK_PER_PHASE
    for (int ph = 0; ph < N_PHASES; ++ph) { a.ph_lo = ph; a.ph_hi = ph + 1; hipLaunchKernelGGL(hymba_fwd, dim3(grid), dim3(NWAVES * 64), LDS_BYTES, stream, a); }
#else
    a.ph_lo = 0; a.ph_hi = N_PHASES;
    hipLaunchKernelGGL(hymba_fwd, dim3(grid), dim3(NWAVES * 64), LDS_BYTES, stream, a);
#endif
    const hipError_t le = hipPeekAtLastError();
    if (le != hipSuccess) fprintf(stderr, "kernel_launch: launch failed: %s\n", hipGetErrorName(le));
}
```

```cpp
#include <hip/hip_runtime.h>
#include <cstdio>
#include <cstdint>

#ifndef MK_PER_PHASE
#define MK_PER_PHASE 0
#endif
#ifndef OVERLAP_CONV
#define OVERLAP_CONV 0
#endif
#ifndef PROBE_BLOCK
#define PROBE_BLOCK 0
#endif
#ifndef PROBE_CLASS
#define PROBE_CLASS (-1)
#endif

#define PROBE_ACC_OFF (131072 + 320 + 64)
__device__ __forceinline__ int my_tid();
__device__ __forceinline__ int lane_now() { unsigned z = 0; asm volatile("" : "+v"(z)); return (int)__builtin_amdgcn_mbcnt_hi(~0u, __builtin_amdgcn_mbcnt_lo(~0u, z)); }
template <int O> __device__ __forceinline__ float shx(float v) {
    if constexpr (O < 32) return __builtin_bit_cast(float, __builtin_amdgcn_ds_swizzle(__builtin_bit_cast(int, v), (O << 10) | 0x1f));
    else return __builtin_bit_cast(float, __builtin_amdgcn_ds_bpermute((lane_now() ^ 32) << 2, __builtin_bit_cast(int, v)));
}
__device__ __forceinline__ float shi(float v, int idx) { return __builtin_bit_cast(float, __builtin_amdgcn_ds_bpermute(idx << 2, __builtin_bit_cast(int, v))); }
#define XSUM16(v) do { v += shx<1>(v); v += shx<2>(v); v += shx<4>(v); v += shx<8>(v); } while (0)
#define XSUM32(v) do { XSUM16(v); v += shx<16>(v); } while (0)
#define XSUM64(v) do { XSUM32(v); v += shx<32>(v); } while (0)
namespace pg8 {
#define PG8_LAS __attribute__((address_space(3)))
#define PG8_GAS __attribute__((address_space(1)))
typedef unsigned short bf16_t;
typedef short bf16x8 __attribute__((ext_vector_type(8)));
typedef float f32x4 __attribute__((ext_vector_type(4)));
typedef unsigned u32x4 __attribute__((ext_vector_type(4)));
constexpr int BM = 256, BK = 64, HALF = 128, HTB = HALF * BK * 2  , STAGE_BYTES = 8 * HTB, NXCD = 8, WGM = 8;

__host__ __device__ __forceinline__ int lds_byte(int r, int c) { const int st = (r >> 4) * 2 + (c >> 5), rr = r & 15, cc = c & 31, ob = rr * 64 + cc * 2; return st * 1024 + (ob ^ (((ob >> 9) & 1) << 5)); }
__host__ __device__ __forceinline__ void stage_rc(int b, int& R, int& C) { const int st = b / 1024, sb = b % 1024, swz = sb ^ (((sb >> 9) & 1) << 5); R = (st >> 1) * 16 + swz / 64; C = (st & 1) * 32 + (swz % 64) / 2; }
__host__ __device__ __forceinline__ int perm32(int rho) { const int n = rho >> 4, i = rho & 15; return 8 * (i >> 2) + 4 * n + (i & 3); }

struct Unit { int pm, pn; };
struct Gemm { const bf16_t* A; const bf16_t* Bt; int M, N, K; };

struct StaticOrder {
    int nM, nN, nwg, G, c;
    __host__ __device__ void init(int M, int N, int G_, int c_) { nM = M / BM; nN = N / BM; nwg = nM * nN; G = G_; c = c_; }
    __host__ __device__ bool next(int i, Unit& u) const {
        const long L = (long)i * G + c; if (L >= nwg) return false;
        int wgid = (int)L; { const int q = nwg / NXCD, r = nwg % NXCD, xcd = wgid % NXCD, off = wgid / NXCD; wgid = (xcd < r ? xcd * (q + 1) : r * (q + 1) + (xcd - r) * q) + off; }
        const int nig = WGM * nN, gid = wgid / nig, fm = gid * WGM, gsz = (nM - fm) < WGM ? (nM - fm) : WGM;
        u.pm = fm + ((wgid % nig) % gsz); u.pn = (wgid % nig) / gsz; return true;
    }
    __device__ __forceinline__ void a_ready(const Unit&) const {}
    __device__ __forceinline__ void done(const Unit&) const {}
};

__device__ __forceinline__ unsigned cvt_pk_bf16(float lo, float hi) { unsigned r; asm volatile("v_cvt_pk_bf16_f32 %0, %1, %2" : "=v"(r) : "v"(lo), "v"(hi)); return r; }

template <class Epi, class Sched, bool ALIGN_EPI = false, bool SP2 = false>
__device__ __forceinline__ void gemm_phase(PG8_LAS unsigned char* lds, const Gemm g, const Sched& S, const Epi& E) {
    int tid_l = my_tid(); asm volatile("" : "+v"(tid_l));
    const int tid = tid_l, wid = __builtin_amdgcn_readfirstlane(tid >> 6), lane = tid & 63, wr = wid >> 2, wc = wid & 3, fr = lane & 15, fq = lane >> 4;
    const int K = g.K, nt = K / BK;
    unsigned voffA[2], voffB[2];
#pragma unroll
    for (int i = 0; i < 2; ++i) { int R, C; stage_rc(tid * 16 + i * 8192, R, C); const int Rb = Epi::PERM ? ((R & ~31) + perm32(R & 31)) : R;
        voffA[i] = (unsigned)(R * K + C) * 2u; voffB[i] = (unsigned)(Rb * K + C) * 2u; }
    const size_t kstep = (size_t)(BK * 2);
    const size_t hstep = (size_t)HALF * K * 2;
    const size_t tstep = 2 * hstep;
    const unsigned ldsw = (unsigned)wid * 1024u;
    const int aoff = lds_byte(wr * 64 + fr, fq * 8), boff = lds_byte(wc * 32 + fr, fq * 8);
#define PG8_SA(b, h) (((b) * 2 + (h)) * HTB)
#define PG8_SB(b, h) ((4 + (b) * 2 + (h)) * HTB)
#define PG8_STAGE(bufoff, gbase, voff) do { _Pragma("unroll") for (int _i = 0; _i < 2; ++_i) \
        __builtin_amdgcn_global_load_lds((const unsigned*)((const char*)(gbase) + (voff)[_i]), (PG8_LAS unsigned*)(lds + (bufoff) + ldsw + _i * 8192), 16, 0, 0); } while (0)
#define PG8_LDA(dst, b, h) do { _Pragma("unroll") for (int m = 0; m < 4; ++m) _Pragma("unroll") for (int k = 0; k < 2; ++k) dst[m][k] = *(const PG8_LAS bf16x8*)(lds + PG8_SA(b, h) + aoff + m * 2048 + k * 1024); } while (0)
#define PG8_LDB(dst, b, h) do { _Pragma("unroll") for (int n = 0; n < 2; ++n) _Pragma("unroll") for (int k = 0; k < 2; ++k) dst[n][k] = *(const PG8_LAS bf16x8*)(lds + PG8_SB(b, h) + boff + n * 2048 + k * 1024); } while (0)
#define PG8_MMA(ai, bj, At, Bt) do { __builtin_amdgcn_s_setprio(1); _Pragma("unroll") for (int m = 0; m < 4; ++m) _Pragma("unroll") for (int n = 0; n < 2; ++n) _Pragma("unroll") for (int k = 0; k < 2; ++k) \
        acc[ai][bj][m][n] = __builtin_amdgcn_mfma_f32_16x16x32_bf16(Bt[n][k], At[m][k], acc[ai][bj][m][n], 0, 0, 0); __builtin_amdgcn_s_setprio(0); } while (0)
#define PG8_WAIT_V(n) asm volatile("s_waitcnt vmcnt(" #n ")" ::: "memory")
#define PG8_WAIT_L(n) asm volatile("s_waitcnt lgkmcnt(" #n ")" ::: "memory")
#define PG8_BAR __builtin_amdgcn_s_barrier()
#define PG8_SCHED __builtin_amdgcn_sched_barrier(0)
    Unit cur, nxt; int ui = 0;
    if (!S.next(0, cur)) return;
    f32x4 acc[2][2][4][2];
#pragma unroll
    for (int a = 0; a < 2; ++a)
#pragma unroll
        for (int b = 0; b < 2; ++b)
#pragma unroll
            for (int m = 0; m < 4; ++m)
#pragma unroll
                for (int n = 0; n < 2; ++n) acc[a][b][m][n] = (f32x4){0.f, 0.f, 0.f, 0.f};
    bf16x8 At[4][2], B0[2][2], B1[2][2];
    const char* cA = (const char*)g.A + (size_t)cur.pm * tstep; const char* cB = (const char*)g.Bt + (size_t)cur.pn * tstep;
    S.a_ready(cur);
    if constexpr (SP2) {
        PG8_STAGE(PG8_SB(0, 0), cB, voffB); PG8_STAGE(PG8_SB(0, 1), cB + hstep, voffB); PG8_STAGE(PG8_SA(0, 0), cA, voffA); PG8_STAGE(PG8_SA(0, 1), cA + hstep, voffA);
        if (wr == 1) PG8_BAR;
        PG8_WAIT_V(2); PG8_BAR;
        PG8_STAGE(PG8_SB(1, 0), cB + kstep, voffB); PG8_STAGE(PG8_SA(1, 0), cA + kstep, voffA); PG8_STAGE(PG8_SB(1, 1), cB + hstep + kstep, voffB);
        PG8_WAIT_V(6); PG8_BAR;
    } else {
        PG8_STAGE(PG8_SB(0, 0), cB, voffB); PG8_STAGE(PG8_SA(0, 0), cA, voffA); PG8_STAGE(PG8_SB(0, 1), cB + hstep, voffB); PG8_STAGE(PG8_SA(0, 1), cA + hstep, voffA);
        if (wr == 1) PG8_BAR;
        PG8_WAIT_V(4); PG8_BAR;
        PG8_STAGE(PG8_SB(1, 0), cB + kstep, voffB); PG8_STAGE(PG8_SA(1, 0), cA + kstep, voffA); PG8_STAGE(PG8_SB(1, 1), cB + hstep + kstep, voffB);
        PG8_WAIT_V(6); PG8_BAR;
    }
    for (;;) {
        const bool has_next = S.next(ui + 1, nxt);
        const char* nA = has_next ? (const char*)g.A + (size_t)nxt.pm * tstep : cA; const char* nB = has_next ? (const char*)g.Bt + (size_t)nxt.pn * tstep : cB;
        for (int t = 0; t < nt; t += 2) {
            const bool last = (t == nt - 2);
            const char* a1 = cA + (size_t)(t + 1) * kstep;
            const char* a2 = last ? nA : cA + (size_t)(t + 2) * kstep; const char* b2 = last ? nB : cB + (size_t)(t + 2) * kstep;
            const char* a3 = a2 + kstep; const char* b3 = b2 + kstep;
            if (last && has_next) S.a_ready(nxt);
            if constexpr (Epi::MID) { if (t == nt / 2) E.mid(acc, cur, wr, wc, fr, fq); }
            if constexpr (SP2) {
            PG8_LDB(B0, 0, 0); PG8_LDB(B1, 0, 1); PG8_SCHED; PG8_LDA(At, 0, 0); PG8_STAGE(PG8_SA(1, 1), a1 + hstep, voffA);
            PG8_WAIT_V(8); PG8_WAIT_L(0); PG8_BAR; PG8_MMA(0, 0, At, B0); PG8_MMA(0, 1, At, B1); PG8_BAR; PG8_SCHED;
            PG8_LDA(At, 0, 1); PG8_STAGE(PG8_SB(0, 0), b2, voffB); PG8_STAGE(PG8_SB(0, 1), b2 + hstep, voffB); PG8_STAGE(PG8_SA(0, 0), a2, voffA);
            PG8_WAIT_V(8); PG8_WAIT_L(0); PG8_BAR; PG8_MMA(1, 0, At, B0); PG8_MMA(1, 1, At, B1); PG8_BAR; PG8_SCHED;
            PG8_LDB(B0, 1, 0); PG8_LDB(B1, 1, 1); PG8_SCHED; PG8_LDA(At, 1, 0); PG8_STAGE(PG8_SA(0, 1), a2 + hstep, voffA);
            PG8_WAIT_V(8); PG8_WAIT_L(0); PG8_BAR; PG8_MMA(0, 0, At, B0); PG8_MMA(0, 1, At, B1); PG8_BAR; PG8_SCHED;
            PG8_LDA(At, 1, 1); PG8_STAGE(PG8_SB(1, 0), b3, voffB); PG8_STAGE(PG8_SB(1, 1), b3 + hstep, voffB); PG8_STAGE(PG8_SA(1, 0), a3, voffA);
            PG8_WAIT_V(8); PG8_WAIT_L(0); PG8_BAR; PG8_MMA(1, 0, At, B0); PG8_MMA(1, 1, At, B1); PG8_BAR; PG8_SCHED;
            } else {
            PG8_LDB(B0, 0, 0); PG8_SCHED; PG8_LDA(At, 0, 0); PG8_STAGE(PG8_SA(1, 1), a1 + hstep, voffA);
            PG8_WAIT_L(8); PG8_BAR; PG8_WAIT_L(0); PG8_MMA(0, 0, At, B0); PG8_BAR; PG8_SCHED;
            PG8_LDB(B1, 0, 1); PG8_STAGE(PG8_SB(0, 0), b2, voffB);
            PG8_BAR; PG8_WAIT_L(0); PG8_MMA(0, 1, At, B1); PG8_BAR;
            PG8_LDA(At, 0, 1); PG8_STAGE(PG8_SA(0, 0), a2, voffA);
            PG8_BAR; PG8_WAIT_L(0); PG8_MMA(1, 0, At, B0); PG8_BAR; PG8_SCHED;
            PG8_STAGE(PG8_SB(0, 1), b2 + hstep, voffB);
            PG8_WAIT_V(6); PG8_BAR; PG8_MMA(1, 1, At, B1); PG8_BAR;
            PG8_LDB(B0, 1, 0); PG8_SCHED; PG8_LDA(At, 1, 0); PG8_STAGE(PG8_SA(0, 1), a2 + hstep, voffA);
            PG8_WAIT_L(8); PG8_BAR; PG8_WAIT_L(0); PG8_MMA(0, 0, At, B0); PG8_BAR; PG8_SCHED;
            PG8_LDB(B1, 1, 1); PG8_STAGE(PG8_SB(1, 0), b3, voffB);
            PG8_BAR; PG8_WAIT_L(0); PG8_MMA(0, 1, At, B1); PG8_BAR;
            PG8_LDA(At, 1, 1); PG8_STAGE(PG8_SA(1, 0), a3, voffA);
            PG8_BAR; PG8_WAIT_L(0); PG8_MMA(1, 0, At, B0); PG8_BAR; PG8_SCHED;
            PG8_STAGE(PG8_SB(1, 1), b3 + hstep, voffB);
            PG8_WAIT_V(6); PG8_BAR; PG8_MMA(1, 1, At, B1); PG8_BAR;
            }
        }
        if constexpr (ALIGN_EPI) { if (wr == 0) PG8_BAR; }
        if constexpr (PROBE_CLASS == 20 + Epi::ID) { unsigned long long t0_ = 0; if ((PROBE_BLOCK < 0 || (int)blockIdx.x == PROBE_BLOCK) && tid == 0) t0_ = __builtin_amdgcn_s_memrealtime();
            E(acc, cur, wr, wc, fr, fq); asm volatile("s_waitcnt vmcnt(0)" ::: "memory");
            if ((PROBE_BLOCK < 0 || (int)blockIdx.x == PROBE_BLOCK) && tid == 0) { volatile PG8_LAS unsigned long long* pa_ = (volatile PG8_LAS unsigned long long*)(lds + PROBE_ACC_OFF); *pa_ = *pa_ + (__builtin_amdgcn_s_memrealtime() - t0_); } }
        else if constexpr (!Epi::AFTER_DRAIN) { E(acc, cur, wr, wc, fr, fq); S.done(cur); }
        if (!has_next) break;
#pragma unroll
        for (int a = 0; a < 2; ++a)
#pragma unroll
            for (int b = 0; b < 2; ++b)
#pragma unroll
                for (int m = 0; m < 4; ++m)
#pragma unroll
                    for (int n = 0; n < 2; ++n) acc[a][b][m][n] = (f32x4){0.f, 0.f, 0.f, 0.f};
        cur = nxt; cA = nA; cB = nB; ++ui;
        if constexpr (ALIGN_EPI) { if (wr == 1) PG8_BAR; }
    }
    PG8_WAIT_V(0);
    if constexpr (!ALIGN_EPI) { if (wr == 0) PG8_BAR; }
    PG8_BAR;
#undef PG8_SA
#undef PG8_SB
#undef PG8_STAGE
#undef PG8_LDA
#undef PG8_LDB
#undef PG8_MMA
#undef PG8_WAIT_V
#undef PG8_WAIT_L
#undef PG8_BAR
#undef PG8_SCHED
}
}

constexpr int NWAVES = 8;
constexpr int D = 2048, NB = 8, SEQ = 2048, DEPTH = 4, HD = 64, NH = 16, FF = 5632, NMETA = 16, PADN = 112;
constexpr int M_REAL = NB * SEQ;
constexpr int M_PAD = M_REAL + 128;
constexpr int META_BLK0 = M_REAL;
constexpr int META_ROW = META_BLK0 + PADN;
constexpr int LPOS = SEQ + 128;
constexpr int N_GU = 2 * FF;
constexpr int N_IN = 18 * 256;
constexpr int IN_W = 4368;
constexpr float EPS = 1e-6f;
constexpr float LOG2E = 1.4426950408889634f;
constexpr float QSCALE = 0.125f * LOG2E;

constexpr size_t MiB = 1u << 20;
constexpr int NSLOT = 13;
constexpr size_t WS_CTL = 0, CTL_ZERO_BYTES = 1 * MiB;
constexpr size_t SZ_WGU = (size_t)N_GU * D * 2, SZ_WD = (size_t)D * FF * 2, SZ_WIN = (size_t)N_IN * D * 2, SZ_WOUT = (size_t)D * D * 2;
constexpr size_t LW_GU1 = 0, LW_D1 = LW_GU1 + SZ_WGU, LW_IN = LW_D1 + SZ_WD, LW_OUT = LW_IN + SZ_WIN, LW_GU2 = LW_OUT + SZ_WOUT, LW_D2 = LW_GU2 + SZ_WGU, LW_STRIDE = LW_D2 + SZ_WD;
constexpr size_t WS_W = 1 * MiB;
constexpr size_t WS_XN = WS_W + DEPTH * LW_STRIDE;
constexpr size_t WS_O = WS_XN + (size_t)M_PAD * D * 2;
constexpr size_t WS_ACT = WS_O + (size_t)M_PAD * D * 2;
constexpr size_t SZ_QK = (size_t)M_PAD * 1024 * 2, SZ_KV = (size_t)M_PAD * 128 * 2;
constexpr size_t WS_FQ = WS_ACT + (size_t)M_PAD * FF * 2, WS_FK = WS_FQ + SZ_QK, WS_FV = WS_FK + SZ_QK, WS_SQ = WS_FV + SZ_QK, WS_SK = WS_SQ + SZ_QK, WS_SV = WS_SK + SZ_KV, WS_LOGF = WS_SV + SZ_KV;
constexpr size_t WS_HB = WS_LOGF + (size_t)M_PAD * 16 * 4;
constexpr size_t WS_SSQ = WS_HB + (size_t)M_PAD * D * 2;
constexpr size_t WS_SSQM = WS_SSQ + (size_t)NSLOT * M_REAL * 32 * 4;
constexpr size_t WS_SSQO = WS_SSQM + (size_t)NSLOT * 16 * 128 * 4;
constexpr size_t WS_SSQOM = WS_SSQO + (size_t)M_REAL * 32 * 4;
constexpr size_t WS_END = WS_SSQOM + 16 * 32 * 4;
static_assert(LW_STRIDE % 256 == 0 && WS_XN % 256 == 0 && WS_ACT % 256 == 0 && WS_FQ % 256 == 0 && WS_SK % 256 == 0 && WS_LOGF % 256 == 0 && WS_HB % 256 == 0, "alignment");
constexpr int CW_TMO = 0, CW_BAR = 4096;

constexpr int RING_OFF = 0, RING_BYTES = 131072;
constexpr int LDSCTL_OFF = RING_BYTES, MISC_OFF = LDSCTL_OFF + 320, PTR_OFF = LDSCTL_OFF + 1024;
constexpr int LDS_BYTES = 155648;
constexpr int WID_OFF = LDSCTL_OFF + 1280;
constexpr int RSTD_ID_OFF = LDSCTL_OFF + 1536, RSTD_OFF = LDSCTL_OFF + 2048;
static_assert(RSTD_OFF + 8 * 128 * 4 <= LDS_BYTES, "LDS map");
constexpr int RSTD2_OFF = 148480;
static_assert(RSTD2_OFF + 8 * 128 * 4 <= LDS_BYTES, "LDS map");
constexpr int ATT_TAB_OFF = 139264;
constexpr int ATT_WTOT_OFF = ATT_TAB_OFF + 8704;
constexpr int ATT_FC_OFF = ATT_WTOT_OFF + 64;
constexpr int ATT_TABF_OFF = 0, ATT_ZERO_OFF = 2176 * 16;
constexpr int ATT_VST_OFF = 0, ATT_VST_PITCH = 128, ATT_VST_BYTES = 64 * ATT_VST_PITCH;
static_assert(ATT_VST_OFF + NWAVES * 2 * ATT_VST_BYTES <= RING_BYTES && ATT_FC_OFF + 256 <= RSTD2_OFF && RSTD_OFF + 8 * 128 * 4 <= ATT_TAB_OFF, "attention LDS");

#define GAS __attribute__((address_space(1)))
#define LAS __attribute__((address_space(3)))
typedef unsigned short bf16;
typedef unsigned v4u __attribute__((ext_vector_type(4)));
typedef float f32x4 __attribute__((ext_vector_type(4)));
typedef float f32x16 __attribute__((ext_vector_type(16)));
typedef short bf16x8 __attribute__((ext_vector_type(8)));
typedef GAS unsigned gu32;
#define RLX_AGENT __ATOMIC_RELAXED, __HIP_MEMORY_SCOPE_AGENT
#define LDS_WAIT() asm volatile("s_waitcnt lgkmcnt(0)" ::: "memory")
__device__ __forceinline__ unsigned f2bf(float f) { unsigned u = __builtin_bit_cast(unsigned, f); return (u + 0x7fffu + ((u >> 16) & 1u)) >> 16; }
__device__ __forceinline__ unsigned pk2(float lo, float hi) { return f2bf(lo) | (f2bf(hi) << 16); }
__device__ __forceinline__ float bf2f(unsigned short b) { return __builtin_bit_cast(float, (unsigned)b << 16); }

__device__ __forceinline__ int hw_wave_key() { return (int)(__builtin_amdgcn_s_getreg(((6 - 1) << 11) | 4) & 63u); }
__device__ __forceinline__ int my_tid() {
    extern __shared__ __attribute__((aligned(16))) unsigned char lds_dyn_[];
    const int wave = __builtin_amdgcn_readfirstlane(((const volatile LAS int*)((LAS unsigned char*)lds_dyn_ + WID_OFF))[hw_wave_key()]);
    unsigned zero = 0u; asm volatile("" : "+v"(zero));
    return wave * 64 + (int)__builtin_amdgcn_mbcnt_hi(~0u, __builtin_amdgcn_mbcnt_lo(~0u, zero));
}
__host__ __device__ __forceinline__ size_t kfrag_idx(int row, int nh, int head, int d) { return ((((size_t)(row >> 5) * nh + head) * 8 + (d >> 3)) * 32 + (row & 31)) * 8 + (d & 7); }
__host__ __device__ __forceinline__ size_t vfrag_idx(int row, int nh, int head, int d) { return (((((size_t)(row >> 4) * nh + head) * 2 + ((row >> 2) & 1)) * 64 + d) * 8) + (((row >> 3) & 1) * 4 + (row & 3)); }
namespace pg8 {
__device__ __forceinline__ unsigned long long tab_ptr(int k) {
    extern __shared__ __attribute__((aligned(16))) unsigned char lds_dyn_[];
    const volatile PG8_LAS unsigned* t = (const volatile PG8_LAS unsigned*)((PG8_LAS unsigned char*)lds_dyn_ + PTR_OFF);
    const unsigned lo = __builtin_amdgcn_readfirstlane(t[2 * k]), hi = __builtin_amdgcn_readfirstlane(t[2 * k + 1]);
    return ((unsigned long long)hi << 32) | lo;
}
__device__ __forceinline__ const PG8_LAS float* ensure_rstd(const PG8_GAS float* ssq, int slot, int pm, int wid, int wr, int lane) {
    extern __shared__ __attribute__((aligned(16))) unsigned char lds_dyn_[];
    volatile PG8_LAS unsigned* idw = (volatile PG8_LAS unsigned*)((PG8_LAS unsigned char*)lds_dyn_ + RSTD_ID_OFF) + wid;
    PG8_LAS float* rv = (PG8_LAS float*)((PG8_LAS unsigned char*)lds_dyn_ + RSTD_OFF) + wid * 128;
    const unsigned want = ((unsigned)(slot + 1) << 16) | (unsigned)(pm + 1);
    if ((unsigned)__builtin_amdgcn_readfirstlane(*idw) != want) {
#pragma unroll
        for (int j = 0; j < 2; ++j) { const int row = pm * BM + HALF * j + 64 * wr + lane; const PG8_GAS f32x4* pp = (const PG8_GAS f32x4*)(ssq + (size_t)row * 32); float t = 0.f;
#pragma unroll
            for (int q = 0; q < 8; ++q) { const f32x4 a = pp[q]; t += (a[0] + a[1]) + (a[2] + a[3]); }
            rv[64 * j + lane] = 1.0f / sqrtf(t * (1.0f / 2048.0f) + 1e-6f); }
        if (lane == 0) *idw = want;
        asm volatile("s_waitcnt lgkmcnt(0)" ::: "memory");
    }
    return rv;
}
__device__ __forceinline__ float silu_mul(float g, float u) {
    const float e = __builtin_amdgcn_exp2f(-1.4426950408889634f * g);
    return g * __builtin_amdgcn_rcpf(1.0f + e) * u;
}
struct EpiSwiGLU {
    static constexpr bool PERM = true, AFTER_DRAIN = false, MID = false; static constexpr int ID = 0;
    int slot;
    __device__ __forceinline__ void operator()(const f32x4 (&acc)[2][2][4][2], const Unit& u, int wr, int wc, int fr, int fq) const {
        PG8_GAS unsigned char* w = (PG8_GAS unsigned char*)tab_ptr(22); PG8_GAS bf16_t* O = (PG8_GAS bf16_t*)(w + WS_ACT); constexpr int ldc = FF; const PG8_GAS float* ssq = (const PG8_GAS float*)(w + WS_SSQ) + (size_t)slot * M_REAL * 32;
        const int row0 = u.pm * BM + wr * 64 + fr, col0 = u.pn * HALF + wc * 32 + 8 * fq;
        const PG8_LAS float* rv = ensure_rstd(ssq, slot, u.pm, wr * 4 + wc, wr, fr + 16 * fq);
        float rs[2][4];
#pragma unroll
        for (int ai = 0; ai < 2; ++ai)
#pragma unroll
            for (int m = 0; m < 4; ++m) rs[ai][m] = rv[64 * ai + 16 * m + fr];
#pragma unroll
        for (int ai = 0; ai < 2; ++ai)
#pragma unroll
            for (int m = 0; m < 4; ++m) { PG8_GAS bf16_t* rowp = O + (size_t)(row0 + ai * HALF + m * 16) * ldc + col0;
                const float r = rs[ai][m];
                const f32x4 g0 = acc[ai][0][m][0] * r, g1 = acc[ai][0][m][1] * r, u0 = acc[ai][1][m][0] * r, u1 = acc[ai][1][m][1] * r;
                u32x4 w; w.x = cvt_pk_bf16(silu_mul(g0[0], u0[0]), silu_mul(g0[1], u0[1])); w.y = cvt_pk_bf16(silu_mul(g0[2], u0[2]), silu_mul(g0[3], u0[3]));
                w.z = cvt_pk_bf16(silu_mul(g1[0], u1[0]), silu_mul(g1[1], u1[1])); w.w = cvt_pk_bf16(silu_mul(g1[2], u1[2]), silu_mul(g1[3], u1[3]));
                *(PG8_GAS u32x4*)rowp = w; }
    }
};
struct EpiResAdd {
    static constexpr bool PERM = true, AFTER_DRAIN = false, MID = false; static constexpr int ID = 1;
    float scale; int slot; int fin;
    __device__ __forceinline__ void operator()(const f32x4 (&acc)[2][2][4][2], const Unit& u, int wr, int wc, int fr, int fq) const {
        PG8_GAS unsigned char* w = (PG8_GAS unsigned char*)tab_ptr(22); PG8_GAS bf16_t* hb = (PG8_GAS bf16_t*)(w + WS_HB); PG8_GAS float* out = (PG8_GAS float*)tab_ptr(21);
        PG8_GAS float* ssq = (PG8_GAS float*)(w + WS_SSQ) + (size_t)slot * M_REAL * 32; constexpr int ldc = D;
        const int row0 = u.pm * BM + wr * 64 + fr, col0 = u.pn * BM + wc * 32 + 8 * fq;
        u32x4 bs[2][4][2];
#pragma unroll
        for (int ai = 0; ai < 2; ++ai)
#pragma unroll
            for (int m = 0; m < 4; ++m)
#pragma unroll
                for (int bj = 0; bj < 2; ++bj) bs[ai][m][bj] = *(const PG8_GAS u32x4*)(hb + (size_t)(row0 + ai * HALF + m * 16) * ldc + col0 + bj * HALF);
#pragma unroll
        for (int ai = 0; ai < 2; ++ai)
#pragma unroll
            for (int m = 0; m < 4; ++m) { float ss = 0.f; const size_t off = (size_t)(row0 + ai * HALF + m * 16) * ldc + col0;
#pragma unroll
                for (int bj = 0; bj < 2; ++bj) { const u32x4 b = bs[ai][m][bj]; const unsigned bw[4] = {b.x, b.y, b.z, b.w}; float v[8];
#pragma unroll
                    for (int e = 0; e < 4; ++e) { v[2 * e] = __builtin_bit_cast(float, bw[e] << 16) + scale * acc[ai][bj][m][e >> 1][(2 * e) & 3]; v[2 * e + 1] = __builtin_bit_cast(float, bw[e] & 0xffff0000u) + scale * acc[ai][bj][m][e >> 1][(2 * e + 1) & 3]; }
                    if (fin) { *(PG8_GAS f32x4*)(out + off + bj * HALF) = (f32x4){v[0], v[1], v[2], v[3]}; *(PG8_GAS f32x4*)(out + off + bj * HALF + 4) = (f32x4){v[4], v[5], v[6], v[7]}; }
                    else { u32x4 wv; wv.x = cvt_pk_bf16(v[0], v[1]); wv.y = cvt_pk_bf16(v[2], v[3]); wv.z = cvt_pk_bf16(v[4], v[5]); wv.w = cvt_pk_bf16(v[6], v[7]); *(PG8_GAS u32x4*)(hb + off + bj * HALF) = wv;
                        const unsigned ww[4] = {wv.x, wv.y, wv.z, wv.w};
#pragma unroll
                        for (int e = 0; e < 4; ++e) { const float lo = __builtin_bit_cast(float, ww[e] << 16), hi2 = __builtin_bit_cast(float, ww[e] & 0xffff0000u); ss += lo * lo + hi2 * hi2; } } }
                if (!fin) { ss += shx<16>(ss); ss += shx<32>(ss);
                    if (fq == 0) ssq[(size_t)(row0 + ai * HALF + m * 16) * 32 + u.pn * 4 + wc] = ss; } }
    }
};
__device__ __forceinline__ void ensure_rstd_o(const PG8_GAS float* ssqo, int slot, int pm, int wid, int wr, int lane, const PG8_LAS float*& rs_out, const PG8_LAS float*& ratio_out) {
    extern __shared__ __attribute__((aligned(16))) unsigned char lds_dyn_[];
    volatile PG8_LAS unsigned* idw = (volatile PG8_LAS unsigned*)((PG8_LAS unsigned char*)lds_dyn_ + RSTD_ID_OFF) + wid;
    PG8_LAS float* rv = (PG8_LAS float*)((PG8_LAS unsigned char*)lds_dyn_ + RSTD_OFF) + wid * 128;
    PG8_LAS float* rq = (PG8_LAS float*)((PG8_LAS unsigned char*)lds_dyn_ + RSTD2_OFF) + wid * 128;
    const unsigned want = ((0x4000u | (unsigned)(slot + 1)) << 16) | (unsigned)(pm + 1);
    if ((unsigned)__builtin_amdgcn_readfirstlane(*idw) != want) {
#pragma unroll
        for (int j = 0; j < 2; ++j) { const int row = pm * BM + HALF * j + 64 * wr + lane; const PG8_GAS f32x4* pp = (const PG8_GAS f32x4*)(ssqo + (size_t)row * 32); float tf = 0.f, ts = 0.f;
#pragma unroll
            for (int q = 0; q < 4; ++q) { const f32x4 a = pp[q], b = pp[4 + q]; tf += (a[0] + a[1]) + (a[2] + a[3]); ts += (b[0] + b[1]) + (b[2] + b[3]); }
            const float rf = 1.0f / sqrtf(tf * (1.0f / 1024.0f) + 1e-6f), rs = 1.0f / sqrtf(ts * (1.0f / 1024.0f) + 1e-6f);
            rv[64 * j + lane] = rs; rq[64 * j + lane] = rf / rs; }
        if (lane == 0) *idw = want;
        asm volatile("s_waitcnt lgkmcnt(0)" ::: "memory");
    }
    rs_out = rv; ratio_out = rq;
}
struct EpiOut {
    static constexpr bool PERM = true, AFTER_DRAIN = false, MID = true; static constexpr int ID = 3;
    int slot;
    __device__ __forceinline__ void mid(f32x4 (&acc)[2][2][4][2], const Unit& u, int wr, int wc, int fr, int fq) const {
        PG8_GAS unsigned char* w = (PG8_GAS unsigned char*)tab_ptr(22); const PG8_LAS float *rs, *rq; ensure_rstd_o((const PG8_GAS float*)(w + WS_SSQO), slot, u.pm, wr * 4 + wc, wr, fr + 16 * fq, rs, rq);
#pragma unroll
        for (int ai = 0; ai < 2; ++ai)
#pragma unroll
            for (int m = 0; m < 4; ++m) { const float q = rq[64 * ai + 16 * m + fr];
#pragma unroll
                for (int bj = 0; bj < 2; ++bj)
#pragma unroll
                    for (int n = 0; n < 2; ++n) acc[ai][bj][m][n] = acc[ai][bj][m][n] * q; }
    }
    __device__ __forceinline__ void operator()(const f32x4 (&acc)[2][2][4][2], const Unit& u, int wr, int wc, int fr, int fq) const {
        PG8_GAS unsigned char* w = (PG8_GAS unsigned char*)tab_ptr(22); PG8_GAS bf16_t* hb = (PG8_GAS bf16_t*)(w + WS_HB);
        PG8_GAS float* ssq = (PG8_GAS float*)(w + WS_SSQ) + (size_t)slot * M_REAL * 32; constexpr int ldc = D;
        const PG8_LAS float *rs, *rq; ensure_rstd_o((const PG8_GAS float*)(w + WS_SSQO), slot, u.pm, wr * 4 + wc, wr, fr + 16 * fq, rs, rq);
        const int row0 = u.pm * BM + wr * 64 + fr, col0 = u.pn * BM + wc * 32 + 8 * fq;
        u32x4 bs[2][4][2];
#pragma unroll
        for (int ai = 0; ai < 2; ++ai)
#pragma unroll
            for (int m = 0; m < 4; ++m)
#pragma unroll
                for (int bj = 0; bj < 2; ++bj) bs[ai][m][bj] = *(const PG8_GAS u32x4*)(hb + (size_t)(row0 + ai * HALF + m * 16) * ldc + col0 + bj * HALF);
#pragma unroll
        for (int ai = 0; ai < 2; ++ai)
#pragma unroll
            for (int m = 0; m < 4; ++m) { float ss = 0.f; const size_t off = (size_t)(row0 + ai * HALF + m * 16) * ldc + col0; const float scale = rs[64 * ai + 16 * m + fr];
#pragma unroll
                for (int bj = 0; bj < 2; ++bj) { const u32x4 b = bs[ai][m][bj]; const unsigned bw[4] = {b.x, b.y, b.z, b.w}; float v[8];
#pragma unroll
                    for (int e = 0; e < 4; ++e) { v[2 * e] = __builtin_bit_cast(float, bw[e] << 16) + scale * acc[ai][bj][m][e >> 1][(2 * e) & 3]; v[2 * e + 1] = __builtin_bit_cast(float, bw[e] & 0xffff0000u) + scale * acc[ai][bj][m][e >> 1][(2 * e + 1) & 3]; }
                    u32x4 wv; wv.x = cvt_pk_bf16(v[0], v[1]); wv.y = cvt_pk_bf16(v[2], v[3]); wv.z = cvt_pk_bf16(v[4], v[5]); wv.w = cvt_pk_bf16(v[6], v[7]); *(PG8_GAS u32x4*)(hb + off + bj * HALF) = wv;
                    const unsigned ww[4] = {wv.x, wv.y, wv.z, wv.w};
#pragma unroll
                    for (int e = 0; e < 4; ++e) { const float lo = __builtin_bit_cast(float, ww[e] << 16), hi2 = __builtin_bit_cast(float, ww[e] & 0xffff0000u); ss += lo * lo + hi2 * hi2; } }
                ss += shx<16>(ss); ss += shx<32>(ss);
                if (fq == 0) ssq[(size_t)(row0 + ai * HALF + m * 16) * 32 + u.pn * 4 + wc] = ss; }
    }
};
struct EpiInProj {
    static constexpr bool PERM = true, AFTER_DRAIN = false, MID = false; static constexpr int ID = 2;
    int ll, slot; float qscale;
    __device__ __forceinline__ void operator()(const f32x4 (&acc)[2][2][4][2], const Unit& u, int wr, int wc, int fr, int fq) const {
        PG8_GAS unsigned char* w = (PG8_GAS unsigned char*)tab_ptr(22); const PG8_GAS float* ssq = (const PG8_GAS float*)(w + WS_SSQ) + (size_t)slot * M_REAL * 32;
        PG8_GAS bf16_t *fq_ = (PG8_GAS bf16_t*)(w + WS_FQ), *fk_ = (PG8_GAS bf16_t*)(w + WS_FK), *fv_ = (PG8_GAS bf16_t*)(w + WS_FV), *sq_ = (PG8_GAS bf16_t*)(w + WS_SQ), *sk_ = (PG8_GAS bf16_t*)(w + WS_SK), *sv_ = (PG8_GAS bf16_t*)(w + WS_SV); PG8_GAS float* logf = (PG8_GAS float*)(w + WS_LOGF);
        const PG8_GAS float *g_fq = (const PG8_GAS float*)tab_ptr(9) + ll * HD, *g_fk = (const PG8_GAS float*)tab_ptr(10) + ll * HD, *g_sq = (const PG8_GAS float*)tab_ptr(11) + ll * HD, *g_sk = (const PG8_GAS float*)tab_ptr(12) + ll * HD, *bfg = (const PG8_GAS float*)tab_ptr(8) + ll * NH;
        const int row0 = u.pm * BM + wr * 64 + fr, pn = u.pn;
        if (pn == 17 && wc != 0) return;
        const PG8_LAS float* rv = ensure_rstd(ssq, slot, u.pm, wr * 4 + wc, wr, fr + 16 * fq);
        float rs[2][4];
#pragma unroll
        for (int ai = 0; ai < 2; ++ai)
#pragma unroll
            for (int m = 0; m < 4; ++m) rs[ai][m] = rv[64 * ai + 16 * m + fr];
        if (pn == 17) {
            if (wc != 0) return;
            if (fq < 2) {
                const f32x4 b0 = *(const PG8_GAS f32x4*)(bfg + 8 * fq), b1 = *(const PG8_GAS f32x4*)(bfg + 8 * fq + 4);
#pragma unroll
                for (int ai = 0; ai < 2; ++ai)
#pragma unroll
                    for (int m = 0; m < 4; ++m) { PG8_GAS float* rowp = logf + (size_t)(row0 + ai * HALF + m * 16) * 16 + 8 * fq;
#pragma unroll
                        for (int n = 0; n < 2; ++n) { f32x4 t = acc[ai][0][m][n] * rs[ai][m] + (n ? b1 : b0), o;
#pragma unroll
                            for (int j = 0; j < 4; ++j) o[j] = fminf(t[j], 0.f) - 0.69314718056f * __builtin_amdgcn_logf(1.0f + __builtin_amdgcn_exp2f(-1.4426950408889634f * fabsf(t[j])));
                            *(PG8_GAS f32x4*)(rowp + 4 * n) = o; } }
            }
            return;
        }
        PG8_GAS bf16_t* dst; int pitch, head, knh = 0; const PG8_GAS float* gain = nullptr; float sc = 1.f;
        if (pn < 16) { const int seg = pn >> 2; head = (pn & 3) * 4 + wc; pitch = 1024;
            if (seg == 0) { dst = fq_; gain = g_fq; sc = qscale; } else if (seg == 1) { dst = fk_; gain = g_fk; knh = 16; } else if (seg == 2) { dst = fv_; } else { dst = sq_; gain = g_sq; sc = qscale; } }
        else { pitch = 128; head = wc & 1; if (wc < 2) { dst = sk_; gain = g_sk; knh = 2; } else { dst = sv_; } }
        const int col0 = head * 64 + 8 * fq;
        if (gain) {
            f32x4 gv[2][2];
#pragma unroll
            for (int bj = 0; bj < 2; ++bj)
#pragma unroll
                for (int n = 0; n < 2; ++n) gv[bj][n] = *(const PG8_GAS f32x4*)(gain + 32 * bj + 8 * fq + 4 * n) * sc;
#pragma unroll
            for (int ai = 0; ai < 2; ++ai)
#pragma unroll
                for (int m = 0; m < 4; ++m) {
                    float ss = 0.f;
#pragma unroll
                    for (int bj = 0; bj < 2; ++bj)
#pragma unroll
                        for (int n = 0; n < 2; ++n) { const f32x4 x = acc[ai][bj][m][n]; ss += (x[0] * x[0] + x[1] * x[1]) + (x[2] * x[2] + x[3] * x[3]); }
                    ss += shx<16>(ss); ss += shx<32>(ss);
                    const float rinv = rs[ai][m] / sqrtf(ss * (1.0f / 64.0f) * rs[ai][m] * rs[ai][m] + 1e-6f);
                    const int row = row0 + ai * HALF + m * 16;
                    PG8_GAS bf16_t* rowp = dst + (size_t)row * pitch + col0;
#pragma unroll
                    for (int bj = 0; bj < 2; ++bj) { const f32x4 v0 = acc[ai][bj][m][0] * rinv * gv[bj][0], v1 = acc[ai][bj][m][1] * rinv * gv[bj][1];
                        u32x4 w; w.x = cvt_pk_bf16(v0[0], v0[1]); w.y = cvt_pk_bf16(v0[2], v0[3]); w.z = cvt_pk_bf16(v1[0], v1[1]); w.w = cvt_pk_bf16(v1[2], v1[3]);
                        if (knh) *(PG8_GAS u32x4*)(dst + kfrag_idx(row, knh, head, 32 * bj + 8 * fq)) = w;
                        else *(PG8_GAS u32x4*)(rowp + 32 * bj) = w; }
                }
        } else {
#pragma unroll
            for (int ai = 0; ai < 2; ++ai)
#pragma unroll
                for (int m = 0; m < 4; ++m) { const int row = row0 + ai * HALF + m * 16; const int vnh = (pn < 16) ? 16 : 2;
#pragma unroll
                    for (int bj = 0; bj < 2; ++bj) { const f32x4 v0 = acc[ai][bj][m][0] * rs[ai][m], v1 = acc[ai][bj][m][1] * rs[ai][m];
                        const unsigned wv[4] = {cvt_pk_bf16(v0[0], v0[1]), cvt_pk_bf16(v0[2], v0[3]), cvt_pk_bf16(v1[0], v1[1]), cvt_pk_bf16(v1[2], v1[3])};
                        PG8_GAS bf16_t* vp = dst + vfrag_idx(row, vnh, head, 32 * bj + 8 * fq);
#pragma unroll
                        for (int e = 0; e < 4; ++e) { vp[16 * e] = (bf16_t)(wv[e] & 0xffffu); vp[16 * e + 8] = (bf16_t)(wv[e] >> 16); } } }
        }
    }
};

}

#define XB_TMO      128
#define XB_XCNT(j)  (256  + 64 * (j))
#define XB_XSUB(j)  (1280 + 64 * (j))
#define XB_XGEN(j)  (2304 + 64 * (j))
#define XB_TOP      3328
#define XB_TOPGEN   3392
#define XCD_BAR_WORDS 3456
#define XB_SPIN_CAP (1u << 18)
__device__ __forceinline__ unsigned xb_ld(unsigned* p)              { return __hip_atomic_load(p, __ATOMIC_RELAXED, __HIP_MEMORY_SCOPE_AGENT); }
__device__ __forceinline__ unsigned xb_add(unsigned* p, unsigned v) { return __hip_atomic_fetch_add(p, v, __ATOMIC_RELAXED, __HIP_MEMORY_SCOPE_AGENT); }
__device__ __forceinline__ unsigned xb_xcc_id() { return (unsigned)__builtin_amdgcn_s_getreg((3 << 11) | 20) & 0xFu; }
#define XB_SPIN(cond, bar) do { unsigned _sp = 0; while (cond) { __builtin_amdgcn_s_sleep(1); \
    if ((++_sp & 255u) == 0u) { if (xb_ld(&(bar)[XB_TMO])) break; if (_sp > XB_SPIN_CAP) { atomicAdd(&(bar)[XB_TMO], 1u); break; } } } } while (0)
struct XcdBarrier { unsigned* bar; unsigned x; volatile LAS unsigned* st; };
__device__ __forceinline__ XcdBarrier xcd_barrier_post(unsigned* bar, volatile LAS unsigned* st) {
    XcdBarrier b; b.bar = bar; b.x = xb_xcc_id(); b.st = st;
    if (threadIdx.x == 0) (void)xb_add(&bar[XB_XCNT(b.x)], 1u);
    return b;
}
__device__ __forceinline__ void xcd_barrier_complete(unsigned* bar, unsigned x, unsigned& nloc, unsigned& nx) {
    const unsigned G = gridDim.x * gridDim.y * gridDim.z;
    unsigned sum, cnt, mine, sp = 0u;
    for (;;) {
        sum = 0u; cnt = 0u; mine = 0u;
#pragma unroll
        for (unsigned j = 0; j < 16; ++j) { const unsigned c = xb_ld(&bar[XB_XCNT(j)]); sum += c; cnt += (c > 0u) ? 1u : 0u; mine = (j == x) ? c : mine; }
        if (sum == G) break;
        __builtin_amdgcn_s_sleep(1);
        if ((++sp & 255u) == 0u) { if (xb_ld(&bar[XB_TMO])) break; if (sp > XB_SPIN_CAP) { atomicAdd(&bar[XB_TMO], 1u); break; } }
    }
    nloc = mine > 0u ? mine : 1u; nx = cnt > 0u ? cnt : 1u;
}
__device__ __forceinline__ void xcd_barrier(const XcdBarrier& b) {
    asm volatile("s_waitcnt vmcnt(0)" ::: "memory");
    __syncthreads();
    if (my_tid() == 0) {
        unsigned* bar = b.bar;
        __builtin_amdgcn_s_waitcnt(0);
        unsigned nloc = b.st[0], nx = b.st[1];
        if (nloc == 0u) { xcd_barrier_complete(bar, b.x, nloc, nx); b.st[0] = nloc; b.st[1] = nx; }
        const unsigned old = xb_add(&bar[XB_XSUB(b.x)], 1u);
        const unsigned gen = old / nloc;
        if (old + 1u == (gen + 1u) * nloc) {
            __builtin_amdgcn_fence(__ATOMIC_RELEASE, "agent");
            asm volatile("s_waitcnt vmcnt(0)" ::: "memory");
            const unsigned og = xb_add(&bar[XB_TOP], 1u);
            const unsigned tg = og / nx;
            if (og + 1u == (tg + 1u) * nx) xb_add(&bar[XB_TOPGEN], 1u);
            else XB_SPIN(xb_ld(&bar[XB_TOPGEN]) == tg, bar);
            __builtin_amdgcn_fence(__ATOMIC_ACQUIRE, "agent");
            xb_add(&bar[XB_XGEN(b.x)], 1u);
            asm volatile("s_waitcnt vmcnt(0)" ::: "memory");
        } else {
            XB_SPIN(xb_ld(&bar[XB_XGEN(b.x)]) == gen, bar);
            __builtin_amdgcn_fence(__ATOMIC_ACQUIRE, "agent");
            asm volatile("s_waitcnt vmcnt(0)" ::: "memory");
        }
    }
    __syncthreads();
}

struct Frame {
    LAS unsigned char* lds;
    volatile LAS unsigned* MISC;
    int tid, lane, wave;
    int vcu, G;
    unsigned char* ws;
};
__device__ __forceinline__ int launder_u(int x) { asm volatile("" : "+v"(x)); return __builtin_amdgcn_readfirstlane(x); }
#define LAUNDER_S(x) ((x) = launder_u(x))
__device__ __forceinline__ const float* inptr(const Frame& F, int k) {
    const volatile LAS unsigned* t = (const volatile LAS unsigned*)(F.lds + PTR_OFF);
    const unsigned lo = __builtin_amdgcn_readfirstlane(t[2 * k]), hi = __builtin_amdgcn_readfirstlane(t[2 * k + 1]);
    return (const float*)(((unsigned long long)hi << 32) | lo);
}
__device__ __forceinline__ unsigned char* wsl(const Frame& F) { const unsigned long long p = (unsigned long long)F.ws; const unsigned lo = (unsigned)launder_u((int)(unsigned)p), hi = (unsigned)launder_u((int)(unsigned)(p >> 32)); return (unsigned char*)(((unsigned long long)hi << 32) | lo); }
__device__ __forceinline__ Frame make_frame() {
    extern __shared__ __attribute__((aligned(16))) unsigned char lds_dyn_[];
    Frame F;
    F.lds = (LAS unsigned char*)lds_dyn_;
    F.MISC = (volatile LAS unsigned*)(F.lds + MISC_OFF);
    int t = my_tid(); asm volatile("" : "+v"(t));
    F.tid = t; F.lane = t & 63; F.wave = __builtin_amdgcn_readfirstlane(t >> 6);
    const int g = launder_u((int)gridDim.x), bx = launder_u((int)blockIdx.x);
    F.G = g; F.vcu = (g % 8 == 0) ? (bx % 8) * (g / 8) + bx / 8 : bx;
    F.ws = (unsigned char*)pg8::tab_ptr(22);
    return F;
}
__device__ __forceinline__ float wave_sum(float v) {
    XSUM64(v);
    return v;
}

constexpr int TP_PITCH = 144;
__device__ __forceinline__ void transpose_item64(const float* Wf, int Nsrc, int ca, int nva, int cb, int nvb, int K, bf16* WTf, int drow0, int k0, LAS unsigned char* scr, int lane, const float* gainf = nullptr) {
    const GAS float* W = (const GAS float*)Wf; GAS bf16* WT = (GAS bf16*)WTf;
    const int sub = (lane >> 3) & 1, c4 = 4 * (lane & 7), g = lane >> 4, nl = 32 * sub + c4;
    const bool ok = c4 < (sub ? nvb : nva);
    const GAS float* src = W + (size_t)(k0 + 2 * g) * Nsrc + (sub ? cb : ca) + c4;
    f32x4 v[16];
#pragma unroll
    for (int i = 0; i < 16; ++i) v[i] = ok ? *(const GAS f32x4*)(src + (size_t)(8 * (i >> 1) + (i & 1)) * Nsrc) : (f32x4){0.f, 0.f, 0.f, 0.f};
    if (gainf) { const GAS float* gp = (const GAS float*)gainf + k0 + 2 * g;
#pragma unroll
        for (int i = 0; i < 16; ++i) v[i] = v[i] * gp[8 * (i >> 1) + (i & 1)]; }
#pragma unroll
    for (int m = 0; m < 8; ++m)
#pragma unroll
        for (int j = 0; j < 4; ++j) *(LAS unsigned*)(scr + (nl + j) * TP_PITCH + (8 * m + 2 * g) * 2) = pk2(v[2 * m][j], v[2 * m + 1][j]);
    LDS_WAIT(); asm volatile("" ::: "memory");
#pragma unroll
    for (int t = 0; t < 8; ++t) { const int id = lane + 64 * t, n = id >> 3, c = id & 7;
        const v4u o = *(const LAS v4u*)(scr + n * TP_PITCH + 16 * c);
        *(GAS v4u*)(WT + (size_t)(drow0 + n) * K + k0 + 8 * c) = o; }
    LDS_WAIT(); asm volatile("" ::: "memory");
}
constexpr int IT_GU = (D / 64) * (N_GU / 64), IT_D = (FF / 64) * (D / 64), IT_IN = (D / 64) * (N_IN / 64), IT_OUT = (D / 64) * (D / 64);
constexpr int IT_LAYER = 2 * IT_GU + 2 * IT_D + IT_IN + IT_OUT;
__device__ __forceinline__ void conv_gu(const float* Wg, const float* Wu, bf16* WT, int r, LAS unsigned char* scr, int lane, const float* gain) {
    constexpr int nrg = N_GU / 64; const int kb = r / nrg, rg = r % nrg, p = rg >> 2, q = rg & 3; const int c0 = 128 * p + 64 * (q & 1);
    transpose_item64(q < 2 ? Wg : Wu, FF, c0, 32, c0 + 32, 32, D, WT, 64 * rg, 64 * kb, scr, lane, gain);
}
__device__ __forceinline__ void conv_plain(const float* W, int K, int N, bf16* WT, int r, LAS unsigned char* scr, int lane, const float* gain_lo = nullptr, const float* gain_hi = nullptr) {
    const int nrg = N / 64, kb = r / nrg, rg = r % nrg;
    const float* gain = gain_lo ? (64 * kb < 1024 ? gain_lo : gain_hi - 1024) : nullptr;
    transpose_item64(W, N, 64 * rg, 32, 64 * rg + 32, 32, K, WT, 64 * rg, 64 * kb, scr, lane, gain);
}
__device__ __forceinline__ int in_src_col(int pn, int wc, int bj) {
    if (pn < 16) { const int seg = pn >> 2, base = seg == 0 ? 0 : seg == 1 ? 1024 : seg == 2 ? 2048 : 3088; return base + 256 * (pn & 3) + 64 * wc + 32 * bj; }
    return (wc < 2 ? 4112 + 64 * wc : 4240 + 64 * (wc - 2)) + 32 * bj;
}
__device__ __forceinline__ void conv_in(const float* W, bf16* WT, int r, LAS unsigned char* scr, int lane, const float* gain) {
    constexpr int nrg = N_IN / 64; const int kb = r / nrg, rg = r % nrg, pn = rg >> 2, q = rg & 3, bj = q >> 1, wc0 = 2 * (q & 1);
    int ca, cb, nva = 32, nvb = 32;
    if (pn < 17) { ca = in_src_col(pn, wc0, bj); cb = in_src_col(pn, wc0 + 1, bj); }
    else { ca = 3072; cb = 3072; nva = (q == 0) ? 16 : 0; nvb = 0; }
    transpose_item64(W, IN_W, ca, nva, cb, nvb, D, WT, 64 * rg, 64 * kb, scr, lane, gain);
}
__device__ __forceinline__ void convert_item(Frame& F, unsigned char* w, int l, int r, LAS unsigned char* scr) {
    unsigned char* wl = w + WS_W + (size_t)l * LW_STRIDE;
    if (r < IT_GU) { conv_gu(inptr(F, 3) + (size_t)l * D * FF, inptr(F, 4) + (size_t)l * D * FF, (bf16*)(wl + LW_GU1), r, scr, F.lane, inptr(F, 2) + (size_t)l * D); return; } r -= IT_GU;
    if (r < IT_D) { conv_plain(inptr(F, 5) + (size_t)l * FF * D, FF, D, (bf16*)(wl + LW_D1), r, scr, F.lane); return; } r -= IT_D;
    if (r < IT_IN) { conv_in(inptr(F, 7) + (size_t)l * D * IN_W, (bf16*)(wl + LW_IN), r, scr, F.lane, inptr(F, 6) + (size_t)l * D); return; } r -= IT_IN;
    if (r < IT_OUT) { conv_plain(inptr(F, 16) + (size_t)l * D * D, D, D, (bf16*)(wl + LW_OUT), r, scr, F.lane, inptr(F, 14) + (size_t)l * 1024, inptr(F, 15) + (size_t)l * 1024); return; } r -= IT_OUT;
    if (r < IT_GU) { conv_gu(inptr(F, 18) + (size_t)l * D * FF, inptr(F, 19) + (size_t)l * D * FF, (bf16*)(wl + LW_GU2), r, scr, F.lane, inptr(F, 17) + (size_t)l * D); return; } r -= IT_GU;
    conv_plain(inptr(F, 20) + (size_t)l * FF * D, FF, D, (bf16*)(wl + LW_D2), r, scr, F.lane);
}
#define IDLE_CONV_K 4
constexpr int R_IDLE = IDLE_CONV_K * 128 * NWAVES, GU2_BASE = IT_GU + IT_D + IT_IN + IT_OUT;
static_assert(R_IDLE <= IT_GU, "idle-slot items are SwiGLU-2 items");
__device__ __forceinline__ void convert_layer(Frame& F, unsigned char* w, int l) {
    LAS unsigned char* scr = F.lds + RING_OFF + F.wave * 16384;
    const int gw = F.vcu * NWAVES + F.wave, NGW = F.G * NWAVES;
    if (F.G == 256) { for (int q = gw; q < IT_LAYER - R_IDLE; q += NGW) convert_item(F, w, l, q < GU2_BASE ? q : q + R_IDLE, scr); }
    else for (int r = gw; r < IT_LAYER; r += NGW) convert_item(F, w, l, r, scr);
}
__device__ __forceinline__ void p0_prologue(Frame& F) {
    const int gw = F.vcu * NWAVES + F.wave, NGW = F.G * NWAVES;
    unsigned char* w = wsl(F);
    for (int l = 0; l < (OVERLAP_CONV ? 1 : DEPTH); ++l) convert_layer(F, w, l);
    const GAS float* x = (const GAS float*)inptr(F, 0); const GAS float* meta = (const GAS float*)inptr(F, 1);
    GAS bf16* HB = (GAS bf16*)(w + WS_HB); GAS float* SSQ0 = (GAS float*)(w + WS_SSQ); GAS float* SSQM0 = (GAS float*)(w + WS_SSQM);
    for (int m = gw; m < M_REAL + NMETA; m += NGW) {
        const int row = m < M_REAL ? m : META_ROW + (m - M_REAL);
        GAS unsigned long long* hb8 = (GAS unsigned long long*)(HB + (size_t)row * D) + F.lane;
        const GAS f32x4* xr = (const GAS f32x4*)(m < M_REAL ? x + (size_t)m * D : meta + (size_t)(m - M_REAL) * D) + F.lane;
        float ss = 0.f;
#pragma unroll
        for (int j = 0; j < 8; ++j) { const f32x4 v = xr[64 * j]; const unsigned w0 = pk2(v.x, v.y), w1 = pk2(v.z, v.w); hb8[64 * j] = (unsigned long long)w0 | ((unsigned long long)w1 << 32);
            const float a0 = __builtin_bit_cast(float, w0 << 16), a1 = __builtin_bit_cast(float, w0 & 0xffff0000u), a2 = __builtin_bit_cast(float, w1 << 16), a3 = __builtin_bit_cast(float, w1 & 0xffff0000u);
            ss += (a0 * a0 + a1 * a1) + (a2 * a2 + a3 * a3); }
        ss = wave_sum(ss);
        if (m < M_REAL) { if (F.lane < 32) SSQ0[(size_t)m * 32 + F.lane] = F.lane == 0 ? ss : 0.f; }
        else { SSQM0[(m - M_REAL) * 128 + F.lane] = F.lane == 0 ? ss : 0.f; SSQM0[(m - M_REAL) * 128 + 64 + F.lane] = 0.f; }
    }
    if (gw < 48) { const int row = META_BLK0 + 64 + gw; const v4u z = (v4u){0u, 0u, 0u, 0u};
#pragma unroll
        for (int j = 0; j < 2; ++j) { ((GAS v4u*)(w + WS_FQ + (size_t)row * 2048))[F.lane + 64 * j] = z;
            ((GAS v4u*)(w + WS_SQ + (size_t)row * 2048))[F.lane + 64 * j] = z; } }
    {
        const v4u z = (v4u){0u, 0u, 0u, 0u}; constexpr int RB = (META_BLK0 + 64) >> 5;
        GAS v4u* fk = (GAS v4u*)((GAS bf16*)(w + WS_FK) + (size_t)RB * 16 * 2048); GAS v4u* sk = (GAS v4u*)((GAS bf16*)(w + WS_SK) + (size_t)RB * 2 * 2048);
        for (int i = gw * 64 + F.lane; i < 2 * 16 * 256; i += NGW * 64) fk[i] = z;
        for (int i = gw * 64 + F.lane; i < 2 * 2 * 256; i += NGW * 64) sk[i] = z;
        constexpr int G16 = (META_BLK0 + 64) >> 4;
        GAS v4u* fv = (GAS v4u*)((GAS bf16*)(w + WS_FV) + (size_t)G16 * 16 * 1024); GAS v4u* sv = (GAS v4u*)((GAS bf16*)(w + WS_SV) + (size_t)G16 * 2 * 1024);
        for (int i = gw * 64 + F.lane; i < 4 * 16 * 128; i += NGW * 64) fv[i] = z;
        for (int i = gw * 64 + F.lane; i < 4 * 2 * 128; i += NGW * 64) sv[i] = z; }
}
__device__ __forceinline__ void onorm_phase(Frame& F, const float* gf, const float* gs) {
    const int gw = F.vcu * NWAVES + F.wave, NGW = F.G * NWAVES;
    unsigned char* w = wsl(F); const GAS bf16* O = (const GAS bf16*)(w + WS_O); GAS bf16* XN = (GAS bf16*)(w + WS_XN);
    for (int mm = gw; mm < M_REAL + NMETA; mm += NGW) {
        const int m = mm < M_REAL ? mm : META_ROW + (mm - M_REAL);
        const GAS v4u* orow = (const GAS v4u*)(O + (size_t)m * D) + F.lane;
        GAS v4u* xrow = (GAS v4u*)(XN + (size_t)m * D) + F.lane;
        float x[4][8]; float sf = 0.f, ss = 0.f;
#pragma unroll
        for (int j = 0; j < 4; ++j) { const v4u w = orow[64 * j]; const unsigned ww[4] = {w.x, w.y, w.z, w.w};
#pragma unroll
            for (int e = 0; e < 4; ++e) { x[j][2 * e] = __builtin_bit_cast(float, ww[e] << 16); x[j][2 * e + 1] = __builtin_bit_cast(float, ww[e] & 0xffff0000u); }
            float q = 0.f;
#pragma unroll
            for (int e = 0; e < 8; ++e) q += x[j][e] * x[j][e];
            if (j < 2) sf += q; else ss += q; }
        const float rf = 1.0f / sqrtf(wave_sum(sf) * (1.0f / 1024.f) + EPS), rs = 1.0f / sqrtf(wave_sum(ss) * (1.0f / 1024.f) + EPS);
#pragma unroll
        for (int j = 0; j < 4; ++j) { const float* gp = (j < 2 ? gf : gs) + (j & 1) * 512 + 8 * F.lane; const f32x4 g0 = *(const GAS f32x4*)gp, g1 = *(const GAS f32x4*)(gp + 4); const float r = j < 2 ? rf : rs;
            v4u w; w.x = pk2(x[j][0] * r * g0.x, x[j][1] * r * g0.y); w.y = pk2(x[j][2] * r * g0.z, x[j][3] * r * g0.w); w.z = pk2(x[j][4] * r * g1.x, x[j][5] * r * g1.y); w.w = pk2(x[j][6] * r * g1.z, x[j][7] * r * g1.w);
            xrow[64 * j] = w; }
    }
}

constexpr int SK_RED_OFF = 0, SK_TILE_OFF = 65536, SK_RSTD_OFF = SK_TILE_OFF + 4096;
template <class Epi, int NST  >
__device__ __forceinline__ void skinny_phase(Frame& F, const GAS bf16* A, int lda, const GAS bf16* Bt, int K, const Epi& E) {
    constexpr int TC = Epi::TC;
    int lane = F.lane; asm volatile("" : "+v"(lane));
    const int w = F.wave;
    LAS float* red = (LAS float*)(F.lds + RING_OFF + SK_RED_OFF);
    LAS float* tile = (LAS float*)(F.lds + RING_OFF + SK_TILE_OFF);
    const int k0 = w * (NST * 32);
    bool first = true;
    for (int task = F.G - 1 - (int)blockIdx.x; task < E.ntasks(); task += F.G) {
        pg8::f32x4 acc[TC];
        const GAS bf16* bp[TC];
#pragma unroll
        for (int c = 0; c < TC; ++c) { acc[c] = (pg8::f32x4){0.f, 0.f, 0.f, 0.f}; bp[c] = Bt + (size_t)(E.btrow(task, c) + (lane & 15)) * K + k0 + 8 * (lane >> 4); }
        const GAS bf16* ap = A + (size_t)(lane & 15) * lda + k0 + 8 * (lane >> 4);
        bf16x8 av[NST], bv[TC][NST];
#pragma unroll
        for (int j = 0; j < NST; ++j) { av[j] = *(const GAS bf16x8*)(ap + 32 * j);
#pragma unroll
            for (int c = 0; c < TC; ++c) bv[c][j] = *(const GAS bf16x8*)(bp[c] + 32 * j); }
        if (first) {
            if constexpr (Epi::KHALF_SCALE) {
                LAS float* rv = (LAS float*)(F.lds + RING_OFF + SK_RSTD_OFF);
#pragma unroll
                for (int j = 0; j < 2; ++j) { const int row = 2 * w + j; float t = lane < 32 ? E.ssqom[row * 32 + lane] : 0.f;
                    XSUM16(t);
                    if (lane == 0) rv[row] = 1.0f / sqrtf(t * (1.0f / 1024.0f) + EPS); if (lane == 16) rv[16 + row] = 1.0f / sqrtf(t * (1.0f / 1024.0f) + EPS); }
            }
            if constexpr (Epi::NEED_RSTD) {
                LAS float* rv = (LAS float*)(F.lds + RING_OFF + SK_RSTD_OFF);
#pragma unroll
                for (int j = 0; j < 2; ++j) { const int row = 2 * w + j; const float t = wave_sum(E.ssqm[row * 128 + lane] + E.ssqm[row * 128 + 64 + lane]); if (lane == 0) rv[row] = 1.0f / sqrtf(t * (1.0f / D) + EPS); }
            }
            first = false;
        }
#pragma unroll
        for (int j = 0; j < NST; ++j)
#pragma unroll
            for (int c = 0; c < TC; ++c) acc[c] = __builtin_amdgcn_mfma_f32_16x16x32_bf16(av[j], bv[c][j], acc[c], 0, 0, 0);
#pragma unroll
        for (int c = 0; c < TC; ++c)
#pragma unroll
            for (int r = 0; r < 4; ++r) red[((w * TC + c) * 4 + r) * 64 + lane] = acc[c][r];
        __syncthreads();
        for (int e = F.tid; e < TC * 256; e += NWAVES * 64) { float sum = 0.f, sum2 = 0.f;
#pragma unroll
            for (int w2 = 0; w2 < 4; ++w2) { sum += red[w2 * TC * 256 + e]; sum2 += red[(w2 + 4) * TC * 256 + e]; }
            const int ln = e & 63, r = (e >> 6) & 3, c = e >> 8, orow = (ln >> 4) * 4 + r;
            if constexpr (Epi::KHALF_SCALE) { const LAS float* rv = (const LAS float*)(F.lds + RING_OFF + SK_RSTD_OFF); sum = sum * rv[orow] + sum2 * rv[16 + orow]; } else sum += sum2;
            tile[orow * 64 + 16 * c + (ln & 15)] = sum; }
        __syncthreads();
        E.store(F, task, tile);
        if (task + F.G < E.ntasks()) __syncthreads();
    }
}
struct SkGU {
    static constexpr int TC = 4; static constexpr bool NEED_RSTD = true, KHALF_SCALE = false;
    GAS bf16* act; const GAS float* ssqm;
    __device__ __forceinline__ int ntasks() const { return FF / 32; }
    __device__ __forceinline__ int btrow(int t, int c) const { const int p = t >> 2, q = t & 3; return 256 * p + 128 * (c >> 1) + 32 * q + 16 * (c & 1); }
    __device__ __forceinline__ void store(Frame& F, int t, const LAS float* tile) const {
        const int row = F.tid >> 5, col = F.tid & 31; const float r = ((const LAS float*)(F.lds + RING_OFF + SK_RSTD_OFF))[row];
        act[(size_t)(META_ROW + row) * FF + 32 * t + col] = (bf16)f2bf(pg8::silu_mul(tile[row * 64 + col] * r, tile[row * 64 + 32 + col] * r));
    }
};
struct SkRes {
    static constexpr int TC = 1; static constexpr bool NEED_RSTD = false, KHALF_SCALE = false;
    float scale; GAS bf16* hb; GAS float* ssqm;
    __device__ __forceinline__ int ntasks() const { return D / 16; }
    __device__ __forceinline__ int btrow(int t, int) const { return 16 * t; }
    __device__ __forceinline__ void store(Frame& F, int t, const LAS float* tile) const {
        if (F.tid < 256) { const int row = F.tid >> 4, col = F.tid & 15; const size_t off = (size_t)(META_ROW + row) * D + 16 * t + col;
            const unsigned hbits = f2bf(bf2f(hb[off]) + scale * tile[row * 64 + col]); hb[off] = (bf16)hbits; const float v = bf2f((bf16)hbits); float ss = v * v;
            XSUM16(ss);
            if (col == 0) ssqm[row * 128 + t] = ss; }
    }
};
struct SkOut {
    static constexpr int TC = 1; static constexpr bool NEED_RSTD = false, KHALF_SCALE = true;
    float scale; GAS bf16* hb; GAS float* ssqm; const GAS float* ssqom;
    __device__ __forceinline__ int ntasks() const { return D / 16; }
    __device__ __forceinline__ int btrow(int t, int) const { return 16 * t; }
    __device__ __forceinline__ void store(Frame& F, int t, const LAS float* tile) const {
        if (F.tid < 256) { const int row = F.tid >> 4, col = F.tid & 15; const size_t off = (size_t)(META_ROW + row) * D + 16 * t + col;
            const unsigned hbits = f2bf(bf2f(hb[off]) + scale * tile[row * 64 + col]); hb[off] = (bf16)hbits; const float v = bf2f((bf16)hbits); float ss = v * v;
            XSUM16(ss);
            if (col == 0) ssqm[row * 128 + t] = ss; }
    }
};
struct SkIn {
    static constexpr int TC = 4; static constexpr bool NEED_RSTD = true, KHALF_SCALE = false;
    GAS bf16 *fq_, *fk_, *fv_, *sq_, *sk_, *sv_; GAS float* logf; const GAS float *g_fq, *g_fk, *g_sq, *g_sk, *bfg; float qscale; const GAS float* ssqm;
    __device__ __forceinline__ int ntasks() const { return 69; }
    __device__ __forceinline__ int btrow(int t, int c) const { if (t == 68) return 17 * 256 + 16 * c; const int pn = t < 64 ? (t >> 2) : 16, wc = t < 64 ? (t & 3) : (t - 64); return 256 * pn + 128 * (c >> 1) + 32 * wc + 16 * (c & 1); }
    __device__ __forceinline__ void store(Frame& F, int t, const LAS float* tile) const {
        if (t == 68) { if (F.tid < 256) { const int row = F.tid >> 4, hh = F.tid & 15; const float z = tile[row * 64 + hh] * ((const LAS float*)(F.lds + RING_OFF + SK_RSTD_OFF))[row] + bfg[hh];
                logf[(size_t)(META_ROW + row) * 16 + hh] = fminf(z, 0.f) - 0.69314718056f * __builtin_amdgcn_logf(1.0f + __builtin_amdgcn_exp2f(-LOG2E * fabsf(z))); } return; }
        const int pn = t < 64 ? (t >> 2) : 16, wc = t < 64 ? (t & 3) : (t - 64);
        GAS bf16* dst; int pitch, head, knh = 0; const GAS float* gain = nullptr; float sc = 1.f;
        if (pn < 16) { const int seg = pn >> 2; head = (pn & 3) * 4 + wc; pitch = 1024;
            if (seg == 0) { dst = fq_; gain = g_fq; sc = qscale; } else if (seg == 1) { dst = fk_; gain = g_fk; knh = 16; } else if (seg == 2) { dst = fv_; } else { dst = sq_; gain = g_sq; sc = qscale; } }
        else { pitch = 128; head = wc & 1; if (wc < 2) { dst = sk_; gain = g_sk; knh = 2; } else { dst = sv_; } }
        const int row = F.tid >> 5, cp = F.tid & 31; const float rr = ((const LAS float*)(F.lds + RING_OFF + SK_RSTD_OFF))[row];
        float v0 = tile[row * 64 + 2 * cp] * rr, v1 = tile[row * 64 + 2 * cp + 1] * rr;
        if (gain) { float ss = v0 * v0 + v1 * v1;
            XSUM32(ss);
            const float rinv = 1.0f / sqrtf(ss * (1.0f / 64.0f) + EPS); v0 = v0 * rinv * gain[2 * cp] * sc; v1 = v1 * rinv * gain[2 * cp + 1] * sc; }
        if (knh) *(GAS unsigned*)(dst + kfrag_idx(META_ROW + row, knh, head, 2 * cp)) = pk2(v0, v1);
        else if (!gain) { GAS bf16* vp = dst + vfrag_idx(META_ROW + row, pn < 16 ? 16 : 2, head, 2 * cp); const unsigned pw = pk2(v0, v1); vp[0] = (bf16)(pw & 0xffffu); vp[8] = (bf16)(pw >> 16); }
        else *(GAS unsigned*)(dst + (size_t)(META_ROW + row) * pitch + head * 64 + 2 * cp) = pk2(v0, v1);
    }
};

__device__ __forceinline__ void split3(float x, unsigned& h, unsigned& m, unsigned& l) { h = f2bf(x); const float r = x - bf2f((unsigned short)h); m = f2bf(r); const float r2 = r - bf2f((unsigned short)m); l = f2bf(r2); }
__device__ __forceinline__ int crow(int r, int hi) { return (r & 3) + 8 * (r >> 2) + 4 * hi; }
typedef short v4i16_t __attribute__((ext_vector_type(4)));
__device__ __forceinline__ float max3f(float a, float b, float c) { return fmaxf(fmaxf(a, b), c); }
constexpr float ATT_THR = 40.0f;
constexpr int ATT_KV_OFF = 36864;
template <int MODE>
__device__ __forceinline__ void kv_dma(Frame& F, unsigned char* w, int gb, int kvh, int c, int image) {
    constexpr int NHK = (MODE == 0) ? 16 : 2; const int wv = F.wave, lane = F.lane; const int rowk = (c == 1) ? META_BLK0 + 64 : gb * SEQ + 64 * (c - 2);
    const GAS bf16* kp = (const GAS bf16*)(w + (MODE == 0 ? WS_FK : WS_SK)) + ((size_t)((rowk >> 5) + (wv >> 2)) * NHK + kvh) * 2048 + (wv & 3) * 512 + lane * 8;
    const GAS bf16* vp = (const GAS bf16*)(w + (MODE == 0 ? WS_FV : WS_SV)) + ((size_t)((rowk >> 4) + (wv >> 1)) * NHK + kvh) * 1024 + (wv & 1) * 512 + lane * 8;
    LAS unsigned char* d = F.lds + RING_OFF + ATT_KV_OFF + image * 16384 + wv * 1024;
    __builtin_amdgcn_global_load_lds((const unsigned*)kp, (LAS unsigned*)d, 16, 0, 0); __builtin_amdgcn_global_load_lds((const unsigned*)vp, (LAS unsigned*)(d + 8192), 16, 0, 0);
}
template <int MODE  , int RES = 0>
__device__ __forceinline__ void attn_group(Frame& F, unsigned char* w, int gb, int kvh, int c_lo, int c_hi, bool active, int b  , int h, int i, const float* sinks, int res_c0 = 0) {
    const int lane = F.lane, r32 = lane & 31, hi = lane >> 5, wv = F.wave;
    const bool meta = b < 0;
    const int qpos0 = meta ? 96 : 128 + 32 * i;
    const int qrow0 = meta ? META_BLK0 + 96 : b * SEQ + 32 * i;
    const int cd = qpos0 >> 6;
    const int cfirst = (MODE == 0) ? (meta ? 1 : __builtin_amdgcn_readfirstlane(((const volatile LAS int*)(F.lds + RING_OFF + ATT_FC_OFF))[i])) : ((qpos0 - 127) < 128 ? 1 : ((qpos0 - 127) >> 6));
    constexpr int NHK = (MODE == 0) ? 16 : 2;
    const GAS bf16* Qp = (const GAS bf16*)(w + (MODE == 0 ? WS_FQ : WS_SQ)) + (size_t)qrow0 * 1024 + h * 64;
    const GAS bf16* kdma = (const GAS bf16*)(w + (MODE == 0 ? WS_FK : WS_SK)) + ((size_t)(wv >> 2) * NHK + kvh) * 2048 + (wv & 3) * 512 + lane * 8;
    const GAS bf16* vdma = (const GAS bf16*)(w + (MODE == 0 ? WS_FV : WS_SV)) + ((size_t)(wv >> 1) * NHK + kvh) * 1024 + (wv & 1) * 512 + lane * 8;
    LAS unsigned char* kvb = F.lds + RING_OFF + ATT_KV_OFF;
    const float sl2 = (MODE == 1) ? exp2f(-0.5f * (float)(h + 1)) * LOG2E : 0.f;
    const LAS unsigned char* tfp = F.lds + RING_OFF + (hi ? ATT_ZERO_OFF : ATT_TABF_OFF + r32 * 16); const int toff = hi ? 0 : 1;
    v4u mfr = hi ? (v4u){0u, 0u, 0u, 0u} : (v4u){0x3F803F80u, 0x3F80u, 0u, 0u};
    bf16x8 qf[4];
    if (active) {
#pragma unroll
        for (int s = 0; s < 4; ++s) qf[s] = *(const GAS bf16x8*)(Qp + (size_t)r32 * 1024 + 16 * s + 8 * hi);
    } else {
#pragma unroll
        for (int s = 0; s < 4; ++s) qf[s] = (bf16x8){0, 0, 0, 0, 0, 0, 0, 0};
    }
#define CHUNK_ROW(c) ((c) == 1 ? META_BLK0 + 64 : gb * SEQ + 64 * ((c) - 2))
#define KV_DMA(c_) do { const int rowk_ = CHUNK_ROW(c_); LAS unsigned char* d_ = kvb + ((c_) % 5) * 16384 + wv * 1024; \
        __builtin_amdgcn_global_load_lds((const unsigned*)(kdma + (size_t)(rowk_ >> 5) * (NHK * 2048)), (LAS unsigned*)d_, 16, 0, 0); \
        __builtin_amdgcn_global_load_lds((const unsigned*)(vdma + (size_t)(rowk_ >> 4) * (NHK * 1024)), (LAS unsigned*)(d_ + 8192), 16, 0, 0); } while (0)
    float m_run = 0.f, l_run = 0.f; f32x16 o0 = {}, o1 = {};
    const float NEG = -1e30f;
    const int sh = RES ? 0 : (wv >> 1);
    if (!RES) { __syncthreads();
        for (int cc = c_lo; cc < c_lo + 4; ++cc) if (cc >= 1 && cc <= res_c0) KV_DMA(cc); }
    for (int t = c_lo; t <= c_hi; ++t) {
        if (!RES) { asm volatile("s_waitcnt vmcnt(0) lgkmcnt(0)" ::: "memory"); __builtin_amdgcn_s_barrier(); __builtin_amdgcn_sched_barrier(0);
            const int cn = t + 4; if (cn >= 1 && cn <= res_c0) KV_DMA(cn); }
        const int c = t + sh;
        if (!(active && c >= cfirst && c <= cd)) continue;
        const LAS unsigned char* cb = kvb + (RES ? (c - res_c0) : (c % 5)) * 16384 + hi * 512 + r32 * 16;
        bf16x8 kf[2][4];
#pragma unroll
        for (int t = 0; t < 2; ++t)
#pragma unroll
            for (int s = 0; s < 4; ++s) kf[t][s] = *(const LAS bf16x8*)(cb + t * 4096 + s * 1024);
        f32x16 p0 = {}, p1 = {};
        bf16x8 ab0, ab1;
        if (MODE == 0) { ab0 = *(const LAS bf16x8*)(tfp + toff * (1024 * c)); ab1 = *(const LAS bf16x8*)(tfp + toff * (1024 * c + 512)); }
        __builtin_amdgcn_s_setprio(1);
#pragma unroll
        for (int s = 0; s < 4; ++s) { p0 = __builtin_amdgcn_mfma_f32_32x32x16_bf16(kf[0][s], qf[s], p0, 0, 0, 0); p1 = __builtin_amdgcn_mfma_f32_32x32x16_bf16(kf[1][s], qf[s], p1, 0, 0, 0); }
        if (MODE == 0) { const bf16x8 mb = __builtin_bit_cast(bf16x8, mfr); p0 = __builtin_amdgcn_mfma_f32_32x32x16_bf16(ab0, mb, p0, 0, 0, 0); p1 = __builtin_amdgcn_mfma_f32_32x32x16_bf16(ab1, mb, p1, 0, 0, 0); }
        __builtin_amdgcn_s_setprio(0);
        bf16x8 vf[4][2];
#pragma unroll
        for (int g = 0; g < 4; ++g)
#pragma unroll
            for (int d = 0; d < 2; ++d) vf[g][d] = *(const LAS bf16x8*)(cb + 8192 + g * 2048 + hi * 512 + d * 512);
        if (MODE == 0) {
            if (c == cd) { const int dq = qpos0 + r32 - 64 * c - 4 * hi;
#pragma unroll
                for (int r = 0; r < 16; ++r) { const int e = (r & 3) + 8 * (r >> 2); if (e > dq) p0[r] = NEG; if (e + 32 > dq) p1[r] = NEG; } }
        } else {
            const float kb0 = (float)(64 * c - qpos0 + 4 * hi) - m_run / sl2;
#pragma unroll
            for (int r = 0; r < 16; ++r) { const float e = (float)((r & 3) + 8 * (r >> 2)); p0[r] = fmaf(sl2, kb0 + e, p0[r]); p1[r] = fmaf(sl2, kb0 + 32.f + e, p1[r]); }
            const int dq = qpos0 + r32 - 64 * c - 4 * hi;
            const int padlim = (c == 1) ? 48 - 4 * hi : -1;
            const bool interior = c != 1 && 64 * c + 63 <= qpos0 && 64 * c > qpos0 + 31 - 128;
            if (!interior) {
#pragma unroll
            for (int r = 0; r < 16; ++r) { const int e = (r & 3) + 8 * (r >> 2);
                if ((unsigned)(dq - e) >= 128u || e < padlim) p0[r] = NEG;
                if ((unsigned)(dq - e - 32) >= 128u || e + 32 < padlim) p1[r] = NEG; } }
        }
        float mx = max3f(p0[0], p0[1], p1[0]);
#pragma unroll
        for (int r = 2; r < 16; r += 2) mx = max3f(mx, p0[r], p0[r + 1]);
#pragma unroll
        for (int r = 1; r < 16; r += 2) mx = max3f(mx, p1[r], (r + 1 < 16) ? p1[r + 1] : p1[r]);
        const bool first = (c == cfirst);
        if (first || __any(mx > ATT_THR)) {
            mx = fmaxf(mx, shx<32>(mx));
            const float dl = first ? fmaxf(mx, -200.f) : fmaxf(mx, 0.f);
            m_run += dl;
            if (MODE == 0) { unsigned h_, m_, l_; split3(-m_run, h_, m_, l_); if (!hi) { mfr.y = 0x3F80u | (h_ << 16); mfr.z = m_ | (l_ << 16); } }
            const float alpha = first ? 0.f : __builtin_amdgcn_exp2f(-dl);
            l_run *= alpha;
#pragma unroll
            for (int r = 0; r < 16; ++r) { p0[r] -= dl; p1[r] -= dl; }
            if (!first) {
#pragma unroll
                for (int r = 0; r < 16; ++r) { o0[r] *= alpha; o1[r] *= alpha; } }
        }
        float rs = 0.f;
#pragma unroll
        for (int r = 0; r < 16; ++r) { p0[r] = __builtin_amdgcn_exp2f(p0[r]); p1[r] = __builtin_amdgcn_exp2f(p1[r]); rs += p0[r] + p1[r]; }
        l_run += rs;
#pragma unroll
        for (int t = 0; t < 2; ++t)
#pragma unroll
            for (int s = 0; s < 2; ++s) {
                const f32x16& pp = t ? p1 : p0;
                v4u wq; wq.x = pg8::cvt_pk_bf16(pp[8 * s + 0], pp[8 * s + 1]); wq.y = pg8::cvt_pk_bf16(pp[8 * s + 2], pp[8 * s + 3]); wq.z = pg8::cvt_pk_bf16(pp[8 * s + 4], pp[8 * s + 5]); wq.w = pg8::cvt_pk_bf16(pp[8 * s + 6], pp[8 * s + 7]);
                const bf16x8 pf = __builtin_bit_cast(bf16x8, wq);
                const bf16x8 v0 = vf[2 * t + s][0], v1 = vf[2 * t + s][1];
                o0 = __builtin_amdgcn_mfma_f32_32x32x16_bf16(v0, pf, o0, 0, 0, 0);
                o1 = __builtin_amdgcn_mfma_f32_32x32x16_bf16(v1, pf, o1, 0, 0, 0);
            }
    }
#undef CHUNK_ROW
#undef KV_DMA
    if (!active) return;
    l_run += shx<32>(l_run);
    if (MODE == 1) l_run += __builtin_amdgcn_exp2f(sinks[h] * LOG2E + sl2 * (float)r32 - m_run);
    float inv = 1.0f / l_run;
    const int qrow0e = launder_u(qrow0), he = launder_u(h);
    int lane_e = lane; asm volatile("" : "+v"(lane_e)); const int r32e = lane_e & 31, hie = lane_e >> 5;
    if (meta && r32e < 16) inv = 0.f;
    GAS bf16* Op = (GAS bf16*)(w + WS_O) + (size_t)(qrow0e + r32e) * D + (MODE == 0 ? 0 : 1024) + he * 64 + 4 * hie;
    GAS float* sqo = meta ? (GAS float*)(w + WS_SSQOM) + (MODE == 0 ? 0 : 16) + he : (GAS float*)(w + WS_SSQO) + (size_t)qrow0e * 32 + (MODE == 0 ? 0 : 16) + he;
    float ss = 0.f;
#pragma unroll
    for (int g = 0; g < 4; ++g) {
        unsigned a[4], c[4];
#pragma unroll
        for (int j = 0; j < 4; ++j) { a[j] = f2bf(o0[4 * g + j] * inv); c[j] = f2bf(o1[4 * g + j] * inv);
            const float v0 = bf2f((bf16)a[j]), v1 = bf2f((bf16)c[j]); ss += v0 * v0 + v1 * v1; }
        *(GAS unsigned long long*)(Op + 8 * g) = (unsigned long long)(a[0] | (a[1] << 16)) | ((unsigned long long)(a[2] | (a[3] << 16)) << 32);
        *(GAS unsigned long long*)(Op + 32 + 8 * g) = (unsigned long long)(c[0] | (c[1] << 16)) | ((unsigned long long)(c[2] | (c[3] << 16)) << 32);
    }
    ss += shx<32>(ss);
    if (hie == 0) { if (!meta) sqo[(size_t)r32e * 32] = ss; else if (r32e >= 16) sqo[(size_t)(r32e - 16) * 32] = ss; }
}
__device__ __forceinline__ void probe_t0(LAS unsigned char* lds) { if (PROBE_CLASS > 50 && (PROBE_BLOCK < 0 || (int)blockIdx.x == PROBE_BLOCK) && my_tid() == 0) *(volatile LAS unsigned long long*)(lds + MISC_OFF + 72) = __builtin_amdgcn_s_memrealtime(); }
__device__ __forceinline__ void probe_t1(LAS unsigned char* lds, int c) { if (PROBE_CLASS == c && (PROBE_BLOCK < 0 || (int)blockIdx.x == PROBE_BLOCK) && my_tid() == 0) { volatile LAS unsigned long long* pa_ = (volatile LAS unsigned long long*)(lds + MISC_OFF + 64); *pa_ = *pa_ + (__builtin_amdgcn_s_memrealtime() - *(volatile LAS unsigned long long*)(lds + MISC_OFF + 72)); } }
__device__ __forceinline__ void attn_phase(Frame& F, const float* sinks, int next_layer  , const float* gq, const float* gk) {
    probe_t0(F.lds);
    unsigned char* w = wsl(F); const GAS float* LOGF = (const GAS float*)(w + WS_LOGF);
    const int bh = F.vcu >> 1, fb = bh >> 4, fh = bh & 15;
    LAS float* tab = (LAS float*)(F.lds + RING_OFF + ATT_TAB_OFF);
    LAS float* wtot = (LAS float*)(F.lds + RING_OFF + ATT_WTOT_OFF);
    float x5[5];
#pragma unroll
    for (int j = 0; j < 5; ++j) { const int p = 5 * F.tid + j; x5[j] = 0.f;
        if (p >= PADN && p < LPOS) { const int row = p < 128 ? META_BLK0 + p : fb * SEQ + p - 128; x5[j] = LOGF[(size_t)row * 16 + fh]; } }
    {
      { const int T0 = F.vcu * 4, sb = T0 >> 7, kvh = (T0 >> 6) & 1, i0 = T0 & 63, m = 1 + (i0 >> 2); const int u_lo = (i0 == 0) ? 1 : 2 * m - 2, u_hi = 2 * m + 1;
        for (int c = u_lo; c <= u_hi; ++c) kv_dma<1>(F, w, sb, kvh, c, c - u_lo);
        asm volatile("s_waitcnt vmcnt(0)" ::: "memory"); __syncthreads();
        for (int k = 0; k < 4; ++k) { const int i = i0 + k, qp = 128 + 32 * i;
            attn_group<1, 1>(F, w, sb, kvh, (qp - 127) < 128 ? 1 : ((qp - 127) >> 6), qp >> 6, true, sb, 8 * kvh + F.wave, i, sinks, u_lo); } }
      probe_t1(F.lds, 53); probe_t0(F.lds);
      if (F.vcu < 32 && (F.vcu & 1) == 1) attn_group<1>(F, w, 0, (F.vcu >> 1) >> 3, 1, 1, F.wave == 0, -1, F.vcu >> 1, 0, sinks, 1); }
    probe_t1(F.lds, 54); probe_t0(F.lds);
    { float v[5]; float tsum = 0.f; const int p0 = 5 * F.tid;
#pragma unroll
      for (int j = 0; j < 5; ++j) { tsum += x5[j]; v[j] = tsum; }
      float inc = tsum;
#pragma unroll
      for (int o = 1; o < 64; o <<= 1) { const float t = shi(inc, F.lane - o); if (F.lane >= o) inc += t; }
      if (F.lane == 63) wtot[F.wave] = inc;
      __syncthreads();
      float base = inc - tsum;
      for (int w = 0; w < F.wave; ++w) base += wtot[w];
#pragma unroll
      for (int j = 0; j < 5; ++j) { const int p = p0 + j; if (p < LPOS) { const float cv = (p < PADN) ? 1e30f : (base + v[j]) * LOG2E; tab[p] = cv;
          unsigned h_, m_, l_; split3(fmaxf(-cv, -60000.f), h_, m_, l_);
          LAS unsigned* tf = (LAS unsigned*)(F.lds + RING_OFF + ATT_TABF_OFF + p * 16); unsigned one2 = 0x3F803F80u, zz = 0u; asm volatile("" : "+v"(one2), "+v"(zz));
          tf[0] = h_ | (m_ << 16); tf[1] = l_ | (one2 << 16); tf[2] = one2; tf[3] = zz; } }
      if (F.tid < 4) ((LAS unsigned*)(F.lds + RING_OFF + ATT_ZERO_OFF))[F.tid] = 0u;
      __syncthreads();
      if (F.wave == 0) { float mq = fabsf(((const GAS float*)gq)[F.lane]), mk = fabsf(((const GAS float*)gk)[F.lane]);
#define XMAX_(v, O) v = fmaxf(v, shx<O>(v))
          XMAX_(mq, 1); XMAX_(mq, 2); XMAX_(mq, 4); XMAX_(mq, 8); XMAX_(mq, 16); XMAX_(mq, 32); XMAX_(mk, 1); XMAX_(mk, 2); XMAX_(mk, 4); XMAX_(mk, 8); XMAX_(mk, 16); XMAX_(mk, 32);
#undef XMAX_
          const float thr = -(80.0f + 2.0f * (64.0f * QSCALE * mq * mk * 1.02f + 1.0f));
          const int q0pos = 128 + 32 * F.lane, cdl = q0pos >> 6; const float tq = tab[q0pos];
          int lo = 1, hi = cdl;
#pragma unroll 1
          for (int it = 0; it < 6; ++it) { const int mid = (lo + hi) >> 1; const bool far = (lo < hi) && (tq - tab[64 * mid + 63] < thr); if (lo < hi) { if (far) lo = mid + 1; else hi = mid; } }
          ((LAS int*)(F.lds + RING_OFF + ATT_FC_OFF))[F.lane] = lo; }
      __syncthreads(); }
    probe_t1(F.lds, 51); probe_t0(F.lds);
    {
      const int odd = F.vcu & 1;
      for (int k = 0; k < 4; ++k) { const int g = (k == 0) ? odd : (k == 1) ? 3 - odd : (k == 2) ? 4 + odd : 7 - odd;
          int tl = 1 << 20;
#pragma unroll
          for (int j = 0; j < 8; ++j) tl = min(tl, ((const volatile LAS int*)(F.lds + RING_OFF + ATT_FC_OFF))[8 * g + j] - (j >> 1));
          tl = __builtin_amdgcn_readfirstlane(tl);
          attn_group<0>(F, w, fb, fh, tl, 2 + 4 * g, true, fb, fh, 8 * g + F.wave, sinks, 2 + 4 * g + 3); }
      probe_t1(F.lds, 52); probe_t0(F.lds);
      if (F.vcu < 32 && odd == 0) attn_group<0>(F, w, 0, fh, 1, 1, F.wave == 0, -1, fh, 0, sinks, 1); }
    __syncthreads();
    probe_t1(F.lds, 54);
}

constexpr int PH_PER_LAYER = 7, N_PHASES = 1 + DEPTH * PH_PER_LAYER;
struct Args { const float* in[21]; float* out; unsigned char* ws; int ph_lo, ph_hi, li, pad; };
__global__ void __launch_bounds__(NWAVES * 64, 2) hymba_fwd(Args args) {
    extern __shared__ __attribute__((aligned(16))) unsigned char lds[];
    {
        LAS unsigned char* l0 = (LAS unsigned char*)lds; const int tid = threadIdx.x;
        for (int u = tid; u < (LDS_BYTES - LDSCTL_OFF) / 4; u += NWAVES * 64) ((LAS unsigned*)(l0 + LDSCTL_OFF))[u] = 0u;
        __syncthreads();
        if ((tid & 63) == 0) ((volatile LAS int*)(l0 + WID_OFF))[hw_wave_key()] = tid >> 6;
        volatile LAS unsigned long long* pt = (volatile LAS unsigned long long*)(l0 + PTR_OFF);
#pragma unroll
        for (int k = 0; k < 21; ++k) if (tid == k) pt[k] = (unsigned long long)args.in[k];
        if (tid == 21) pt[21] = (unsigned long long)args.out;
        if (tid == 22) pt[22] = (unsigned long long)args.ws;
        __syncthreads();
#if !MK_PER_PHASE
        (void)xcd_barrier_post((unsigned*)((gu32*)(args.ws + WS_CTL) + CW_BAR), (volatile LAS unsigned*)(l0 + MISC_OFF) + 8);
#endif
    }
    const int lo = args.ph_lo, hi = args.ph_hi;
#define IN(k) (lo <= (k) && (k) < hi)
#define PROBE_T0() if (PROBE_CLASS == 60 && (PROBE_BLOCK < 0 || (int)blockIdx.x == PROBE_BLOCK) && my_tid() == 0) { *(volatile LAS unsigned long long*)((LAS unsigned char*)lds + MISC_OFF + 72) = __builtin_amdgcn_s_memtime(); } else if (PROBE_CLASS >= 0 && (PROBE_BLOCK < 0 || (int)blockIdx.x == PROBE_BLOCK) && my_tid() == 0) { *(volatile LAS unsigned long long*)((LAS unsigned char*)lds + MISC_OFF + 72) = __builtin_amdgcn_s_memrealtime(); }
#define PROBE_T1(c) if (PROBE_CLASS == 60 && (c) == 2 && (PROBE_BLOCK < 0 || (int)blockIdx.x == PROBE_BLOCK) && my_tid() == 0) { volatile LAS unsigned long long* pa_ = (volatile LAS unsigned long long*)((LAS unsigned char*)lds + MISC_OFF + 64); *pa_ = *pa_ + (__builtin_amdgcn_s_memtime() - *(volatile LAS unsigned long long*)((LAS unsigned char*)lds + MISC_OFF + 72)) / 24ull; } else if (PROBE_CLASS == (c) && (PROBE_BLOCK < 0 || (int)blockIdx.x == PROBE_BLOCK) && my_tid() == 0) { volatile LAS unsigned long long* pa_ = (volatile LAS unsigned long long*)((LAS unsigned char*)lds + MISC_OFF + 64); *pa_ = *pa_ + (__builtin_amdgcn_s_memrealtime() - *(volatile LAS unsigned long long*)((LAS unsigned char*)lds + MISC_OFF + 72)); }
#define SEAM(k) do { if (IN(k) && IN((k) + 1)) { PROBE_T0() unsigned char* wsb_ = (unsigned char*)pg8::tab_ptr(22); \
        if (MK_PER_PHASE) { if (my_tid() == 0) __hip_atomic_store((gu32*)(wsb_ + WS_CTL) + CW_TMO, 0xBADBA0u, RLX_AGENT); } \
        else { XcdBarrier bar_; bar_.bar = (unsigned*)((gu32*)(wsb_ + WS_CTL) + CW_BAR); bar_.x = xb_xcc_id(); bar_.st = (volatile LAS unsigned*)((LAS unsigned char*)lds + MISC_OFF) + 8; xcd_barrier(bar_); if (PROBE_CLASS == 50) xcd_barrier(bar_); } PROBE_T1(8) } } while (0)
#define PHASE_BEGIN(k) if (IN(k)) { PROBE_T0() Frame P = make_frame(); \
        unsigned char* w = wsl(P); int ll = l; LAUNDER_S(ll); unsigned char* wl = w + WS_W + (size_t)ll * LW_STRIDE; (void)wl; int bxl = blockIdx.x; LAUNDER_S(bxl);
#define PHASE_END(k, c) PROBE_T1(c) } SEAM(k);
    typedef pg8::StaticOrder SO;
    if (IN(0)) { PROBE_T0() Frame P = make_frame(); p0_prologue(P); PROBE_T1(0) } SEAM(0);
    for (int l = 0; l < DEPTH; ++l) {
        const int pb = 1 + l * PH_PER_LAYER;
#define SSQ(j) ((GAS float*)(w + WS_SSQM) + (size_t)(3 * ll + (j)) * 16 * 128)
#define HBM ((const GAS bf16*)(w + WS_HB) + (size_t)META_ROW * D)
        PHASE_BEGIN(pb + 0) pg8::Gemm g{(const bf16*)(w + WS_HB), (const bf16*)(wl + LW_GU1), M_REAL, N_GU, D}; SO S; S.init(M_REAL, N_GU, P.G, bxl);
            pg8::EpiSwiGLU E{3 * ll + 0}; pg8::gemm_phase<pg8::EpiSwiGLU, SO, true, true>(P.lds + RING_OFF, g, S, E);
            SkGU K2{(GAS bf16*)(w + WS_ACT), SSQ(0)}; skinny_phase<SkGU, D / 256>(P, HBM, D, (const GAS bf16*)(wl + LW_GU1), D, K2); PHASE_END(pb + 0, 2)
        PHASE_BEGIN(pb + 1) pg8::Gemm g{(const bf16*)(w + WS_ACT), (const bf16*)(wl + LW_D1), M_REAL, D, FF}; SO S; S.init(M_REAL, D, P.G, bxl);
            pg8::EpiResAdd E{0.5f, 3 * ll + 1, 0}; pg8::gemm_phase<pg8::EpiResAdd, SO, true, true>(P.lds + RING_OFF, g, S, E);
            SkRes K2{0.5f, (GAS bf16*)(w + WS_HB), SSQ(1)}; skinny_phase<SkRes, FF / 256>(P, (const GAS bf16*)(w + WS_ACT) + (size_t)META_ROW * FF, FF, (const GAS bf16*)(wl + LW_D1), FF, K2); PHASE_END(pb + 1, 3)
        PHASE_BEGIN(pb + 2) pg8::Gemm g{(const bf16*)(w + WS_HB), (const bf16*)(wl + LW_IN), M_REAL, N_IN, D}; SO S; S.init(M_REAL, N_IN, P.G, bxl);
            pg8::EpiInProj E{ll, 3 * ll + 1, QSCALE};
            pg8::gemm_phase<pg8::EpiInProj, SO, true, true>(P.lds + RING_OFF, g, S, E);
            SkIn K2{(GAS bf16*)(w + WS_FQ), (GAS bf16*)(w + WS_FK), (GAS bf16*)(w + WS_FV), (GAS bf16*)(w + WS_SQ), (GAS bf16*)(w + WS_SK), (GAS bf16*)(w + WS_SV), (GAS float*)(w + WS_LOGF), (const GAS float*)(inptr(P, 9) + ll * HD), (const GAS float*)(inptr(P, 10) + ll * HD), (const GAS float*)(inptr(P, 11) + ll * HD), (const GAS float*)(inptr(P, 12) + ll * HD), (const GAS float*)(inptr(P, 8) + ll * NH), QSCALE, SSQ(1)}; skinny_phase<SkIn, D / 256>(P, HBM, D, (const GAS bf16*)(wl + LW_IN), D, K2);
            if (IDLE_CONV_K > 0 && P.G == 256 && bxl >= 128) { __syncthreads(); LAS unsigned char* scr = P.lds + RING_OFF + P.wave * 16384; const int iw = (bxl - 128) * NWAVES + P.wave;
                for (int k = 0; k < IDLE_CONV_K; ++k) convert_item(P, w, ll, GU2_BASE + iw + k * 128 * NWAVES, scr); }
            PHASE_END(pb + 2, 4)
        PHASE_BEGIN(pb + 3) attn_phase(P, inptr(P, 13) + ll * NH, OVERLAP_CONV ? ll + 1 : DEPTH, inptr(P, 9) + ll * HD, inptr(P, 10) + ll * HD); PHASE_END(pb + 3, 5)
        PHASE_BEGIN(pb + 4) pg8::Gemm g{(const bf16*)(w + WS_O), (const bf16*)(wl + LW_OUT), M_REAL, D, D}; SO S; S.init(M_REAL, D, P.G, bxl);
            pg8::EpiOut E{3 * ll + 2}; pg8::gemm_phase<pg8::EpiOut, SO, true, true>(P.lds + RING_OFF, g, S, E);
            SkOut K2{1.0f, (GAS bf16*)(w + WS_HB), SSQ(2), (const GAS float*)(w + WS_SSQOM)}; skinny_phase<SkOut, D / 256>(P, (const GAS bf16*)(w + WS_O) + (size_t)META_ROW * D, D, (const GAS bf16*)(wl + LW_OUT), D, K2); PHASE_END(pb + 4, 7)
        PHASE_BEGIN(pb + 5) pg8::Gemm g{(const bf16*)(w + WS_HB), (const bf16*)(wl + LW_GU2), M_REAL, N_GU, D}; SO S; S.init(M_REAL, N_GU, P.G, bxl);
            pg8::EpiSwiGLU E{3 * ll + 2}; pg8::gemm_phase<pg8::EpiSwiGLU, SO, true, true>(P.lds + RING_OFF, g, S, E);
            if (ll < DEPTH - 1) { SkGU K2{(GAS bf16*)(w + WS_ACT), SSQ(2)}; skinny_phase<SkGU, D / 256>(P, HBM, D, (const GAS bf16*)(wl + LW_GU2), D, K2); } PHASE_END(pb + 5, 2)
        PHASE_BEGIN(pb + 6) pg8::Gemm g{(const bf16*)(w + WS_ACT), (const bf16*)(wl + LW_D2), M_REAL, D, FF}; SO S; S.init(M_REAL, D, P.G, bxl);
            const bool fin = (ll == DEPTH - 1);
            pg8::EpiResAdd E{0.5f, 3 * ll + 3, fin ? 1 : 0}; pg8::gemm_phase<pg8::EpiResAdd, SO, true, true>(P.lds + RING_OFF, g, S, E);
            if (!fin) { SkRes K2{0.5f, (GAS bf16*)(w + WS_HB), SSQ(3)}; skinny_phase<SkRes, FF / 256>(P, (const GAS bf16*)(w + WS_ACT) + (size_t)META_ROW * FF, FF, (const GAS bf16*)(wl + LW_D2), FF, K2); } PHASE_END(pb + 6, 3)
#undef SSQ
#undef HBM
    }
    if (PROBE_CLASS >= 0 && (PROBE_BLOCK < 0 || (int)blockIdx.x == PROBE_BLOCK) && my_tid() == 0) { const unsigned long long t0 = __builtin_amdgcn_s_memrealtime(), dt = *(volatile LAS unsigned long long*)((LAS unsigned char*)lds + MISC_OFF + 64);
        while (__builtin_amdgcn_s_memrealtime() - t0 < dt) __builtin_amdgcn_s_sleep(8); }
#undef IN
#undef SEAM
#undef PHASE_BEGIN
#undef PHASE_END
}

extern "C" void kernel_launch(void* const* d_in, const int* in_sizes, int n_in, void* d_out, int out_size, void* d_ws, size_t ws_size, hipStream_t stream) {
    static int grid = 0;
    if (grid == 0) {
        if (n_in != 21 || in_sizes[0] != M_REAL * D || out_size != M_REAL * D || ws_size < WS_END) { fprintf(stderr, "kernel_launch: unexpected shapes (n_in %d, in0 %d, out %d, ws %zu, need %zu); nothing launched\n", n_in, n_in > 0 ? in_sizes[0] : -1, out_size, ws_size, (size_t)WS_END); grid = -1; return; }
        int dev = 0, cus = 0, per_cu = 0;
        if (hipGetDevice(&dev) != hipSuccess || hipDeviceGetAttribute(&cus, hipDeviceAttributeMultiprocessorCount, dev) != hipSuccess) { fprintf(stderr, "kernel_launch: device query failed\n"); grid = -1; return; }
        if (hipFuncSetAttribute((const void*)hymba_fwd, hipFuncAttributeMaxDynamicSharedMemorySize, LDS_BYTES) != hipSuccess) { fprintf(stderr, "kernel_launch: hipFuncSetAttribute failed\n"); grid = -1; return; }
        if (hipOccupancyMaxActiveBlocksPerMultiprocessor(&per_cu, (const void*)hymba_fwd, NWAVES * 64, LDS_BYTES) != hipSuccess || per_cu < 1) fprintf(stderr, "kernel_launch: note: occupancy query reports %d workgroups per CU\n", per_cu);
        (void)hipGetLastError();
        grid = cus;
        if (grid != 256) fprintf(stderr, "kernel_launch: note: %d CUs (the attention phase's static deal assumes 256)\n", grid);
    }
    if (grid < 0) return;
    if (hipMemsetAsync((char*)d_ws + WS_CTL, 0, CTL_ZERO_BYTES, stream) != hipSuccess) { fprintf(stderr, "kernel_launch: memset failed\n"); return; }
    Args a{};
    for (int i = 0; i < 21; ++i) a.in[i] = (const float*)d_in[i];
    a.out = (float*)d_out; a.ws = (unsigned char*)d_ws; a.li = 0; a.pad = 0;
#if MK_PER_PHASE
    for (int ph = 0; ph < N_PHASES; ++ph) { a.ph_lo = ph; a.ph_hi = ph + 1; hipLaunchKernelGGL(hymba_fwd, dim3(grid), dim3(NWAVES * 64), LDS_BYTES, stream, a); }
#else
    a.ph_lo = 0; a.ph_hi = N_PHASES;
    hipLaunchKernelGGL(hymba_fwd, dim3(grid), dim3(NWAVES * 64), LDS_BYTES, stream, a);
#endif
    const hipError_t le = hipPeekAtLastError();
    if (le != hipSuccess) fprintf(stderr, "kernel_launch: launch failed: %s\n", hipGetErrorName(le));
}
```
